# Optimizing an MI355X kernel written in HIP

```python
import jax, jax.numpy as jnp
from jax import lax
import numpy as np

D_MODEL = 1024
BATCH = 4
SEQ = 4096
DEPTH = 2
DEC_BATCH = 32
DEC_SEQ = 64
PAST_LEN = 2048

CHUNK = 64
EPS = 1e-6
MLA_HEADS = 4
Q_LORA = 384
KV_LORA = 256
QK_NOPE = 128
QK_ROPE = 64
V_HEAD = 128
MLA_WIDTH = MLA_HEADS * V_HEAD
MLA_SCALE = (QK_NOPE + QK_ROPE) ** -0.5
ROPE_BASE = 10000.0
Q_BLOCK = 128
HGRN_HEADS = 4
HGRN_EXPAND = 64
HGRN_HEAD_DIM = 64
HGRN_KEY = HGRN_HEADS * HGRN_EXPAND
HGRN_WIDTH = HGRN_HEADS * HGRN_HEAD_DIM
CMLP_GROUPS = 4
CMLP_GROUP_DIM = 64
CMLP_WIDTH = CMLP_GROUPS * CMLP_GROUP_DIM
CMLP_CHUNK = 128
MIX_WIDTH = MLA_WIDTH + HGRN_WIDTH + CMLP_WIDTH
D_FF = 2816
IN_SIZES = (Q_LORA, KV_LORA, QK_ROPE, HGRN_KEY, HGRN_KEY, HGRN_WIDTH, HGRN_WIDTH, CMLP_WIDTH, CMLP_WIDTH)
IN_WIDTH = Q_LORA + KV_LORA + QK_ROPE + 2 * HGRN_KEY + 2 * HGRN_WIDTH + 2 * CMLP_WIDTH

kernel_name = 'hybrid_stream_mla_hgrn2_gmlp_step'


def _in_offsets():
    out, acc = [], 0
    for s in IN_SIZES[:-1]:
        acc += s
        out.append(acc)
    return out


def _rmsnorm(x, g):
    x32 = x.astype(jnp.float32)
    y = x32 * lax.rsqrt(jnp.mean(x32 * x32, axis=-1, keepdims=True) + EPS)
    return (y * g.astype(jnp.float32)).astype(x.dtype)


def _swiglu(x, w_gate, w_up, w_down):
    return (jax.nn.silu(x @ w_gate) * (x @ w_up)) @ w_down


def _rope_tables(pos, dim):
    inv_freq = ROPE_BASE ** (-jnp.arange(0, dim, 2, dtype=jnp.float32) / dim)
    ang = pos.astype(jnp.float32)[:, None] * inv_freq[None, :]
    return jnp.cos(ang), jnp.sin(ang)


def _apply_rope(x, cos, sin):
    x32 = x.astype(jnp.float32)
    half = x.shape[-1] // 2
    x1, x2 = x32[..., :half], x32[..., half:]
    return jnp.concatenate([x1 * cos - x2 * sin, x2 * cos + x1 * sin], axis=-1).astype(x.dtype)


def _mla_attend(q_lat, q_pe, c_all, kpe_all, q_pos, k_pos):
    s = (jnp.einsum('bqhc,bkc->bhqk', q_lat, c_all)
         + jnp.einsum('bqhr,bkr->bhqk', q_pe, kpe_all)).astype(jnp.float32) * MLA_SCALE
    visible = (k_pos[None, :] // CHUNK) <= (q_pos[:, None] // CHUNK)
    s = jnp.where(visible[None, None], s, -jnp.inf)
    p = jax.nn.softmax(s, axis=-1).astype(c_all.dtype)
    return jnp.einsum('bhqk,bkc->bqhc', p, c_all)


def _mla(q_a, kv_a, kpe_raw, pos, qa_g, w_qb, kva_g, w_uk, w_uv, c_past, kpe_past):
    B, T, _ = q_a.shape
    q = (_rmsnorm(q_a, qa_g) @ w_qb).reshape(B, T, MLA_HEADS, QK_NOPE + QK_ROPE)
    q_nope, q_pe = q[..., :QK_NOPE], q[..., QK_NOPE:]
    cos, sin = _rope_tables(pos, QK_ROPE)
    q_pe = _apply_rope(q_pe, cos[:, None, :], sin[:, None, :])
    c_new = _rmsnorm(kv_a, kva_g)
    kpe_new = _apply_rope(kpe_raw, cos, sin)
    q_lat = jnp.einsum('bthn,chn->bthc', q_nope, w_uk)
    if c_past is None:
        c_all, kpe_all = c_new, kpe_new
    else:
        c_all = jnp.concatenate([c_past.astype(c_new.dtype), c_new], axis=1)
        kpe_all = jnp.concatenate([kpe_past.astype(kpe_new.dtype), kpe_new], axis=1)
    k_pos = jnp.arange(c_all.shape[1], dtype=jnp.int32)
    if T > Q_BLOCK and T % Q_BLOCK == 0:
        nb = T // Q_BLOCK
        blk = lambda a: jnp.moveaxis(a.reshape((B, nb, Q_BLOCK) + a.shape[2:]), 1, 0)
        o_lat = lax.map(lambda args: _mla_attend(args[0], args[1], c_all, kpe_all, args[2], k_pos),
                        (blk(q_lat), blk(q_pe), pos.reshape(nb, Q_BLOCK)))
        o_lat = jnp.moveaxis(o_lat, 0, 1).reshape(B, T, MLA_HEADS, KV_LORA)
    else:
        o_lat = _mla_attend(q_lat, q_pe, c_all, kpe_all, pos, k_pos)
    o = jnp.einsum('bthc,chv->bthv', o_lat, w_uv).reshape(B, T, MLA_WIDTH)
    return o, c_new, kpe_new


def _hgrn2(hq, hf, hi, hg, lb, out_g, S0):
    B, T, _ = hq.shape
    f32 = jnp.float32
    zf = hf.astype(f32)
    logf = jnp.logaddexp(jnp.log(lb), jnp.log1p(-lb) + jax.nn.log_sigmoid(zf))
    k = (1.0 - lb) * jax.nn.sigmoid(-zf)
    q = hq.astype(f32).reshape(B, T, HGRN_HEADS, HGRN_EXPAND)
    k = k.reshape(B, T, HGRN_HEADS, HGRN_EXPAND)
    logf = logf.reshape(B, T, HGRN_HEADS, HGRN_EXPAND)
    v = hi.astype(f32).reshape(B, T, HGRN_HEADS, HGRN_HEAD_DIM)
    L = min(CHUNK, T)
    n = T // L
    to_chunks = lambda a: jnp.moveaxis(a.reshape((B, n, L) + a.shape[2:]), 1, 0)
    causal = jnp.tril(jnp.ones((L, L), dtype=bool))[None, :, :, None, None]

    def step(S, inp):
        qc, kc, vc, lc = inp
        b = jnp.cumsum(lc, axis=1)
        o_inter = jnp.einsum('bthe,bhed->bthd', qc * jnp.exp(b), S)
        diff = b[:, :, None] - b[:, None, :]
        decay = jnp.where(causal, jnp.exp(jnp.where(causal, diff, 0.0)), 0.0)
        A = jnp.einsum('bthe,btshe,bshe->bhts', qc, decay, kc)
        o_intra = jnp.einsum('bhts,bshd->bthd', A, vc)
        b_last = b[:, -1]
        S_new = (jnp.exp(b_last)[..., None] * S
                 + jnp.einsum('bshe,bshd->bhed', kc * jnp.exp(b_last[:, None] - b), vc))
        return S_new, o_inter + o_intra

    if S0 is None:
        S0 = jnp.zeros((B, HGRN_HEADS, HGRN_EXPAND, HGRN_HEAD_DIM), f32)
    else:
        S0 = S0.astype(f32)
    S_fin, o = lax.scan(step, S0, (to_chunks(q), to_chunks(k), to_chunks(v), to_chunks(logf)))
    o = jnp.moveaxis(o, 0, 1).reshape(B, T, HGRN_HEADS, HGRN_HEAD_DIM)
    gate = jax.nn.silu(hg.astype(f32).reshape(B, T, HGRN_HEADS, HGRN_HEAD_DIM))
    o = _rmsnorm(o, out_g.reshape(HGRN_HEADS, HGRN_HEAD_DIM)) * gate
    return o.reshape(B, T, HGRN_WIDTH).astype(hq.dtype), S_fin


def _chunk_mlp(cu, cv, v_g, w_s, b_s):
    B, T, _ = cu.shape
    u = jax.nn.gelu(cu)
    v = _rmsnorm(jax.nn.gelu(cv).reshape(B, T, CMLP_GROUPS, CMLP_GROUP_DIM),
                 v_g.reshape(CMLP_GROUPS, CMLP_GROUP_DIM))
    L = min(CMLP_CHUNK, T)
    n = T // L
    w = w_s[:, :L, :L] * jnp.tril(jnp.ones((L, L), w_s.dtype))
    mixed = (jnp.einsum('gts,bnsgd->bntgd', w, v.reshape(B, n, L, CMLP_GROUPS, CMLP_GROUP_DIM))
             + jnp.transpose(b_s[:, :L])[None, None, :, :, None])
    out = u * mixed.reshape(B, T, CMLP_WIDTH).astype(u.dtype)
    return out, v.reshape(B, T, CMLP_WIDTH)


def _trunk(x, pos, cache_ckv, cache_kpe, state_S, p):
    offsets = _in_offsets()
    lb_all = jnp.cumsum(jax.nn.softmax(p['hgrn_lb_logits'].astype(jnp.float32), axis=0), axis=0)
    lb_all = lb_all - lb_all[0:1]
    ckv_rows, kpe_rows, states, v_rows = [], [], [], []
    for l in range(DEPTH):
        ng = p['norm_g'][l]
        h = _rmsnorm(x, ng[0])
        x = x + 0.5 * _rmsnorm(_swiglu(h, p['ffn_w_gate'][l, 0], p['ffn_w_up'][l, 0], p['ffn_w_down'][l, 0]), ng[1])
        h = _rmsnorm(x, ng[2])
        z = h @ p['w_in'][l]
        q_a, kv_a, kpe_raw, hq, hf, hi, hg, cu, cv = jnp.split(z, offsets, axis=-1)
        o_a, c_new, kpe_new = _mla(q_a, kv_a, kpe_raw, pos, p['mla_qa_g'][l], p['mla_wqb'][l],
                                   p['mla_kva_g'][l], p['mla_w_uk'][l], p['mla_w_uv'][l],
                                   None if cache_ckv is None else cache_ckv[l],
                                   None if cache_kpe is None else cache_kpe[l])
        o_b, S_new = _hgrn2(hq, hf, hi, hg, lb_all[l], p['hgrn_out_g'][l],
                            None if state_S is None else state_S[l])
        o_c, v_new = _chunk_mlp(cu, cv, p['cmlp_v_g'][l], p['cmlp_w_s'][l], p['cmlp_b_s'][l])
        mix = jnp.concatenate([o_a, o_b.astype(o_a.dtype), o_c.astype(o_a.dtype)], axis=-1) @ p['w_out'][l]
        x = x + _rmsnorm(mix, ng[3])
        h = _rmsnorm(x, ng[4])
        x = x + 0.5 * _rmsnorm(_swiglu(h, p['ffn_w_gate'][l, 1], p['ffn_w_up'][l, 1], p['ffn_w_down'][l, 1]), ng[5])
        ckv_rows.append(c_new)
        kpe_rows.append(kpe_new)
        states.append(S_new)
        v_rows.append(v_new)
    return x, jnp.stack(ckv_rows), jnp.stack(kpe_rows), jnp.stack(states), jnp.stack(v_rows)


def setup_inputs(seed: int = 0) -> dict:
    key = jax.random.key(seed)
    ks = jax.random.split(key, 24)
    f32 = jnp.float32
    nrm = lambda k, shape, scale: jax.random.normal(k, shape, f32) * scale
    gain = lambda k, shape: 1.0 + 0.02 * jax.random.normal(k, shape, f32)
    return {
        'x_prompt': nrm(ks[0], (BATCH, SEQ, D_MODEL), 1.0),
        'x_sample': nrm(ks[1], (DEC_BATCH, DEC_SEQ, D_MODEL), 1.0),
        'cache_mla_ckv': nrm(ks[2], (DEPTH, DEC_BATCH, PAST_LEN, KV_LORA), 1.0),
        'cache_mla_kpe': nrm(ks[3], (DEPTH, DEC_BATCH, PAST_LEN, QK_ROPE), 1.0),
        'state_hgrn': nrm(ks[4], (DEPTH, DEC_BATCH, HGRN_HEADS, HGRN_EXPAND, HGRN_HEAD_DIM), 0.5),
        'norm_g': gain(ks[5], (DEPTH, 6, D_MODEL)),
        'ffn_w_gate': nrm(ks[6], (DEPTH, 2, D_MODEL, D_FF), D_MODEL ** -0.5),
        'ffn_w_up': nrm(ks[7], (DEPTH, 2, D_MODEL, D_FF), D_MODEL ** -0.5),
        'ffn_w_down': nrm(ks[8], (DEPTH, 2, D_FF, D_MODEL), D_FF ** -0.5),
        'w_in': nrm(ks[9], (DEPTH, D_MODEL, IN_WIDTH), D_MODEL ** -0.5),
        'w_out': nrm(ks[10], (DEPTH, MIX_WIDTH, D_MODEL), MIX_WIDTH ** -0.5),
        'mla_qa_g': gain(ks[11], (DEPTH, Q_LORA)),
        'mla_wqb': nrm(ks[12], (DEPTH, Q_LORA, MLA_HEADS * (QK_NOPE + QK_ROPE)), Q_LORA ** -0.5),
        'mla_kva_g': gain(ks[13], (DEPTH, KV_LORA)),
        'mla_w_uk': nrm(ks[14], (DEPTH, KV_LORA, MLA_HEADS, QK_NOPE), KV_LORA ** -0.5),
        'mla_w_uv': nrm(ks[15], (DEPTH, KV_LORA, MLA_HEADS, V_HEAD), KV_LORA ** -0.5),
        'hgrn_lb_logits': nrm(ks[16], (DEPTH, HGRN_KEY), 0.5),
        'hgrn_out_g': gain(ks[17], (DEPTH, HGRN_WIDTH)),
        'cmlp_v_g': gain(ks[18], (DEPTH, CMLP_WIDTH)),
        'cmlp_w_s': nrm(ks[19], (DEPTH, CMLP_GROUPS, CMLP_CHUNK, CMLP_CHUNK), CMLP_CHUNK ** -0.5),
        'cmlp_b_s': 1.0 + 0.1 * jax.random.normal(ks[20], (DEPTH, CMLP_GROUPS, CMLP_CHUNK), f32),
    }


def reference(x_prompt, x_sample, cache_mla_ckv, cache_mla_kpe, state_hgrn, norm_g, ffn_w_gate,
              ffn_w_up, ffn_w_down, w_in, w_out, mla_qa_g, mla_wqb, mla_kva_g, mla_w_uk, mla_w_uv,
              hgrn_lb_logits, hgrn_out_g, cmlp_v_g, cmlp_w_s, cmlp_b_s):
    p = dict(norm_g=norm_g, ffn_w_gate=ffn_w_gate, ffn_w_up=ffn_w_up, ffn_w_down=ffn_w_down,
             w_in=w_in, w_out=w_out, mla_qa_g=mla_qa_g, mla_wqb=mla_wqb, mla_kva_g=mla_kva_g,
             mla_w_uk=mla_w_uk, mla_w_uv=mla_w_uv, hgrn_lb_logits=hgrn_lb_logits,
             hgrn_out_g=hgrn_out_g, cmlp_v_g=cmlp_v_g, cmlp_w_s=cmlp_w_s, cmlp_b_s=cmlp_b_s)
    pos_p = jnp.arange(x_prompt.shape[1], dtype=jnp.int32)
    y_prompt, ckv_p, kpe_p, hgrn_p, _ = _trunk(x_prompt, pos_p, None, None, None, p)
    past = cache_mla_ckv.shape[2]
    pos_s = past + jnp.arange(x_sample.shape[1], dtype=jnp.int32)
    y_sample, ckv_s, kpe_s, hgrn_s, cmlp_v_s = _trunk(x_sample, pos_s, cache_mla_ckv, cache_mla_kpe, state_hgrn, p)
    return (y_prompt, y_sample, ckv_p, kpe_p, hgrn_p, ckv_s, kpe_s, hgrn_s, cmlp_v_s)
```

```cpp
#include <hip/hip_runtime.h>
#include <hip/hip_cooperative_groups.h>
#include <cstdio>
namespace cg = cooperative_groups;
#ifndef ONE_LAUNCH
#define ONE_LAUNCH 1
#endif
namespace pg8 {
#define PG8_LAS __attribute__((address_space(3)))
typedef unsigned short bf16_t;
typedef short bf16x8 __attribute__((ext_vector_type(8)));
typedef float f32x4 __attribute__((ext_vector_type(4)));
typedef unsigned u32x4 __attribute__((ext_vector_type(4)));
constexpr int BM = 256, BK = 64, HALF = 128, HTB = HALF * BK * 2  , STAGE_BYTES = 8 * HTB, NXCD = 8, WGM = 8;

__host__ __device__ __forceinline__ int lds_byte(int r, int c) { const int st = (r >> 4) * 2 + (c >> 5), rr = r & 15, cc = c & 31, ob = rr * 64 + cc * 2; return st * 1024 + (ob ^ (((ob >> 9) & 1) << 5)); }
__host__ __device__ __forceinline__ void stage_rc(int b, int& R, int& C) { const int st = b / 1024, sb = b % 1024, swz = sb ^ (((sb >> 9) & 1) << 5); R = (st >> 1) * 16 + swz / 64; C = (st & 1) * 32 + (swz % 64) / 2; }
__host__ __device__ __forceinline__ int perm32(int rho) { const int n = rho >> 4, i = rho & 15; return 8 * (i >> 2) + 4 * n + (i & 3); }

struct Unit { int pm, pn; };
struct Gemm { const bf16_t* A; const bf16_t* Bt; int M, N, K; };

struct StaticOrder {
    int nM, nN, nwg, G, c;
    __host__ __device__ void init(int M, int N, int G_, int c_) { nM = M / BM; nN = N / BM; nwg = nM * nN; G = G_; c = c_; }
    __host__ __device__ bool next(int i, Unit& u) const {
        const long L = (long)i * G + c; if (L >= nwg) return false;
        int wgid = (int)L; { const int q = nwg / NXCD, r = nwg % NXCD, xcd = wgid % NXCD, off = wgid / NXCD; wgid = (xcd < r ? xcd * (q + 1) : r * (q + 1) + (xcd - r) * q) + off; }
        const int nig = WGM * nN, gid = wgid / nig, fm = gid * WGM, gsz = (nM - fm) < WGM ? (nM - fm) : WGM;
        u.pm = fm + ((wgid % nig) % gsz); u.pn = (wgid % nig) / gsz; return true;
    }
    __device__ __forceinline__ void a_ready(const Unit&) const {}
    __device__ __forceinline__ void done(const Unit&) const {}
};
__device__ __forceinline__ unsigned cvt_pk_bf16(float lo, float hi) { unsigned r; asm volatile("v_cvt_pk_bf16_f32 %0, %1, %2" : "=v"(r) : "v"(lo), "v"(hi)); return r; }
typedef float f32x2 __attribute__((ext_vector_type(2)));
template <class Epi, class Sched, bool STAMP = false>
__device__ __forceinline__ void gemm_phase(PG8_LAS unsigned char* lds, const Gemm g, const Sched& S, const Epi& E, unsigned long long* stamps) {
    int tid = threadIdx.x; asm volatile("" : "+v"(tid)); const int wid = __builtin_amdgcn_readfirstlane(tid >> 6), lane = tid & 63, wr = wid >> 2, wc = wid & 3, fr = lane & 15, fq = lane >> 4;
    const int K = g.K, nt = K / BK;
    int ts_lo = 0, ts_hi = 0, nts = 0; const unsigned long long rt_entry = STAMP ? (unsigned long long)wall_clock64() : 0ull;
#define PG8_STAMP() do { if (STAMP && wid == 0 && nts < 64) { const unsigned long long _c = (unsigned long long)clock64(); \
        ts_lo = (lane == nts) ? (int)(unsigned)_c : ts_lo; ts_hi = (lane == nts) ? (int)(unsigned)(_c >> 32) : ts_hi; ++nts; } } while (0)
    PG8_STAMP();
    unsigned voffA[2], voffB[2];
#pragma unroll
    for (int i = 0; i < 2; ++i) { int R, C; stage_rc(tid * 16 + i * 8192, R, C); const int Rb = Epi::PERM ? ((R & ~31) + perm32(R & 31)) : R;
        voffA[i] = (unsigned)(R * K + C) * 2u; voffB[i] = (unsigned)(Rb * K + C) * 2u; }
    const size_t kstep = (size_t)(BK * 2);
    const size_t hstep = (size_t)HALF * K * 2;
    const size_t tstep = 2 * hstep;
    const unsigned ldsw = (unsigned)wid * 1024u;
    const int aoff = lds_byte(wr * 64 + fr, fq * 8), boff = lds_byte(wc * 32 + fr, fq * 8);
#define PG8_SA(b, h) (((b) * 2 + (h)) * HTB)
#define PG8_SB(b, h) ((4 + (b) * 2 + (h)) * HTB)
#define PG8_STAGE(bufoff, gbase, voff) do { _Pragma("unroll") for (int _i = 0; _i < 2; ++_i) \
        __builtin_amdgcn_global_load_lds((const unsigned*)((const char*)(gbase) + (voff)[_i]), (PG8_LAS unsigned*)(lds + (bufoff) + ldsw + _i * 8192), 16, 0, 0); } while (0)
#define PG8_LDA(dst, b, h) do { _Pragma("unroll") for (int m = 0; m < 4; ++m) _Pragma("unroll") for (int k = 0; k < 2; ++k) dst[m][k] = *(const PG8_LAS bf16x8*)(lds + PG8_SA(b, h) + aoff + m * 2048 + k * 1024); } while (0)
#define PG8_LDB(dst, b, h) do { _Pragma("unroll") for (int n = 0; n < 2; ++n) _Pragma("unroll") for (int k = 0; k < 2; ++k) dst[n][k] = *(const PG8_LAS bf16x8*)(lds + PG8_SB(b, h) + boff + n * 2048 + k * 1024); } while (0)
#define PG8_MMA(ai, bj, At, Bt) do { __builtin_amdgcn_s_setprio(1); _Pragma("unroll") for (int m = 0; m < 4; ++m) _Pragma("unroll") for (int n = 0; n < 2; ++n) _Pragma("unroll") for (int k = 0; k < 2; ++k) \
        acc[ai][bj][m][n] = __builtin_amdgcn_mfma_f32_16x16x32_bf16(Bt[n][k], At[m][k], acc[ai][bj][m][n], 0, 0, 0); __builtin_amdgcn_s_setprio(0); } while (0)
#define PG8_WAIT_V(n) asm volatile("s_waitcnt vmcnt(" #n ")" ::: "memory")
#define PG8_WAIT_L(n) asm volatile("s_waitcnt lgkmcnt(" #n ")" ::: "memory")
#define PG8_BAR __builtin_amdgcn_s_barrier()
#define PG8_SCHED __builtin_amdgcn_sched_barrier(0)
    Unit cur, nxt; int ui = 0;
    if (!S.next(0, cur)) return;
    f32x4 acc[2][2][4][2];
#pragma unroll
    for (int a = 0; a < 2; ++a)
#pragma unroll
        for (int b = 0; b < 2; ++b)
#pragma unroll
            for (int m = 0; m < 4; ++m)
#pragma unroll
                for (int n = 0; n < 2; ++n) acc[a][b][m][n] = (f32x4){0.f, 0.f, 0.f, 0.f};
    bf16x8 At[4][2], B0[2][2], B1[2][2];
    const char* cA = (const char*)g.A + (size_t)cur.pm * tstep; const char* cB = (const char*)g.Bt + (size_t)cur.pn * tstep;
    S.a_ready(cur);
    PG8_STAGE(PG8_SB(0, 0), cB, voffB); PG8_STAGE(PG8_SA(0, 0), cA, voffA); PG8_STAGE(PG8_SB(0, 1), cB + hstep, voffB); PG8_STAGE(PG8_SA(0, 1), cA + hstep, voffA);
    if (wr == 1) PG8_BAR;
    PG8_WAIT_V(4); PG8_BAR;
    PG8_STAGE(PG8_SB(1, 0), cB + kstep, voffB); PG8_STAGE(PG8_SA(1, 0), cA + kstep, voffA); PG8_STAGE(PG8_SB(1, 1), cB + hstep + kstep, voffB);
    PG8_WAIT_V(6); PG8_BAR;
    PG8_STAMP();
    for (;;) {
        const bool has_next = S.next(ui + 1, nxt);
        const char* nA = has_next ? (const char*)g.A + (size_t)nxt.pm * tstep : cA; const char* nB = has_next ? (const char*)g.Bt + (size_t)nxt.pn * tstep : cB;
        for (int t = 0; t < nt; t += 2) {
            const bool last = (t == nt - 2);
            const char* a1 = cA + (size_t)(t + 1) * kstep;
            const char* a2 = last ? nA : cA + (size_t)(t + 2) * kstep; const char* b2 = last ? nB : cB + (size_t)(t + 2) * kstep;
            const char* a3 = a2 + kstep; const char* b3 = b2 + kstep;
            if (last && has_next) S.a_ready(nxt);
            PG8_LDB(B0, 0, 0); PG8_SCHED; PG8_LDA(At, 0, 0); PG8_STAGE(PG8_SA(1, 1), a1 + hstep, voffA);
            PG8_WAIT_L(8); PG8_BAR; PG8_WAIT_L(0); PG8_MMA(0, 0, At, B0); PG8_BAR; PG8_SCHED;
            PG8_LDB(B1, 0, 1); PG8_STAGE(PG8_SB(0, 0), b2, voffB);
            PG8_BAR; PG8_WAIT_L(0); PG8_MMA(0, 1, At, B1); PG8_BAR;
            PG8_LDA(At, 0, 1); PG8_STAGE(PG8_SA(0, 0), a2, voffA);
            PG8_BAR; PG8_WAIT_L(0); PG8_MMA(1, 0, At, B0); PG8_BAR; PG8_SCHED;
            PG8_STAGE(PG8_SB(0, 1), b2 + hstep, voffB);
            PG8_WAIT_V(6); PG8_BAR; PG8_MMA(1, 1, At, B1); PG8_BAR;
            PG8_LDB(B0, 1, 0); PG8_SCHED; PG8_LDA(At, 1, 0); PG8_STAGE(PG8_SA(0, 1), a2 + hstep, voffA);
            PG8_WAIT_L(8); PG8_BAR; PG8_WAIT_L(0); PG8_MMA(0, 0, At, B0); PG8_BAR; PG8_SCHED;
            PG8_LDB(B1, 1, 1); PG8_STAGE(PG8_SB(1, 0), b3, voffB);
            PG8_BAR; PG8_WAIT_L(0); PG8_MMA(0, 1, At, B1); PG8_BAR;
            PG8_LDA(At, 1, 1); PG8_STAGE(PG8_SA(1, 0), a3, voffA);
            PG8_BAR; PG8_WAIT_L(0); PG8_MMA(1, 0, At, B0); PG8_BAR; PG8_SCHED;
            PG8_STAGE(PG8_SB(1, 1), b3 + hstep, voffB);
            PG8_WAIT_V(6); PG8_BAR; PG8_MMA(1, 1, At, B1); PG8_BAR;
        }
        PG8_STAMP();
        if constexpr (!Epi::AFTER_DRAIN) { E(acc, cur, wr, wc, fr, fq); S.done(cur); }
        PG8_STAMP();
        if (!has_next) break;
#pragma unroll
        for (int a = 0; a < 2; ++a)
#pragma unroll
            for (int b = 0; b < 2; ++b)
#pragma unroll
                for (int m = 0; m < 4; ++m)
#pragma unroll
                    for (int n = 0; n < 2; ++n) acc[a][b][m][n] = (f32x4){0.f, 0.f, 0.f, 0.f};
        cur = nxt; cA = nA; cB = nB; ++ui;
    }
    PG8_WAIT_V(0);
    if (wr == 0) PG8_BAR;
    PG8_BAR;
    if constexpr (Epi::AFTER_DRAIN) { E.fused(acc, cur, wr, wc, fr, fq, lds, wid, lane); S.done(cur); }
    PG8_STAMP();
    if (STAMP && wid == 0) { stamps[lane] = lane < nts ? (((unsigned long long)(unsigned)ts_hi << 32) | (unsigned)ts_lo) : 0ull;
        if (lane == 62) stamps[62] = rt_entry; if (lane == 63) stamps[63] = (unsigned long long)wall_clock64(); }
#undef PG8_STAMP
#undef PG8_SA
#undef PG8_SB
#undef PG8_STAGE
#undef PG8_LDA
#undef PG8_LDB
#undef PG8_MMA
#undef PG8_WAIT_V
#undef PG8_WAIT_L
#undef PG8_BAR
#undef PG8_SCHED
}
}
using pg8::bf16_t; using pg8::bf16x8; using pg8::f32x4; using pg8::u32x4; using pg8::Unit; using pg8::cvt_pk_bf16;
#define LAS __attribute__((address_space(3)))
typedef unsigned u32x2 __attribute__((ext_vector_type(2)));

constexpr int DM = 1024, DFF = 2816, MP = 16384, MS = 2048, MT = 18432, INWP = 2304, ZW = 2304;
constexpr int NTILE = 288;
constexpr float EPS = 1e-6f;
constexpr float QSCALE = 0.07216878364870322f * 1.4426950408889634f;
constexpr int ZQ = 0, ZKV = 384, ZPE = 640, ZHQ = 704, ZHF = 960, ZHI = 1216, ZHG = 1472, ZCU = 1728, ZCV = 1984;
constexpr size_t SZ_WGU = 4ull * 5632 * 1024 * 2, SZ_WDN = 4ull * 1024 * 2816 * 2, SZ_WIN = 2ull * 2304 * 1024 * 2, SZ_WQ = 2ull * 1280 * 384 * 2, SZ_WMIX = 2ull * 1024 * 1536 * 2;
constexpr size_t OFF_WGU = 0, OFF_WDN = OFF_WGU + SZ_WGU, OFF_WIN = OFF_WDN + SZ_WDN, OFF_WQ = OFF_WIN + SZ_WIN, OFF_WMIX = OFF_WQ + SZ_WQ;
constexpr size_t OFF_X = OFF_WMIX + SZ_WMIX, SZ_X = (size_t)MT * 1024 * 4;
constexpr size_t OFF_D = OFF_X + SZ_X, SZ_D = (size_t)MT * 1024 * 2;
constexpr size_t OFF_H = OFF_D + SZ_D, SZ_H = (size_t)MT * 1024 * 2;
constexpr size_t OFF_ACT = OFF_H + SZ_H, SZ_ACT = (size_t)MT * 2816 * 2;
constexpr size_t KROWS = 16384 + 32 * 2112;
constexpr size_t OFF_KC = OFF_ACT + SZ_ACT, SZ_KC = KROWS * 640;
constexpr size_t OFF_CT = OFF_KC + SZ_KC, SZ_CT = KROWS * 512;
constexpr size_t OFF_MIXA = OFF_CT + SZ_CT, SZ_MIXA = (size_t)MT * 1536 * 2;
constexpr size_t OFF_SST = OFF_MIXA + SZ_MIXA, SZ_SST = 1024ull * 4096 * 4;
constexpr size_t OFF_ROPE = OFF_SST + SZ_SST, SZ_ROPE = 4096ull * 32 * 8;
constexpr size_t OFF_CTL = OFF_ROPE + SZ_ROPE, SZ_CTL = 4096;
constexpr size_t WS_END = OFF_CTL + SZ_CTL;
constexpr size_t OFF_Z = OFF_ACT, SZ_Z = (size_t)MT * ZW * 2;
constexpr size_t OFF_QN = OFF_Z + SZ_Z;
constexpr size_t OFF_Q = OFF_D;
constexpr size_t OFF_U = OFF_Q + (size_t)MT * 1280 * 2;
constexpr size_t OFF_DEC = OFF_U + 1152ull * 4096 * 4;
static_assert(OFF_QN + (size_t)MT * 384 * 2 <= OFF_ACT + SZ_ACT, "z/qn overlay");
static_assert(OFF_DEC + 1152ull * 64 * 4 <= OFF_H + SZ_H, "Q/U overlay");
constexpr size_t O_Y = 0, O_CKVP = 18874368, O_KPEP = 27262976, O_HGP = 29360128, O_CKVS = 29491200, O_KPES = 30539776, O_HGS = 30801920, O_CMV = 31850496;

constexpr int LDS_BYTES = 131072;
constexpr int NPHASE = 25;

struct Args { const float* in[21]; float* out; unsigned char* ws; int ph_lo, ph_hi; };

__device__ __forceinline__ float bf2f(unsigned short b) { return __uint_as_float(((unsigned)b) << 16); }
__device__ __forceinline__ float bflo(unsigned w) { return __uint_as_float(w << 16); }
__device__ __forceinline__ float bfhi(unsigned w) { return __uint_as_float(w & 0xffff0000u); }
__device__ __forceinline__ unsigned short f2bf(float f) { unsigned u = __float_as_uint(f); u += 0x7FFFu + ((u >> 16) & 1u); return (unsigned short)(u >> 16); }
__device__ __forceinline__ float wave_sum(float v) {
#pragma unroll
    for (int o = 32; o >= 1; o >>= 1) v += __shfl_xor(v, o);
    return v; }
__device__ __forceinline__ float sigmoidf_(float x) { return __builtin_amdgcn_rcpf(1.0f + __expf(-x)); }
__device__ __forceinline__ float siluf_(float x) { return x * sigmoidf_(x); }
__device__ __forceinline__ float geluf_(float x) { const float y = 0.7978845608028654f * (x + 0.044715f * x * x * x); const float t = 1.0f - 2.0f * __builtin_amdgcn_rcpf(__expf(2.0f * y) + 1.0f); return 0.5f * x * (1.0f + t); }

struct EpiBf {
    static constexpr bool PERM = true, AFTER_DRAIN = false;
    bf16_t* O; int ldc;
    __device__ __forceinline__ void operator()(const f32x4 (&acc)[2][2][4][2], const Unit& u, int wr, int wc, int fr, int fq) const {
        const int row0 = u.pm * 256 + wr * 64 + fr, col0 = u.pn * 256 + wc * 32 + 8 * fq;
#pragma unroll
        for (int ai = 0; ai < 2; ++ai)
#pragma unroll
            for (int m = 0; m < 4; ++m) { bf16_t* rowp = O + (size_t)(row0 + ai * 128 + m * 16) * ldc + col0;
#pragma unroll
                for (int bj = 0; bj < 2; ++bj) { const f32x4 v0 = acc[ai][bj][m][0], v1 = acc[ai][bj][m][1];
                    u32x4 w; w.x = cvt_pk_bf16(v0[0], v0[1]); w.y = cvt_pk_bf16(v0[2], v0[3]); w.z = cvt_pk_bf16(v1[0], v1[1]); w.w = cvt_pk_bf16(v1[2], v1[3]);
                    *(u32x4*)(rowp + bj * 128) = w; } }
    }
};
struct EpiSwiGLU {
    static constexpr bool PERM = true, AFTER_DRAIN = false;
    bf16_t* O;
    __device__ __forceinline__ void operator()(const f32x4 (&acc)[2][2][4][2], const Unit& u, int wr, int wc, int fr, int fq) const {
        const int row0 = u.pm * 256 + wr * 64 + fr, col0 = u.pn * 128 + wc * 32 + 8 * fq;
#pragma unroll
        for (int ai = 0; ai < 2; ++ai)
#pragma unroll
            for (int m = 0; m < 4; ++m) { bf16_t* rowp = O + (size_t)(row0 + ai * 128 + m * 16) * DFF + col0;
                const f32x4 g0 = acc[ai][0][m][0], g1 = acc[ai][0][m][1], u0 = acc[ai][1][m][0], u1 = acc[ai][1][m][1];
                u32x4 w; w.x = cvt_pk_bf16(siluf_(g0[0]) * u0[0], siluf_(g0[1]) * u0[1]); w.y = cvt_pk_bf16(siluf_(g0[2]) * u0[2], siluf_(g0[3]) * u0[3]);
                w.z = cvt_pk_bf16(siluf_(g1[0]) * u1[0], siluf_(g1[1]) * u1[1]); w.w = cvt_pk_bf16(siluf_(g1[2]) * u1[2], siluf_(g1[3]) * u1[3]);
                *(u32x4*)rowp = w; }
    }
};
struct EpiQ {
    static constexpr bool PERM = true, AFTER_DRAIN = false;
    bf16_t* Q;
    __device__ __forceinline__ void operator()(const f32x4 (&acc)[2][2][4][2], const Unit& u, int wr, int wc, int fr, int fq) const {
        const int row0 = u.pm * 256 + wr * 64 + fr;
        const int off0 = u.pn < 4 ? u.pn * 320 + wc * 32 + 8 * fq : wc * 320 + 256 + 8 * fq, bjs = u.pn < 4 ? 128 : 32;
#pragma unroll
        for (int ai = 0; ai < 2; ++ai)
#pragma unroll
            for (int m = 0; m < 4; ++m) { bf16_t* rowp = Q + (size_t)(row0 + ai * 128 + m * 16) * 1280 + off0;
#pragma unroll
                for (int bj = 0; bj < 2; ++bj) { const f32x4 v0 = acc[ai][bj][m][0], v1 = acc[ai][bj][m][1];
                    u32x4 w; w.x = cvt_pk_bf16(v0[0], v0[1]); w.y = cvt_pk_bf16(v0[2], v0[3]); w.z = cvt_pk_bf16(v1[0], v1[1]); w.w = cvt_pk_bf16(v1[2], v1[3]);
                    *(u32x4*)(rowp + bj * bjs) = w; } }
    }
};
template <class Epi> __device__ __forceinline__ void run_gemm(unsigned char* lds, const bf16_t* A, const bf16_t* Bt, int M, int N, int K, const Epi& E) {
    pg8::Gemm g{A, Bt, M, N, K}; pg8::StaticOrder S; S.init(M, N, (int)gridDim.x, (int)blockIdx.x);
    pg8::gemm_phase<Epi, pg8::StaticOrder, false>((PG8_LAS unsigned char*)lds, g, S, E, nullptr);
}
__device__ __forceinline__ void tr_tile(const float* __restrict__ src, int srcN, bf16_t* __restrict__ dst, int dstK, int k0, int n0, int mode, float* T) {
    int tid = threadIdx.x; asm volatile("" : "+v"(tid));
#pragma unroll
    for (int e = 0; e < 8; ++e) { const int idx = tid + 512 * e, kk = idx >> 6, nn = idx & 63; T[kk * 65 + nn] = src[(size_t)(k0 + kk) * srcN + n0 + nn]; }
    __syncthreads();
#pragma unroll
    for (int e = 0; e < 4; ++e) { const int idx = tid + 512 * e, nn = idx >> 5, kp = idx & 31; const int n = n0 + nn;
        const int row = mode == 0 ? n : ((n >> 7) * 256 + (n & 127) + (mode == 2 ? 128 : 0));
        *(unsigned*)(dst + (size_t)row * dstK + k0 + 2 * kp) = cvt_pk_bf16(T[(2 * kp) * 65 + nn], T[(2 * kp + 1) * 65 + nn]); }
    __syncthreads();
}
__device__ __forceinline__ void tr_task(const float* src, int srcN, int K, bf16_t* dst, int dstK, int mode, float* T) {
    const int tn = srcN >> 6, nt = (K >> 6) * tn;
    for (int t = blockIdx.x; t < nt; t += gridDim.x) tr_tile(src, srcN, dst, dstK, (t / tn) * 64, (t % tn) * 64, mode, T);
}
__device__ __forceinline__ void ew_phase(const bf16_t* __restrict__ D, const float* __restrict__ xa, const float* __restrict__ xb  , float* __restrict__ xout,
                                         const float* __restrict__ gpost, float coef, const float* __restrict__ gpre, bf16_t* __restrict__ hout) {
    int tid = threadIdx.x; asm volatile("" : "+v"(tid)); const int lane = tid & 63, wave = tid >> 6;
    for (int r = blockIdx.x * 8 + wave; r < MT; r += gridDim.x * 8) {
        const float* xr = (xb && r >= MP) ? xb + (size_t)(r - MP) * DM : xa + (size_t)r * DM;
        float4 xv[4];
#pragma unroll
        for (int i = 0; i < 4; ++i) xv[i] = *(const float4*)(xr + lane * 4 + 256 * i);
        if (D) {
            float dv[4][4]; float ss = 0.f;
#pragma unroll
            for (int i = 0; i < 4; ++i) { const uint2 w = *(const uint2*)(D + (size_t)r * DM + lane * 4 + 256 * i); dv[i][0] = bflo(w.x); dv[i][1] = bfhi(w.x); dv[i][2] = bflo(w.y); dv[i][3] = bfhi(w.y);
                ss += dv[i][0] * dv[i][0] + dv[i][1] * dv[i][1] + dv[i][2] * dv[i][2] + dv[i][3] * dv[i][3]; }
            ss = wave_sum(ss); const float rs = coef * rsqrtf(ss * (1.0f / 1024.0f) + EPS);
#pragma unroll
            for (int i = 0; i < 4; ++i) { const float4 g = *(const float4*)(gpost + lane * 4 + 256 * i);
                xv[i].x += dv[i][0] * rs * g.x; xv[i].y += dv[i][1] * rs * g.y; xv[i].z += dv[i][2] * rs * g.z; xv[i].w += dv[i][3] * rs * g.w; }
        }
#pragma unroll
        for (int i = 0; i < 4; ++i) *(float4*)(xout + (size_t)r * DM + lane * 4 + 256 * i) = xv[i];
        if (hout) {
            float ss = 0.f;
#pragma unroll
            for (int i = 0; i < 4; ++i) ss += xv[i].x * xv[i].x + xv[i].y * xv[i].y + xv[i].z * xv[i].z + xv[i].w * xv[i].w;
            ss = wave_sum(ss); const float rs = rsqrtf(ss * (1.0f / 1024.0f) + EPS);
#pragma unroll
            for (int i = 0; i < 4; ++i) { const float4 g = *(const float4*)(gpre + lane * 4 + 256 * i); uint2 w;
                w.x = cvt_pk_bf16(xv[i].x * rs * g.x, xv[i].y * rs * g.y); w.y = cvt_pk_bf16(xv[i].z * rs * g.z, xv[i].w * rs * g.w);
                *(uint2*)(hout + (size_t)r * DM + lane * 4 + 256 * i) = w; }
        }
    }
}
__device__ void phase_init(const Args& a, unsigned char* lds) {
    unsigned char* ws = a.ws; float* T = (float*)lds;
    int tid = threadIdx.x; asm volatile("" : "+v"(tid)); const size_t gtid = (size_t)blockIdx.x * 512 + tid, gsz = (size_t)gridDim.x * 512;
    if (blockIdx.x == 0 && tid < 64) ((unsigned*)(ws + OFF_CTL))[tid] = 0u;
    for (size_t i = gtid; i < 4096 * 32; i += gsz) { const int pos = (int)(i >> 5), fi = (int)(i & 31);
        const float w = exp2f(-(float)fi * (13.287712379549449f / 32.0f)); const double ang = (double)((float)pos * w);
        const double k = rint(ang * 0.15915494309189535); const float rr = (float)(ang - k * 6.283185307179586);
        ((float2*)(ws + OFF_ROPE))[i] = make_float2(__cosf(rr), __sinf(rr)); }
    for (int l = 0; l < 2; ++l) {
        for (int f = 0; f < 2; ++f) { const size_t lf = (size_t)(l * 2 + f);
            tr_task(a.in[6] + lf * 1024 * 2816, 2816, 1024, (bf16_t*)(ws + OFF_WGU) + lf * 5632 * 1024, 1024, 1, T);
            tr_task(a.in[7] + lf * 1024 * 2816, 2816, 1024, (bf16_t*)(ws + OFF_WGU) + lf * 5632 * 1024, 1024, 2, T);
            tr_task(a.in[8] + lf * 2816 * 1024, 1024, 2816, (bf16_t*)(ws + OFF_WDN) + lf * 1024 * 2816, 2816, 0, T); }
        bf16_t* win = (bf16_t*)(ws + OFF_WIN) + (size_t)l * 2304 * 1024;
        tr_task(a.in[9] + (size_t)l * 1024 * 2240, 2240, 1024, win, 1024, 0, T);
        for (size_t i = gtid; i < 64 * 1024 / 2; i += gsz) ((unsigned*)(win + 2240 * 1024))[i] = 0u;
        bf16_t* wmix = (bf16_t*)(ws + OFF_WMIX) + (size_t)l * 1024 * 1536;
        tr_task(a.in[10] + (size_t)l * 1024 * 1024 + 512 * 1024, 1024, 512, wmix + 1024, 1536, 0, T);
        { const float* wuv = a.in[15] + (size_t)l * 256 * 512; const float* wo = a.in[10] + (size_t)l * 1024 * 1024;
          for (size_t i = gtid; i < 1024 * 1024; i += gsz) { const int n = (int)(i & 1023), hc = (int)(i >> 10), h = hc >> 8, c = hc & 255;
              const float* av = wuv + (c * 4 + h) * 128; const float* bv = wo + (size_t)(h * 128) * 1024 + n; float s = 0.f;
#pragma unroll 8
              for (int v = 0; v < 128; ++v) s += av[v] * bv[(size_t)v * 1024];
              wmix[(size_t)n * 1536 + hc] = f2bf(s); } }
        { bf16_t* wq = (bf16_t*)(ws + OFF_WQ) + (size_t)l * 1280 * 384; const float* wuk = a.in[14] + (size_t)l * 256 * 512; const float* wqb = a.in[12] + (size_t)l * 384 * 768;
          for (size_t i = gtid; i < 1024 * 384; i += gsz) { const int k = (int)(i % 384), hc = (int)(i / 384), h = hc >> 8, c = hc & 255;
              const float4* av = (const float4*)(wuk + (c * 4 + h) * 128); const float4* bv = (const float4*)(wqb + (size_t)k * 768 + h * 192); float s = 0.f;
#pragma unroll 4
              for (int v = 0; v < 32; ++v) { const float4 x = av[v], y = bv[v]; s += x.x * y.x + x.y * y.y + x.z * y.z + x.w * y.w; }
              wq[i] = f2bf(s * QSCALE); }
          for (size_t i = gtid; i < 256 * 384; i += gsz) { const int k = (int)(i % 384), j = (int)(i / 384), half = j >> 7, jj = j & 127, h = jj >> 5, fi = jj & 31;
              wq[(size_t)(1024 + j) * 384 + k] = f2bf(wqb[(size_t)k * 768 + h * 192 + 128 + half * 32 + fi] * QSCALE); } }
    }
    ew_phase(nullptr, a.in[0], a.in[1], (float*)(ws + OFF_X), nullptr, 0.f, a.in[5], (bf16_t*)(ws + OFF_H));
}

__device__ __forceinline__ int keyof32(int p) { const int g = p >> 3, j = p & 7; return j < 4 ? 4 * g + j : 16 + 4 * g + (j - 4); }
__device__ __forceinline__ void ct_write(const bf16_t* ctile, bf16_t* dst  , size_t rowstride) {
    int tid = threadIdx.x; asm volatile("" : "+v"(tid)); const int c = tid >> 1, half = tid & 1;
    unsigned w[16];
#pragma unroll
    for (int p = 0; p < 32; p += 2) { const int t0 = 32 * half + keyof32(p), t1 = 32 * half + keyof32(p + 1);
        w[p >> 1] = (unsigned)ctile[t0 * 264 + c] | ((unsigned)ctile[t1 * 264 + c] << 16); }
    uint4* d = (uint4*)(dst + (size_t)c * rowstride + 32 * half);
#pragma unroll
    for (int i = 0; i < 4; ++i) d[i] = make_uint4(w[4 * i], w[4 * i + 1], w[4 * i + 2], w[4 * i + 3]);
}
__device__ void prep_token_tile(const Args& a, int l, int T, unsigned char* lds, const float lbv  ) {
    unsigned char* ws = a.ws; int tid = threadIdx.x; asm volatile("" : "+v"(tid)); const int lane = tid & 63, wave = tid >> 6;
    const bf16_t* z = (const bf16_t*)(ws + OFF_Z); const int r0 = T * 64;
    const bool prm = T < 256; const int b = prm ? (T >> 6) : (T - 256), j = prm ? (T & 63) : 0; const int pos0 = prm ? j * 64 : 2048;
    bf16_t* kc = (bf16_t*)(ws + OFF_KC) + (prm ? (size_t)(b * 4096 + j * 64) : (size_t)16384 + (size_t)b * 2112 + 2048) * 320;
    bf16_t* ct = (bf16_t*)(ws + OFF_CT) + (prm ? (size_t)b * 256 * 4096 + j * 64 : (size_t)16384 * 256 + (size_t)b * 256 * 2112 + 2048);
    const size_t ctstride = prm ? 4096 : 2112;
    float* ockv = a.out + (prm ? O_CKVP + ((size_t)(l * 4 + b) * 4096 + j * 64) * 256 : O_CKVS + ((size_t)(l * 32 + b) * 64) * 256);
    float* okpe = a.out + (prm ? O_KPEP + ((size_t)(l * 4 + b) * 4096 + j * 64) * 64 : O_KPES + ((size_t)(l * 32 + b) * 64) * 64);
    bf16_t* qn = (bf16_t*)(ws + OFF_QN); const float* qag = a.in[11] + l * 384; const float* kvg = a.in[13] + l * 256;
    const float2* rope = (const float2*)(ws + OFF_ROPE);
    bf16_t* ctile = (bf16_t*)lds;
    for (int t = wave; t < 64; t += 8) { const bf16_t* zr = z + (size_t)(r0 + t) * ZW;
        { float v[6]; float ss = 0.f;
#pragma unroll
          for (int i = 0; i < 3; ++i) { const unsigned w = *(const unsigned*)(zr + ZQ + 2 * lane + 128 * i); v[2 * i] = bflo(w); v[2 * i + 1] = bfhi(w); ss += v[2 * i] * v[2 * i] + v[2 * i + 1] * v[2 * i + 1]; }
          ss = wave_sum(ss); const float rs = rsqrtf(ss * (1.0f / 384.0f) + EPS);
#pragma unroll
          for (int i = 0; i < 3; ++i) { const int c = 2 * lane + 128 * i; *(unsigned*)(qn + (size_t)(r0 + t) * 384 + c) = cvt_pk_bf16(v[2 * i] * rs * qag[c], v[2 * i + 1] * rs * qag[c + 1]); } }
        { const uint2 w = *(const uint2*)(zr + ZKV + 4 * lane); float v0 = bflo(w.x), v1 = bfhi(w.x), v2 = bflo(w.y), v3 = bfhi(w.y);
          float ss = wave_sum(v0 * v0 + v1 * v1 + v2 * v2 + v3 * v3); const float rs = rsqrtf(ss * (1.0f / 256.0f) + EPS); const float4 g = *(const float4*)(kvg + 4 * lane);
          v0 *= rs * g.x; v1 *= rs * g.y; v2 *= rs * g.z; v3 *= rs * g.w;
          *(float4*)(ockv + (size_t)t * 256 + 4 * lane) = make_float4(v0, v1, v2, v3);
          uint2 o; o.x = cvt_pk_bf16(v0, v1); o.y = cvt_pk_bf16(v2, v3);
          *(uint2*)(kc + (size_t)t * 320 + 4 * lane) = o; *(uint2*)(ctile + t * 264 + 4 * lane) = o; }
        if (lane < 32) { const float x1 = bf2f(zr[ZPE + lane]), x2 = bf2f(zr[ZPE + 32 + lane]); const float2 cs = rope[(pos0 + t) * 32 + lane];
          const float o1 = x1 * cs.x - x2 * cs.y, o2 = x2 * cs.x + x1 * cs.y;
          okpe[(size_t)t * 64 + lane] = o1; okpe[(size_t)t * 64 + 32 + lane] = o2; kc[(size_t)t * 320 + 256 + lane] = f2bf(o1); kc[(size_t)t * 320 + 288 + lane] = f2bf(o2); }
    }
    __syncthreads();
    ct_write(ctile, ct, ctstride);
    __syncthreads();
    float* lf = (float*)lds; float* vt = (float*)(lds + 65536);
    const int ep = tid & 255, hf = tid >> 8;
    for (int t = 32 * hf; t < 32 * hf + 32; ++t) { const bf16_t* zr = z + (size_t)(r0 + t) * ZW; const float zf = bf2f(zr[ZHF + ep]);
        const float f = lbv + (1.0f - lbv) * sigmoidf_(zf); lf[t * 256 + ep] = __logf(f); vt[t * 256 + ep] = bf2f(zr[ZHI + ep]); }
    __syncthreads();
    if (tid < 256) { float s = 0.f; for (int t = 0; t < 64; ++t) { s += lf[t * 256 + tid]; lf[t * 256 + tid] = s; } }
    __syncthreads();
    const float bl = lf[63 * 256 + ep];
    __syncthreads();
    for (int t = 32 * hf; t < 32 * hf + 32; ++t) { const float zf = bf2f(z[(size_t)(r0 + t) * ZW + ZHF + ep]);
        lf[t * 256 + ep] = (1.0f - lbv) * sigmoidf_(-zf) * __expf(bl - lf[t * 256 + ep]); }
    if (hf == 0) ((float*)(ws + OFF_DEC))[T * 256 + ep] = __expf(bl);
    __syncthreads();
    { const int h = tid >> 7, eb = (tid & 127) >> 3, db = tid & 7; float acc[4][8];
#pragma unroll
      for (int i = 0; i < 4; ++i)
#pragma unroll
          for (int jj = 0; jj < 8; ++jj) acc[i][jj] = 0.f;
      for (int s = 0; s < 64; ++s) { const float4 kv = *(const float4*)(lf + s * 256 + h * 64 + eb * 4); const float4 v0 = *(const float4*)(vt + s * 256 + h * 64 + db * 8), v1 = *(const float4*)(vt + s * 256 + h * 64 + db * 8 + 4);
          const float kk[4] = {kv.x, kv.y, kv.z, kv.w}; const float vv[8] = {v0.x, v0.y, v0.z, v0.w, v1.x, v1.y, v1.z, v1.w};
#pragma unroll
          for (int i = 0; i < 4; ++i)
#pragma unroll
              for (int jj = 0; jj < 8; ++jj) acc[i][jj] += kk[i] * vv[jj]; }
      float* U = (float*)(ws + OFF_U) + (size_t)(T * 4 + h) * 4096;
#pragma unroll
      for (int i = 0; i < 4; ++i) { *(float4*)(U + (eb * 4 + i) * 64 + db * 8) = make_float4(acc[i][0], acc[i][1], acc[i][2], acc[i][3]); *(float4*)(U + (eb * 4 + i) * 64 + db * 8 + 4) = make_float4(acc[i][4], acc[i][5], acc[i][6], acc[i][7]); } }
    __syncthreads();
}
__device__ void prep_cache_tile(const Args& a, int l, int P, unsigned char* lds) {
    unsigned char* ws = a.ws; int tid = threadIdx.x; asm volatile("" : "+v"(tid)); const int b = P >> 5, kt = P & 31;
    const float* ckv = a.in[2] + ((size_t)(l * 32 + b) * 2048 + kt * 64) * 256; const float* kpe = a.in[3] + ((size_t)(l * 32 + b) * 2048 + kt * 64) * 64;
    bf16_t* kc = (bf16_t*)(ws + OFF_KC) + ((size_t)16384 + (size_t)b * 2112 + kt * 64) * 320;
    bf16_t* ct = (bf16_t*)(ws + OFF_CT) + (size_t)16384 * 256 + (size_t)b * 256 * 2112 + kt * 64;
    bf16_t* ctile = (bf16_t*)lds;
#pragma unroll
    for (int i = 0; i < 8; ++i) { const int q = tid + 512 * i, t = q >> 6, c4 = q & 63; const float4 v = *(const float4*)(ckv + (size_t)t * 256 + c4 * 4);
        uint2 o; o.x = cvt_pk_bf16(v.x, v.y); o.y = cvt_pk_bf16(v.z, v.w); *(uint2*)(kc + (size_t)t * 320 + c4 * 4) = o; *(uint2*)(ctile + t * 264 + c4 * 4) = o; }
#pragma unroll
    for (int i = 0; i < 2; ++i) { const int q = tid + 512 * i, t = q >> 4, c4 = q & 15; const float4 v = *(const float4*)(kpe + (size_t)t * 64 + c4 * 4);
        uint2 o; o.x = cvt_pk_bf16(v.x, v.y); o.y = cvt_pk_bf16(v.z, v.w); *(uint2*)(kc + (size_t)t * 320 + 256 + c4 * 4) = o; }
    __syncthreads();
    ct_write(ctile, ct, 2112);
    __syncthreads();
}
__device__ __forceinline__ float lb_of(const Args& a, int l, int e) { if (l == 0) return 0.f; const float a0 = a.in[16][e], a1 = a.in[16][256 + e]; return 1.0f / (1.0f + __expf(a0 - a1)); }
__device__ void phase_prep(const Args& a, int l, unsigned char* lds) {
    int tid0 = threadIdx.x; asm volatile("" : "+v"(tid0)); const float lbv = lb_of(a, l, tid0 & 255);
    for (int t = blockIdx.x; t < NTILE + 1024; t += gridDim.x) { if (t < NTILE) prep_token_tile(a, l, t, lds, lbv); else prep_cache_tile(a, l, t - NTILE, lds); }
}
__device__ void phase_scan(const Args& a, int l) {
    unsigned char* ws = a.ws; int tid = threadIdx.x; asm volatile("" : "+v"(tid)); const size_t gtid = (size_t)blockIdx.x * 512 + tid, gsz = (size_t)gridDim.x * 512;
    const float* U = (const float*)(ws + OFF_U); const float* dec = (const float*)(ws + OFF_DEC); float* sst = (float*)(ws + OFF_SST);
    for (size_t i = gtid; i < 16 * 4096; i += gsz) { const int bh = (int)(i >> 12), ed = (int)(i & 4095), b = bh >> 2, h = bh & 3, e = ed >> 6; float S = 0.f;
#pragma unroll 8
        for (int j = 0; j < 64; ++j) { const size_t ch = (size_t)((b * 64 + j) * 4 + h); sst[ch * 4096 + ed] = S; S = dec[ch * 64 + e] * S + U[ch * 4096 + ed]; }
        a.out[O_HGP + (size_t)(l * 16 + bh) * 4096 + ed] = S; }
    for (size_t i = gtid; i < 128 * 4096; i += gsz) { const int bh = (int)(i >> 12), ed = (int)(i & 4095), b = bh >> 2, h = bh & 3, e = ed >> 6; const size_t ch = (size_t)((256 + b) * 4 + h);
        const float S0 = a.in[4][(size_t)(l * 128 + bh) * 4096 + ed];
        a.out[O_HGS + (size_t)(l * 128 + bh) * 4096 + ed] = dec[ch * 64 + e] * S0 + U[ch * 4096 + ed]; }
}
constexpr int KSTR = 656, VSTR = 144, VOFF = 64 * KSTR;
__device__ void attn_item(const Args& a, int idx, unsigned char* ldsg) {
    unsigned char* ws = a.ws; LAS unsigned char* lds = (LAS unsigned char*)ldsg;
    int tid = threadIdx.x; asm volatile("" : "+v"(tid)); const int lane = tid & 63, wave = tid >> 6, lr = lane & 15, g = lane >> 4;
    int b, hp, nkt, r0; const unsigned char* kcb; const unsigned char* ctb; size_t ctstride;
    if (idx >= 256 && idx < 320) { const int s = idx - 256; b = s >> 1; hp = s & 1; nkt = 33; r0 = MP + b * 64;
        kcb = ws + OFF_KC + ((size_t)16384 + (size_t)b * 2112) * 640; ctb = ws + OFF_CT + ((size_t)16384 * 256 + (size_t)b * 256 * 2112) * 2; ctstride = 4224; }
    else { const int k = idx < 256 ? idx : idx - 64; const int j = 63 - (k >> 3), sub = k & 7; b = sub >> 1; hp = sub & 1; nkt = j + 1; r0 = b * 4096 + j * 64;
        kcb = ws + OFF_KC + (size_t)b * 4096 * 640; ctb = ws + OFF_CT + (size_t)b * 256 * 4096 * 2; ctstride = 8192; }
    const int head = hp * 2 + (wave >> 2); const int qrow = r0 + (wave & 3) * 16 + lr;
    bf16x8 qf[10];
    { const bf16_t* qp = (const bf16_t*)(ws + OFF_Q) + (size_t)qrow * 1280 + head * 320 + g * 8;
#pragma unroll
      for (int ks = 0; ks < 10; ++ks) qf[ks] = *(const bf16x8*)(qp + ks * 32);
      const int pos = qrow < MP ? (qrow & 4095) : 2048 + ((qrow - MP) & 63); const float2* rp = (const float2*)(ws + OFF_ROPE) + pos * 32 + 8 * g;
      u32x4 w1 = __builtin_bit_cast(u32x4, qf[8]), w2 = __builtin_bit_cast(u32x4, qf[9]);
#pragma unroll
      for (int jp = 0; jp < 4; ++jp) { const float2 ca = rp[2 * jp], cb = rp[2 * jp + 1]; const float a1 = bflo(w1[jp]), b1 = bfhi(w1[jp]), a2 = bflo(w2[jp]), b2 = bfhi(w2[jp]);
          w1[jp] = cvt_pk_bf16(a1 * ca.x - a2 * ca.y, b1 * cb.x - b2 * cb.y); w2[jp] = cvt_pk_bf16(a2 * ca.x + a1 * ca.y, b2 * cb.x + b1 * cb.y); }
      qf[8] = __builtin_bit_cast(bf16x8, w1); qf[9] = __builtin_bit_cast(bf16x8, w2); }
    f32x4 o[16];
#pragma unroll
    for (int i = 0; i < 16; ++i) o[i] = (f32x4){0.f, 0.f, 0.f, 0.f};
    float mrun = -1e30f, lsum = 0.f;
    u32x4 pk[5], pv[4];
#define ATT_GLOAD(kt) do { _Pragma("unroll") for (int i = 0; i < 5; ++i) pk[i] = *(const u32x4*)(kcb + (size_t)(kt) * 40960 + (size_t)(tid + 512 * i) * 16); \
        _Pragma("unroll") for (int i = 0; i < 4; ++i) { const int q = tid + 512 * i; pv[i] = *(const u32x4*)(ctb + (size_t)(q >> 3) * ctstride + (size_t)(kt) * 128 + (q & 7) * 16); } } while (0)
#define ATT_LSTORE() do { _Pragma("unroll") for (int i = 0; i < 5; ++i) { const int q = tid + 512 * i; *(LAS u32x4*)(lds + (q / 40) * KSTR + (q % 40) * 16) = pk[i]; } \
        _Pragma("unroll") for (int i = 0; i < 4; ++i) { const int q = tid + 512 * i; *(LAS u32x4*)(lds + VOFF + (q >> 3) * VSTR + (q & 7) * 16) = pv[i]; } } while (0)
    ATT_GLOAD(0);
    __syncthreads();
    ATT_LSTORE();
    __syncthreads();
    for (int kt = 0; kt < nkt; ++kt) {
        if (kt + 1 < nkt) ATT_GLOAD(kt + 1);
        f32x4 s[4];
#pragma unroll
        for (int i = 0; i < 4; ++i) s[i] = (f32x4){0.f, 0.f, 0.f, 0.f};
#pragma unroll
        for (int ks = 0; ks < 10; ++ks)
#pragma unroll
            for (int k4 = 0; k4 < 4; ++k4) { const bf16x8 af = *(const LAS bf16x8*)(lds + (16 * k4 + lr) * KSTR + (ks * 32 + g * 8) * 2);
                s[k4] = __builtin_amdgcn_mfma_f32_16x16x32_bf16(af, qf[ks], s[k4], 0, 0, 0); }
        float mx = s[0][0];
#pragma unroll
        for (int k4 = 0; k4 < 4; ++k4)
#pragma unroll
            for (int i = 0; i < 4; ++i) mx = fmaxf(mx, s[k4][i]);
        mx = fmaxf(mx, __shfl_xor(mx, 16)); mx = fmaxf(mx, __shfl_xor(mx, 32));
        const float mnew = fmaxf(mrun, mx), alpha = exp2f(mrun - mnew); mrun = mnew;
        float ps = 0.f;
#pragma unroll
        for (int k4 = 0; k4 < 4; ++k4)
#pragma unroll
            for (int i = 0; i < 4; ++i) { s[k4][i] = exp2f(s[k4][i] - mnew); ps += s[k4][i]; }
        lsum = lsum * alpha + ps;
#pragma unroll
        for (int i = 0; i < 16; ++i) o[i] *= alpha;
        bf16x8 pb[2];
#pragma unroll
        for (int s2 = 0; s2 < 2; ++s2) { u32x4 w; w.x = cvt_pk_bf16(s[2 * s2][0], s[2 * s2][1]); w.y = cvt_pk_bf16(s[2 * s2][2], s[2 * s2][3]);
            w.z = cvt_pk_bf16(s[2 * s2 + 1][0], s[2 * s2 + 1][1]); w.w = cvt_pk_bf16(s[2 * s2 + 1][2], s[2 * s2 + 1][3]); pb[s2] = __builtin_bit_cast(bf16x8, w); }
#pragma unroll
        for (int ct = 0; ct < 16; ++ct)
#pragma unroll
            for (int s2 = 0; s2 < 2; ++s2) { const bf16x8 vf = *(const LAS bf16x8*)(lds + VOFF + (16 * ct + lr) * VSTR + (32 * s2 + 8 * g) * 2);
                o[ct] = __builtin_amdgcn_mfma_f32_16x16x32_bf16(vf, pb[s2], o[ct], 0, 0, 0); }
        __syncthreads();
        if (kt + 1 < nkt) ATT_LSTORE();
        __syncthreads();
    }
#undef ATT_GLOAD
#undef ATT_LSTORE
    lsum += __shfl_xor(lsum, 16); lsum += __shfl_xor(lsum, 32);
    const float inv = 1.0f / lsum;
    bf16_t* op = (bf16_t*)(ws + OFF_MIXA) + (size_t)qrow * 1536 + head * 256 + 4 * g;
#pragma unroll
    for (int ct = 0; ct < 16; ++ct) { uint2 w; w.x = cvt_pk_bf16(o[ct][0] * inv, o[ct][1] * inv); w.y = cvt_pk_bf16(o[ct][2] * inv, o[ct][3] * inv); *(uint2*)(op + 16 * ct) = w; }
}
constexpr int H_BC = 0, H_X = 16640, H_Y = H_X + 64 * 132 * 4, H_QT = H_Y + 128 * 68 * 4, H_KT = H_QT + 16640, H_END = H_KT + 64 * 68 * 4;
static_assert(H_END <= LDS_BYTES, "hgrn lds");
__device__ void hgrn_out_tile(const Args& a, int l, int T, unsigned char* lds) {
    unsigned char* ws = a.ws; int tid = threadIdx.x; asm volatile("" : "+v"(tid)); asm volatile("" : "+s"(l)); const int lane = tid & 63, wave = tid >> 6;
    const bf16_t* z = (const bf16_t*)(ws + OFF_Z); const int r0 = T * 64;
    float* bc = (float*)(lds + H_BC); float* X = (float*)(lds + H_X); float* Y = (float*)(lds + H_Y); float* Qt = (float*)(lds + H_QT); float* Kt = (float*)(lds + H_KT);
    const int e = tid & 63, tq = tid >> 6; const int ty = tid >> 4, tx = tid & 15;
    for (int h = 0; h < 4; ++h) {
        const float lbv = lb_of(a, l, h * 64 + e);
#pragma unroll
        for (int i = 0; i < 8; ++i) { const int t = tq * 8 + i; const float zf = bf2f(z[(size_t)(r0 + t) * ZW + ZHF + h * 64 + e]);
            bc[t * 65 + e] = __logf(fmaxf(lbv + (1.0f - lbv) * sigmoidf_(zf), 1e-30f)); }
        __syncthreads();
#pragma unroll
        for (int i = 0; i < 8; ++i) { const int ee = wave * 8 + i; float v = bc[lane * 65 + ee];
#pragma unroll
            for (int o = 1; o < 64; o <<= 1) { const float u = __shfl_up(v, o); if (lane >= o) v += u; }
            bc[lane * 65 + ee] = v; }
        __syncthreads();
        { const float rr = bc[31 * 65 + e];
#pragma unroll
          for (int i = 0; i < 8; ++i) { const int t = tq * 8 + i; const bf16_t* zr = z + (size_t)(r0 + t) * ZW; const float bb = bc[t * 65 + e];
              const float q = bf2f(zr[ZHQ + h * 64 + e]), zf = bf2f(zr[ZHF + h * 64 + e]); const float k = (1.0f - lbv) * sigmoidf_(-zf);
              X[t * 132 + e] = q * __expf(bb); Qt[t * 65 + e] = q * __expf(fminf(bb - rr, 80.f)); Kt[e * 68 + t] = k * __expf(fminf(rr - bb, 80.f));
              Y[(64 + t) * 68 + e] = bf2f(zr[ZHI + h * 64 + e]); }
          const float* S0 = T < 256 ? (const float*)(ws + OFF_SST) + (size_t)(T * 4 + h) * 4096 : a.in[4] + (size_t)(l * 128 + (T - 256) * 4 + h) * 4096;
#pragma unroll
          for (int i = 0; i < 8; ++i) { const int ed = tid + 512 * i; Y[(ed >> 6) * 68 + (ed & 63)] = S0[ed]; } }
        __syncthreads();
        { float acc[2][4];
#pragma unroll
          for (int i = 0; i < 2; ++i)
#pragma unroll
              for (int jj = 0; jj < 4; ++jj) acc[i][jj] = 0.f;
          for (int k = 0; k < 64; ++k) { const float x0 = Qt[(2 * ty) * 65 + k], x1 = Qt[(2 * ty + 1) * 65 + k]; const float4 y = *(const float4*)(Kt + k * 68 + 4 * tx);
              acc[0][0] += x0 * y.x; acc[0][1] += x0 * y.y; acc[0][2] += x0 * y.z; acc[0][3] += x0 * y.w; acc[1][0] += x1 * y.x; acc[1][1] += x1 * y.y; acc[1][2] += x1 * y.z; acc[1][3] += x1 * y.w; }
#pragma unroll
          for (int i = 0; i < 2; ++i)
#pragma unroll
              for (int jj = 0; jj < 4; ++jj) { const int t = 2 * ty + i, s = 4 * tx + jj; X[t * 132 + 64 + s] = (s <= t) ? acc[i][jj] : 0.f; } }
        __syncthreads();
        { float acc[2][4];
#pragma unroll
          for (int i = 0; i < 2; ++i)
#pragma unroll
              for (int jj = 0; jj < 4; ++jj) acc[i][jj] = 0.f;
          for (int k = 0; k < 128; ++k) { const float x0 = X[(2 * ty) * 132 + k], x1 = X[(2 * ty + 1) * 132 + k]; const float4 y = *(const float4*)(Y + k * 68 + 4 * tx);
              acc[0][0] += x0 * y.x; acc[0][1] += x0 * y.y; acc[0][2] += x0 * y.z; acc[0][3] += x0 * y.w; acc[1][0] += x1 * y.x; acc[1][1] += x1 * y.y; acc[1][2] += x1 * y.z; acc[1][3] += x1 * y.w; }
          const float4 og = *(const float4*)(a.in[17] + l * 256 + h * 64 + 4 * tx);
#pragma unroll
          for (int i = 0; i < 2; ++i) { const int t = 2 * ty + i; float ss = acc[i][0] * acc[i][0] + acc[i][1] * acc[i][1] + acc[i][2] * acc[i][2] + acc[i][3] * acc[i][3];
              ss += __shfl_xor(ss, 1); ss += __shfl_xor(ss, 2); ss += __shfl_xor(ss, 4); ss += __shfl_xor(ss, 8);
              const float rs = rsqrtf(ss * (1.0f / 64.0f) + EPS);
              const uint2 gw = *(const uint2*)(z + (size_t)(r0 + t) * ZW + ZHG + h * 64 + 4 * tx);
              uint2 w; w.x = cvt_pk_bf16(acc[i][0] * rs * og.x * siluf_(bflo(gw.x)), acc[i][1] * rs * og.y * siluf_(bfhi(gw.x)));
              w.y = cvt_pk_bf16(acc[i][2] * rs * og.z * siluf_(bflo(gw.y)), acc[i][3] * rs * og.w * siluf_(bfhi(gw.y)));
              *(uint2*)((bf16_t*)(ws + OFF_MIXA) + (size_t)(r0 + t) * 1536 + 1024 + h * 64 + 4 * tx) = w; } }
        __syncthreads();
    }
}
template <int R  > __device__ __forceinline__ void cmlp_core(const Args& a, int l, int g, int r0, const float* w, const float* v) {
    int tid = threadIdx.x; asm volatile("" : "+v"(tid)); const int ty = tid >> 4, tx = tid & 15; const bf16_t* z = (const bf16_t*)(a.ws + OFF_Z);
    float acc[R][4];
#pragma unroll
    for (int i = 0; i < R; ++i)
#pragma unroll
        for (int jj = 0; jj < 4; ++jj) acc[i][jj] = 0.f;
    const int smax = R * ty + R - 1;
    for (int s = 0; s <= smax; ++s) { const float4 y = *(const float4*)(v + s * 68 + 4 * tx);
#pragma unroll
        for (int i = 0; i < R; ++i) { const int t = R * ty + i; const float x = (s <= t) ? w[t * 129 + s] : 0.f; acc[i][0] += x * y.x; acc[i][1] += x * y.y; acc[i][2] += x * y.z; acc[i][3] += x * y.w; } }
#pragma unroll
    for (int i = 0; i < R; ++i) { const int t = R * ty + i; const float bs = a.in[20][(size_t)(l * 4 + g) * 128 + t];
        const uint2 cw = *(const uint2*)(z + (size_t)(r0 + t) * ZW + ZCU + g * 64 + 4 * tx);
        uint2 o; o.x = cvt_pk_bf16(geluf_(bflo(cw.x)) * (acc[i][0] + bs), geluf_(bfhi(cw.x)) * (acc[i][1] + bs)); o.y = cvt_pk_bf16(geluf_(bflo(cw.y)) * (acc[i][2] + bs), geluf_(bfhi(cw.y)) * (acc[i][3] + bs));
        *(uint2*)((bf16_t*)(a.ws + OFF_MIXA) + (size_t)(r0 + t) * 1536 + 1280 + g * 64 + 4 * tx) = o; }
}
__device__ void cmlp_item(const Args& a, int l, int it, unsigned char* lds) {
    int tid = threadIdx.x; asm volatile("" : "+v"(tid)); asm volatile("" : "+s"(l)); const int lane = tid & 63, wave = tid >> 6; const int ci = it >> 2, g = it & 3;
    const bool prm = ci < 128; const int L = prm ? 128 : 64, r0 = prm ? ci * 128 : MP + (ci - 128) * 64;
    const bf16_t* z = (const bf16_t*)(a.ws + OFF_Z); float* w = (float*)lds; float* v = (float*)(lds + 128 * 129 * 4);
    const float* wsrc = a.in[19] + (size_t)(l * 4 + g) * 128 * 128;
    for (int i = tid; i < L * L; i += 512) { const int t = prm ? (i >> 7) : (i >> 6), s = prm ? (i & 127) : (i & 63); w[t * 129 + s] = wsrc[t * 128 + s]; }
    const float vg = a.in[18][l * 256 + g * 64 + lane];
    for (int t = wave; t < L; t += 8) { const float x = geluf_(bf2f(z[(size_t)(r0 + t) * ZW + ZCV + g * 64 + lane])); const float ss = wave_sum(x * x);
        const float vv = x * rsqrtf(ss * (1.0f / 64.0f) + EPS) * vg; v[t * 68 + lane] = vv;
        if (!prm) a.out[O_CMV + ((size_t)(l * 32 + (ci - 128)) * 64 + t) * 256 + g * 64 + lane] = vv; }
    __syncthreads();
    if (prm) cmlp_core<4>(a, l, g, r0, w, v); else cmlp_core<2>(a, l, g, r0, w, v);
    __syncthreads();
}
__device__ void phase_mix(const Args& a, int l, unsigned char* lds) {
    unsigned* ctr = (unsigned*)(a.ws + OFF_CTL) + 16 * (l + 1); LAS unsigned* slot = (LAS unsigned*)(lds + LDS_BYTES - 16);
    for (;;) {
        __syncthreads();
        { int t0 = threadIdx.x; asm volatile("" : "+v"(t0)); if (t0 == 0) *slot = atomicAdd(ctr, 1u); }
        __syncthreads();
        const int it = (int)*slot;
        if (it >= 576 + NTILE + 640) break;
        if (it < 576) attn_item(a, it, lds); else if (it < 576 + NTILE) hgrn_out_tile(a, l, it - 576, lds); else cmlp_item(a, l, it - 576 - NTILE, lds);
    }
}
__global__ void __launch_bounds__(512) mk_fwd(Args a) {
    extern __shared__ __attribute__((aligned(16))) unsigned char lds[];
    for (int ph = a.ph_lo; ph < a.ph_hi; ++ph) {
        unsigned char* ws = a.ws; asm volatile("" : "+s"(ws));
        if (ph == 0) phase_init(a, lds);
        else { const int l = (ph - 1) / 12, p = (ph - 1) % 12; const float* ng = a.in[5] + (size_t)l * 6 * 1024;
            bf16_t* H = (bf16_t*)(ws + OFF_H); bf16_t* ACT = (bf16_t*)(ws + OFF_ACT); bf16_t* D = (bf16_t*)(ws + OFF_D); float* X = (float*)(ws + OFF_X);
            switch (p) {
            case 0: case 9: { const int f = p == 0 ? 0 : 1; EpiSwiGLU E{ACT}; run_gemm(lds, H, (const bf16_t*)(ws + OFF_WGU) + (size_t)(l * 2 + f) * 5632 * 1024, MT, 5632, 1024, E); } break;
            case 1: case 10: { const int f = p == 1 ? 0 : 1; EpiBf E{D, 1024}; run_gemm(lds, ACT, (const bf16_t*)(ws + OFF_WDN) + (size_t)(l * 2 + f) * 1024 * 2816, MT, 1024, 2816, E); } break;
            case 2: ew_phase(D, X, nullptr, X, ng + 1024, 0.5f, ng + 2048, H); break;
            case 3: { EpiBf E{(bf16_t*)(ws + OFF_Z), ZW}; run_gemm(lds, H, (const bf16_t*)(ws + OFF_WIN) + (size_t)l * 2304 * 1024, MT, 2304, 1024, E); } break;
            case 4: phase_prep(a, l, lds); break;
            case 5: { phase_scan(a, l); EpiQ E{(bf16_t*)(ws + OFF_Q)}; run_gemm(lds, (const bf16_t*)(ws + OFF_QN), (const bf16_t*)(ws + OFF_WQ) + (size_t)l * 1280 * 384, MT, 1280, 384, E); } break;
            case 6: phase_mix(a, l, lds); break;
            case 7: { EpiBf E{D, 1024}; run_gemm(lds, (const bf16_t*)(ws + OFF_MIXA), (const bf16_t*)(ws + OFF_WMIX) + (size_t)l * 1024 * 1536, MT, 1024, 1536, E); } break;
            case 8: ew_phase(D, X, nullptr, X, ng + 3 * 1024, 1.0f, ng + 4 * 1024, H); break;
            case 11: if (l == 0) ew_phase(D, X, nullptr, X, ng + 5 * 1024, 0.5f, ng + 6 * 1024, H); else ew_phase(D, X, nullptr, a.out + O_Y, ng + 5 * 1024, 0.5f, nullptr, nullptr); break;
            }
        }
        if (ph + 1 < a.ph_hi) { __threadfence(); cg::this_grid().sync(); }
    }
}

extern "C" void kernel_launch(void* const* d_in, const int* in_sizes, int n_in, void* d_out, int out_size, void* d_ws, size_t ws_size, hipStream_t stream) {
    static int grid = 0;
    if (grid == 0) {
        if (n_in != 21 || ws_size < WS_END) { fprintf(stderr, "kernel_launch: bad inputs n_in %d ws %zu need %zu\n", n_in, ws_size, (size_t)WS_END); grid = -1; return; }
        int dev = 0, cus = 0, per_cu = 0;
        hipGetDevice(&dev); hipDeviceGetAttribute(&cus, hipDeviceAttributeMultiprocessorCount, dev);
        if (hipFuncSetAttribute((const void*)mk_fwd, hipFuncAttributeMaxDynamicSharedMemorySize, LDS_BYTES) != hipSuccess) { fprintf(stderr, "hipFuncSetAttribute failed\n"); grid = -1; return; }
        if (hipOccupancyMaxActiveBlocksPerMultiprocessor(&per_cu, (const void*)mk_fwd, 512, LDS_BYTES) != hipSuccess || per_cu < 1) per_cu = 1;
        (void)hipGetLastError();
        grid = cus * 1;
    }
    if (grid < 0) return;
    Args a{};
    for (int i = 0; i < 21; ++i) a.in[i] = (const float*)d_in[i];
    a.out = (float*)d_out; a.ws = (unsigned char*)d_ws;
#if ONE_LAUNCH
    a.ph_lo = 0; a.ph_hi = NPHASE;
    void* args[] = {&a};
    hipError_t e = hipLaunchCooperativeKernel((const void*)mk_fwd, dim3(grid), dim3(512), args, LDS_BYTES, stream);
    if (e != hipSuccess) fprintf(stderr, "cooperative launch failed: %s (grid %d)\n", hipGetErrorString(e), grid);
#else
    for (int ph = 0; ph < NPHASE; ++ph) { a.ph_lo = ph; a.ph_hi = ph + 1; hipLaunchKernelGGL(mk_fwd, dim3(grid), dim3(512), LDS_BYTES, stream, a); }
#endif
}
```

```cpp
#include <hip/hip_runtime.h>
#include <hip/hip_cooperative_groups.h>
#include <cstdio>
namespace cg = cooperative_groups;
#ifndef ONE_LAUNCH
#define ONE_LAUNCH 1
#endif
#ifndef PROBE_DUP
#define PROBE_DUP 0
#endif
#ifndef PROBE_MIX
#define PROBE_MIX 0
#endif
namespace pg8 {
#define PG8_LAS __attribute__((address_space(3)))
typedef unsigned short bf16_t;
typedef short bf16x8 __attribute__((ext_vector_type(8)));
typedef float f32x4 __attribute__((ext_vector_type(4)));
typedef unsigned u32x4 __attribute__((ext_vector_type(4)));
constexpr int BM = 256, BK = 64, HALF = 128, HTB = HALF * BK * 2  , STAGE_BYTES = 8 * HTB, NXCD = 8, WGM = 8;

__host__ __device__ __forceinline__ int lds_byte(int r, int c) { const int st = (r >> 4) * 2 + (c >> 5), rr = r & 15, cc = c & 31, ob = rr * 64 + cc * 2; return st * 1024 + (ob ^ (((ob >> 9) & 1) << 5)); }
__host__ __device__ __forceinline__ void stage_rc(int b, int& R, int& C) { const int st = b / 1024, sb = b % 1024, swz = sb ^ (((sb >> 9) & 1) << 5); R = (st >> 1) * 16 + swz / 64; C = (st & 1) * 32 + (swz % 64) / 2; }
__host__ __device__ __forceinline__ int perm32(int rho) { const int n = rho >> 4, i = rho & 15; return 8 * (i >> 2) + 4 * n + (i & 3); }

struct Unit { int pm, pn, ks, nt, koff; };
struct Gemm { const bf16_t* A; const bf16_t* Bt; int M, N, K, ld; };

struct StaticOrder {
    int nM, nN, nwg, G, c, nN0, unt, ukb;
    __host__ __device__ void init(int M, int N, int G_, int c_, int nsplit = 1) { nM = M / BM; nN0 = N / BM; nN = nN0 * nsplit; nwg = nM * nN; G = G_; c = c_; }
    __host__ __device__ bool next(int i, Unit& u) const {
        const long L = (long)i * G + c; if (L >= nwg) return false;
        int wgid = (int)L; { const int q = nwg / NXCD, r = nwg % NXCD, xcd = wgid % NXCD, off = wgid / NXCD; wgid = (xcd < r ? xcd * (q + 1) : r * (q + 1) + (xcd - r) * q) + off; }
        const int nig = WGM * nN, gid = wgid / nig, fm = gid * WGM, gsz = (nM - fm) < WGM ? (nM - fm) : WGM;
        u.pm = fm + ((wgid % nig) % gsz); const int pn = (wgid % nig) / gsz; u.ks = pn / nN0; u.pn = pn - u.ks * nN0; u.nt = unt; u.koff = u.ks * ukb; return true;
    }
    __device__ __forceinline__ void a_ready(const Unit&) const {}
    __device__ __forceinline__ void done(const Unit&) const {}
};
__device__ __forceinline__ unsigned cvt_pk_bf16(float lo, float hi) { unsigned r; asm volatile("v_cvt_pk_bf16_f32 %0, %1, %2" : "=v"(r) : "v"(lo), "v"(hi)); return r; }
typedef float f32x2 __attribute__((ext_vector_type(2)));
template <class Epi, class Sched, bool STAMP = false>
__device__ __forceinline__ void gemm_phase(PG8_LAS unsigned char* lds, const Gemm g, const Sched& S, const Epi& E, unsigned long long* stamps) {
    int tid = threadIdx.x; asm volatile("" : "+v"(tid)); const int wid = __builtin_amdgcn_readfirstlane(tid >> 6), lane = tid & 63, wr = wid >> 2, wc = wid & 3, fr = lane & 15, fq = lane >> 4;
    const int K = g.ld;
    int ts_lo = 0, ts_hi = 0, nts = 0; const unsigned long long rt_entry = STAMP ? (unsigned long long)wall_clock64() : 0ull;
#define PG8_STAMP() do { if (STAMP && wid == 0 && nts < 64) { const unsigned long long _c = (unsigned long long)clock64(); \
        ts_lo = (lane == nts) ? (int)(unsigned)_c : ts_lo; ts_hi = (lane == nts) ? (int)(unsigned)(_c >> 32) : ts_hi; ++nts; } } while (0)
    PG8_STAMP();
    unsigned voffA[2], voffB[2];
#pragma unroll
    for (int i = 0; i < 2; ++i) { int R, C; stage_rc(tid * 16 + i * 8192, R, C); const int Rb = Epi::PERM ? ((R & ~31) + perm32(R & 31)) : R;
        voffA[i] = (unsigned)(R * K + C) * 2u; voffB[i] = (unsigned)(Rb * K + C) * 2u; }
    const size_t kstep = (size_t)(BK * 2);
    const size_t hstep = (size_t)HALF * K * 2;
    const size_t tstep = 2 * hstep;
    const unsigned ldsw = (unsigned)wid * 1024u;
    const int aoff = lds_byte(wr * 64 + fr, fq * 8), boff = lds_byte(wc * 32 + fr, fq * 8);
#define PG8_SA(b, h) (((b) * 2 + (h)) * HTB)
#define PG8_SB(b, h) ((4 + (b) * 2 + (h)) * HTB)
#define PG8_STAGE(bufoff, gbase, voff) do { _Pragma("unroll") for (int _i = 0; _i < 2; ++_i) \
        __builtin_amdgcn_global_load_lds((const unsigned*)((const char*)(gbase) + (voff)[_i]), (PG8_LAS unsigned*)(lds + (bufoff) + ldsw + _i * 8192), 16, 0, 0); } while (0)
#define PG8_LDA(dst, b, h) do { _Pragma("unroll") for (int m = 0; m < 4; ++m) _Pragma("unroll") for (int k = 0; k < 2; ++k) dst[m][k] = *(const PG8_LAS bf16x8*)(lds + PG8_SA(b, h) + aoff + m * 2048 + k * 1024); } while (0)
#define PG8_LDB(dst, b, h) do { _Pragma("unroll") for (int n = 0; n < 2; ++n) _Pragma("unroll") for (int k = 0; k < 2; ++k) dst[n][k] = *(const PG8_LAS bf16x8*)(lds + PG8_SB(b, h) + boff + n * 2048 + k * 1024); } while (0)
#define PG8_MMA(ai, bj, At, Bt) do { __builtin_amdgcn_s_setprio(1); _Pragma("unroll") for (int m = 0; m < 4; ++m) _Pragma("unroll") for (int n = 0; n < 2; ++n) _Pragma("unroll") for (int k = 0; k < 2; ++k) \
        acc[ai][bj][m][n] = __builtin_amdgcn_mfma_f32_16x16x32_bf16(Bt[n][k], At[m][k], acc[ai][bj][m][n], 0, 0, 0); __builtin_amdgcn_s_setprio(0); } while (0)
#define PG8_WAIT_V(n) asm volatile("s_waitcnt vmcnt(" #n ")" ::: "memory")
#define PG8_WAIT_L(n) asm volatile("s_waitcnt lgkmcnt(" #n ")" ::: "memory")
#define PG8_BAR __builtin_amdgcn_s_barrier()
#define PG8_SCHED __builtin_amdgcn_sched_barrier(0)
    Unit cur, nxt; int ui = 0;
    if (!S.next(0, cur)) return;
    f32x4 acc[2][2][4][2];
#pragma unroll
    for (int a = 0; a < 2; ++a)
#pragma unroll
        for (int b = 0; b < 2; ++b)
#pragma unroll
            for (int m = 0; m < 4; ++m)
#pragma unroll
                for (int n = 0; n < 2; ++n) acc[a][b][m][n] = (f32x4){0.f, 0.f, 0.f, 0.f};
    bf16x8 At[4][2], B0[2][2], B1[2][2];
    const char* cA = (const char*)g.A + (size_t)cur.pm * tstep + (size_t)cur.koff; const char* cB = (const char*)g.Bt + (size_t)cur.pn * tstep + (size_t)cur.koff;
    S.a_ready(cur);
    PG8_STAGE(PG8_SB(0, 0), cB, voffB); PG8_STAGE(PG8_SA(0, 0), cA, voffA); PG8_STAGE(PG8_SB(0, 1), cB + hstep, voffB); PG8_STAGE(PG8_SA(0, 1), cA + hstep, voffA);
    if (wr == 1) PG8_BAR;
    PG8_WAIT_V(4); PG8_BAR;
    PG8_STAGE(PG8_SB(1, 0), cB + kstep, voffB); PG8_STAGE(PG8_SA(1, 0), cA + kstep, voffA); PG8_STAGE(PG8_SB(1, 1), cB + hstep + kstep, voffB);
    PG8_WAIT_V(6); PG8_BAR;
    PG8_STAMP();
    for (;;) {
        const bool has_next = S.next(ui + 1, nxt);
        const char* nA = has_next ? (const char*)g.A + (size_t)nxt.pm * tstep + (size_t)nxt.koff : cA; const char* nB = has_next ? (const char*)g.Bt + (size_t)nxt.pn * tstep + (size_t)nxt.koff : cB;
        const int nt = cur.nt;
        for (int t = 0; t < nt; t += 2) {
            const bool last = (t == nt - 2);
            const char* a1 = cA + (size_t)(t + 1) * kstep;
            const char* a2 = last ? nA : cA + (size_t)(t + 2) * kstep; const char* b2 = last ? nB : cB + (size_t)(t + 2) * kstep;
            const char* a3 = a2 + kstep; const char* b3 = b2 + kstep;
            if (last && has_next) S.a_ready(nxt);
            PG8_LDB(B0, 0, 0); PG8_SCHED; PG8_LDA(At, 0, 0); PG8_STAGE(PG8_SA(1, 1), a1 + hstep, voffA);
            PG8_WAIT_L(8); PG8_BAR; PG8_WAIT_L(0); PG8_MMA(0, 0, At, B0); PG8_BAR; PG8_SCHED;
            PG8_LDB(B1, 0, 1); PG8_STAGE(PG8_SB(0, 0), b2, voffB);
            PG8_BAR; PG8_WAIT_L(0); PG8_MMA(0, 1, At, B1); PG8_BAR;
            PG8_LDA(At, 0, 1); PG8_STAGE(PG8_SA(0, 0), a2, voffA);
            PG8_BAR; PG8_WAIT_L(0); PG8_MMA(1, 0, At, B0); PG8_BAR; PG8_SCHED;
            PG8_STAGE(PG8_SB(0, 1), b2 + hstep, voffB);
            PG8_WAIT_V(6); PG8_BAR; PG8_MMA(1, 1, At, B1); PG8_BAR;
            PG8_LDB(B0, 1, 0); PG8_SCHED; PG8_LDA(At, 1, 0); PG8_STAGE(PG8_SA(0, 1), a2 + hstep, voffA);
            PG8_WAIT_L(8); PG8_BAR; PG8_WAIT_L(0); PG8_MMA(0, 0, At, B0); PG8_BAR; PG8_SCHED;
            PG8_LDB(B1, 1, 1); PG8_STAGE(PG8_SB(1, 0), b3, voffB);
            PG8_BAR; PG8_WAIT_L(0); PG8_MMA(0, 1, At, B1); PG8_BAR;
            PG8_LDA(At, 1, 1); PG8_STAGE(PG8_SA(1, 0), a3, voffA);
            PG8_BAR; PG8_WAIT_L(0); PG8_MMA(1, 0, At, B0); PG8_BAR; PG8_SCHED;
            PG8_STAGE(PG8_SB(1, 1), b3 + hstep, voffB);
            PG8_WAIT_V(6); PG8_BAR; PG8_MMA(1, 1, At, B1); PG8_BAR;
        }
        PG8_STAMP();
        if constexpr (!Epi::AFTER_DRAIN) { E(acc, cur, wr, wc, fr, fq); S.done(cur); }
        PG8_STAMP();
        if (!has_next) break;
#pragma unroll
        for (int a = 0; a < 2; ++a)
#pragma unroll
            for (int b = 0; b < 2; ++b)
#pragma unroll
                for (int m = 0; m < 4; ++m)
#pragma unroll
                    for (int n = 0; n < 2; ++n) acc[a][b][m][n] = (f32x4){0.f, 0.f, 0.f, 0.f};
        cur = nxt; cA = nA; cB = nB; ++ui;
    }
    PG8_WAIT_V(0);
    if (wr == 0) PG8_BAR;
    PG8_BAR;
    if constexpr (Epi::AFTER_DRAIN) { E.fused(acc, cur, wr, wc, fr, fq, lds, wid, lane); S.done(cur); }
    PG8_STAMP();
    if (STAMP && wid == 0) { stamps[lane] = lane < nts ? (((unsigned long long)(unsigned)ts_hi << 32) | (unsigned)ts_lo) : 0ull;
        if (lane == 62) stamps[62] = rt_entry; if (lane == 63) stamps[63] = (unsigned long long)wall_clock64(); }
#undef PG8_STAMP
#undef PG8_SA
#undef PG8_SB
#undef PG8_STAGE
#undef PG8_LDA
#undef PG8_LDB
#undef PG8_MMA
#undef PG8_WAIT_V
#undef PG8_WAIT_L
#undef PG8_BAR
#undef PG8_SCHED
}
}
using pg8::bf16_t; using pg8::bf16x8; using pg8::f32x4; using pg8::u32x4; using pg8::Unit; using pg8::cvt_pk_bf16;
#define LAS __attribute__((address_space(3)))
typedef unsigned u32x2 __attribute__((ext_vector_type(2)));

constexpr int DM = 1024, DFF = 2816, MP = 16384, MS = 2048, MT = 18432, INWP = 2304, ZW = 2304;
constexpr int NTILE = 288;
constexpr float EPS = 1e-6f;
constexpr float QSCALE = 0.07216878364870322f * 1.4426950408889634f;
constexpr int ZQ = 0, ZKV = 384, ZPE = 640, ZHQ = 704, ZHF = 960, ZHI = 1216, ZHG = 1472, ZCU = 1728, ZCV = 1984;
constexpr size_t SZ_WGU = 4ull * 5632 * 1024 * 2, SZ_WDN = 4ull * 1024 * 2816 * 2, SZ_WIN = 2ull * 2304 * 1024 * 2, SZ_WQ = 2ull * 1280 * 384 * 2, SZ_WMIX = 2ull * 1024 * 1536 * 2;
constexpr size_t SKEW = 69888;
constexpr size_t OFF_WGU = 0, OFF_WDN = OFF_WGU + SZ_WGU + SKEW, OFF_WIN = OFF_WDN + SZ_WDN + SKEW, OFF_WQ = OFF_WIN + SZ_WIN + SKEW, OFF_WMIX = OFF_WQ + SZ_WQ + SKEW;
constexpr size_t OFF_X = OFF_WMIX + SZ_WMIX + SKEW, SZ_X = (size_t)MT * 1024 * 4;
constexpr size_t OFF_D = OFF_X + SZ_X + SKEW, SZ_D = (size_t)MT * 1024 * 2;
constexpr size_t OFF_H = OFF_D + SZ_D + SKEW, SZ_H = (size_t)MT * 1024 * 2;
constexpr size_t OFF_ACT = OFF_H + SZ_H + SKEW, SZ_ACT = (size_t)MT * 2816 * 2;
constexpr size_t KROWS = 16384 + 32 * 2112;
constexpr size_t OFF_KC = OFF_ACT + SZ_ACT + SKEW, SZ_KC = KROWS * 640;
constexpr size_t OFF_CT = OFF_KC + SZ_KC + SKEW, SZ_CT = KROWS * 512;
constexpr size_t OFF_MIXA = OFF_CT + SZ_CT + SKEW, SZ_MIXA = (size_t)MT * 1536 * 2;
constexpr size_t OFF_SST = OFF_MIXA + SZ_MIXA + SKEW, SZ_SST = 1024ull * 4096 * 4;
constexpr size_t OFF_ROPE = OFF_SST + SZ_SST + SKEW, SZ_ROPE = 4096ull * 32 * 8;
constexpr size_t OFF_CTL = OFF_ROPE + SZ_ROPE + SKEW, SZ_CTL = 32768;
constexpr size_t OFF_BCUM = OFF_CTL + SZ_CTL + SKEW, SZ_BCUM = (size_t)MT * 256 * 4;
constexpr size_t WS_END = OFF_BCUM + SZ_BCUM;
constexpr size_t OFF_Z = OFF_ACT, SZ_Z = (size_t)MT * ZW * 2;
constexpr size_t OFF_QN = OFF_Z + SZ_Z + SKEW;
constexpr size_t OFF_Q = OFF_X + 1048576 + SKEW;
constexpr size_t OFF_U = OFF_Q + (size_t)MT * 1280 * 2 + SKEW;
constexpr size_t OFF_DEC = OFF_U + 1152ull * 4096 * 4;
static_assert(OFF_QN + (size_t)MT * 384 * 2 <= OFF_ACT + SZ_ACT, "z/qn overlay");
static_assert(OFF_DEC + 1152ull * 64 * 4 <= OFF_X + SZ_X, "Q/U overlay");
constexpr size_t O_Y = 0, O_CKVP = 18874368, O_KPEP = 27262976, O_HGP = 29360128, O_CKVS = 29491200, O_KPES = 30539776, O_HGS = 30801920, O_CMV = 31850496;

constexpr int LDS_MAIN = 157696, LDS_BYTES = LDS_MAIN + 64;
constexpr int NPHASE = 25;

struct Args { const float* in[21]; float* out; unsigned char* ws; int ph_lo, ph_hi; };
typedef const __attribute__((address_space(4))) Args CArgs;

__device__ __forceinline__ int bid_() { int b = blockIdx.x; asm volatile("" : "+s"(b)); return b; }
__device__ __forceinline__ int gdim_() { int g = gridDim.x; asm volatile("" : "+s"(g)); return g; }
__device__ __forceinline__ float bf2f(unsigned short b) { return __uint_as_float(((unsigned)b) << 16); }
__device__ __forceinline__ float bflo(unsigned w) { return __uint_as_float(w << 16); }
__device__ __forceinline__ float bfhi(unsigned w) { return __uint_as_float(w & 0xffff0000u); }
__device__ __forceinline__ unsigned short f2bf(float f) { unsigned u = __float_as_uint(f); u += 0x7FFFu + ((u >> 16) & 1u); return (unsigned short)(u >> 16); }
__device__ __forceinline__ float wave_sum(float v) {
#pragma unroll
    for (int o = 32; o >= 1; o >>= 1) v += __shfl_xor(v, o);
    return v; }
__device__ __forceinline__ float sigmoidf_(float x) { return __builtin_amdgcn_rcpf(1.0f + __expf(-x)); }
__device__ __forceinline__ float siluf_(float x) { return x * sigmoidf_(x); }
__device__ __forceinline__ float geluf_(float x) { const float y = 0.7978845608028654f * (x + 0.044715f * x * x * x); return x - x * __builtin_amdgcn_rcpf(__expf(2.0f * y) + 1.0f); }

struct EpiBf {
    static constexpr bool PERM = true, AFTER_DRAIN = false;
    bf16_t* O; int ldc; bf16_t* O1;
    __device__ __forceinline__ void operator()(const f32x4 (&acc)[2][2][4][2], const Unit& u, int wr, int wc, int fr, int fq) const {
        const int row0 = u.pm * 256 + wr * 64 + fr, col0 = u.pn * 256 + wc * 32 + 8 * fq; bf16_t* Ob = (O1 && u.ks >= 0) ? O1 + ((long)u.ks * MS - MP) * (long)ldc : O;
#pragma unroll
        for (int ai = 0; ai < 2; ++ai)
#pragma unroll
            for (int m = 0; m < 4; ++m) { bf16_t* rowp = Ob + (size_t)(row0 + ai * 128 + m * 16) * ldc + col0;
#pragma unroll
                for (int bj = 0; bj < 2; ++bj) { const f32x4 v0 = acc[ai][bj][m][0], v1 = acc[ai][bj][m][1];
                    u32x4 w; w.x = cvt_pk_bf16(v0[0], v0[1]); w.y = cvt_pk_bf16(v0[2], v0[3]); w.z = cvt_pk_bf16(v1[0], v1[1]); w.w = cvt_pk_bf16(v1[2], v1[3]);
                    *(u32x4*)(rowp + bj * 128) = w; } }
    }
};
struct EpiSwiGLU {
    static constexpr bool PERM = true, AFTER_DRAIN = false;
    bf16_t* O;
    __device__ __forceinline__ void operator()(const f32x4 (&acc)[2][2][4][2], const Unit& u, int wr, int wc, int fr, int fq) const {
        const int row0 = u.pm * 256 + wr * 64 + fr, col0 = u.pn * 128 + wc * 32 + 8 * fq;
#pragma unroll
        for (int ai = 0; ai < 2; ++ai)
#pragma unroll
            for (int m = 0; m < 4; ++m) { bf16_t* rowp = O + (size_t)(row0 + ai * 128 + m * 16) * DFF + col0;
                const f32x4 g0 = acc[ai][0][m][0], g1 = acc[ai][0][m][1], u0 = acc[ai][1][m][0], u1 = acc[ai][1][m][1];
                u32x4 w; w.x = cvt_pk_bf16(siluf_(g0[0]) * u0[0], siluf_(g0[1]) * u0[1]); w.y = cvt_pk_bf16(siluf_(g0[2]) * u0[2], siluf_(g0[3]) * u0[3]);
                w.z = cvt_pk_bf16(siluf_(g1[0]) * u1[0], siluf_(g1[1]) * u1[1]); w.w = cvt_pk_bf16(siluf_(g1[2]) * u1[2], siluf_(g1[3]) * u1[3]);
                *(u32x4*)rowp = w; }
    }
};
struct EpiQ {
    static constexpr bool PERM = true, AFTER_DRAIN = false;
    bf16_t* Q;
    __device__ __forceinline__ void operator()(const f32x4 (&acc)[2][2][4][2], const Unit& u, int wr, int wc, int fr, int fq) const {
        const int row0 = u.pm * 256 + wr * 64 + fr;
        const int off0 = u.pn < 4 ? u.pn * 320 + wc * 32 + 8 * fq : wc * 320 + 256 + 8 * fq, bjs = u.pn < 4 ? 128 : 32;
#pragma unroll
        for (int ai = 0; ai < 2; ++ai)
#pragma unroll
            for (int m = 0; m < 4; ++m) { bf16_t* rowp = Q + (size_t)(row0 + ai * 128 + m * 16) * 1280 + off0;
#pragma unroll
                for (int bj = 0; bj < 2; ++bj) { const f32x4 v0 = acc[ai][bj][m][0], v1 = acc[ai][bj][m][1];
                    u32x4 w; w.x = cvt_pk_bf16(v0[0], v0[1]); w.y = cvt_pk_bf16(v0[2], v0[3]); w.z = cvt_pk_bf16(v1[0], v1[1]); w.w = cvt_pk_bf16(v1[2], v1[3]);
                    *(u32x4*)(rowp + bj * bjs) = w; } }
    }
};
struct TailSplitOrder {
    int G, c, nsp, nt_full, nt_sub, kb_sub;
    __device__ bool next(int i, Unit& u) const {
        const int L = i * G + c;
        if (L < 256) { const int off = L >> 3; u.pm = (L & 7) * 8 + (off >> 2); u.pn = off & 3; u.ks = -1; u.nt = nt_full; u.koff = 0; return true; }
        const int s2 = L - 256; if (s2 >= 32 * nsp) return false;
        const int pair = s2 & 31; u.pm = 64 + (pair >> 2); u.pn = pair & 3; u.ks = s2 >> 5; u.nt = nt_sub; u.koff = u.ks * kb_sub; return true;
    }
    __device__ __forceinline__ void a_ready(const Unit&) const {}
    __device__ __forceinline__ void done(const Unit&) const {}
};
template <class Epi> __device__ __forceinline__ void run_gemm(unsigned char* lds, const bf16_t* A, const bf16_t* Bt, int M, int N, int K, const Epi& E, int nsp = 0  ) {
    pg8::Gemm g{A, Bt, M, N, K, K};
    if (nsp) { TailSplitOrder S; S.G = gdim_(); S.c = bid_(); S.nsp = nsp; S.nt_full = K / 64; S.nt_sub = K / nsp / 64; S.kb_sub = K / nsp * 2; pg8::gemm_phase<Epi, TailSplitOrder, false>((PG8_LAS unsigned char*)lds, g, S, E, nullptr); }
    else { pg8::StaticOrder S; S.init(M, N, gdim_(), bid_(), 1); S.unt = K / 64; S.ukb = K * 2; pg8::gemm_phase<Epi, pg8::StaticOrder, false>((PG8_LAS unsigned char*)lds, g, S, E, nullptr); }
}
#define GAS __attribute__((address_space(1)))
#define XB_TMO      128
#define XB_XCNT(j)  (256  + 64 * (j))
#define XB_XSUB(j)  (1280 + 64 * (j))
#define XB_XGEN(j)  (2304 + 64 * (j))
#define XB_TOP      3328
#define XB_TOPGEN   3392
#define XCD_BAR_WORDS 3456
#define XB_SPIN_CAP (1u << 18)

__device__ __forceinline__ unsigned xb_ld(unsigned* p)              { return __hip_atomic_load(p, __ATOMIC_RELAXED, __HIP_MEMORY_SCOPE_AGENT); }
__device__ __forceinline__ unsigned xb_add(unsigned* p, unsigned v) { return __hip_atomic_fetch_add(p, v, __ATOMIC_RELAXED, __HIP_MEMORY_SCOPE_AGENT); }
__device__ __forceinline__ unsigned xb_xcc_id() { return (unsigned)__builtin_amdgcn_s_getreg((3 << 11) | 20) & 0xFu; }
#define XB_SPIN(cond, bar) do { unsigned _sp = 0; while (cond) { __builtin_amdgcn_s_sleep(1); \
    if ((++_sp & 255u) == 0u) { if (xb_ld(&(bar)[XB_TMO])) break; if (_sp > XB_SPIN_CAP) { atomicAdd(&(bar)[XB_TMO], 1u); break; } } } } while (0)

struct XcdBarrier {
    unsigned* bar; unsigned x;
    volatile LAS unsigned* st;
};

__device__ __forceinline__ XcdBarrier xcd_barrier_post(unsigned* bar, volatile LAS unsigned* st) {
    XcdBarrier b; b.bar = bar; b.x = xb_xcc_id(); b.st = st;
    if (threadIdx.x == 0) (void)xb_add(&bar[XB_XCNT(b.x)], 1u);
    return b;
}
__device__ __forceinline__ void xcd_barrier_complete(unsigned* bar, unsigned x, unsigned& nloc, unsigned& nx) {
    const unsigned G = gridDim.x * gridDim.y * gridDim.z;
    unsigned sum, cnt, mine, sp = 0u;
    for (;;) {
        sum = 0u; cnt = 0u; mine = 0u;
#pragma unroll
        for (unsigned j = 0; j < 16; ++j) { const unsigned c = xb_ld(&bar[XB_XCNT(j)]); sum += c; cnt += (c > 0u) ? 1u : 0u; mine = (j == x) ? c : mine; }
        if (sum == G) break;
        __builtin_amdgcn_s_sleep(1);
        if ((++sp & 255u) == 0u) { if (xb_ld(&bar[XB_TMO])) break; if (sp > XB_SPIN_CAP) { atomicAdd(&bar[XB_TMO], 1u); break; } }
    }
    nloc = mine > 0u ? mine : 1u; nx = cnt > 0u ? cnt : 1u;
}

__device__ __forceinline__ void xcd_barrier(const XcdBarrier& b) {
    asm volatile("s_waitcnt vmcnt(0)" ::: "memory");
    __syncthreads();
    if (threadIdx.x == 0) {
        unsigned* bar = b.bar; asm volatile("" : "+s"(bar));
        __builtin_amdgcn_s_waitcnt(0);
        unsigned nloc = b.st[0], nx = b.st[1];
        if (nloc == 0u) { xcd_barrier_complete(bar, b.x, nloc, nx); b.st[0] = nloc; b.st[1] = nx; }
        const unsigned old = xb_add(&bar[XB_XSUB(b.x)], 1u);
        const unsigned gen = old / nloc;
        if (old + 1u == (gen + 1u) * nloc) {
            __builtin_amdgcn_fence(__ATOMIC_RELEASE, "agent");
            asm volatile("s_waitcnt vmcnt(0)" ::: "memory");
            const unsigned og = xb_add(&bar[XB_TOP], 1u);
            const unsigned tg = og / nx;
            if (og + 1u == (tg + 1u) * nx) xb_add(&bar[XB_TOPGEN], 1u);
            else XB_SPIN(xb_ld(&bar[XB_TOPGEN]) == tg, bar);
            __builtin_amdgcn_fence(__ATOMIC_ACQUIRE, "agent");
            xb_add(&bar[XB_XGEN(b.x)], 1u);
            asm volatile("s_waitcnt vmcnt(0)" ::: "memory");
        } else {
            XB_SPIN(xb_ld(&bar[XB_XGEN(b.x)]) == gen, bar);
            __builtin_amdgcn_fence(__ATOMIC_ACQUIRE, "agent");
            asm volatile("s_waitcnt vmcnt(0)" ::: "memory");
        }
    }
    __syncthreads();
}
__device__ __forceinline__ void tr_tile(const float* __restrict__ src, int srcN, bf16_t* __restrict__ dst, int dstK, int k0, int n0, int mode, float* T) {
    int tid = threadIdx.x; asm volatile("" : "+v"(tid));
    float4 v[4];
#pragma unroll
    for (int e = 0; e < 4; ++e) { const int idx = tid + 512 * e, kk = idx >> 4, n4 = idx & 15; v[e] = *(const float4*)(src + (size_t)(k0 + kk) * srcN + n0 + 4 * n4); }
#pragma unroll
    for (int e = 0; e < 4; ++e) { const int idx = tid + 512 * e, kk = idx >> 4, n4 = idx & 15; float* t = T + kk * 65 + 4 * n4; t[0] = v[e].x; t[1] = v[e].y; t[2] = v[e].z; t[3] = v[e].w; }
    __syncthreads();
#pragma unroll
    for (int e = 0; e < 2; ++e) { const int idx = tid + 512 * e, nn = idx >> 4, kq = idx & 15; const int n = n0 + nn;
        const int row = mode == 0 ? n : ((n >> 7) * 256 + (n & 127) + (mode == 2 ? 128 : 0)); const float* t = T + (8 * kq) * 65 + nn;
        u32x4 w; w.x = cvt_pk_bf16(t[0], t[65]); w.y = cvt_pk_bf16(t[130], t[195]); w.z = cvt_pk_bf16(t[260], t[325]); w.w = cvt_pk_bf16(t[390], t[455]);
        *(u32x4*)(dst + (size_t)row * dstK + k0 + 8 * kq) = w; }
    __syncthreads();
}
__device__ __forceinline__ void tr_task(const float* src, int srcN, int K, bf16_t* dst, int dstK, int mode, float* T) {
    const int tn = srcN >> 6, nt = (K >> 7) * tn;
    for (int t = bid_(); t < nt; t += gdim_()) tr_tile(src, srcN, dst, dstK, (t / tn) * 128, (t % tn) * 64, mode, T);
}
template <bool XIN_F32, bool XOUT_F32>
__device__ __forceinline__ void ew_phase(const bf16_t* __restrict__ D, const bf16_t* D1  , int nsp, const void* xa  , const float* __restrict__ xb  , void* xout  ,
                                         const float* __restrict__ gpost, float coef, const float* __restrict__ gpre, bf16_t* hout, const float* __restrict__ gin, float* rsb  ) {
    int tid = threadIdx.x; asm volatile("" : "+v"(tid)); const int lane = tid & 63, wave = tid >> 6;
    const int rstep = gdim_() * 8;
    for (int rb = bid_() * 8 + wave; rb < MT; rb += 2 * rstep) {
        float4 xv[2][4]; float dv[2][4][4];
#pragma unroll
        for (int u = 0; u < 2; ++u) { const int r = rb + u * rstep; if (r < MT) {
            if (XIN_F32) { const float* xr = (xb && r >= MP) ? xb + (size_t)(r - MP) * DM : (const float*)xa + (size_t)r * DM;
#pragma unroll
                for (int i = 0; i < 4; ++i) xv[u][i] = *(const float4*)(xr + lane * 4 + 256 * i); }
            else {
#pragma unroll
                for (int i = 0; i < 4; ++i) { const uint2 w = *(const uint2*)((const bf16_t*)xa + (size_t)r * DM + lane * 4 + 256 * i); xv[u][i] = make_float4(bflo(w.x), bfhi(w.x), bflo(w.y), bfhi(w.y)); }
                const float ir = __builtin_amdgcn_rcpf(rsb[r]);
#pragma unroll
                for (int i = 0; i < 4; ++i) { const float4 gi = *(const float4*)(gin + lane * 4 + 256 * i);
                    xv[u][i].x *= ir * __builtin_amdgcn_rcpf(gi.x); xv[u][i].y *= ir * __builtin_amdgcn_rcpf(gi.y); xv[u][i].z *= ir * __builtin_amdgcn_rcpf(gi.z); xv[u][i].w *= ir * __builtin_amdgcn_rcpf(gi.w); } }
            if (D) {
#pragma unroll
                for (int i = 0; i < 4; ++i) { const uint2 w = *(const uint2*)(D + (size_t)r * DM + lane * 4 + 256 * i); dv[u][i][0] = bflo(w.x); dv[u][i][1] = bfhi(w.x); dv[u][i][2] = bflo(w.y); dv[u][i][3] = bfhi(w.y);
                    } } } }
        if (D1) {
#pragma unroll
            for (int u = 0; u < 2; ++u) { const int r = rb + u * rstep; if (r >= MP && r < MT) {
#pragma unroll
                for (int i = 0; i < 4; ++i) { dv[u][i][0] = 0.f; dv[u][i][1] = 0.f; dv[u][i][2] = 0.f; dv[u][i][3] = 0.f; }
                for (int ks = 0; ks < nsp; ++ks) {
#pragma unroll
                    for (int i = 0; i < 4; ++i) { const uint2 w1 = *(const uint2*)(D1 + ((size_t)ks * MS + (r - MP)) * DM + lane * 4 + 256 * i); dv[u][i][0] += bflo(w1.x); dv[u][i][1] += bfhi(w1.x); dv[u][i][2] += bflo(w1.y); dv[u][i][3] += bfhi(w1.y); } } } } }
#pragma unroll
        for (int u = 0; u < 2; ++u) { const int r = rb + u * rstep; if (r < MT) {
            if (D) { float ss = 0.f;
#pragma unroll
                for (int i = 0; i < 4; ++i) ss += dv[u][i][0] * dv[u][i][0] + dv[u][i][1] * dv[u][i][1] + dv[u][i][2] * dv[u][i][2] + dv[u][i][3] * dv[u][i][3];
                ss = wave_sum(ss); const float rs = coef * rsqrtf(ss * (1.0f / 1024.0f) + EPS);
#pragma unroll
                for (int i = 0; i < 4; ++i) { const float4 g = *(const float4*)(gpost + lane * 4 + 256 * i);
                    xv[u][i].x += dv[u][i][0] * rs * g.x; xv[u][i].y += dv[u][i][1] * rs * g.y; xv[u][i].z += dv[u][i][2] * rs * g.z; xv[u][i].w += dv[u][i][3] * rs * g.w; } }
            if (XOUT_F32) {
#pragma unroll
                for (int i = 0; i < 4; ++i) *(float4*)((float*)xout + (size_t)r * DM + lane * 4 + 256 * i) = xv[u][i]; }

            if (hout) { float ss = 0.f;
#pragma unroll
                for (int i = 0; i < 4; ++i) ss += xv[u][i].x * xv[u][i].x + xv[u][i].y * xv[u][i].y + xv[u][i].z * xv[u][i].z + xv[u][i].w * xv[u][i].w;
                ss = wave_sum(ss); const float rs = rsqrtf(ss * (1.0f / 1024.0f) + EPS); if (lane == 0) rsb[r] = rs;
#pragma unroll
                for (int i = 0; i < 4; ++i) { const float4 g = *(const float4*)(gpre + lane * 4 + 256 * i); uint2 w;
                    w.x = cvt_pk_bf16(xv[u][i].x * rs * g.x, xv[u][i].y * rs * g.y); w.y = cvt_pk_bf16(xv[u][i].z * rs * g.z, xv[u][i].w * rs * g.w);
                    *(uint2*)(hout + (size_t)r * DM + lane * 4 + 256 * i) = w; } } } }
    }
}
__device__ __forceinline__ int wtask_count(int kind) { return kind < 6 ? 352 : kind == 6 ? 281 : kind == 7 ? 64 : kind == 8 ? 256 : kind == 9 ? 96 : 192; }
__device__ void wtask_run(CArgs& a, int l, int kind, int t, unsigned char* lds) {
    unsigned char* ws = a.ws; float* T = (float*)lds; int tid = threadIdx.x; asm volatile("" : "+v"(tid));
    if (kind < 6) { const int f = kind / 3, m = kind % 3; const size_t lf = (size_t)(l * 2 + f);
        if (m < 2) tr_tile(a.in[6 + m] + lf * 1024 * 2816, 2816, (bf16_t*)(ws + OFF_WGU) + lf * 5632 * 1024, 1024, (t / 44) * 128, (t % 44) * 64, 1 + m, T);
        else tr_tile(a.in[8] + lf * 2816 * 1024, 1024, (bf16_t*)(ws + OFF_WDN) + lf * 1024 * 2816, 2816, (t / 16) * 128, (t % 16) * 64, 0, T);
    } else if (kind == 6) { bf16_t* win = (bf16_t*)(ws + OFF_WIN) + (size_t)l * 2304 * 1024;
        if (t < 280) tr_tile(a.in[9] + (size_t)l * 1024 * 2240, 2240, win, 1024, (t / 35) * 128, (t % 35) * 64, 0, T);
        else { for (int i = tid; i < 64 * 1024 / 2; i += 512) ((unsigned*)(win + 2240 * 1024))[i] = 0u; }
    } else if (kind == 7) { bf16_t* wmix = (bf16_t*)(ws + OFF_WMIX) + (size_t)l * 1024 * 1536;
        tr_tile(a.in[10] + (size_t)l * 1024 * 1024 + 512 * 1024, 1024, wmix + 1024, 1536, (t / 16) * 128, (t % 16) * 64, 0, T);
    } else if (kind == 8) {
        bf16_t* wmix = (bf16_t*)(ws + OFF_WMIX) + (size_t)l * 1024 * 1536; const float* wuv = a.in[15] + (size_t)l * 256 * 512; const float* wo = a.in[10] + (size_t)l * 1024 * 1024;
        const int i = t * 512 + tid; const int n = i & 1023, hcb = t >> 1, h = hcb >> 5, cb = hcb & 31;
        float* W = T;
        __syncthreads();
#pragma unroll
        for (int e = 0; e < 2; ++e) { const int q = tid + 512 * e, j = q >> 7, v = q & 127; W[v * 8 + j] = wuv[((8 * cb + j) * 4 + h) * 128 + v]; }
        __syncthreads();
        const float* bv = wo + (size_t)(h * 128) * 1024 + n; float acc[8];
#pragma unroll
        for (int j = 0; j < 8; ++j) acc[j] = 0.f;
#pragma unroll 1
        for (int v0 = 0; v0 < 128; v0 += 16) { float bb[16];
#pragma unroll
            for (int u = 0; u < 16; ++u) bb[u] = bv[(size_t)(v0 + u) * 1024];
#pragma unroll
            for (int u = 0; u < 16; ++u) { const float4 w0 = *(const float4*)(W + (v0 + u) * 8), w1 = *(const float4*)(W + (v0 + u) * 8 + 4);
                acc[0] += w0.x * bb[u]; acc[1] += w0.y * bb[u]; acc[2] += w0.z * bb[u]; acc[3] += w0.w * bb[u]; acc[4] += w1.x * bb[u]; acc[5] += w1.y * bb[u]; acc[6] += w1.z * bb[u]; acc[7] += w1.w * bb[u]; } }
        u32x4 w; w.x = cvt_pk_bf16(acc[0], acc[1]); w.y = cvt_pk_bf16(acc[2], acc[3]); w.z = cvt_pk_bf16(acc[4], acc[5]); w.w = cvt_pk_bf16(acc[6], acc[7]);
        *(u32x4*)(wmix + (size_t)n * 1536 + h * 256 + 8 * cb) = w;
        __syncthreads();
    } else { bf16_t* wq = (bf16_t*)(ws + OFF_WQ) + (size_t)l * 1280 * 384; const float* wuk = a.in[14] + (size_t)l * 256 * 512; const float* wqb = a.in[12] + (size_t)l * 384 * 768;
        const int i = t * 512 + tid;
        if (kind == 9) {
            const int k = i % 384, hcb = i / 384, h = hcb >> 5, cb = hcb & 31;
            const float4* bv = (const float4*)(wqb + (size_t)k * 768 + h * 192); float acc[8];
#pragma unroll
            for (int j = 0; j < 8; ++j) acc[j] = 0.f;
#pragma unroll 2
            for (int v = 0; v < 32; ++v) { const float4 y = bv[v];
#pragma unroll
                for (int j = 0; j < 8; ++j) { const float4 x = *(const float4*)(wuk + ((8 * cb + j) * 4 + h) * 128 + 4 * v); acc[j] += x.x * y.x + x.y * y.y + x.z * y.z + x.w * y.w; } }
#pragma unroll
            for (int j = 0; j < 8; ++j) wq[(size_t)(h * 256 + 8 * cb + j) * 384 + k] = f2bf(acc[j] * QSCALE);
        } else {
            const int k = i % 384, j = i / 384, half = j >> 7, jj = j & 127, h = jj >> 5, fi = jj & 31;
            wq[(size_t)(1024 + j) * 384 + k] = f2bf(wqb[(size_t)k * 768 + h * 192 + 128 + half * 32 + fi] * QSCALE); }
    }
}
__device__ void wtasks(CArgs& a, int l, int k0, int k1, int cw, unsigned char* lds) {
    unsigned* ctr = (unsigned*)(a.ws + OFF_CTL) + cw; LAS unsigned* slot = (LAS unsigned*)(lds + LDS_MAIN + 16);
    int total = 0; for (int k = k0; k < k1; ++k) total += wtask_count(k);
    unsigned nxt = 0u; { int t0 = threadIdx.x; asm volatile("" : "+v"(t0)); if (t0 == 0) nxt = atomicAdd(ctr, 1u); }
    for (;;) {
        __syncthreads();
        { int t0 = threadIdx.x; asm volatile("" : "+v"(t0)); if (t0 == 0) *slot = nxt; }
        __syncthreads();
        int it = (int)*slot;
        if (it >= total) break;
        { int t0 = threadIdx.x; asm volatile("" : "+v"(t0)); if (t0 == 0) nxt = atomicAdd(ctr, 1u); }
        int k = k0; while (it >= wtask_count(k)) { it -= wtask_count(k); ++k; }
        wtask_run(a, l, k, it, lds);
    }
}
__device__ void phase_init(CArgs& a, unsigned char* lds) {
    unsigned char* ws = a.ws;
    int tid = threadIdx.x; asm volatile("" : "+v"(tid)); const size_t gtid = (size_t)bid_() * 512 + tid, gsz = (size_t)gdim_() * 512;
    for (size_t i = gtid; i < 4096 * 32; i += gsz) { const int pos = (int)(i >> 5), fi = (int)(i & 31);
        const float w = exp2f(-(float)fi * (13.287712379549449f / 32.0f)); const double ang = (double)((float)pos * w);
        const double k = rint(ang * 0.15915494309189535); const float rr = (float)(ang - k * 6.283185307179586);
        ((float2*)(ws + OFF_ROPE))[i] = make_float2(__cosf(rr), __sinf(rr)); }
    wtasks(a, 0, 0, 3, 256, lds); wtasks(a, 0, 6, 7, 272, lds);
    ew_phase<true, false>(nullptr, nullptr, 0, a.in[0], a.in[1], nullptr, nullptr, 0.f, a.in[5], (bf16_t*)(ws + OFF_H), nullptr, (float*)(ws + OFF_X));
}
__device__ void tail_wtasks(CArgs& a, int ph, unsigned char* lds) {
    switch (ph) {
    case 1:  wtasks(a, 0, 10, 11, 257, lds); wtasks(a, 0, 7, 8, 258, lds); break;
    case 2:  wtasks(a, 0, 3, 4, 259, lds); break;
    case 4:  wtasks(a, 0, 9, 10, 260, lds); wtasks(a, 0, 4, 5, 261, lds); break;
    case 6:  wtasks(a, 0, 8, 9, 262, lds); break;
    case 8:  wtasks(a, 0, 5, 6, 263, lds); break;
    case 10: wtasks(a, 1, 0, 3, 264, lds); wtasks(a, 1, 6, 7, 265, lds); wtasks(a, 1, 9, 10, 266, lds); break;
    case 11: wtasks(a, 1, 10, 11, 267, lds); wtasks(a, 1, 7, 8, 268, lds); break;
    case 14: wtasks(a, 1, 3, 4, 269, lds); break;
    case 16: wtasks(a, 1, 4, 6, 270, lds); break;
    case 18: wtasks(a, 1, 8, 9, 271, lds); break;
    default: break; }
}
__device__ __forceinline__ int keyof32(int p) { const int g = p >> 3, j = p & 7; return j < 4 ? 4 * g + j : 16 + 4 * g + (j - 4); }
__device__ __forceinline__ void ct_write(const bf16_t* ctile, bf16_t* dst  , size_t rowstride) {
    int tid = threadIdx.x; asm volatile("" : "+v"(tid)); const int c = tid >> 1, half = tid & 1;
    unsigned w[16];
#pragma unroll
    for (int p = 0; p < 32; p += 2) { const int t0 = 32 * half + keyof32(p), t1 = 32 * half + keyof32(p + 1);
        w[p >> 1] = (unsigned)ctile[t0 * 264 + c] | ((unsigned)ctile[t1 * 264 + c] << 16); }
    uint4* d = (uint4*)(dst + (size_t)c * rowstride + 32 * half);
#pragma unroll
    for (int i = 0; i < 4; ++i) d[i] = make_uint4(w[4 * i], w[4 * i + 1], w[4 * i + 2], w[4 * i + 3]);
}
__device__ __forceinline__ float lb_of(CArgs& a, int l, int e) { if (l == 0) return 0.f; const float a0 = a.in[16][e], a1 = a.in[16][256 + e]; return 1.0f / (1.0f + __expf(a0 - a1)); }
__device__ void prep_mla_tile(CArgs& a, int l, int T, unsigned char* lds) {
    unsigned char* ws = a.ws; int tid = threadIdx.x; asm volatile("" : "+v"(tid)); const int lane = tid & 63, wave = tid >> 6;
    const bf16_t* z = (const bf16_t*)(ws + OFF_Z); const int r0 = T * 64;
    const bool prm = T < 256; const int b = prm ? (T >> 6) : (T - 256), j = prm ? (T & 63) : 0; const int pos0 = prm ? j * 64 : 2048;
    bf16_t* kc = (bf16_t*)(ws + OFF_KC) + (prm ? (size_t)(b * 4096 + j * 64) : (size_t)16384 + (size_t)b * 2112 + 2048) * 320;
    bf16_t* ct = (bf16_t*)(ws + OFF_CT) + (prm ? (size_t)b * 256 * 4096 + j * 64 : (size_t)16384 * 256 + (size_t)b * 256 * 2112 + 2048);
    const size_t ctstride = prm ? 4096 : 2112;
    float* ockv = a.out + (prm ? O_CKVP + ((size_t)(l * 4 + b) * 4096 + j * 64) * 256 : O_CKVS + ((size_t)(l * 32 + b) * 64) * 256);
    float* okpe = a.out + (prm ? O_KPEP + ((size_t)(l * 4 + b) * 4096 + j * 64) * 64 : O_KPES + ((size_t)(l * 32 + b) * 64) * 64);
    bf16_t* qn = (bf16_t*)(ws + OFF_QN); const float* qag = a.in[11] + l * 384; const float* kvg = a.in[13] + l * 256;
    const float2* rope = (const float2*)(ws + OFF_ROPE);
    bf16_t* ctile = (bf16_t*)lds;
    float qg[6];
#pragma unroll
    for (int i = 0; i < 3; ++i) { qg[2 * i] = qag[2 * lane + 128 * i]; qg[2 * i + 1] = qag[2 * lane + 128 * i + 1]; }
    const float4 g4 = *(const float4*)(kvg + 4 * lane);
#pragma unroll 1
    for (int tb = 0; tb < 8; tb += 4) {
        unsigned wq[4][3]; uint2 wk[4]; bf16_t p1[4], p2[4];
#pragma unroll
        for (int u = 0; u < 4; ++u) { const bf16_t* zr = z + (size_t)(r0 + wave + 8 * (tb + u)) * ZW;
#pragma unroll
            for (int i = 0; i < 3; ++i) wq[u][i] = *(const unsigned*)(zr + ZQ + 2 * lane + 128 * i);
            wk[u] = *(const uint2*)(zr + ZKV + 4 * lane); p1[u] = zr[ZPE + (lane & 31)]; p2[u] = zr[ZPE + 32 + (lane & 31)]; }
#pragma unroll
        for (int u = 0; u < 4; ++u) { const int t = wave + 8 * (tb + u);
            { float v[6]; float ss = 0.f;
#pragma unroll
              for (int i = 0; i < 3; ++i) { v[2 * i] = bflo(wq[u][i]); v[2 * i + 1] = bfhi(wq[u][i]); ss += v[2 * i] * v[2 * i] + v[2 * i + 1] * v[2 * i + 1]; }
              ss = wave_sum(ss); const float rs = rsqrtf(ss * (1.0f / 384.0f) + EPS);
#pragma unroll
              for (int i = 0; i < 3; ++i) *(unsigned*)(qn + (size_t)(r0 + t) * 384 + 2 * lane + 128 * i) = cvt_pk_bf16(v[2 * i] * rs * qg[2 * i], v[2 * i + 1] * rs * qg[2 * i + 1]); }
            { float v0 = bflo(wk[u].x), v1 = bfhi(wk[u].x), v2 = bflo(wk[u].y), v3 = bfhi(wk[u].y);
              const float ss = wave_sum(v0 * v0 + v1 * v1 + v2 * v2 + v3 * v3); const float rs = rsqrtf(ss * (1.0f / 256.0f) + EPS);
              v0 *= rs * g4.x; v1 *= rs * g4.y; v2 *= rs * g4.z; v3 *= rs * g4.w;
              *(float4*)(ockv + (size_t)t * 256 + 4 * lane) = make_float4(v0, v1, v2, v3);
              uint2 o; o.x = cvt_pk_bf16(v0, v1); o.y = cvt_pk_bf16(v2, v3);
              *(uint2*)(kc + (size_t)t * 320 + 4 * lane) = o; *(uint2*)(ctile + t * 264 + 4 * lane) = o; }
            if (lane < 32) { const float x1 = bf2f(p1[u]), x2 = bf2f(p2[u]); const float2 cs = rope[(pos0 + t) * 32 + lane];
              const float o1 = x1 * cs.x - x2 * cs.y, o2 = x2 * cs.x + x1 * cs.y;
              okpe[(size_t)t * 64 + lane] = o1; okpe[(size_t)t * 64 + 32 + lane] = o2; kc[(size_t)t * 320 + 256 + lane] = f2bf(o1); kc[(size_t)t * 320 + 288 + lane] = f2bf(o2); } }
    }
    __syncthreads();
    ct_write(ctile, ct, ctstride);
    __syncthreads();
}
__device__ void prep_hgrn_tile(CArgs& a, int l, int T, unsigned char* lds) {
    unsigned char* ws = a.ws; int tid = threadIdx.x; asm volatile("" : "+v"(tid)); asm volatile("" : "+s"(l));
    const bf16_t* z = (const bf16_t*)(ws + OFF_Z); const int r0 = T * 64;
    float* lf = (float*)lds; float* vt = (float*)(lds + 65536); float* tot = (float*)(lds + 131072);
    const int ep = tid & 255, hf = tid >> 8; const float lbv = lb_of(a, l, ep);
    bf16_t zfr[32]; float pref[32];
    { bf16_t zvr[32];
#pragma unroll
      for (int i = 0; i < 32; ++i) { const bf16_t* zr = z + (size_t)(r0 + 32 * hf + i) * ZW; zfr[i] = zr[ZHF + ep]; zvr[i] = zr[ZHI + ep]; }
      float run = 0.f;
#pragma unroll
      for (int i = 0; i < 32; ++i) { const float f = lbv + (1.0f - lbv) * sigmoidf_(bf2f(zfr[i])); run += __logf(fmaxf(f, 1e-30f)); pref[i] = run; vt[(32 * hf + i) * 256 + ep] = bf2f(zvr[i]); }
      tot[hf * 256 + ep] = run; }
    __syncthreads();
    { const float t0 = tot[ep], bl = t0 + tot[256 + ep], off = hf ? t0 : 0.f;
#pragma unroll
      for (int i = 0; i < 32; ++i) { lf[(32 * hf + i) * 256 + ep] = (1.0f - lbv) * sigmoidf_(-bf2f(zfr[i])) * __expf(bl - pref[i] - off); ((float*)(ws + OFF_BCUM))[(size_t)(r0 + 32 * hf + i) * 256 + ep] = pref[i] + off; }
      if (hf == 0) ((float*)(ws + OFF_DEC))[T * 256 + ep] = __expf(bl); }
    __syncthreads();
    { const int h = tid >> 7, eb = (tid & 127) >> 3, db = tid & 7; float acc[4][8];
#pragma unroll
      for (int i = 0; i < 4; ++i)
#pragma unroll
          for (int jj = 0; jj < 8; ++jj) acc[i][jj] = 0.f;
#pragma unroll 4
      for (int s = 0; s < 64; ++s) { const float4 kv = *(const float4*)(lf + s * 256 + h * 64 + eb * 4); const float4 v0 = *(const float4*)(vt + s * 256 + h * 64 + db * 8), v1 = *(const float4*)(vt + s * 256 + h * 64 + db * 8 + 4);
          const float kk[4] = {kv.x, kv.y, kv.z, kv.w}; const float vv[8] = {v0.x, v0.y, v0.z, v0.w, v1.x, v1.y, v1.z, v1.w};
#pragma unroll
          for (int i = 0; i < 4; ++i)
#pragma unroll
              for (int jj = 0; jj < 8; ++jj) acc[i][jj] += kk[i] * vv[jj]; }
      float* U = (float*)(ws + OFF_U) + (size_t)(T * 4 + h) * 4096;
#pragma unroll
      for (int i = 0; i < 4; ++i) { *(float4*)(U + (eb * 4 + i) * 64 + db * 8) = make_float4(acc[i][0], acc[i][1], acc[i][2], acc[i][3]); *(float4*)(U + (eb * 4 + i) * 64 + db * 8 + 4) = make_float4(acc[i][4], acc[i][5], acc[i][6], acc[i][7]); } }
    __syncthreads();
}
__device__ void prep_cache_tile(CArgs& a, int l, int P, unsigned char* lds) {
    unsigned char* ws = a.ws; int tid = threadIdx.x; asm volatile("" : "+v"(tid)); const int b = P >> 5, kt = P & 31;
    const float* ckv = a.in[2] + ((size_t)(l * 32 + b) * 2048 + kt * 64) * 256; const float* kpe = a.in[3] + ((size_t)(l * 32 + b) * 2048 + kt * 64) * 64;
    bf16_t* kc = (bf16_t*)(ws + OFF_KC) + ((size_t)16384 + (size_t)b * 2112 + kt * 64) * 320;
    bf16_t* ct = (bf16_t*)(ws + OFF_CT) + (size_t)16384 * 256 + (size_t)b * 256 * 2112 + kt * 64;
    bf16_t* ctile = (bf16_t*)lds;
#pragma unroll
    for (int i = 0; i < 8; ++i) { const int q = tid + 512 * i, t = q >> 6, c4 = q & 63; const float4 v = *(const float4*)(ckv + (size_t)t * 256 + c4 * 4);
        uint2 o; o.x = cvt_pk_bf16(v.x, v.y); o.y = cvt_pk_bf16(v.z, v.w); *(uint2*)(kc + (size_t)t * 320 + c4 * 4) = o; *(uint2*)(ctile + t * 264 + c4 * 4) = o; }
#pragma unroll
    for (int i = 0; i < 2; ++i) { const int q = tid + 512 * i, t = q >> 4, c4 = q & 15; const float4 v = *(const float4*)(kpe + (size_t)t * 64 + c4 * 4);
        uint2 o; o.x = cvt_pk_bf16(v.x, v.y); o.y = cvt_pk_bf16(v.z, v.w); *(uint2*)(kc + (size_t)t * 320 + 256 + c4 * 4) = o; }
    __syncthreads();
    ct_write(ctile, ct, 2112);
    __syncthreads();
}
__device__ void phase_prep(CArgs& a, int l, unsigned char* lds, int rep = 0) {
    unsigned* ctr = (unsigned*)(a.ws + OFF_CTL) + 16 * (l + 1) + 8 + 128 * rep; LAS unsigned* slot = (LAS unsigned*)(lds + LDS_MAIN + 16);
    unsigned nxt = 0u; { int t0 = threadIdx.x; asm volatile("" : "+v"(t0)); if (t0 == 0) nxt = atomicAdd(ctr, 1u); }
    for (;;) {
        __syncthreads();
        { int t0 = threadIdx.x; asm volatile("" : "+v"(t0)); if (t0 == 0) *slot = nxt; }
        __syncthreads();
        const int it = (int)*slot;
        if (it >= 2 * NTILE) break;
        { int t0 = threadIdx.x; asm volatile("" : "+v"(t0)); if (t0 == 0) nxt = atomicAdd(ctr, 1u); }
        if (it < NTILE) prep_hgrn_tile(a, l, it, lds); else prep_mla_tile(a, l, it - NTILE, lds);
    }
}
__device__ void phase_cache(CArgs& a, int l, unsigned char* lds) {
    unsigned* ctr = (unsigned*)(a.ws + OFF_CTL) + 16 * (l + 1) + 12; LAS unsigned* slot = (LAS unsigned*)(lds + LDS_MAIN + 16);
    unsigned nxt = 0u; { int t0 = threadIdx.x; asm volatile("" : "+v"(t0)); if (t0 == 0) nxt = atomicAdd(ctr, 1u); }
    for (;;) {
        __syncthreads();
        { int t0 = threadIdx.x; asm volatile("" : "+v"(t0)); if (t0 == 0) *slot = nxt; }
        __syncthreads();
        const int it = (int)*slot;
        if (it >= 1024) break;
        { int t0 = threadIdx.x; asm volatile("" : "+v"(t0)); if (t0 == 0) nxt = atomicAdd(ctr, 1u); }
        prep_cache_tile(a, l, it, lds);
    }
}
__device__ void phase_scan(CArgs& a, int l) {
    unsigned char* ws = a.ws; int tid = threadIdx.x; asm volatile("" : "+v"(tid)); const size_t gtid = (size_t)bid_() * 512 + tid, gsz = (size_t)gdim_() * 512;
    const float* U = (const float*)(ws + OFF_U); const float* dec = (const float*)(ws + OFF_DEC); float* sst = (float*)(ws + OFF_SST);
    for (size_t i = gtid; i < 16 * 4096; i += gsz) { const int bh = (int)(i >> 12), ed = (int)(i & 4095), b = bh >> 2, h = bh & 3, e = ed >> 6; float S = 0.f;
#pragma unroll 16
        for (int j = 0; j < 64; ++j) { const size_t ch = (size_t)((b * 64 + j) * 4 + h); sst[ch * 4096 + ed] = S; S = dec[ch * 64 + e] * S + U[ch * 4096 + ed]; }
        a.out[O_HGP + (size_t)(l * 16 + bh) * 4096 + ed] = S; }
    for (size_t i = gtid; i < 128 * 4096; i += gsz) { const int bh = (int)(i >> 12), ed = (int)(i & 4095), b = bh >> 2, h = bh & 3, e = ed >> 6; const size_t ch = (size_t)((256 + b) * 4 + h);
        const float S0 = a.in[4][(size_t)(l * 128 + bh) * 4096 + ed];
        a.out[O_HGS + (size_t)(l * 128 + bh) * 4096 + ed] = dec[ch * 64 + e] * S0 + U[ch * 4096 + ed]; }
}
constexpr int KSTR = 656, VSTR = 144, VOFF = 64 * KSTR, ABUF = VOFF + 256 * VSTR;
__device__ __forceinline__ int swz16(int row) { return (((row & 15) + 4) >> 3) & 1; }
__device__ void attn_item(CArgs& a, int idx, unsigned char* ldsg) {
    unsigned char* ws = a.ws; LAS unsigned char* lds = (LAS unsigned char*)ldsg;
    int tid = threadIdx.x; asm volatile("" : "+v"(tid)); const int lane = tid & 63, wave = __builtin_amdgcn_readfirstlane(tid >> 6), lr = lane & 15, g = lane >> 4;
    const int gx = (g ^ swz16(lr)) * 16;
    int b, hp, nkt, r0; const unsigned char* kcb; const unsigned char* ctb; int ctstride;
    if (idx >= 256 && idx < 320) { const int s = idx - 256; b = s >> 1; hp = s & 1; nkt = 33; r0 = MP + b * 64;
        kcb = ws + OFF_KC + ((size_t)16384 + (size_t)b * 2112) * 640; ctb = ws + OFF_CT + ((size_t)16384 * 256 + (size_t)b * 256 * 2112) * 2; ctstride = 4224; }
    else { const int k = idx < 256 ? idx : idx - 64; const int j = 63 - (k >> 3), sub = k & 7; b = sub >> 1; hp = sub & 1; nkt = j + 1; r0 = b * 4096 + j * 64;
        kcb = ws + OFF_KC + (size_t)b * 4096 * 640; ctb = ws + OFF_CT + (size_t)b * 256 * 4096 * 2; ctstride = 8192; }
    const int head = hp * 2 + (wave >> 2); const int qrow = r0 + (wave & 3) * 16 + lr;
    unsigned ko[6], vo[5];
#pragma unroll
    for (int i = 0; i < 6; ++i) { const int n = i * 512 + tid, row = n / 41, pc = n - row * 41; ko[i] = (unsigned)(row * 640 + (pc < 40 ? (pc ^ swz16(row)) * 16 : 0)); }
#pragma unroll
    for (int i = 0; i < 5; ++i) { const int n = i * 512 + tid, row = n / 9, pc = n - row * 9; vo[i] = (unsigned)(row * ctstride + (pc < 8 ? (pc ^ swz16(row)) * 16 : 0)); }
#define ATT_DMA(kt, bo) do { const unsigned char* kg = kcb + (size_t)(kt) * 40960; const unsigned char* vg = ctb + (size_t)(kt) * 128; \
        _Pragma("unroll") for (int i = 0; i < 6; ++i) if (i < 5 || wave == 0) __builtin_amdgcn_global_load_lds((const unsigned*)(kg + ko[i]), (LAS unsigned*)(lds + (bo) + (i * 512 + wave * 64) * 16), 16, 0, 0); \
        _Pragma("unroll") for (int i = 0; i < 5; ++i) if (i < 4 || wave < 4) __builtin_amdgcn_global_load_lds((const unsigned*)(vg + vo[i]), (LAS unsigned*)(lds + (bo) + VOFF + (i * 512 + wave * 64) * 16), 16, 0, 0); } while (0)
    __syncthreads();
    ATT_DMA(0, 0);
    bf16x8 qf[10];
    { const bf16_t* qp = (const bf16_t*)(ws + OFF_Q) + (size_t)qrow * 1280 + head * 320 + g * 8;
#pragma unroll
      for (int ks = 0; ks < 10; ++ks) qf[ks] = *(const bf16x8*)(qp + ks * 32);
      const int pos = qrow < MP ? (qrow & 4095) : 2048 + ((qrow - MP) & 63); const float2* rp = (const float2*)(ws + OFF_ROPE) + pos * 32 + 8 * g;
      u32x4 w1 = __builtin_bit_cast(u32x4, qf[8]), w2 = __builtin_bit_cast(u32x4, qf[9]);
      float4 cs4[4];
#pragma unroll
      for (int jp = 0; jp < 4; ++jp) cs4[jp] = *(const float4*)(rp + 2 * jp);
#pragma unroll
      for (int jp = 0; jp < 4; ++jp) { const float a1 = bflo(w1[jp]), b1 = bfhi(w1[jp]), a2 = bflo(w2[jp]), b2 = bfhi(w2[jp]);
          w1[jp] = cvt_pk_bf16(a1 * cs4[jp].x - a2 * cs4[jp].y, b1 * cs4[jp].z - b2 * cs4[jp].w); w2[jp] = cvt_pk_bf16(a2 * cs4[jp].x + a1 * cs4[jp].y, b2 * cs4[jp].z + b1 * cs4[jp].w); }
      qf[8] = __builtin_bit_cast(bf16x8, w1); qf[9] = __builtin_bit_cast(bf16x8, w2); }
    f32x4 o[16];
#pragma unroll
    for (int i = 0; i < 16; ++i) o[i] = (f32x4){0.f, 0.f, 0.f, 0.f};
    float mrun = -1e30f, lsum = 0.f;
    asm volatile("s_waitcnt vmcnt(0)" ::: "memory");
    __syncthreads();
    const int koff = lr * KSTR + gx, voff = VOFF + lr * VSTR + gx;
    for (int kt = 0; kt < nkt; ++kt) {
        const int bo = (kt & 1) * ABUF;
        if (kt + 1 < nkt) ATT_DMA(kt + 1, ABUF - bo);
        const LAS unsigned char* kb = lds + bo + koff; const LAS unsigned char* vb = lds + bo + voff;
        f32x4 s[4];
#pragma unroll
        for (int i = 0; i < 4; ++i) s[i] = (f32x4){0.f, 0.f, 0.f, 0.f};
        bf16x8 kf[2][4];
#pragma unroll
        for (int k4 = 0; k4 < 4; ++k4) kf[0][k4] = *(const LAS bf16x8*)(kb + k4 * 16 * KSTR);
#pragma unroll
        for (int ks = 0; ks < 10; ++ks) {
            if (ks < 9) {
#pragma unroll
                for (int k4 = 0; k4 < 4; ++k4) kf[(ks + 1) & 1][k4] = *(const LAS bf16x8*)(kb + k4 * 16 * KSTR + (ks + 1) * 64); }
            __builtin_amdgcn_sched_barrier(0);
#pragma unroll
            for (int k4 = 0; k4 < 4; ++k4) s[k4] = __builtin_amdgcn_mfma_f32_16x16x32_bf16(kf[ks & 1][k4], qf[ks], s[k4], 0, 0, 0);
            __builtin_amdgcn_sched_barrier(0);
        }
        bf16x8 vf[2][4];
#pragma unroll
        for (int q4 = 0; q4 < 4; ++q4) vf[0][q4] = *(const LAS bf16x8*)(vb + (q4 >> 1) * 16 * VSTR + (q4 & 1) * 64);
        __builtin_amdgcn_sched_barrier(0);
        float mx = s[0][0];
#pragma unroll
        for (int k4 = 0; k4 < 4; ++k4)
#pragma unroll
            for (int i = 0; i < 4; ++i) mx = fmaxf(mx, s[k4][i]);
        mx = fmaxf(mx, __shfl_xor(mx, 16)); mx = fmaxf(mx, __shfl_xor(mx, 32));
        if (!__all(mx - mrun <= 8.0f)) {
            const float mnew = fmaxf(mrun, mx), alpha = __builtin_amdgcn_exp2f(mrun - mnew); mrun = mnew; lsum *= alpha;
#pragma unroll
            for (int i = 0; i < 16; ++i) o[i] *= alpha; }
        float ps = 0.f;
#pragma unroll
        for (int k4 = 0; k4 < 4; ++k4)
#pragma unroll
            for (int i = 0; i < 4; ++i) { s[k4][i] = __builtin_amdgcn_exp2f(s[k4][i] - mrun); ps += s[k4][i]; }
        lsum += ps;
        bf16x8 pb[2];
#pragma unroll
        for (int s2 = 0; s2 < 2; ++s2) { u32x4 w; w.x = cvt_pk_bf16(s[2 * s2][0], s[2 * s2][1]); w.y = cvt_pk_bf16(s[2 * s2][2], s[2 * s2][3]);
            w.z = cvt_pk_bf16(s[2 * s2 + 1][0], s[2 * s2 + 1][1]); w.w = cvt_pk_bf16(s[2 * s2 + 1][2], s[2 * s2 + 1][3]); pb[s2] = __builtin_bit_cast(bf16x8, w); }
#pragma unroll
        for (int cp = 0; cp < 8; ++cp) {
            if (cp < 7) {
#pragma unroll
                for (int q4 = 0; q4 < 4; ++q4) vf[(cp + 1) & 1][q4] = *(const LAS bf16x8*)(vb + (2 * (cp + 1) + (q4 >> 1)) * 16 * VSTR + (q4 & 1) * 64); }
            __builtin_amdgcn_sched_barrier(0);
#pragma unroll
            for (int q4 = 0; q4 < 4; ++q4) o[2 * cp + (q4 >> 1)] = __builtin_amdgcn_mfma_f32_16x16x32_bf16(vf[cp & 1][q4], pb[q4 & 1], o[2 * cp + (q4 >> 1)], 0, 0, 0);
            __builtin_amdgcn_sched_barrier(0);
        }
        asm volatile("s_waitcnt vmcnt(0)" ::: "memory");
        __syncthreads();
    }
#undef ATT_DMA
    lsum += __shfl_xor(lsum, 16); lsum += __shfl_xor(lsum, 32);
    const float inv = 1.0f / lsum;
    bf16_t* op = (bf16_t*)(ws + OFF_MIXA) + (size_t)qrow * 1536 + head * 256 + 4 * g;
#pragma unroll
    for (int ct = 0; ct < 16; ++ct) { uint2 w; w.x = cvt_pk_bf16(o[ct][0] * inv, o[ct][1] * inv); w.y = cvt_pk_bf16(o[ct][2] * inv, o[ct][3] * inv); *(uint2*)(op + 16 * ct) = w; }
}
constexpr int HS = 72;
constexpr int H_BC = 0, H_QT = 2 * 16640, H_KT = H_QT + 2 * 64 * HS * 2, H_QH = H_KT + 2 * 64 * HS * 2, H_VT = H_QH + 2 * 64 * HS * 2, H_ST = H_VT + 2 * 64 * HS * 2, H_END = H_ST + 2 * 64 * HS * 2;
static_assert(H_END <= LDS_MAIN, "hgrn lds");
__device__ __forceinline__ int posof64(int t) { const int u = t & 31; const int p = u < 16 ? 8 * (u >> 2) + (u & 3) : 8 * ((u - 16) >> 2) + 4 + ((u - 16) & 3); return (t & 32) + p; }
__device__ void hgrn_out_tile(CArgs& a, int l, int T, unsigned char* ldsg) {
    unsigned char* ws = a.ws; int tid = threadIdx.x; asm volatile("" : "+v"(tid)); asm volatile("" : "+s"(l)); const int lane = tid & 63, wave = tid >> 6, lr = lane & 15, g = lane >> 4;
    LAS unsigned char* lds = (LAS unsigned char*)ldsg;
    const bf16_t* z = (const bf16_t*)(ws + OFF_Z); const int r0 = T * 64;
    const int c = tid & 127, hh = c >> 6, e = c & 63, tq = tid >> 7;
    LAS float* bc = (LAS float*)(lds + H_BC) + hh * 4160;
    LAS bf16_t* QT = (LAS bf16_t*)(lds + H_QT) + hh * 64 * HS; LAS bf16_t* KT = (LAS bf16_t*)(lds + H_KT) + hh * 64 * HS; LAS bf16_t* QH = (LAS bf16_t*)(lds + H_QH) + hh * 64 * HS; LAS bf16_t* VT = (LAS bf16_t*)(lds + H_VT) + hh * 64 * HS;
    const float lbv0 = lb_of(a, l, hh * 64 + e), lbv1 = lb_of(a, l, (2 + hh) * 64 + e);
    for (int hp = 0; hp < 2; ++hp) {
        const int h = 2 * hp + hh; const float lbv = hp ? lbv1 : lbv0;
        { const float* bcum = (const float*)(ws + OFF_BCUM) + (size_t)r0 * 256 + h * 64 + e; const float rr = bcum[31 * 256];
          float s0v[16];
#pragma unroll
          for (int i = 0; i < 16; ++i) { const int idx = tid + 512 * i, h2 = idx >> 12, ed = idx & 4095; const int hg = 2 * hp + h2;
              const float* S0 = T < 256 ? (const float*)(ws + OFF_SST) + (size_t)(T * 4 + hg) * 4096 : a.in[4] + (size_t)(l * 128 + (T - 256) * 4 + hg) * 4096;
              s0v[i] = S0[ed]; }
#pragma unroll 1
          for (int i0 = 0; i0 < 16; i0 += 8) {
          bf16_t zq[8], zf16[8], zv[8]; float bbv[8];
#pragma unroll
          for (int i = 0; i < 8; ++i) { const bf16_t* zr = z + (size_t)(r0 + tq * 16 + i0 + i) * ZW + h * 64 + e; zq[i] = zr[ZHQ]; zf16[i] = zr[ZHF]; zv[i] = zr[ZHI]; bbv[i] = bcum[(tq * 16 + i0 + i) * 256]; }
#pragma unroll
          for (int i = 0; i < 8; ++i) { const int t = tq * 16 + i0 + i; const float bb = bbv[i];
              const float q = bf2f(zq[i]), zf = bf2f(zf16[i]); const float k = (1.0f - lbv) * sigmoidf_(-zf);
              QH[t * HS + e] = f2bf(q * __expf(bb)); QT[t * HS + e] = f2bf(q * __expf(fminf(bb - rr, 80.f))); KT[t * HS + e] = f2bf(k * __expf(fminf(rr - bb, 80.f)));
              VT[e * HS + posof64(t)] = zv[i]; } }
#pragma unroll
          for (int i = 0; i < 16; ++i) { const int idx = tid + 512 * i, h2 = idx >> 12, ed = idx & 4095; ((LAS bf16_t*)(lds + H_ST))[h2 * 64 * HS + (ed & 63) * HS + (ed >> 6)] = f2bf(s0v[i]); } }
        __syncthreads();
        { const int wh = wave >> 2, tb = wave & 3; const int hw = 2 * hp + wh;
          const LAS unsigned char* qt = lds + H_QT + wh * 64 * HS * 2; const LAS unsigned char* kt = lds + H_KT + wh * 64 * HS * 2; const LAS unsigned char* qh = lds + H_QH + wh * 64 * HS * 2;
          const LAS unsigned char* vt = lds + H_VT + wh * 64 * HS * 2; const LAS unsigned char* st = lds + H_ST + wh * 64 * HS * 2;
          const int trow = 16 * tb + lr;
          float4 ogv[4]; uint2 gwv[4];
#pragma unroll
          for (int db = 0; db < 4; ++db) { const int d0 = hw * 64 + 16 * db + 4 * g; ogv[db] = *(const float4*)(a.in[17] + l * 256 + d0); gwv[db] = *(const uint2*)(z + (size_t)(r0 + trow) * ZW + ZHG + d0); }
          bf16x8 qtf[2], qhf[2];
#pragma unroll
          for (int ks = 0; ks < 2; ++ks) { qtf[ks] = *(const LAS bf16x8*)(qt + trow * (HS * 2) + (32 * ks + 8 * g) * 2); qhf[ks] = *(const LAS bf16x8*)(qh + trow * (HS * 2) + (32 * ks + 8 * g) * 2); }
          f32x4 aT[4];
#pragma unroll
          for (int sb = 0; sb < 4; ++sb) { aT[sb] = (f32x4){0.f, 0.f, 0.f, 0.f};
#pragma unroll
              for (int ks = 0; ks < 2; ++ks) { const bf16x8 kf = *(const LAS bf16x8*)(kt + (16 * sb + lr) * (HS * 2) + (32 * ks + 8 * g) * 2); aT[sb] = __builtin_amdgcn_mfma_f32_16x16x32_bf16(kf, qtf[ks], aT[sb], 0, 0, 0); }
#pragma unroll
              for (int i = 0; i < 4; ++i) aT[sb][i] = (16 * sb + 4 * g + i <= trow) ? aT[sb][i] : 0.f; }
          bf16x8 pb[2];
#pragma unroll
          for (int s2 = 0; s2 < 2; ++s2) { u32x4 w; w.x = cvt_pk_bf16(aT[2 * s2][0], aT[2 * s2][1]); w.y = cvt_pk_bf16(aT[2 * s2][2], aT[2 * s2][3]);
              w.z = cvt_pk_bf16(aT[2 * s2 + 1][0], aT[2 * s2 + 1][1]); w.w = cvt_pk_bf16(aT[2 * s2 + 1][2], aT[2 * s2 + 1][3]); pb[s2] = __builtin_bit_cast(bf16x8, w); }
          f32x4 o[4]; float ss = 0.f;
#pragma unroll
          for (int db = 0; db < 4; ++db) { o[db] = (f32x4){0.f, 0.f, 0.f, 0.f};
#pragma unroll
              for (int ks = 0; ks < 2; ++ks) { const bf16x8 sf = *(const LAS bf16x8*)(st + (16 * db + lr) * (HS * 2) + (32 * ks + 8 * g) * 2); o[db] = __builtin_amdgcn_mfma_f32_16x16x32_bf16(sf, qhf[ks], o[db], 0, 0, 0); }
#pragma unroll
              for (int s2 = 0; s2 < 2; ++s2) { const bf16x8 vf = *(const LAS bf16x8*)(vt + (16 * db + lr) * (HS * 2) + (32 * s2 + 8 * g) * 2); o[db] = __builtin_amdgcn_mfma_f32_16x16x32_bf16(vf, pb[s2], o[db], 0, 0, 0); }
              ss += o[db][0] * o[db][0] + o[db][1] * o[db][1] + o[db][2] * o[db][2] + o[db][3] * o[db][3]; }
          ss += __shfl_xor(ss, 16); ss += __shfl_xor(ss, 32);
          const float rs = rsqrtf(ss * (1.0f / 64.0f) + EPS);
#pragma unroll
          for (int db = 0; db < 4; ++db) { const int d0 = hw * 64 + 16 * db + 4 * g; const float4 og = ogv[db]; const uint2 gw = gwv[db];
              uint2 w; w.x = cvt_pk_bf16(o[db][0] * rs * og.x * siluf_(bflo(gw.x)), o[db][1] * rs * og.y * siluf_(bfhi(gw.x)));
              w.y = cvt_pk_bf16(o[db][2] * rs * og.z * siluf_(bflo(gw.y)), o[db][3] * rs * og.w * siluf_(bfhi(gw.y)));
              *(uint2*)((bf16_t*)(ws + OFF_MIXA) + (size_t)(r0 + trow) * 1536 + 1024 + d0) = w; } }
        __syncthreads();
    }
}
template <bool PRM> __device__ __forceinline__ void cmlp_item_t(CArgs& a, int l, int it, unsigned char* ldsg) {
    int tid = threadIdx.x; asm volatile("" : "+v"(tid)); asm volatile("" : "+s"(l)); const int lane = tid & 63, wave = tid >> 6, lr = lane & 15, lg = lane >> 4; const int ci = it >> 2, g = it & 3;
    constexpr int L = PRM ? 128 : 64, WS = L + 8;
    const int r0 = PRM ? ci * 128 : MP + (ci - 128) * 64;
    LAS unsigned char* lds = (LAS unsigned char*)ldsg; LAS bf16_t* Wb = (LAS bf16_t*)lds; LAS bf16_t* vT = (LAS bf16_t*)(lds + 128 * 136 * 2);
    const bf16_t* z = (const bf16_t*)(a.ws + OFF_Z); const float* wsrc = a.in[19] + (size_t)(l * 4 + g) * 128 * 128;
    const float vg = a.in[18][l * 256 + g * 64 + lane];
    bf16_t zc[L / 8];
#pragma unroll
    for (int i = 0; i < L / 8; ++i) zc[i] = z[(size_t)(r0 + wave + 8 * i) * ZW + ZCV + g * 64 + lane];
    { constexpr int NQ = L * L / 4 / 512, SH = PRM ? 5 : 4; float4 wv[NQ];
#pragma unroll
      for (int i = 0; i < NQ; ++i) { const int idx = tid + 512 * i, t = idx >> SH, s4 = idx & ((1 << SH) - 1); wv[i] = *(const float4*)(wsrc + t * 128 + 4 * s4); }
#pragma unroll
      for (int i = 0; i < NQ; ++i) { const int idx = tid + 512 * i, t = idx >> SH, s0 = 4 * (idx & ((1 << SH) - 1));
          u32x2 w; w.x = cvt_pk_bf16(s0 <= t ? wv[i].x : 0.f, s0 + 1 <= t ? wv[i].y : 0.f); w.y = cvt_pk_bf16(s0 + 2 <= t ? wv[i].z : 0.f, s0 + 3 <= t ? wv[i].w : 0.f);
          *(LAS u32x2*)(Wb + t * WS + s0) = w; } }
    {
#pragma unroll
      for (int i = 0; i < L / 8; ++i) { const int t = wave + 8 * i; const float x = geluf_(bf2f(zc[i])); const float ss = wave_sum(x * x);
          const float vv = x * rsqrtf(ss * (1.0f / 64.0f) + EPS) * vg; vT[lane * WS + t] = f2bf(vv);
          if (!PRM) a.out[O_CMV + ((size_t)(l * 32 + (ci - 128)) * 64 + t) * 256 + g * 64 + lane] = vv; } }
    __syncthreads();
    { constexpr int NT = PRM ? 4 : 2;
      const int tt = PRM ? wave : (wave & 3); const int t = 16 * tt + lr; const float bs = a.in[20][(size_t)(l * 4 + g) * 128 + t];
      uint2 cwv[NT];
#pragma unroll
      for (int n = 0; n < NT; ++n) { const int dt = PRM ? n : 2 * (wave >> 2) + n; cwv[n] = *(const uint2*)(z + (size_t)(r0 + t) * ZW + ZCU + g * 64 + 16 * dt + 4 * lg); }
#pragma unroll
      for (int n = 0; n < NT; ++n) { const int dt = PRM ? n : 2 * (wave >> 2) + n; f32x4 acc = (f32x4){0.f, 0.f, 0.f, 0.f};
#pragma unroll
          for (int ks = 0; ks < L / 32; ++ks) { if (32 * ks <= 16 * tt + 15) {
              const bf16x8 vf = *(const LAS bf16x8*)(vT + (16 * dt + lr) * WS + 32 * ks + 8 * lg); const bf16x8 wf = *(const LAS bf16x8*)(Wb + t * WS + 32 * ks + 8 * lg);
              acc = __builtin_amdgcn_mfma_f32_16x16x32_bf16(vf, wf, acc, 0, 0, 0); } }
          const int d0 = g * 64 + 16 * dt + 4 * lg; const uint2 cw = cwv[n];
          uint2 o; o.x = cvt_pk_bf16(geluf_(bflo(cw.x)) * (acc[0] + bs), geluf_(bfhi(cw.x)) * (acc[1] + bs)); o.y = cvt_pk_bf16(geluf_(bflo(cw.y)) * (acc[2] + bs), geluf_(bfhi(cw.y)) * (acc[3] + bs));
          *(uint2*)((bf16_t*)(a.ws + OFF_MIXA) + (size_t)(r0 + t) * 1536 + 1280 + d0) = o; } }
    __syncthreads();
}
__device__ void cmlp_item(CArgs& a, int l, int it, unsigned char* lds) { if ((it >> 2) < 128) cmlp_item_t<true>(a, l, it, lds); else cmlp_item_t<false>(a, l, it, lds); }
__device__ void phase_mix(CArgs& a, int l, unsigned char* lds, int rep) {
    unsigned* ctr = (unsigned*)(a.ws + OFF_CTL) + 16 * (l + 1) + 128 * rep; LAS unsigned* slot = (LAS unsigned*)(lds + LDS_MAIN + 16);
    for (;;) {
        __syncthreads();
        { int t0 = threadIdx.x; asm volatile("" : "+v"(t0)); if (t0 == 0) *slot = atomicAdd(ctr, 1u); }
        __syncthreads();
        const int it = (int)*slot;
        if (it >= 576 + NTILE + 640) break;
        if (it < 576) { attn_item(a, it, lds); if (PROBE_MIX & 1) { __syncthreads(); attn_item(a, it, lds); } }
        else if (it < 576 + NTILE) { hgrn_out_tile(a, l, it - 576, lds); if (PROBE_MIX & 2) { __syncthreads(); hgrn_out_tile(a, l, it - 576, lds); } }
        else { cmlp_item(a, l, it - 576 - NTILE, lds); if (PROBE_MIX & 4) { __syncthreads(); cmlp_item(a, l, it - 576 - NTILE, lds); } }
    }
}
__global__ void __launch_bounds__(512) mk_fwd(Args a_) {
    extern __shared__ __attribute__((aligned(16))) unsigned char lds[];
    if (threadIdx.x < 16) ((LAS unsigned*)(lds + LDS_MAIN))[threadIdx.x] = 0u;
    __syncthreads();
    XcdBarrier bar = xcd_barrier_post((unsigned*)(a_.ws + OFF_CTL) + 1024, (volatile LAS unsigned*)(lds + LDS_MAIN));
    const int ph_lo = a_.ph_lo, ph_hi = a_.ph_hi;
    for (int ph = ph_lo; ph < ph_hi; ++ph) {
        CArgs* ap = (CArgs*)__builtin_amdgcn_kernarg_segment_ptr(); asm volatile("" : "+s"(ap)); CArgs& a = *ap;
        unsigned char* ws = a.ws;
        if (ph == 0) { phase_init(a, lds); if ((PROBE_DUP >> 12) & 1) { __syncthreads(); phase_init(a, lds); } }
        else { const int l = (ph - 1) / 12, p = (ph - 1) % 12; const float* ng = a.in[5] + (size_t)l * 6 * 1024;
            bf16_t* H = (bf16_t*)(ws + OFF_H); bf16_t* ACT = (bf16_t*)(ws + OFF_ACT); bf16_t* D = (bf16_t*)(ws + OFF_D); bf16_t* D1 = (bf16_t*)(ws + ((p == 7 || p == 8) ? OFF_ACT : OFF_MIXA));   float* RS = (float*)(ws + OFF_X);
            const int reps = ((PROBE_DUP >> p) & 1) ? 2 : 1;
            for (int rep = 0; rep < reps; ++rep) {
            if (rep) __syncthreads();
            switch (p) {
            case 0: case 9: { const int f = p == 0 ? 0 : 1; EpiSwiGLU E{ACT}; run_gemm(lds, H, (const bf16_t*)(ws + OFF_WGU) + (size_t)(l * 2 + f) * 5632 * 1024, MT, 5632, 1024, E);
                if (p == 0 && !rep) phase_cache(a, l, lds); } break;
            case 1: case 10: { const int f = p == 1 ? 0 : 1; EpiBf E{D, 1024, D1}; run_gemm(lds, ACT, (const bf16_t*)(ws + OFF_WDN) + (size_t)(l * 2 + f) * 1024 * 2816, MT, 1024, 2816, E, 11); } break;
            case 2: ew_phase<false, false>(D, D1, 11, H, nullptr, nullptr, ng + 1024, 0.5f, ng + 2048, H, ng, RS); break;
            case 3: { EpiBf E{(bf16_t*)(ws + OFF_Z), ZW, nullptr}; run_gemm(lds, H, (const bf16_t*)(ws + OFF_WIN) + (size_t)l * 2304 * 1024, MT, 2304, 1024, E); } break;
            case 4: phase_prep(a, l, lds, rep); break;
            case 5: { phase_scan(a, l); EpiQ E{(bf16_t*)(ws + OFF_Q)}; run_gemm(lds, (const bf16_t*)(ws + OFF_QN), (const bf16_t*)(ws + OFF_WQ) + (size_t)l * 1280 * 384, MT, 1280, 384, E); } break;
            case 6: phase_mix(a, l, lds, rep); break;
            case 7: { EpiBf E{D, 1024, D1}; run_gemm(lds, (const bf16_t*)(ws + OFF_MIXA), (const bf16_t*)(ws + OFF_WMIX) + (size_t)l * 1024 * 1536, MT, 1024, 1536, E, 6); } break;
            case 8: ew_phase<false, false>(D, D1, 6, H, nullptr, nullptr, ng + 3 * 1024, 1.0f, ng + 4 * 1024, H, ng + 2048, RS); break;
            case 11: if (l == 0) ew_phase<false, false>(D, D1, 11, H, nullptr, nullptr, ng + 5 * 1024, 0.5f, ng + 6 * 1024, H, ng + 4 * 1024, RS); else ew_phase<false, true>(D, D1, 11, H, nullptr, a.out + O_Y, ng + 5 * 1024, 0.5f, nullptr, nullptr, ng + 4 * 1024, RS); break;
            }
            }
            tail_wtasks(a, ph, lds);
        }
        if (ph + 1 < ph_hi) {
            if (ph_lo < 0) { __threadfence(); cg::this_grid().sync(); }
            xcd_barrier(bar); }
    }
}

extern "C" void kernel_launch(void* const* d_in, const int* in_sizes, int n_in, void* d_out, int out_size, void* d_ws, size_t ws_size, hipStream_t stream) {
    static int grid = 0;
    if (grid == 0) {
        if (n_in != 21 || ws_size < WS_END) { fprintf(stderr, "kernel_launch: bad inputs n_in %d ws %zu need %zu\n", n_in, ws_size, (size_t)WS_END); grid = -1; return; }
        int dev = 0, cus = 0, per_cu = 0;
        hipGetDevice(&dev); hipDeviceGetAttribute(&cus, hipDeviceAttributeMultiprocessorCount, dev);
        if (hipFuncSetAttribute((const void*)mk_fwd, hipFuncAttributeMaxDynamicSharedMemorySize, LDS_BYTES) != hipSuccess) { fprintf(stderr, "hipFuncSetAttribute failed\n"); grid = -1; return; }
        if (hipOccupancyMaxActiveBlocksPerMultiprocessor(&per_cu, (const void*)mk_fwd, 512, LDS_BYTES) != hipSuccess || per_cu < 1) per_cu = 1;
        (void)hipGetLastError();
        grid = cus * 1;
    }
    if (grid < 0) return;
    if (hipMemsetAsync((char*)d_ws + OFF_CTL, 0, SZ_CTL, stream) != hipSuccess) { fprintf(stderr, "memset failed\n"); return; }
    Args a{};
    for (int i = 0; i < 21; ++i) a.in[i] = (const float*)d_in[i];
    a.out = (float*)d_out; a.ws = (unsigned char*)d_ws;
#if ONE_LAUNCH
    a.ph_lo = 0; a.ph_hi = NPHASE;
    void* args[] = {&a};
    hipError_t e = hipLaunchCooperativeKernel((const void*)mk_fwd, dim3(grid), dim3(512), args, LDS_BYTES, stream);
    if (e != hipSuccess) fprintf(stderr, "cooperative launch failed: %s (grid %d)\n", hipGetErrorString(e), grid);
#else
    for (int ph = 0; ph < NPHASE; ++ph) { a.ph_lo = ph; a.ph_hi = ph + 1; hipLaunchKernelGGL(mk_fwd, dim3(grid), dim3(512), LDS_BYTES, stream, a); }
#endif
}
```

```cpp
#include <hip/hip_runtime.h>
#include <hip/hip_cooperative_groups.h>
#include <cstdio>
namespace cg = cooperative_groups;
#ifndef ONE_LAUNCH
#define ONE_LAUNCH 1
#endif
#ifndef PROBE_DUP
#define PROBE_DUP 0
#endif
#ifndef PROBE_MIX
#define PROBE_MIX 0
#endif
namespace pg8 {
#define PG8_LAS __attribute__((address_space(3)))
typedef unsigned short bf16_t;
typedef short bf16x8 __attribute__((ext_vector_type(8)));
typedef float f32x4 __attribute__((ext_vector_type(4)));
typedef unsigned u32x4 __attribute__((ext_vector_type(4)));
constexpr int BM = 256, BK = 64, HALF = 128, HTB = HALF * BK * 2  , STAGE_BYTES = 8 * HTB, NXCD = 8, WGM = 8;

__host__ __device__ __forceinline__ int lds_byte(int r, int c) { const int st = (r >> 4) * 2 + (c >> 5), rr = r & 15, cc = c & 31, ob = rr * 64 + cc * 2; return st * 1024 + (ob ^ (((ob >> 9) & 1) << 5)); }
__host__ __device__ __forceinline__ void stage_rc(int b, int& R, int& C) { const int st = b / 1024, sb = b % 1024, swz = sb ^ (((sb >> 9) & 1) << 5); R = (st >> 1) * 16 + swz / 64; C = (st & 1) * 32 + (swz % 64) / 2; }
__host__ __device__ __forceinline__ int perm32(int rho) { const int n = rho >> 4, i = rho & 15; return 8 * (i >> 2) + 4 * n + (i & 3); }

struct Unit { int pm, pn, ks, nt, koff; };
struct Gemm { const bf16_t* A; const bf16_t* Bt; int M, N, K, ld; };

struct StaticOrder {
    int nM, nN, nwg, G, c, nN0, unt, ukb;
    __host__ __device__ void init(int M, int N, int G_, int c_, int nsplit = 1) { nM = M / BM; nN0 = N / BM; nN = nN0 * nsplit; nwg = nM * nN; G = G_; c = c_; }
    __host__ __device__ bool next(int i, Unit& u) const {
        const long L = (long)i * G + c; if (L >= nwg) return false;
        int wgid = (int)L; { const int q = nwg / NXCD, r = nwg % NXCD, xcd = wgid % NXCD, off = wgid / NXCD; wgid = (xcd < r ? xcd * (q + 1) : r * (q + 1) + (xcd - r) * q) + off; }
        const int nig = WGM * nN, gid = wgid / nig, fm = gid * WGM, gsz = (nM - fm) < WGM ? (nM - fm) : WGM;
        u.pm = fm + ((wgid % nig) % gsz); const int pn = (wgid % nig) / gsz; u.ks = pn / nN0; u.pn = pn - u.ks * nN0; u.nt = unt; u.koff = u.ks * ukb; return true;
    }
    __device__ __forceinline__ void a_ready(const Unit&) const {}
    __device__ __forceinline__ void done(const Unit&) const {}
};
__device__ __forceinline__ unsigned cvt_pk_bf16(float lo, float hi) { unsigned r; asm volatile("v_cvt_pk_bf16_f32 %0, %1, %2" : "=v"(r) : "v"(lo), "v"(hi)); return r; }
typedef float f32x2 __attribute__((ext_vector_type(2)));
template <class Epi, class Sched, bool STAMP = false>
__device__ __forceinline__ void gemm_phase(PG8_LAS unsigned char* lds, const Gemm g, const Sched& S, const Epi& E, unsigned long long* stamps) {
    int tid = threadIdx.x; asm volatile("" : "+v"(tid)); const int wid = __builtin_amdgcn_readfirstlane(tid >> 6), lane = tid & 63, wr = wid >> 2, wc = wid & 3, fr = lane & 15, fq = lane >> 4;
    const int K = g.ld;
    int ts_lo = 0, ts_hi = 0, nts = 0; const unsigned long long rt_entry = STAMP ? (unsigned long long)wall_clock64() : 0ull;
#define PG8_STAMP() do { if (STAMP && wid == 0 && nts < 64) { const unsigned long long _c = (unsigned long long)clock64(); \
        ts_lo = (lane == nts) ? (int)(unsigned)_c : ts_lo; ts_hi = (lane == nts) ? (int)(unsigned)(_c >> 32) : ts_hi; ++nts; } } while (0)
    PG8_STAMP();
    unsigned voffA[2], voffB[2];
#pragma unroll
    for (int i = 0; i < 2; ++i) { int R, C; stage_rc(tid * 16 + i * 8192, R, C); const int Rb = Epi::PERM ? ((R & ~31) + perm32(R & 31)) : R;
        voffA[i] = (unsigned)(R * K + C) * 2u; voffB[i] = (unsigned)(Rb * K + C) * 2u; }
    const size_t kstep = (size_t)(BK * 2);
    const size_t hstep = (size_t)HALF * K * 2;
    const size_t tstep = 2 * hstep;
    const unsigned ldsw = (unsigned)wid * 1024u;
    const int aoff = lds_byte(wr * 64 + fr, fq * 8), boff = lds_byte(wc * 32 + fr, fq * 8);
#define PG8_SA(b, h) (((b) * 2 + (h)) * HTB)
#define PG8_SB(b, h) ((4 + (b) * 2 + (h)) * HTB)
#define PG8_STAGE(bufoff, gbase, voff) do { _Pragma("unroll") for (int _i = 0; _i < 2; ++_i) \
        __builtin_amdgcn_global_load_lds((const unsigned*)((const char*)(gbase) + (voff)[_i]), (PG8_LAS unsigned*)(lds + (bufoff) + ldsw + _i * 8192), 16, 0, 0); } while (0)
#define PG8_LDA(dst, b, h) do { _Pragma("unroll") for (int m = 0; m < 4; ++m) _Pragma("unroll") for (int k = 0; k < 2; ++k) dst[m][k] = *(const PG8_LAS bf16x8*)(lds + PG8_SA(b, h) + aoff + m * 2048 + k * 1024); } while (0)
#define PG8_LDB(dst, b, h) do { _Pragma("unroll") for (int n = 0; n < 2; ++n) _Pragma("unroll") for (int k = 0; k < 2; ++k) dst[n][k] = *(const PG8_LAS bf16x8*)(lds + PG8_SB(b, h) + boff + n * 2048 + k * 1024); } while (0)
#define PG8_MMA(ai, bj, At, Bt) do { __builtin_amdgcn_s_setprio(1); _Pragma("unroll") for (int m = 0; m < 4; ++m) _Pragma("unroll") for (int n = 0; n < 2; ++n) _Pragma("unroll") for (int k = 0; k < 2; ++k) \
        acc[ai][bj][m][n] = __builtin_amdgcn_mfma_f32_16x16x32_bf16(Bt[n][k], At[m][k], acc[ai][bj][m][n], 0, 0, 0); __builtin_amdgcn_s_setprio(0); } while (0)
#define PG8_WAIT_V(n) asm volatile("s_waitcnt vmcnt(" #n ")" ::: "memory")
#define PG8_WAIT_L(n) asm volatile("s_waitcnt lgkmcnt(" #n ")" ::: "memory")
#define PG8_BAR __builtin_amdgcn_s_barrier()
#define PG8_SCHED __builtin_amdgcn_sched_barrier(0)
    Unit cur, nxt; int ui = 0;
    if (!S.next(0, cur)) return;
    f32x4 acc[2][2][4][2];
#pragma unroll
    for (int a = 0; a < 2; ++a)
#pragma unroll
        for (int b = 0; b < 2; ++b)
#pragma unroll
            for (int m = 0; m < 4; ++m)
#pragma unroll
                for (int n = 0; n < 2; ++n) acc[a][b][m][n] = (f32x4){0.f, 0.f, 0.f, 0.f};
    bf16x8 At[4][2], B0[2][2], B1[2][2];
    const char* cA = (const char*)g.A + (size_t)cur.pm * tstep + (size_t)cur.koff; const char* cB = (const char*)g.Bt + (size_t)cur.pn * tstep + (size_t)cur.koff;
    S.a_ready(cur);
    PG8_STAGE(PG8_SB(0, 0), cB, voffB); PG8_STAGE(PG8_SA(0, 0), cA, voffA); PG8_STAGE(PG8_SB(0, 1), cB + hstep, voffB); PG8_STAGE(PG8_SA(0, 1), cA + hstep, voffA);
    if (wr == 1) PG8_BAR;
    PG8_WAIT_V(4); PG8_BAR;
    PG8_STAGE(PG8_SB(1, 0), cB + kstep, voffB); PG8_STAGE(PG8_SA(1, 0), cA + kstep, voffA); PG8_STAGE(PG8_SB(1, 1), cB + hstep + kstep, voffB);
    PG8_WAIT_V(6); PG8_BAR;
    PG8_STAMP();
    for (;;) {
        const bool has_next = S.next(ui + 1, nxt);
        const char* nA = has_next ? (const char*)g.A + (size_t)nxt.pm * tstep + (size_t)nxt.koff : cA; const char* nB = has_next ? (const char*)g.Bt + (size_t)nxt.pn * tstep + (size_t)nxt.koff : cB;
        const int nt = cur.nt;
        for (int t = 0; t < nt; t += 2) {
            const bool last = (t == nt - 2);
            const char* a1 = cA + (size_t)(t + 1) * kstep;
            const char* a2 = last ? nA : cA + (size_t)(t + 2) * kstep; const char* b2 = last ? nB : cB + (size_t)(t + 2) * kstep;
            const char* a3 = a2 + kstep; const char* b3 = b2 + kstep;
            if (last && has_next) S.a_ready(nxt);
            PG8_LDB(B0, 0, 0); PG8_SCHED; PG8_LDA(At, 0, 0); PG8_STAGE(PG8_SA(1, 1), a1 + hstep, voffA);
            PG8_WAIT_L(8); PG8_BAR; PG8_WAIT_L(0); PG8_MMA(0, 0, At, B0); PG8_BAR; PG8_SCHED;
            PG8_LDB(B1, 0, 1); PG8_STAGE(PG8_SB(0, 0), b2, voffB);
            PG8_BAR; PG8_WAIT_L(0); PG8_MMA(0, 1, At, B1); PG8_BAR;
            PG8_LDA(At, 0, 1); PG8_STAGE(PG8_SA(0, 0), a2, voffA);
            PG8_BAR; PG8_WAIT_L(0); PG8_MMA(1, 0, At, B0); PG8_BAR; PG8_SCHED;
            PG8_STAGE(PG8_SB(0, 1), b2 + hstep, voffB);
            PG8_WAIT_V(6); PG8_BAR; PG8_MMA(1, 1, At, B1); PG8_BAR;
            PG8_LDB(B0, 1, 0); PG8_SCHED; PG8_LDA(At, 1, 0); PG8_STAGE(PG8_SA(0, 1), a2 + hstep, voffA);
            PG8_WAIT_L(8); PG8_BAR; PG8_WAIT_L(0); PG8_MMA(0, 0, At, B0); PG8_BAR; PG8_SCHED;
            PG8_LDB(B1, 1, 1); PG8_STAGE(PG8_SB(1, 0), b3, voffB);
            PG8_BAR; PG8_WAIT_L(0); PG8_MMA(0, 1, At, B1); PG8_BAR;
            PG8_LDA(At, 1, 1); PG8_STAGE(PG8_SA(1, 0), a3, voffA);
            PG8_BAR; PG8_WAIT_L(0); PG8_MMA(1, 0, At, B0); PG8_BAR; PG8_SCHED;
            PG8_STAGE(PG8_SB(1, 1), b3 + hstep, voffB);
            PG8_WAIT_V(6); PG8_BAR; PG8_MMA(1, 1, At, B1); PG8_BAR;
        }
        PG8_STAMP();
        if constexpr (!Epi::AFTER_DRAIN) { E(acc, cur, wr, wc, fr, fq); S.done(cur); }
        PG8_STAMP();
        if (!has_next) break;
#pragma unroll
        for (int a = 0; a < 2; ++a)
#pragma unroll
            for (int b = 0; b < 2; ++b)
#pragma unroll
                for (int m = 0; m < 4; ++m)
#pragma unroll
                    for (int n = 0; n < 2; ++n) acc[a][b][m][n] = (f32x4){0.f, 0.f, 0.f, 0.f};
        cur = nxt; cA = nA; cB = nB; ++ui;
    }
    PG8_WAIT_V(0);
    if (wr == 0) PG8_BAR;
    PG8_BAR;
    if constexpr (Epi::AFTER_DRAIN) { E.fused(acc, cur, wr, wc, fr, fq, lds, wid, lane); S.done(cur); }
    PG8_STAMP();
    if (STAMP && wid == 0) { stamps[lane] = lane < nts ? (((unsigned long long)(unsigned)ts_hi << 32) | (unsigned)ts_lo) : 0ull;
        if (lane == 62) stamps[62] = rt_entry; if (lane == 63) stamps[63] = (unsigned long long)wall_clock64(); }
#undef PG8_STAMP
#undef PG8_SA
#undef PG8_SB
#undef PG8_STAGE
#undef PG8_LDA
#undef PG8_LDB
#undef PG8_MMA
#undef PG8_WAIT_V
#undef PG8_WAIT_L
#undef PG8_BAR
#undef PG8_SCHED
}
}
using pg8::bf16_t; using pg8::bf16x8; using pg8::f32x4; using pg8::u32x4; using pg8::Unit; using pg8::cvt_pk_bf16;
#define LAS __attribute__((address_space(3)))
typedef unsigned u32x2 __attribute__((ext_vector_type(2)));

constexpr int DM = 1024, DFF = 2816, MP = 16384, MS = 2048, MT = 18432, INWP = 2304, ZW = 2304;
constexpr int NTILE = 288;
constexpr float EPS = 1e-6f;
constexpr float QSCALE = 0.07216878364870322f * 1.4426950408889634f;
constexpr int ZQ = 0, ZKV = 384, ZPE = 640, ZHQ = 704, ZHF = 960, ZHI = 1216, ZHG = 1472, ZCU = 1728, ZCV = 1984;
constexpr size_t SZ_WGU = 4ull * 5632 * 1024 * 2, SZ_WDN = 4ull * 1024 * 2816 * 2, SZ_WIN = 2ull * 2304 * 1024 * 2, SZ_WQ = 2ull * 1280 * 384 * 2, SZ_WMIX = 2ull * 1024 * 1536 * 2;
constexpr size_t SKEW = 69888;
constexpr size_t OFF_WGU = 0, OFF_WDN = OFF_WGU + SZ_WGU + SKEW, OFF_WIN = OFF_WDN + SZ_WDN + SKEW, OFF_WQ = OFF_WIN + SZ_WIN + SKEW, OFF_WMIX = OFF_WQ + SZ_WQ + SKEW;
constexpr size_t OFF_X = OFF_WMIX + SZ_WMIX + SKEW, SZ_X = (size_t)MT * 1024 * 4;
constexpr size_t OFF_D = OFF_X + SZ_X + SKEW, SZ_D = (size_t)MT * 1024 * 2;
constexpr size_t OFF_H = OFF_D + SZ_D + SKEW, SZ_H = (size_t)MT * 1024 * 2;
constexpr size_t OFF_ACT = OFF_H + SZ_H + SKEW, SZ_ACT = (size_t)MT * 2816 * 2;
constexpr size_t KROWS = 16384 + 32 * 2112;
constexpr size_t OFF_KC = OFF_ACT + SZ_ACT + SKEW, SZ_KC = KROWS * 640;
constexpr size_t OFF_CT = OFF_KC + SZ_KC + SKEW, SZ_CT = KROWS * 512;
constexpr size_t OFF_MIXA = OFF_CT + SZ_CT + SKEW, SZ_MIXA = (size_t)MT * 1536 * 2;
constexpr size_t OFF_SST = OFF_MIXA + SZ_MIXA + SKEW, SZ_SST = 1024ull * 4096 * 4;
constexpr size_t OFF_ROPE = OFF_SST + SZ_SST + SKEW, SZ_ROPE = 4096ull * 32 * 8;
constexpr size_t OFF_CTL = OFF_ROPE + SZ_ROPE + SKEW, SZ_CTL = 32768;
constexpr size_t OFF_BCUM = OFF_CTL + SZ_CTL + SKEW, SZ_BCUM = (size_t)MT * 256 * 4;
constexpr size_t WS_END = OFF_BCUM + SZ_BCUM;
constexpr size_t OFF_Z = OFF_ACT, SZ_Z = (size_t)MT * ZW * 2;
constexpr size_t OFF_QN = OFF_Z + SZ_Z + SKEW;
constexpr size_t OFF_Q = OFF_X + 1048576 + SKEW;
constexpr size_t OFF_U = OFF_Q + (size_t)MT * 1280 * 2 + SKEW;
constexpr size_t OFF_DEC = OFF_U + 1152ull * 4096 * 4;
static_assert(OFF_QN + (size_t)MT * 384 * 2 <= OFF_ACT + SZ_ACT, "z/qn overlay");
static_assert(OFF_DEC + 1152ull * 64 * 4 <= OFF_X + SZ_X, "Q/U overlay");
constexpr size_t O_Y = 0, O_CKVP = 18874368, O_KPEP = 27262976, O_HGP = 29360128, O_CKVS = 29491200, O_KPES = 30539776, O_HGS = 30801920, O_CMV = 31850496;

constexpr int LDS_MAIN = 157696, LDS_BYTES = LDS_MAIN + 64;
constexpr int NPHASE = 25;

struct Args { const float* in[21]; float* out; unsigned char* ws; int ph_lo, ph_hi; };
typedef const __attribute__((address_space(4))) Args CArgs;

__device__ __forceinline__ int bid_() { int b = blockIdx.x; asm volatile("" : "+s"(b)); return b; }
__device__ __forceinline__ int gdim_() { int g = gridDim.x; asm volatile("" : "+s"(g)); return g; }
__device__ __forceinline__ float bf2f(unsigned short b) { return __uint_as_float(((unsigned)b) << 16); }
__device__ __forceinline__ float bflo(unsigned w) { return __uint_as_float(w << 16); }
__device__ __forceinline__ float bfhi(unsigned w) { return __uint_as_float(w & 0xffff0000u); }
__device__ __forceinline__ unsigned short f2bf(float f) { unsigned u = __float_as_uint(f); u += 0x7FFFu + ((u >> 16) & 1u); return (unsigned short)(u >> 16); }
__device__ __forceinline__ float wave_sum(float v) {
#pragma unroll
    for (int o = 32; o >= 1; o >>= 1) v += __shfl_xor(v, o);
    return v; }
__device__ __forceinline__ float sigmoidf_(float x) { return __builtin_amdgcn_rcpf(1.0f + __expf(-x)); }
__device__ __forceinline__ float siluf_(float x) { return x * sigmoidf_(x); }
__device__ __forceinline__ float geluf_(float x) { const float y = 0.7978845608028654f * (x + 0.044715f * x * x * x); return x - x * __builtin_amdgcn_rcpf(__expf(2.0f * y) + 1.0f); }

struct EpiBf {
    static constexpr bool PERM = true, AFTER_DRAIN = false;
    bf16_t* O; int ldc; bf16_t* O1;
    __device__ __forceinline__ void operator()(const f32x4 (&acc)[2][2][4][2], const Unit& u, int wr, int wc, int fr, int fq) const {
        const int row0 = u.pm * 256 + wr * 64 + fr, col0 = u.pn * 256 + wc * 32 + 8 * fq; bf16_t* Ob = (O1 && u.ks >= 0) ? O1 + ((long)u.ks * MS - MP) * (long)ldc : O;
#pragma unroll
        for (int ai = 0; ai < 2; ++ai)
#pragma unroll
            for (int m = 0; m < 4; ++m) { bf16_t* rowp = Ob + (size_t)(row0 + ai * 128 + m * 16) * ldc + col0;
#pragma unroll
                for (int bj = 0; bj < 2; ++bj) { const f32x4 v0 = acc[ai][bj][m][0], v1 = acc[ai][bj][m][1];
                    u32x4 w; w.x = cvt_pk_bf16(v0[0], v0[1]); w.y = cvt_pk_bf16(v0[2], v0[3]); w.z = cvt_pk_bf16(v1[0], v1[1]); w.w = cvt_pk_bf16(v1[2], v1[3]);
                    *(u32x4*)(rowp + bj * 128) = w; } }
    }
};
struct EpiSwiGLU {
    static constexpr bool PERM = true, AFTER_DRAIN = false;
    bf16_t* O;
    __device__ __forceinline__ void operator()(const f32x4 (&acc)[2][2][4][2], const Unit& u, int wr, int wc, int fr, int fq) const {
        const int row0 = u.pm * 256 + wr * 64 + fr, col0 = u.pn * 128 + wc * 32 + 8 * fq;
#pragma unroll
        for (int ai = 0; ai < 2; ++ai)
#pragma unroll
            for (int m = 0; m < 4; ++m) { bf16_t* rowp = O + (size_t)(row0 + ai * 128 + m * 16) * DFF + col0;
                const f32x4 g0 = acc[ai][0][m][0], g1 = acc[ai][0][m][1], u0 = acc[ai][1][m][0], u1 = acc[ai][1][m][1];
                u32x4 w; w.x = cvt_pk_bf16(siluf_(g0[0]) * u0[0], siluf_(g0[1]) * u0[1]); w.y = cvt_pk_bf16(siluf_(g0[2]) * u0[2], siluf_(g0[3]) * u0[3]);
                w.z = cvt_pk_bf16(siluf_(g1[0]) * u1[0], siluf_(g1[1]) * u1[1]); w.w = cvt_pk_bf16(siluf_(g1[2]) * u1[2], siluf_(g1[3]) * u1[3]);
                *(u32x4*)rowp = w; }
    }
};
struct EpiQ {
    static constexpr bool PERM = true, AFTER_DRAIN = false;
    bf16_t* Q;
    __device__ __forceinline__ void operator()(const f32x4 (&acc)[2][2][4][2], const Unit& u, int wr, int wc, int fr, int fq) const {
        const int row0 = u.pm * 256 + wr * 64 + fr;
        const int off0 = u.pn < 4 ? u.pn * 320 + wc * 32 + 8 * fq : wc * 320 + 256 + 8 * fq, bjs = u.pn < 4 ? 128 : 32;
#pragma unroll
        for (int ai = 0; ai < 2; ++ai)
#pragma unroll
            for (int m = 0; m < 4; ++m) { bf16_t* rowp = Q + (size_t)(row0 + ai * 128 + m * 16) * 1280 + off0;
#pragma unroll
                for (int bj = 0; bj < 2; ++bj) { const f32x4 v0 = acc[ai][bj][m][0], v1 = acc[ai][bj][m][1];
                    u32x4 w; w.x = cvt_pk_bf16(v0[0], v0[1]); w.y = cvt_pk_bf16(v0[2], v0[3]); w.z = cvt_pk_bf16(v1[0], v1[1]); w.w = cvt_pk_bf16(v1[2], v1[3]);
                    *(u32x4*)(rowp + bj * bjs) = w; } }
    }
};
struct TailSplitOrder {
    int G, c, nsp, nt_full, nt_sub, kb_sub;
    __device__ bool next(int i, Unit& u) const {
        const int L = i * G + c;
        if (L < 256) { const int off = L >> 3; u.pm = (L & 7) * 8 + (off >> 2); u.pn = off & 3; u.ks = -1; u.nt = nt_full; u.koff = 0; return true; }
        const int s2 = L - 256; if (s2 >= 32 * nsp) return false;
        const int pair = s2 & 31; u.pm = 64 + (pair >> 2); u.pn = pair & 3; u.ks = s2 >> 5; u.nt = nt_sub; u.koff = u.ks * kb_sub; return true;
    }
    __device__ __forceinline__ void a_ready(const Unit&) const {}
    __device__ __forceinline__ void done(const Unit&) const {}
};
template <class Epi> __device__ __forceinline__ void run_gemm(unsigned char* lds, const bf16_t* A, const bf16_t* Bt, int M, int N, int K, const Epi& E, int nsp = 0  ) {
    pg8::Gemm g{A, Bt, M, N, K, K};
    if (nsp) { TailSplitOrder S; S.G = gdim_(); S.c = bid_(); S.nsp = nsp; S.nt_full = K / 64; S.nt_sub = K / nsp / 64; S.kb_sub = K / nsp * 2; pg8::gemm_phase<Epi, TailSplitOrder, false>((PG8_LAS unsigned char*)lds, g, S, E, nullptr); }
    else { pg8::StaticOrder S; S.init(M, N, gdim_(), bid_(), 1); S.unt = K / 64; S.ukb = K * 2; pg8::gemm_phase<Epi, pg8::StaticOrder, false>((PG8_LAS unsigned char*)lds, g, S, E, nullptr); }
}
#define GAS __attribute__((address_space(1)))
#define XB_TMO      128
#define XB_XCNT(j)  (256  + 64 * (j))
#define XB_XSUB(j)  (1280 + 64 * (j))
#define XB_XGEN(j)  (2304 + 64 * (j))
#define XB_TOP      3328
#define XB_TOPGEN   3392
#define XCD_BAR_WORDS 3456
#define XB_SPIN_CAP (1u << 18)

__device__ __forceinline__ unsigned xb_ld(unsigned* p)              { return __hip_atomic_load(p, __ATOMIC_RELAXED, __HIP_MEMORY_SCOPE_AGENT); }
__device__ __forceinline__ unsigned xb_add(unsigned* p, unsigned v) { return __hip_atomic_fetch_add(p, v, __ATOMIC_RELAXED, __HIP_MEMORY_SCOPE_AGENT); }
__device__ __forceinline__ unsigned xb_xcc_id() { return (unsigned)__builtin_amdgcn_s_getreg((3 << 11) | 20) & 0xFu; }
#define XB_SPIN(cond, bar) do { unsigned _sp = 0; while (cond) { __builtin_amdgcn_s_sleep(1); \
    if ((++_sp & 255u) == 0u) { if (xb_ld(&(bar)[XB_TMO])) break; if (_sp > XB_SPIN_CAP) { atomicAdd(&(bar)[XB_TMO], 1u); break; } } } } while (0)

struct XcdBarrier {
    unsigned* bar; unsigned x;
    volatile LAS unsigned* st;
};

__device__ __forceinline__ XcdBarrier xcd_barrier_post(unsigned* bar, volatile LAS unsigned* st) {
    XcdBarrier b; b.bar = bar; b.x = xb_xcc_id(); b.st = st;
    if (threadIdx.x == 0) (void)xb_add(&bar[XB_XCNT(b.x)], 1u);
    return b;
}
__device__ __forceinline__ void xcd_barrier_complete(unsigned* bar, unsigned x, unsigned& nloc, unsigned& nx) {
    const unsigned G = gridDim.x * gridDim.y * gridDim.z;
    unsigned sum, cnt, mine, sp = 0u;
    for (;;) {
        sum = 0u; cnt = 0u; mine = 0u;
#pragma unroll
        for (unsigned j = 0; j < 16; ++j) { const unsigned c = xb_ld(&bar[XB_XCNT(j)]); sum += c; cnt += (c > 0u) ? 1u : 0u; mine = (j == x) ? c : mine; }
        if (sum == G) break;
        __builtin_amdgcn_s_sleep(1);
        if ((++sp & 255u) == 0u) { if (xb_ld(&bar[XB_TMO])) break; if (sp > XB_SPIN_CAP) { atomicAdd(&bar[XB_TMO], 1u); break; } }
    }
    nloc = mine > 0u ? mine : 1u; nx = cnt > 0u ? cnt : 1u;
}

__device__ __forceinline__ void xcd_barrier(const XcdBarrier& b) {
    asm volatile("s_waitcnt vmcnt(0)" ::: "memory");
    __syncthreads();
    if (threadIdx.x == 0) {
        unsigned* bar = b.bar; asm volatile("" : "+s"(bar));
        __builtin_amdgcn_s_waitcnt(0);
        unsigned nloc = b.st[0], nx = b.st[1];
        if (nloc == 0u) { xcd_barrier_complete(bar, b.x, nloc, nx); b.st[0] = nloc; b.st[1] = nx; }
        const unsigned old = xb_add(&bar[XB_XSUB(b.x)], 1u);
        const unsigned gen = old / nloc;
        if (old + 1u == (gen + 1u) * nloc) {
            __builtin_amdgcn_fence(__ATOMIC_RELEASE, "agent");
            asm volatile("s_waitcnt vmcnt(0)" ::: "memory");
            const unsigned og = xb_add(&bar[XB_TOP], 1u);
            const unsigned tg = og / nx;
            if (og + 1u == (tg + 1u) * nx) xb_add(&bar[XB_TOPGEN], 1u);
            else XB_SPIN(xb_ld(&bar[XB_TOPGEN]) == tg, bar);
            __builtin_amdgcn_fence(__ATOMIC_ACQUIRE, "agent");
            xb_add(&bar[XB_XGEN(b.x)], 1u);
            asm volatile("s_waitcnt vmcnt(0)" ::: "memory");
        } else {
            XB_SPIN(xb_ld(&bar[XB_XGEN(b.x)]) == gen, bar);
            __builtin_amdgcn_fence(__ATOMIC_ACQUIRE, "agent");
            asm volatile("s_waitcnt vmcnt(0)" ::: "memory");
        }
    }
    __syncthreads();
}
__device__ __forceinline__ void tr_tile(const float* __restrict__ src, int srcN, bf16_t* __restrict__ dst, int dstK, int k0, int n0, int mode, float* T) {
    int tid = threadIdx.x; asm volatile("" : "+v"(tid));
    float4 v[4];
#pragma unroll
    for (int e = 0; e < 4; ++e) { const int idx = tid + 512 * e, kk = idx >> 4, n4 = idx & 15; v[e] = *(const float4*)(src + (size_t)(k0 + kk) * srcN + n0 + 4 * n4); }
#pragma unroll
    for (int e = 0; e < 4; ++e) { const int idx = tid + 512 * e, kk = idx >> 4, n4 = idx & 15; float* t = T + kk * 65 + 4 * n4; t[0] = v[e].x; t[1] = v[e].y; t[2] = v[e].z; t[3] = v[e].w; }
    __syncthreads();
#pragma unroll
    for (int e = 0; e < 2; ++e) { const int idx = tid + 512 * e, nn = idx >> 4, kq = idx & 15; const int n = n0 + nn;
        const int row = mode == 0 ? n : ((n >> 7) * 256 + (n & 127) + (mode == 2 ? 128 : 0)); const float* t = T + (8 * kq) * 65 + nn;
        u32x4 w; w.x = cvt_pk_bf16(t[0], t[65]); w.y = cvt_pk_bf16(t[130], t[195]); w.z = cvt_pk_bf16(t[260], t[325]); w.w = cvt_pk_bf16(t[390], t[455]);
        *(u32x4*)(dst + (size_t)row * dstK + k0 + 8 * kq) = w; }
    __syncthreads();
}
__device__ __forceinline__ void tr_task(const float* src, int srcN, int K, bf16_t* dst, int dstK, int mode, float* T) {
    const int tn = srcN >> 6, nt = (K >> 7) * tn;
    for (int t = bid_(); t < nt; t += gdim_()) tr_tile(src, srcN, dst, dstK, (t / tn) * 128, (t % tn) * 64, mode, T);
}
template <bool XIN_F32, bool XOUT_F32>
__device__ __forceinline__ void ew_phase(const bf16_t* __restrict__ D, const bf16_t* D1  , int nsp, const void* xa  , const float* __restrict__ xb  , void* xout  ,
                                         const float* __restrict__ gpost, float coef, const float* __restrict__ gpre, bf16_t* hout, const float* __restrict__ gin, float* rsb  ) {
    int tid = threadIdx.x; asm volatile("" : "+v"(tid)); const int lane = tid & 63, wave = tid >> 6;
    const int rstep = gdim_() * 8;
    for (int rb = bid_() * 8 + wave; rb < MT; rb += 2 * rstep) {
        float4 xv[2][4]; float dv[2][4][4];
#pragma unroll
        for (int u = 0; u < 2; ++u) { const int r = rb + u * rstep; if (r < MT) {
            if (XIN_F32) { const float* xr = (xb && r >= MP) ? xb + (size_t)(r - MP) * DM : (const float*)xa + (size_t)r * DM;
#pragma unroll
                for (int i = 0; i < 4; ++i) xv[u][i] = *(const float4*)(xr + lane * 4 + 256 * i); }
            else {
#pragma unroll
                for (int i = 0; i < 4; ++i) { const uint2 w = *(const uint2*)((const bf16_t*)xa + (size_t)r * DM + lane * 4 + 256 * i); xv[u][i] = make_float4(bflo(w.x), bfhi(w.x), bflo(w.y), bfhi(w.y)); }
                const float ir = __builtin_amdgcn_rcpf(rsb[r]);
#pragma unroll
                for (int i = 0; i < 4; ++i) { const float4 gi = *(const float4*)(gin + lane * 4 + 256 * i);
                    xv[u][i].x *= ir * __builtin_amdgcn_rcpf(gi.x); xv[u][i].y *= ir * __builtin_amdgcn_rcpf(gi.y); xv[u][i].z *= ir * __builtin_amdgcn_rcpf(gi.z); xv[u][i].w *= ir * __builtin_amdgcn_rcpf(gi.w); } }
            if (D) {
#pragma unroll
                for (int i = 0; i < 4; ++i) { const uint2 w = *(const uint2*)(D + (size_t)r * DM + lane * 4 + 256 * i); dv[u][i][0] = bflo(w.x); dv[u][i][1] = bfhi(w.x); dv[u][i][2] = bflo(w.y); dv[u][i][3] = bfhi(w.y);
                    } } } }
        if (D1) {
#pragma unroll
            for (int u = 0; u < 2; ++u) { const int r = rb + u * rstep; if (r >= MP && r < MT) {
#pragma unroll
                for (int i = 0; i < 4; ++i) { dv[u][i][0] = 0.f; dv[u][i][1] = 0.f; dv[u][i][2] = 0.f; dv[u][i][3] = 0.f; }
#pragma unroll 4
                for (int ks = 0; ks < nsp; ++ks) {
#pragma unroll
                    for (int i = 0; i < 4; ++i) { const uint2 w1 = *(const uint2*)(D1 + ((size_t)ks * MS + (r - MP)) * DM + lane * 4 + 256 * i); dv[u][i][0] += bflo(w1.x); dv[u][i][1] += bfhi(w1.x); dv[u][i][2] += bflo(w1.y); dv[u][i][3] += bfhi(w1.y); } } } } }
#pragma unroll
        for (int u = 0; u < 2; ++u) { const int r = rb + u * rstep; if (r < MT) {
            if (D) { float ss = 0.f;
#pragma unroll
                for (int i = 0; i < 4; ++i) ss += dv[u][i][0] * dv[u][i][0] + dv[u][i][1] * dv[u][i][1] + dv[u][i][2] * dv[u][i][2] + dv[u][i][3] * dv[u][i][3];
                ss = wave_sum(ss); const float rs = coef * rsqrtf(ss * (1.0f / 1024.0f) + EPS);
#pragma unroll
                for (int i = 0; i < 4; ++i) { const float4 g = *(const float4*)(gpost + lane * 4 + 256 * i);
                    xv[u][i].x += dv[u][i][0] * rs * g.x; xv[u][i].y += dv[u][i][1] * rs * g.y; xv[u][i].z += dv[u][i][2] * rs * g.z; xv[u][i].w += dv[u][i][3] * rs * g.w; } }
            if (XOUT_F32) {
#pragma unroll
                for (int i = 0; i < 4; ++i) *(float4*)((float*)xout + (size_t)r * DM + lane * 4 + 256 * i) = xv[u][i]; }

            if (hout) { float ss = 0.f;
#pragma unroll
                for (int i = 0; i < 4; ++i) ss += xv[u][i].x * xv[u][i].x + xv[u][i].y * xv[u][i].y + xv[u][i].z * xv[u][i].z + xv[u][i].w * xv[u][i].w;
                ss = wave_sum(ss); const float rs = rsqrtf(ss * (1.0f / 1024.0f) + EPS); if (lane == 0) rsb[r] = rs;
#pragma unroll
                for (int i = 0; i < 4; ++i) { const float4 g = *(const float4*)(gpre + lane * 4 + 256 * i); uint2 w;
                    w.x = cvt_pk_bf16(xv[u][i].x * rs * g.x, xv[u][i].y * rs * g.y); w.y = cvt_pk_bf16(xv[u][i].z * rs * g.z, xv[u][i].w * rs * g.w);
                    *(uint2*)(hout + (size_t)r * DM + lane * 4 + 256 * i) = w; } } } }
    }
}
__device__ __forceinline__ int wtask_count(int kind) { return kind < 6 ? 352 : kind == 6 ? 281 : kind == 7 ? 64 : kind == 8 ? 256 : kind == 9 ? 96 : 192; }
__device__ void wtask_run(CArgs& a, int l, int kind, int t, unsigned char* lds) {
    unsigned char* ws = a.ws; float* T = (float*)lds; int tid = threadIdx.x; asm volatile("" : "+v"(tid));
    if (kind < 6) { const int f = kind / 3, m = kind % 3; const size_t lf = (size_t)(l * 2 + f);
        if (m < 2) tr_tile(a.in[6 + m] + lf * 1024 * 2816, 2816, (bf16_t*)(ws + OFF_WGU) + lf * 5632 * 1024, 1024, (t / 44) * 128, (t % 44) * 64, 1 + m, T);
        else tr_tile(a.in[8] + lf * 2816 * 1024, 1024, (bf16_t*)(ws + OFF_WDN) + lf * 1024 * 2816, 2816, (t / 16) * 128, (t % 16) * 64, 0, T);
    } else if (kind == 6) { bf16_t* win = (bf16_t*)(ws + OFF_WIN) + (size_t)l * 2304 * 1024;
        if (t < 280) tr_tile(a.in[9] + (size_t)l * 1024 * 2240, 2240, win, 1024, (t / 35) * 128, (t % 35) * 64, 0, T);
        else { for (int i = tid; i < 64 * 1024 / 2; i += 512) ((unsigned*)(win + 2240 * 1024))[i] = 0u; }
    } else if (kind == 7) { bf16_t* wmix = (bf16_t*)(ws + OFF_WMIX) + (size_t)l * 1024 * 1536;
        tr_tile(a.in[10] + (size_t)l * 1024 * 1024 + 512 * 1024, 1024, wmix + 1024, 1536, (t / 16) * 128, (t % 16) * 64, 0, T);
    } else if (kind == 8) {
        bf16_t* wmix = (bf16_t*)(ws + OFF_WMIX) + (size_t)l * 1024 * 1536; const float* wuv = a.in[15] + (size_t)l * 256 * 512; const float* wo = a.in[10] + (size_t)l * 1024 * 1024;
        const int i = t * 512 + tid; const int n = i & 1023, hcb = t >> 1, h = hcb >> 5, cb = hcb & 31;
        float* W = T;
        __syncthreads();
#pragma unroll
        for (int e = 0; e < 2; ++e) { const int q = tid + 512 * e, j = q >> 7, v = q & 127; W[v * 8 + j] = wuv[((8 * cb + j) * 4 + h) * 128 + v]; }
        __syncthreads();
        const float* bv = wo + (size_t)(h * 128) * 1024 + n; float acc[8];
#pragma unroll
        for (int j = 0; j < 8; ++j) acc[j] = 0.f;
#pragma unroll 1
        for (int v0 = 0; v0 < 128; v0 += 16) { float bb[16];
#pragma unroll
            for (int u = 0; u < 16; ++u) bb[u] = bv[(size_t)(v0 + u) * 1024];
#pragma unroll
            for (int u = 0; u < 16; ++u) { const float4 w0 = *(const float4*)(W + (v0 + u) * 8), w1 = *(const float4*)(W + (v0 + u) * 8 + 4);
                acc[0] += w0.x * bb[u]; acc[1] += w0.y * bb[u]; acc[2] += w0.z * bb[u]; acc[3] += w0.w * bb[u]; acc[4] += w1.x * bb[u]; acc[5] += w1.y * bb[u]; acc[6] += w1.z * bb[u]; acc[7] += w1.w * bb[u]; } }
        u32x4 w; w.x = cvt_pk_bf16(acc[0], acc[1]); w.y = cvt_pk_bf16(acc[2], acc[3]); w.z = cvt_pk_bf16(acc[4], acc[5]); w.w = cvt_pk_bf16(acc[6], acc[7]);
        *(u32x4*)(wmix + (size_t)n * 1536 + h * 256 + 8 * cb) = w;
        __syncthreads();
    } else { bf16_t* wq = (bf16_t*)(ws + OFF_WQ) + (size_t)l * 1280 * 384; const float* wuk = a.in[14] + (size_t)l * 256 * 512; const float* wqb = a.in[12] + (size_t)l * 384 * 768;
        const int i = t * 512 + tid;
        if (kind == 9) {
            const int k = i % 384, hcb = i / 384, h = hcb >> 5, cb = hcb & 31;
            const float4* bv = (const float4*)(wqb + (size_t)k * 768 + h * 192); float acc[8];
#pragma unroll
            for (int j = 0; j < 8; ++j) acc[j] = 0.f;
#pragma unroll 2
            for (int v = 0; v < 32; ++v) { const float4 y = bv[v];
#pragma unroll
                for (int j = 0; j < 8; ++j) { const float4 x = *(const float4*)(wuk + ((8 * cb + j) * 4 + h) * 128 + 4 * v); acc[j] += x.x * y.x + x.y * y.y + x.z * y.z + x.w * y.w; } }
#pragma unroll
            for (int j = 0; j < 8; ++j) wq[(size_t)(h * 256 + 8 * cb + j) * 384 + k] = f2bf(acc[j] * QSCALE);
        } else {
            const int k = i % 384, j = i / 384, half = j >> 7, jj = j & 127, h = jj >> 5, fi = jj & 31;
            wq[(size_t)(1024 + j) * 384 + k] = f2bf(wqb[(size_t)k * 768 + h * 192 + 128 + half * 32 + fi] * QSCALE); }
    }
}
__device__ void wtasks(CArgs& a, int l, int k0, int k1, int cw, unsigned char* lds) {
    unsigned* ctr = (unsigned*)(a.ws + OFF_CTL) + cw; LAS unsigned* slot = (LAS unsigned*)(lds + LDS_MAIN + 16);
    int total = 0; for (int k = k0; k < k1; ++k) total += wtask_count(k);
    for (;;) {
        __syncthreads();
        { int t0 = threadIdx.x; asm volatile("" : "+v"(t0)); if (t0 == 0) *slot = atomicAdd(ctr, 1u); }
        __syncthreads();
        int it = (int)*slot;
        if (it >= total) break;
        int k = k0; while (it >= wtask_count(k)) { it -= wtask_count(k); ++k; }
        wtask_run(a, l, k, it, lds);
    }
}
__device__ void phase_init(CArgs& a, unsigned char* lds) {
    unsigned char* ws = a.ws;
    int tid = threadIdx.x; asm volatile("" : "+v"(tid)); const size_t gtid = (size_t)bid_() * 512 + tid, gsz = (size_t)gdim_() * 512;
    for (size_t i = gtid; i < 4096 * 32; i += gsz) { const int pos = (int)(i >> 5), fi = (int)(i & 31);
        const float w = exp2f(-(float)fi * (13.287712379549449f / 32.0f)); const double ang = (double)((float)pos * w);
        const double k = rint(ang * 0.15915494309189535); const float rr = (float)(ang - k * 6.283185307179586);
        ((float2*)(ws + OFF_ROPE))[i] = make_float2(__cosf(rr), __sinf(rr)); }
    wtasks(a, 0, 0, 3, 256, lds); wtasks(a, 0, 6, 7, 272, lds);
    ew_phase<true, false>(nullptr, nullptr, 0, a.in[0], a.in[1], nullptr, nullptr, 0.f, a.in[5], (bf16_t*)(ws + OFF_H), nullptr, (float*)(ws + OFF_X));
}
__device__ void tail_wtasks(CArgs& a, int ph, unsigned char* lds) {
    switch (ph) {
    case 1:  wtasks(a, 0, 10, 11, 257, lds); wtasks(a, 0, 7, 8, 258, lds); break;
    case 2:  wtasks(a, 0, 3, 4, 259, lds); break;
    case 4:  wtasks(a, 0, 9, 10, 260, lds); wtasks(a, 0, 4, 5, 261, lds); break;
    case 6:  wtasks(a, 0, 8, 9, 262, lds); break;
    case 8:  wtasks(a, 0, 5, 6, 263, lds); break;
    case 10: wtasks(a, 1, 0, 3, 264, lds); wtasks(a, 1, 6, 7, 265, lds); wtasks(a, 1, 9, 10, 266, lds); break;
    case 11: wtasks(a, 1, 10, 11, 267, lds); wtasks(a, 1, 7, 8, 268, lds); break;
    case 14: wtasks(a, 1, 3, 4, 269, lds); break;
    case 16: wtasks(a, 1, 4, 6, 270, lds); break;
    case 18: wtasks(a, 1, 8, 9, 271, lds); break;
    default: break; }
}
__device__ __forceinline__ int keyof32(int p) { const int g = p >> 3, j = p & 7; return j < 4 ? 4 * g + j : 16 + 4 * g + (j - 4); }
__device__ __forceinline__ void ct_write(const bf16_t* ctile, bf16_t* dst  , size_t rowstride) {
    int tid = threadIdx.x; asm volatile("" : "+v"(tid)); const int c = tid >> 1, half = tid & 1;
    unsigned w[16];
#pragma unroll
    for (int p = 0; p < 32; p += 2) { const int t0 = 32 * half + keyof32(p), t1 = 32 * half + keyof32(p + 1);
        w[p >> 1] = (unsigned)ctile[t0 * 264 + c] | ((unsigned)ctile[t1 * 264 + c] << 16); }
    uint4* d = (uint4*)(dst + (size_t)c * rowstride + 32 * half);
#pragma unroll
    for (int i = 0; i < 4; ++i) d[i] = make_uint4(w[4 * i], w[4 * i + 1], w[4 * i + 2], w[4 * i + 3]);
}
__device__ __forceinline__ float lb_of(CArgs& a, int l, int e) { if (l == 0) return 0.f; const float a0 = a.in[16][e], a1 = a.in[16][256 + e]; return 1.0f / (1.0f + __expf(a0 - a1)); }
__device__ void prep_mla_tile(CArgs& a, int l, int T, unsigned char* lds) {
    unsigned char* ws = a.ws; int tid = threadIdx.x; asm volatile("" : "+v"(tid)); const int lane = tid & 63, wave = tid >> 6;
    const bf16_t* z = (const bf16_t*)(ws + OFF_Z); const int r0 = T * 64;
    const bool prm = T < 256; const int b = prm ? (T >> 6) : (T - 256), j = prm ? (T & 63) : 0; const int pos0 = prm ? j * 64 : 2048;
    bf16_t* kc = (bf16_t*)(ws + OFF_KC) + (prm ? (size_t)(b * 4096 + j * 64) : (size_t)16384 + (size_t)b * 2112 + 2048) * 320;
    bf16_t* ct = (bf16_t*)(ws + OFF_CT) + (prm ? (size_t)b * 256 * 4096 + j * 64 : (size_t)16384 * 256 + (size_t)b * 256 * 2112 + 2048);
    const size_t ctstride = prm ? 4096 : 2112;
    float* ockv = a.out + (prm ? O_CKVP + ((size_t)(l * 4 + b) * 4096 + j * 64) * 256 : O_CKVS + ((size_t)(l * 32 + b) * 64) * 256);
    float* okpe = a.out + (prm ? O_KPEP + ((size_t)(l * 4 + b) * 4096 + j * 64) * 64 : O_KPES + ((size_t)(l * 32 + b) * 64) * 64);
    bf16_t* qn = (bf16_t*)(ws + OFF_QN); const float* qag = a.in[11] + l * 384; const float* kvg = a.in[13] + l * 256;
    const float2* rope = (const float2*)(ws + OFF_ROPE);
    bf16_t* ctile = (bf16_t*)lds;
    float qg[6];
#pragma unroll
    for (int i = 0; i < 3; ++i) { qg[2 * i] = qag[2 * lane + 128 * i]; qg[2 * i + 1] = qag[2 * lane + 128 * i + 1]; }
    const float4 g4 = *(const float4*)(kvg + 4 * lane);
#pragma unroll 1
    for (int tb = 0; tb < 8; tb += 4) {
        unsigned wq[4][3]; uint2 wk[4]; bf16_t p1[4], p2[4];
#pragma unroll
        for (int u = 0; u < 4; ++u) { const bf16_t* zr = z + (size_t)(r0 + wave + 8 * (tb + u)) * ZW;
#pragma unroll
            for (int i = 0; i < 3; ++i) wq[u][i] = *(const unsigned*)(zr + ZQ + 2 * lane + 128 * i);
            wk[u] = *(const uint2*)(zr + ZKV + 4 * lane); p1[u] = zr[ZPE + (lane & 31)]; p2[u] = zr[ZPE + 32 + (lane & 31)]; }
#pragma unroll
        for (int u = 0; u < 4; ++u) { const int t = wave + 8 * (tb + u);
            { float v[6]; float ss = 0.f;
#pragma unroll
              for (int i = 0; i < 3; ++i) { v[2 * i] = bflo(wq[u][i]); v[2 * i + 1] = bfhi(wq[u][i]); ss += v[2 * i] * v[2 * i] + v[2 * i + 1] * v[2 * i + 1]; }
              ss = wave_sum(ss); const float rs = rsqrtf(ss * (1.0f / 384.0f) + EPS);
#pragma unroll
              for (int i = 0; i < 3; ++i) *(unsigned*)(qn + (size_t)(r0 + t) * 384 + 2 * lane + 128 * i) = cvt_pk_bf16(v[2 * i] * rs * qg[2 * i], v[2 * i + 1] * rs * qg[2 * i + 1]); }
            { float v0 = bflo(wk[u].x), v1 = bfhi(wk[u].x), v2 = bflo(wk[u].y), v3 = bfhi(wk[u].y);
              const float ss = wave_sum(v0 * v0 + v1 * v1 + v2 * v2 + v3 * v3); const float rs = rsqrtf(ss * (1.0f / 256.0f) + EPS);
              v0 *= rs * g4.x; v1 *= rs * g4.y; v2 *= rs * g4.z; v3 *= rs * g4.w;
              *(float4*)(ockv + (size_t)t * 256 + 4 * lane) = make_float4(v0, v1, v2, v3);
              uint2 o; o.x = cvt_pk_bf16(v0, v1); o.y = cvt_pk_bf16(v2, v3);
              *(uint2*)(kc + (size_t)t * 320 + 4 * lane) = o; *(uint2*)(ctile + t * 264 + 4 * lane) = o; }
            if (lane < 32) { const float x1 = bf2f(p1[u]), x2 = bf2f(p2[u]); const float2 cs = rope[(pos0 + t) * 32 + lane];
              const float o1 = x1 * cs.x - x2 * cs.y, o2 = x2 * cs.x + x1 * cs.y;
              okpe[(size_t)t * 64 + lane] = o1; okpe[(size_t)t * 64 + 32 + lane] = o2; kc[(size_t)t * 320 + 256 + lane] = f2bf(o1); kc[(size_t)t * 320 + 288 + lane] = f2bf(o2); } }
    }
    __syncthreads();
    ct_write(ctile, ct, ctstride);
    __syncthreads();
}
__device__ void prep_hgrn_tile(CArgs& a, int l, int T, unsigned char* lds) {
    unsigned char* ws = a.ws; int tid = threadIdx.x; asm volatile("" : "+v"(tid)); asm volatile("" : "+s"(l));
    const bf16_t* z = (const bf16_t*)(ws + OFF_Z); const int r0 = T * 64;
    float* lf = (float*)lds; float* vt = (float*)(lds + 65536); float* tot = (float*)(lds + 131072);
    const int ep = tid & 255, hf = tid >> 8; const float lbv = lb_of(a, l, ep);
    bf16_t zfr[32]; float pref[32];
    { bf16_t zvr[32];
#pragma unroll
      for (int i = 0; i < 32; ++i) { const bf16_t* zr = z + (size_t)(r0 + 32 * hf + i) * ZW; zfr[i] = zr[ZHF + ep]; zvr[i] = zr[ZHI + ep]; }
      float run = 0.f;
#pragma unroll
      for (int i = 0; i < 32; ++i) { const float f = lbv + (1.0f - lbv) * sigmoidf_(bf2f(zfr[i])); run += __logf(fmaxf(f, 1e-30f)); pref[i] = run; vt[(32 * hf + i) * 256 + ep] = bf2f(zvr[i]); }
      tot[hf * 256 + ep] = run; }
    __syncthreads();
    { const float t0 = tot[ep], bl = t0 + tot[256 + ep], off = hf ? t0 : 0.f;
#pragma unroll
      for (int i = 0; i < 32; ++i) { lf[(32 * hf + i) * 256 + ep] = (1.0f - lbv) * sigmoidf_(-bf2f(zfr[i])) * __expf(bl - pref[i] - off); ((float*)(ws + OFF_BCUM))[(size_t)(r0 + 32 * hf + i) * 256 + ep] = pref[i] + off; }
      if (hf == 0) ((float*)(ws + OFF_DEC))[T * 256 + ep] = __expf(bl); }
    __syncthreads();
    { const int h = tid >> 7, eb = (tid & 127) >> 3, db = tid & 7; float acc[4][8];
#pragma unroll
      for (int i = 0; i < 4; ++i)
#pragma unroll
          for (int jj = 0; jj < 8; ++jj) acc[i][jj] = 0.f;
#pragma unroll 4
      for (int s = 0; s < 64; ++s) { const float4 kv = *(const float4*)(lf + s * 256 + h * 64 + eb * 4); const float4 v0 = *(const float4*)(vt + s * 256 + h * 64 + db * 8), v1 = *(const float4*)(vt + s * 256 + h * 64 + db * 8 + 4);
          const float kk[4] = {kv.x, kv.y, kv.z, kv.w}; const float vv[8] = {v0.x, v0.y, v0.z, v0.w, v1.x, v1.y, v1.z, v1.w};
#pragma unroll
          for (int i = 0; i < 4; ++i)
#pragma unroll
              for (int jj = 0; jj < 8; ++jj) acc[i][jj] += kk[i] * vv[jj]; }
      float* U = (float*)(ws + OFF_U) + (size_t)(T * 4 + h) * 4096;
#pragma unroll
      for (int i = 0; i < 4; ++i) { *(float4*)(U + (eb * 4 + i) * 64 + db * 8) = make_float4(acc[i][0], acc[i][1], acc[i][2], acc[i][3]); *(float4*)(U + (eb * 4 + i) * 64 + db * 8 + 4) = make_float4(acc[i][4], acc[i][5], acc[i][6], acc[i][7]); } }
    __syncthreads();
}
__device__ void prep_cache_tile(CArgs& a, int l, int P, unsigned char* lds) {
    unsigned char* ws = a.ws; int tid = threadIdx.x; asm volatile("" : "+v"(tid)); const int b = P >> 5, kt = P & 31;
    const float* ckv = a.in[2] + ((size_t)(l * 32 + b) * 2048 + kt * 64) * 256; const float* kpe = a.in[3] + ((size_t)(l * 32 + b) * 2048 + kt * 64) * 64;
    bf16_t* kc = (bf16_t*)(ws + OFF_KC) + ((size_t)16384 + (size_t)b * 2112 + kt * 64) * 320;
    bf16_t* ct = (bf16_t*)(ws + OFF_CT) + (size_t)16384 * 256 + (size_t)b * 256 * 2112 + kt * 64;
    bf16_t* ctile = (bf16_t*)lds;
#pragma unroll
    for (int i = 0; i < 8; ++i) { const int q = tid + 512 * i, t = q >> 6, c4 = q & 63; const float4 v = *(const float4*)(ckv + (size_t)t * 256 + c4 * 4);
        uint2 o; o.x = cvt_pk_bf16(v.x, v.y); o.y = cvt_pk_bf16(v.z, v.w); *(uint2*)(kc + (size_t)t * 320 + c4 * 4) = o; *(uint2*)(ctile + t * 264 + c4 * 4) = o; }
#pragma unroll
    for (int i = 0; i < 2; ++i) { const int q = tid + 512 * i, t = q >> 4, c4 = q & 15; const float4 v = *(const float4*)(kpe + (size_t)t * 64 + c4 * 4);
        uint2 o; o.x = cvt_pk_bf16(v.x, v.y); o.y = cvt_pk_bf16(v.z, v.w); *(uint2*)(kc + (size_t)t * 320 + 256 + c4 * 4) = o; }
    __syncthreads();
    ct_write(ctile, ct, 2112);
    __syncthreads();
}
__device__ void phase_prep(CArgs& a, int l, unsigned char* lds, int rep = 0) {
    unsigned* ctr = (unsigned*)(a.ws + OFF_CTL) + 16 * (l + 1) + 8 + 128 * rep; LAS unsigned* slot = (LAS unsigned*)(lds + LDS_MAIN + 16);
    for (;;) {
        __syncthreads();
        { int t0 = threadIdx.x; asm volatile("" : "+v"(t0)); if (t0 == 0) *slot = atomicAdd(ctr, 1u); }
        __syncthreads();
        const int it = (int)*slot;
        if (it >= 2 * NTILE) break;
        if (it < NTILE) prep_hgrn_tile(a, l, it, lds); else prep_mla_tile(a, l, it - NTILE, lds);
    }
}
__device__ void phase_cache(CArgs& a, int l, unsigned char* lds) {
    unsigned* ctr = (unsigned*)(a.ws + OFF_CTL) + 16 * (l + 1) + 12; LAS unsigned* slot = (LAS unsigned*)(lds + LDS_MAIN + 16);
    for (;;) {
        __syncthreads();
        { int t0 = threadIdx.x; asm volatile("" : "+v"(t0)); if (t0 == 0) *slot = atomicAdd(ctr, 1u); }
        __syncthreads();
        const int it = (int)*slot;
        if (it >= 1024) break;
        prep_cache_tile(a, l, it, lds);
    }
}
__device__ void phase_scan(CArgs& a, int l) {
    unsigned char* ws = a.ws; int tid = threadIdx.x; asm volatile("" : "+v"(tid)); const size_t gtid = (size_t)bid_() * 512 + tid, gsz = (size_t)gdim_() * 512;
    const float* U = (const float*)(ws + OFF_U); const float* dec = (const float*)(ws + OFF_DEC); float* sst = (float*)(ws + OFF_SST);
    for (size_t i = gtid; i < 16 * 4096; i += gsz) { const int bh = (int)(i >> 12), ed = (int)(i & 4095), b = bh >> 2, h = bh & 3, e = ed >> 6; float S = 0.f;
#pragma unroll 16
        for (int j = 0; j < 64; ++j) { const size_t ch = (size_t)((b * 64 + j) * 4 + h); sst[ch * 4096 + ed] = S; S = dec[ch * 64 + e] * S + U[ch * 4096 + ed]; }
        a.out[O_HGP + (size_t)(l * 16 + bh) * 4096 + ed] = S; }
    for (size_t i = gtid; i < 128 * 4096; i += gsz) { const int bh = (int)(i >> 12), ed = (int)(i & 4095), b = bh >> 2, h = bh & 3, e = ed >> 6; const size_t ch = (size_t)((256 + b) * 4 + h);
        const float S0 = a.in[4][(size_t)(l * 128 + bh) * 4096 + ed];
        a.out[O_HGS + (size_t)(l * 128 + bh) * 4096 + ed] = dec[ch * 64 + e] * S0 + U[ch * 4096 + ed]; }
}
constexpr int KSTR = 656, VSTR = 144, VOFF = 64 * KSTR, ABUF = VOFF + 256 * VSTR;
__device__ __forceinline__ int swz16(int row) { return (((row & 15) + 4) >> 3) & 1; }
__device__ void attn_item(CArgs& a, int idx, unsigned char* ldsg) {
    unsigned char* ws = a.ws; LAS unsigned char* lds = (LAS unsigned char*)ldsg;
    int tid = threadIdx.x; asm volatile("" : "+v"(tid)); const int lane = tid & 63, wave = __builtin_amdgcn_readfirstlane(tid >> 6), lr = lane & 15, g = lane >> 4;
    const int gx = (g ^ swz16(lr)) * 16;
    int b, hp, nkt, r0; const unsigned char* kcb; const unsigned char* ctb; int ctstride;
    if (idx >= 256 && idx < 320) { const int s = idx - 256; b = s >> 1; hp = s & 1; nkt = 33; r0 = MP + b * 64;
        kcb = ws + OFF_KC + ((size_t)16384 + (size_t)b * 2112) * 640; ctb = ws + OFF_CT + ((size_t)16384 * 256 + (size_t)b * 256 * 2112) * 2; ctstride = 4224; }
    else { const int k = idx < 256 ? idx : idx - 64; const int j = 63 - (k >> 3), sub = k & 7; b = sub >> 1; hp = sub & 1; nkt = j + 1; r0 = b * 4096 + j * 64;
        kcb = ws + OFF_KC + (size_t)b * 4096 * 640; ctb = ws + OFF_CT + (size_t)b * 256 * 4096 * 2; ctstride = 8192; }
    const int head = hp * 2 + (wave >> 2); const int qrow = r0 + (wave & 3) * 16 + lr;
    unsigned ko[6], vo[5];
#pragma unroll
    for (int i = 0; i < 6; ++i) { const int n = i * 512 + tid, row = n / 41, pc = n - row * 41; ko[i] = (unsigned)(row * 640 + (pc < 40 ? (pc ^ swz16(row)) * 16 : 0)); }
#pragma unroll
    for (int i = 0; i < 5; ++i) { const int n = i * 512 + tid, row = n / 9, pc = n - row * 9; vo[i] = (unsigned)(row * ctstride + (pc < 8 ? (pc ^ swz16(row)) * 16 : 0)); }
#define ATT_DMA(kt, bo) do { const unsigned char* kg = kcb + (size_t)(kt) * 40960; const unsigned char* vg = ctb + (size_t)(kt) * 128; \
        _Pragma("unroll") for (int i = 0; i < 6; ++i) if (i < 5 || wave == 0) __builtin_amdgcn_global_load_lds((const unsigned*)(kg + ko[i]), (LAS unsigned*)(lds + (bo) + (i * 512 + wave * 64) * 16), 16, 0, 0); \
        _Pragma("unroll") for (int i = 0; i < 5; ++i) if (i < 4 || wave < 4) __builtin_amdgcn_global_load_lds((const unsigned*)(vg + vo[i]), (LAS unsigned*)(lds + (bo) + VOFF + (i * 512 + wave * 64) * 16), 16, 0, 0); } while (0)
    __syncthreads();
    ATT_DMA(0, 0);
    bf16x8 qf[10];
    { const bf16_t* qp = (const bf16_t*)(ws + OFF_Q) + (size_t)qrow * 1280 + head * 320 + g * 8;
#pragma unroll
      for (int ks = 0; ks < 10; ++ks) qf[ks] = *(const bf16x8*)(qp + ks * 32);
      const int pos = qrow < MP ? (qrow & 4095) : 2048 + ((qrow - MP) & 63); const float2* rp = (const float2*)(ws + OFF_ROPE) + pos * 32 + 8 * g;
      u32x4 w1 = __builtin_bit_cast(u32x4, qf[8]), w2 = __builtin_bit_cast(u32x4, qf[9]);
      float4 cs4[4];
#pragma unroll
      for (int jp = 0; jp < 4; ++jp) cs4[jp] = *(const float4*)(rp + 2 * jp);
#pragma unroll
      for (int jp = 0; jp < 4; ++jp) { const float a1 = bflo(w1[jp]), b1 = bfhi(w1[jp]), a2 = bflo(w2[jp]), b2 = bfhi(w2[jp]);
          w1[jp] = cvt_pk_bf16(a1 * cs4[jp].x - a2 * cs4[jp].y, b1 * cs4[jp].z - b2 * cs4[jp].w); w2[jp] = cvt_pk_bf16(a2 * cs4[jp].x + a1 * cs4[jp].y, b2 * cs4[jp].z + b1 * cs4[jp].w); }
      qf[8] = __builtin_bit_cast(bf16x8, w1); qf[9] = __builtin_bit_cast(bf16x8, w2); }
    f32x4 o[16];
#pragma unroll
    for (int i = 0; i < 16; ++i) o[i] = (f32x4){0.f, 0.f, 0.f, 0.f};
    float mrun = -1e30f, lsum = 0.f;
    asm volatile("s_waitcnt vmcnt(0)" ::: "memory");
    __syncthreads();
    const int koff = lr * KSTR + gx, voff = VOFF + lr * VSTR + gx;
    for (int kt = 0; kt < nkt; ++kt) {
        const int bo = (kt & 1) * ABUF;
        if (kt + 1 < nkt) ATT_DMA(kt + 1, ABUF - bo);
        const LAS unsigned char* kb = lds + bo + koff; const LAS unsigned char* vb = lds + bo + voff;
        f32x4 s[4];
#pragma unroll
        for (int i = 0; i < 4; ++i) s[i] = (f32x4){0.f, 0.f, 0.f, 0.f};
        bf16x8 kf[2][4];
#pragma unroll
        for (int k4 = 0; k4 < 4; ++k4) kf[0][k4] = *(const LAS bf16x8*)(kb + k4 * 16 * KSTR);
#pragma unroll
        for (int ks = 0; ks < 10; ++ks) {
            if (ks < 9) {
#pragma unroll
                for (int k4 = 0; k4 < 4; ++k4) kf[(ks + 1) & 1][k4] = *(const LAS bf16x8*)(kb + k4 * 16 * KSTR + (ks + 1) * 64); }
            __builtin_amdgcn_sched_barrier(0);
#pragma unroll
            for (int k4 = 0; k4 < 4; ++k4) s[k4] = __builtin_amdgcn_mfma_f32_16x16x32_bf16(kf[ks & 1][k4], qf[ks], s[k4], 0, 0, 0);
            __builtin_amdgcn_sched_barrier(0);
        }
        bf16x8 vf[2][4];
#pragma unroll
        for (int q4 = 0; q4 < 4; ++q4) vf[0][q4] = *(const LAS bf16x8*)(vb + (q4 >> 1) * 16 * VSTR + (q4 & 1) * 64);
        __builtin_amdgcn_sched_barrier(0);
        float mx = s[0][0];
#pragma unroll
        for (int k4 = 0; k4 < 4; ++k4)
#pragma unroll
            for (int i = 0; i < 4; ++i) mx = fmaxf(mx, s[k4][i]);
        mx = fmaxf(mx, __shfl_xor(mx, 16)); mx = fmaxf(mx, __shfl_xor(mx, 32));
        if (!__all(mx - mrun <= 8.0f)) {
            const float mnew = fmaxf(mrun, mx), alpha = __builtin_amdgcn_exp2f(mrun - mnew); mrun = mnew; lsum *= alpha;
#pragma unroll
            for (int i = 0; i < 16; ++i) o[i] *= alpha; }
        float ps = 0.f;
#pragma unroll
        for (int k4 = 0; k4 < 4; ++k4)
#pragma unroll
            for (int i = 0; i < 4; ++i) { s[k4][i] = __builtin_amdgcn_exp2f(s[k4][i] - mrun); ps += s[k4][i]; }
        lsum += ps;
        bf16x8 pb[2];
#pragma unroll
        for (int s2 = 0; s2 < 2; ++s2) { u32x4 w; w.x = cvt_pk_bf16(s[2 * s2][0], s[2 * s2][1]); w.y = cvt_pk_bf16(s[2 * s2][2], s[2 * s2][3]);
            w.z = cvt_pk_bf16(s[2 * s2 + 1][0], s[2 * s2 + 1][1]); w.w = cvt_pk_bf16(s[2 * s2 + 1][2], s[2 * s2 + 1][3]); pb[s2] = __builtin_bit_cast(bf16x8, w); }
#pragma unroll
        for (int cp = 0; cp < 8; ++cp) {
            if (cp < 7) {
#pragma unroll
                for (int q4 = 0; q4 < 4; ++q4) vf[(cp + 1) & 1][q4] = *(const LAS bf16x8*)(vb + (2 * (cp + 1) + (q4 >> 1)) * 16 * VSTR + (q4 & 1) * 64); }
            __builtin_amdgcn_sched_barrier(0);
#pragma unroll
            for (int q4 = 0; q4 < 4; ++q4) o[2 * cp + (q4 >> 1)] = __builtin_amdgcn_mfma_f32_16x16x32_bf16(vf[cp & 1][q4], pb[q4 & 1], o[2 * cp + (q4 >> 1)], 0, 0, 0);
            __builtin_amdgcn_sched_barrier(0);
        }
        asm volatile("s_waitcnt vmcnt(0)" ::: "memory");
        __syncthreads();
    }
#undef ATT_DMA
    lsum += __shfl_xor(lsum, 16); lsum += __shfl_xor(lsum, 32);
    const float inv = 1.0f / lsum;
    bf16_t* op = (bf16_t*)(ws + OFF_MIXA) + (size_t)qrow * 1536 + head * 256 + 4 * g;
#pragma unroll
    for (int ct = 0; ct < 16; ++ct) { uint2 w; w.x = cvt_pk_bf16(o[ct][0] * inv, o[ct][1] * inv); w.y = cvt_pk_bf16(o[ct][2] * inv, o[ct][3] * inv); *(uint2*)(op + 16 * ct) = w; }
}
constexpr int HS = 72;
constexpr int H_BC = 0, H_QT = 2 * 16640, H_KT = H_QT + 2 * 64 * HS * 2, H_QH = H_KT + 2 * 64 * HS * 2, H_VT = H_QH + 2 * 64 * HS * 2, H_ST = H_VT + 2 * 64 * HS * 2, H_END = H_ST + 2 * 64 * HS * 2;
static_assert(H_END <= LDS_MAIN, "hgrn lds");
__device__ __forceinline__ int posof64(int t) { const int u = t & 31; const int p = u < 16 ? 8 * (u >> 2) + (u & 3) : 8 * ((u - 16) >> 2) + 4 + ((u - 16) & 3); return (t & 32) + p; }
__device__ void hgrn_out_tile(CArgs& a, int l, int T, unsigned char* ldsg) {
    unsigned char* ws = a.ws; int tid = threadIdx.x; asm volatile("" : "+v"(tid)); asm volatile("" : "+s"(l)); const int lane = tid & 63, wave = tid >> 6, lr = lane & 15, g = lane >> 4;
    LAS unsigned char* lds = (LAS unsigned char*)ldsg;
    const bf16_t* z = (const bf16_t*)(ws + OFF_Z); const int r0 = T * 64;
    const int c = tid & 127, hh = c >> 6, e = c & 63, tq = tid >> 7;
    LAS float* bc = (LAS float*)(lds + H_BC) + hh * 4160;
    LAS bf16_t* QT = (LAS bf16_t*)(lds + H_QT) + hh * 64 * HS; LAS bf16_t* KT = (LAS bf16_t*)(lds + H_KT) + hh * 64 * HS; LAS bf16_t* QH = (LAS bf16_t*)(lds + H_QH) + hh * 64 * HS; LAS bf16_t* VT = (LAS bf16_t*)(lds + H_VT) + hh * 64 * HS;
    const float lbv0 = lb_of(a, l, hh * 64 + e), lbv1 = lb_of(a, l, (2 + hh) * 64 + e);
    for (int hp = 0; hp < 2; ++hp) {
        const int h = 2 * hp + hh; const float lbv = hp ? lbv1 : lbv0;
        { const float* bcum = (const float*)(ws + OFF_BCUM) + (size_t)r0 * 256 + h * 64 + e; const float rr = bcum[31 * 256];
          float s0v[16];
#pragma unroll
          for (int i = 0; i < 16; ++i) { const int idx = tid + 512 * i, h2 = idx >> 12, ed = idx & 4095; const int hg = 2 * hp + h2;
              const float* S0 = T < 256 ? (const float*)(ws + OFF_SST) + (size_t)(T * 4 + hg) * 4096 : a.in[4] + (size_t)(l * 128 + (T - 256) * 4 + hg) * 4096;
              s0v[i] = S0[ed]; }
#pragma unroll 1
          for (int i0 = 0; i0 < 16; i0 += 8) {
          bf16_t zq[8], zf16[8], zv[8]; float bbv[8];
#pragma unroll
          for (int i = 0; i < 8; ++i) { const bf16_t* zr = z + (size_t)(r0 + tq * 16 + i0 + i) * ZW + h * 64 + e; zq[i] = zr[ZHQ]; zf16[i] = zr[ZHF]; zv[i] = zr[ZHI]; bbv[i] = bcum[(tq * 16 + i0 + i) * 256]; }
#pragma unroll
          for (int i = 0; i < 8; ++i) { const int t = tq * 16 + i0 + i; const float bb = bbv[i];
              const float q = bf2f(zq[i]), zf = bf2f(zf16[i]); const float k = (1.0f - lbv) * sigmoidf_(-zf);
              QH[t * HS + e] = f2bf(q * __expf(bb)); QT[t * HS + e] = f2bf(q * __expf(fminf(bb - rr, 80.f))); KT[t * HS + e] = f2bf(k * __expf(fminf(rr - bb, 80.f)));
              VT[e * HS + posof64(t)] = zv[i]; } }
#pragma unroll
          for (int i = 0; i < 16; ++i) { const int idx = tid + 512 * i, h2 = idx >> 12, ed = idx & 4095; ((LAS bf16_t*)(lds + H_ST))[h2 * 64 * HS + (ed & 63) * HS + (ed >> 6)] = f2bf(s0v[i]); } }
        __syncthreads();
        { const int wh = wave >> 2, tb = wave & 3; const int hw = 2 * hp + wh;
          const LAS unsigned char* qt = lds + H_QT + wh * 64 * HS * 2; const LAS unsigned char* kt = lds + H_KT + wh * 64 * HS * 2; const LAS unsigned char* qh = lds + H_QH + wh * 64 * HS * 2;
          const LAS unsigned char* vt = lds + H_VT + wh * 64 * HS * 2; const LAS unsigned char* st = lds + H_ST + wh * 64 * HS * 2;
          const int trow = 16 * tb + lr;
          float4 ogv[4]; uint2 gwv[4];
#pragma unroll
          for (int db = 0; db < 4; ++db) { const int d0 = hw * 64 + 16 * db + 4 * g; ogv[db] = *(const float4*)(a.in[17] + l * 256 + d0); gwv[db] = *(const uint2*)(z + (size_t)(r0 + trow) * ZW + ZHG + d0); }
          bf16x8 qtf[2], qhf[2];
#pragma unroll
          for (int ks = 0; ks < 2; ++ks) { qtf[ks] = *(const LAS bf16x8*)(qt + trow * (HS * 2) + (32 * ks + 8 * g) * 2); qhf[ks] = *(const LAS bf16x8*)(qh + trow * (HS * 2) + (32 * ks + 8 * g) * 2); }
          f32x4 aT[4];
#pragma unroll
          for (int sb = 0; sb < 4; ++sb) { aT[sb] = (f32x4){0.f, 0.f, 0.f, 0.f};
#pragma unroll
              for (int ks = 0; ks < 2; ++ks) { const bf16x8 kf = *(const LAS bf16x8*)(kt + (16 * sb + lr) * (HS * 2) + (32 * ks + 8 * g) * 2); aT[sb] = __builtin_amdgcn_mfma_f32_16x16x32_bf16(kf, qtf[ks], aT[sb], 0, 0, 0); }
#pragma unroll
              for (int i = 0; i < 4; ++i) aT[sb][i] = (16 * sb + 4 * g + i <= trow) ? aT[sb][i] : 0.f; }
          bf16x8 pb[2];
#pragma unroll
          for (int s2 = 0; s2 < 2; ++s2) { u32x4 w; w.x = cvt_pk_bf16(aT[2 * s2][0], aT[2 * s2][1]); w.y = cvt_pk_bf16(aT[2 * s2][2], aT[2 * s2][3]);
              w.z = cvt_pk_bf16(aT[2 * s2 + 1][0], aT[2 * s2 + 1][1]); w.w = cvt_pk_bf16(aT[2 * s2 + 1][2], aT[2 * s2 + 1][3]); pb[s2] = __builtin_bit_cast(bf16x8, w); }
          f32x4 o[4]; float ss = 0.f;
#pragma unroll
          for (int db = 0; db < 4; ++db) { o[db] = (f32x4){0.f, 0.f, 0.f, 0.f};
#pragma unroll
              for (int ks = 0; ks < 2; ++ks) { const bf16x8 sf = *(const LAS bf16x8*)(st + (16 * db + lr) * (HS * 2) + (32 * ks + 8 * g) * 2); o[db] = __builtin_amdgcn_mfma_f32_16x16x32_bf16(sf, qhf[ks], o[db], 0, 0, 0); }
#pragma unroll
              for (int s2 = 0; s2 < 2; ++s2) { const bf16x8 vf = *(const LAS bf16x8*)(vt + (16 * db + lr) * (HS * 2) + (32 * s2 + 8 * g) * 2); o[db] = __builtin_amdgcn_mfma_f32_16x16x32_bf16(vf, pb[s2], o[db], 0, 0, 0); }
              ss += o[db][0] * o[db][0] + o[db][1] * o[db][1] + o[db][2] * o[db][2] + o[db][3] * o[db][3]; }
          ss += __shfl_xor(ss, 16); ss += __shfl_xor(ss, 32);
          const float rs = rsqrtf(ss * (1.0f / 64.0f) + EPS);
#pragma unroll
          for (int db = 0; db < 4; ++db) { const int d0 = hw * 64 + 16 * db + 4 * g; const float4 og = ogv[db]; const uint2 gw = gwv[db];
              uint2 w; w.x = cvt_pk_bf16(o[db][0] * rs * og.x * siluf_(bflo(gw.x)), o[db][1] * rs * og.y * siluf_(bfhi(gw.x)));
              w.y = cvt_pk_bf16(o[db][2] * rs * og.z * siluf_(bflo(gw.y)), o[db][3] * rs * og.w * siluf_(bfhi(gw.y)));
              *(uint2*)((bf16_t*)(ws + OFF_MIXA) + (size_t)(r0 + trow) * 1536 + 1024 + d0) = w; } }
        __syncthreads();
    }
}
template <bool PRM> __device__ __forceinline__ void cmlp_item_t(CArgs& a, int l, int it, unsigned char* ldsg) {
    int tid = threadIdx.x; asm volatile("" : "+v"(tid)); asm volatile("" : "+s"(l)); const int lane = tid & 63, wave = tid >> 6, lr = lane & 15, lg = lane >> 4; const int ci = it >> 2, g = it & 3;
    constexpr int L = PRM ? 128 : 64, WS = L + 8;
    const int r0 = PRM ? ci * 128 : MP + (ci - 128) * 64;
    LAS unsigned char* lds = (LAS unsigned char*)ldsg; LAS bf16_t* Wb = (LAS bf16_t*)lds; LAS bf16_t* vT = (LAS bf16_t*)(lds + 128 * 136 * 2);
    const bf16_t* z = (const bf16_t*)(a.ws + OFF_Z); const float* wsrc = a.in[19] + (size_t)(l * 4 + g) * 128 * 128;
    const float vg = a.in[18][l * 256 + g * 64 + lane];
    bf16_t zc[L / 8];
#pragma unroll
    for (int i = 0; i < L / 8; ++i) zc[i] = z[(size_t)(r0 + wave + 8 * i) * ZW + ZCV + g * 64 + lane];
    { constexpr int NQ = L * L / 4 / 512, SH = PRM ? 5 : 4; float4 wv[NQ];
#pragma unroll
      for (int i = 0; i < NQ; ++i) { const int idx = tid + 512 * i, t = idx >> SH, s4 = idx & ((1 << SH) - 1); wv[i] = *(const float4*)(wsrc + t * 128 + 4 * s4); }
#pragma unroll
      for (int i = 0; i < NQ; ++i) { const int idx = tid + 512 * i, t = idx >> SH, s0 = 4 * (idx & ((1 << SH) - 1));
          u32x2 w; w.x = cvt_pk_bf16(s0 <= t ? wv[i].x : 0.f, s0 + 1 <= t ? wv[i].y : 0.f); w.y = cvt_pk_bf16(s0 + 2 <= t ? wv[i].z : 0.f, s0 + 3 <= t ? wv[i].w : 0.f);
          *(LAS u32x2*)(Wb + t * WS + s0) = w; } }
    {
#pragma unroll
      for (int i = 0; i < L / 8; ++i) { const int t = wave + 8 * i; const float x = geluf_(bf2f(zc[i])); const float ss = wave_sum(x * x);
          const float vv = x * rsqrtf(ss * (1.0f / 64.0f) + EPS) * vg; vT[lane * WS + t] = f2bf(vv);
          if (!PRM) a.out[O_CMV + ((size_t)(l * 32 + (ci - 128)) * 64 + t) * 256 + g * 64 + lane] = vv; } }
    __syncthreads();
    { constexpr int NT = PRM ? 4 : 2;
      const int tt = PRM ? wave : (wave & 3); const int t = 16 * tt + lr; const float bs = a.in[20][(size_t)(l * 4 + g) * 128 + t];
      uint2 cwv[NT];
#pragma unroll
      for (int n = 0; n < NT; ++n) { const int dt = PRM ? n : 2 * (wave >> 2) + n; cwv[n] = *(const uint2*)(z + (size_t)(r0 + t) * ZW + ZCU + g * 64 + 16 * dt + 4 * lg); }
#pragma unroll
      for (int n = 0; n < NT; ++n) { const int dt = PRM ? n : 2 * (wave >> 2) + n; f32x4 acc = (f32x4){0.f, 0.f, 0.f, 0.f};
#pragma unroll
          for (int ks = 0; ks < L / 32; ++ks) { if (32 * ks <= 16 * tt + 15) {
              const bf16x8 vf = *(const LAS bf16x8*)(vT + (16 * dt + lr) * WS + 32 * ks + 8 * lg); const bf16x8 wf = *(const LAS bf16x8*)(Wb + t * WS + 32 * ks + 8 * lg);
              acc = __builtin_amdgcn_mfma_f32_16x16x32_bf16(vf, wf, acc, 0, 0, 0); } }
          const int d0 = g * 64 + 16 * dt + 4 * lg; const uint2 cw = cwv[n];
          uint2 o; o.x = cvt_pk_bf16(geluf_(bflo(cw.x)) * (acc[0] + bs), geluf_(bfhi(cw.x)) * (acc[1] + bs)); o.y = cvt_pk_bf16(geluf_(bflo(cw.y)) * (acc[2] + bs), geluf_(bfhi(cw.y)) * (acc[3] + bs));
          *(uint2*)((bf16_t*)(a.ws + OFF_MIXA) + (size_t)(r0 + t) * 1536 + 1280 + d0) = o; } }
    __syncthreads();
}
__device__ void cmlp_item(CArgs& a, int l, int it, unsigned char* lds) { if ((it >> 2) < 128) cmlp_item_t<true>(a, l, it, lds); else cmlp_item_t<false>(a, l, it, lds); }
__device__ void phase_mix(CArgs& a, int l, unsigned char* lds, int rep) {
    unsigned* ctr = (unsigned*)(a.ws + OFF_CTL) + 16 * (l + 1) + 128 * rep; LAS unsigned* slot = (LAS unsigned*)(lds + LDS_MAIN + 16);
    for (;;) {
        __syncthreads();
        { int t0 = threadIdx.x; asm volatile("" : "+v"(t0)); if (t0 == 0) *slot = atomicAdd(ctr, 1u); }
        __syncthreads();
        const int it = (int)*slot;
        if (it >= 576 + NTILE + 640) break;
        if (it < 576) { attn_item(a, it, lds); if (PROBE_MIX & 1) { __syncthreads(); attn_item(a, it, lds); } }
        else if (it < 576 + NTILE) { hgrn_out_tile(a, l, it - 576, lds); if (PROBE_MIX & 2) { __syncthreads(); hgrn_out_tile(a, l, it - 576, lds); } }
        else { cmlp_item(a, l, it - 576 - NTILE, lds); if (PROBE_MIX & 4) { __syncthreads(); cmlp_item(a, l, it - 576 - NTILE, lds); } }
    }
}
__global__ void __launch_bounds__(512) mk_fwd(Args a_) {
    extern __shared__ __attribute__((aligned(16))) unsigned char lds[];
    if (threadIdx.x < 16) ((LAS unsigned*)(lds + LDS_MAIN))[threadIdx.x] = 0u;
    __syncthreads();
    XcdBarrier bar = xcd_barrier_post((unsigned*)(a_.ws + OFF_CTL) + 1024, (volatile LAS unsigned*)(lds + LDS_MAIN));
    const int ph_lo = a_.ph_lo, ph_hi = a_.ph_hi;
    for (int ph = ph_lo; ph < ph_hi; ++ph) {
        CArgs* ap = (CArgs*)__builtin_amdgcn_kernarg_segment_ptr(); asm volatile("" : "+s"(ap)); CArgs& a = *ap;
        unsigned char* ws = a.ws;
        if (ph == 0) { phase_init(a, lds); if ((PROBE_DUP >> 12) & 1) { __syncthreads(); phase_init(a, lds); } }
        else { const int l = (ph - 1) / 12, p = (ph - 1) % 12; const float* ng = a.in[5] + (size_t)l * 6 * 1024;
            bf16_t* H = (bf16_t*)(ws + OFF_H); bf16_t* ACT = (bf16_t*)(ws + OFF_ACT); bf16_t* D = (bf16_t*)(ws + OFF_D); bf16_t* D1 = (bf16_t*)(ws + ((p == 7 || p == 8) ? OFF_ACT : OFF_MIXA));   float* RS = (float*)(ws + OFF_X);
            const int reps = ((PROBE_DUP >> p) & 1) ? 2 : 1;
            for (int rep = 0; rep < reps; ++rep) {
            if (rep) __syncthreads();
            switch (p) {
            case 0: case 9: { const int f = p == 0 ? 0 : 1; EpiSwiGLU E{ACT}; run_gemm(lds, H, (const bf16_t*)(ws + OFF_WGU) + (size_t)(l * 2 + f) * 5632 * 1024, MT, 5632, 1024, E);
                if (p == 0 && !rep) phase_cache(a, l, lds); } break;
            case 1: case 10: { const int f = p == 1 ? 0 : 1; EpiBf E{D, 1024, D1}; run_gemm(lds, ACT, (const bf16_t*)(ws + OFF_WDN) + (size_t)(l * 2 + f) * 1024 * 2816, MT, 1024, 2816, E, 11); } break;
            case 2: ew_phase<false, false>(D, D1, 11, H, nullptr, nullptr, ng + 1024, 0.5f, ng + 2048, H, ng, RS); break;
            case 3: { EpiBf E{(bf16_t*)(ws + OFF_Z), ZW, nullptr}; run_gemm(lds, H, (const bf16_t*)(ws + OFF_WIN) + (size_t)l * 2304 * 1024, MT, 2304, 1024, E); } break;
            case 4: phase_prep(a, l, lds, rep); break;
            case 5: { phase_scan(a, l); EpiQ E{(bf16_t*)(ws + OFF_Q)}; run_gemm(lds, (const bf16_t*)(ws + OFF_QN), (const bf16_t*)(ws + OFF_WQ) + (size_t)l * 1280 * 384, MT, 1280, 384, E); } break;
            case 6: phase_mix(a, l, lds, rep); break;
            case 7: { EpiBf E{D, 1024, D1}; run_gemm(lds, (const bf16_t*)(ws + OFF_MIXA), (const bf16_t*)(ws + OFF_WMIX) + (size_t)l * 1024 * 1536, MT, 1024, 1536, E, 6); } break;
            case 8: ew_phase<false, false>(D, D1, 6, H, nullptr, nullptr, ng + 3 * 1024, 1.0f, ng + 4 * 1024, H, ng + 2048, RS); break;
            case 11: if (l == 0) ew_phase<false, false>(D, D1, 11, H, nullptr, nullptr, ng + 5 * 1024, 0.5f, ng + 6 * 1024, H, ng + 4 * 1024, RS); else ew_phase<false, true>(D, D1, 11, H, nullptr, a.out + O_Y, ng + 5 * 1024, 0.5f, nullptr, nullptr, ng + 4 * 1024, RS); break;
            }
            }
            tail_wtasks(a, ph, lds);
        }
        if (ph + 1 < ph_hi) {
            if (ph_lo < 0) { __threadfence(); cg::this_grid().sync(); }
            xcd_barrier(bar); }
    }
}

extern "C" void kernel_launch(void* const* d_in, const int* in_sizes, int n_in, void* d_out, int out_size, void* d_ws, size_t ws_size, hipStream_t stream) {
    static int grid = 0;
    if (grid == 0) {
        if (n_in != 21 || ws_size < WS_END) { fprintf(stderr, "kernel_launch: bad inputs n_in %d ws %zu need %zu\n", n_in, ws_size, (size_t)WS_END); grid = -1; return; }
        int dev = 0, cus = 0, per_cu = 0;
        hipGetDevice(&dev); hipDeviceGetAttribute(&cus, hipDeviceAttributeMultiprocessorCount, dev);
        if (hipFuncSetAttribute((const void*)mk_fwd, hipFuncAttributeMaxDynamicSharedMemorySize, LDS_BYTES) != hipSuccess) { fprintf(stderr, "hipFuncSetAttribute failed\n"); grid = -1; return; }
        if (hipOccupancyMaxActiveBlocksPerMultiprocessor(&per_cu, (const void*)mk_fwd, 512, LDS_BYTES) != hipSuccess || per_cu < 1) per_cu = 1;
        (void)hipGetLastError();
        grid = cus * 1;
    }
    if (grid < 0) return;
    if (hipMemsetAsync((char*)d_ws + OFF_CTL, 0, SZ_CTL, stream) != hipSuccess) { fprintf(stderr, "memset failed\n"); return; }
    Args a{};
    for (int i = 0; i < 21; ++i) a.in[i] = (const float*)d_in[i];
    a.out = (float*)d_out; a.ws = (unsigned char*)d_ws;
#if ONE_LAUNCH
    a.ph_lo = 0; a.ph_hi = NPHASE;
    void* args[] = {&a};
    hipError_t e = hipLaunchCooperativeKernel((const void*)mk_fwd, dim3(grid), dim3(512), args, LDS_BYTES, stream);
    if (e != hipSuccess) fprintf(stderr, "cooperative launch failed: %s (grid %d)\n", hipGetErrorString(e), grid);
#else
    for (int ph = 0; ph < NPHASE; ++ph) { a.ph_lo = ph; a.ph_hi = ph + 1; hipLaunchKernelGGL(mk_fwd, dim3(grid), dim3(512), LDS_BYTES, stream, a); }
#endif
}
```

```cpp
#include <hip/hip_runtime.h>
#include <hip/hip_cooperative_groups.h>
#include <cstdio>
namespace cg = cooperative_groups;
#ifndef ONE_LAUNCH
#define ONE_LAUNCH 1
#endif
#ifndef PROBE_DUP
#define PROBE_DUP 0
#endif
#ifndef PROBE_MIX
#define PROBE_MIX 0
#endif
namespace pg8 {
#define PG8_LAS __attribute__((address_space(3)))
typedef unsigned short bf16_t;
typedef short bf16x8 __attribute__((ext_vector_type(8)));
typedef float f32x4 __attribute__((ext_vector_type(4)));
typedef unsigned u32x4 __attribute__((ext_vector_type(4)));
constexpr int BM = 256, BK = 64, HALF = 128, HTB = HALF * BK * 2  , STAGE_BYTES = 8 * HTB, NXCD = 8, WGM = 8;

__host__ __device__ __forceinline__ int lds_byte(int r, int c) { const int st = (r >> 4) * 2 + (c >> 5), rr = r & 15, cc = c & 31, ob = rr * 64 + cc * 2; return st * 1024 + (ob ^ (((ob >> 9) & 1) << 5)); }
__host__ __device__ __forceinline__ void stage_rc(int b, int& R, int& C) { const int st = b / 1024, sb = b % 1024, swz = sb ^ (((sb >> 9) & 1) << 5); R = (st >> 1) * 16 + swz / 64; C = (st & 1) * 32 + (swz % 64) / 2; }
__host__ __device__ __forceinline__ int perm32(int rho) { const int n = rho >> 4, i = rho & 15; return 8 * (i >> 2) + 4 * n + (i & 3); }

struct Unit { int pm, pn, ks, nt, koff; };
struct Gemm { const bf16_t* A; const bf16_t* Bt; int M, N, K, ld; };

struct StaticOrder {
    int nM, nN, nwg, G, c, nN0, unt, ukb;
    __host__ __device__ void init(int M, int N, int G_, int c_, int nsplit = 1) { nM = M / BM; nN0 = N / BM; nN = nN0 * nsplit; nwg = nM * nN; G = G_; c = c_; }
    __host__ __device__ bool next(int i, Unit& u) const {
        const long L = (long)i * G + c; if (L >= nwg) return false;
        int wgid = (int)L; { const int q = nwg / NXCD, r = nwg % NXCD, xcd = wgid % NXCD, off = wgid / NXCD; wgid = (xcd < r ? xcd * (q + 1) : r * (q + 1) + (xcd - r) * q) + off; }
        const int nig = WGM * nN, gid = wgid / nig, fm = gid * WGM, gsz = (nM - fm) < WGM ? (nM - fm) : WGM;
        u.pm = fm + ((wgid % nig) % gsz); const int pn = (wgid % nig) / gsz; u.ks = pn / nN0; u.pn = pn - u.ks * nN0; u.nt = unt; u.koff = u.ks * ukb; return true;
    }
    __device__ __forceinline__ void a_ready(const Unit&) const {}
    __device__ __forceinline__ void done(const Unit&) const {}
};
__device__ __forceinline__ unsigned cvt_pk_bf16(float lo, float hi) { unsigned r; asm volatile("v_cvt_pk_bf16_f32 %0, %1, %2" : "=v"(r) : "v"(lo), "v"(hi)); return r; }
typedef float f32x2 __attribute__((ext_vector_type(2)));
template <class Epi, class Sched, bool STAMP = false>
__device__ __forceinline__ void gemm_phase(PG8_LAS unsigned char* lds, const Gemm g, const Sched& S, const Epi& E, unsigned long long* stamps) {
    int tid = threadIdx.x; asm volatile("" : "+v"(tid)); const int wid = __builtin_amdgcn_readfirstlane(tid >> 6), lane = tid & 63, wr = wid >> 2, wc = wid & 3, fr = lane & 15, fq = lane >> 4;
    const int K = g.ld;
    int ts_lo = 0, ts_hi = 0, nts = 0; const unsigned long long rt_entry = STAMP ? (unsigned long long)wall_clock64() : 0ull;
#define PG8_STAMP() do { if (STAMP && wid == 0 && nts < 64) { const unsigned long long _c = (unsigned long long)clock64(); \
        ts_lo = (lane == nts) ? (int)(unsigned)_c : ts_lo; ts_hi = (lane == nts) ? (int)(unsigned)(_c >> 32) : ts_hi; ++nts; } } while (0)
    PG8_STAMP();
    unsigned voffA[2], voffB[2];
#pragma unroll
    for (int i = 0; i < 2; ++i) { int R, C; stage_rc(tid * 16 + i * 8192, R, C); const int Rb = Epi::PERM ? ((R & ~31) + perm32(R & 31)) : R;
        voffA[i] = (unsigned)(R * K + C) * 2u; voffB[i] = (unsigned)(Rb * K + C) * 2u; }
    const size_t kstep = (size_t)(BK * 2);
    const size_t hstep = (size_t)HALF * K * 2;
    const size_t tstep = 2 * hstep;
    const unsigned ldsw = (unsigned)wid * 1024u;
    const int aoff = lds_byte(wr * 64 + fr, fq * 8), boff = lds_byte(wc * 32 + fr, fq * 8);
#define PG8_SA(b, h) (((b) * 2 + (h)) * HTB)
#define PG8_SB(b, h) ((4 + (b) * 2 + (h)) * HTB)
#define PG8_STAGE(bufoff, gbase, voff) do { _Pragma("unroll") for (int _i = 0; _i < 2; ++_i) \
        __builtin_amdgcn_global_load_lds((const unsigned*)((const char*)(gbase) + (voff)[_i]), (PG8_LAS unsigned*)(lds + (bufoff) + ldsw + _i * 8192), 16, 0, 0); } while (0)
#define PG8_LDA(dst, b, h) do { _Pragma("unroll") for (int m = 0; m < 4; ++m) _Pragma("unroll") for (int k = 0; k < 2; ++k) dst[m][k] = *(const PG8_LAS bf16x8*)(lds + PG8_SA(b, h) + aoff + m * 2048 + k * 1024); } while (0)
#define PG8_LDB(dst, b, h) do { _Pragma("unroll") for (int n = 0; n < 2; ++n) _Pragma("unroll") for (int k = 0; k < 2; ++k) dst[n][k] = *(const PG8_LAS bf16x8*)(lds + PG8_SB(b, h) + boff + n * 2048 + k * 1024); } while (0)
#define PG8_MMA(ai, bj, At, Bt) do { __builtin_amdgcn_s_setprio(1); _Pragma("unroll") for (int m = 0; m < 4; ++m) _Pragma("unroll") for (int n = 0; n < 2; ++n) _Pragma("unroll") for (int k = 0; k < 2; ++k) \
        acc[ai][bj][m][n] = __builtin_amdgcn_mfma_f32_16x16x32_bf16(Bt[n][k], At[m][k], acc[ai][bj][m][n], 0, 0, 0); __builtin_amdgcn_s_setprio(0); } while (0)
#define PG8_WAIT_V(n) asm volatile("s_waitcnt vmcnt(" #n ")" ::: "memory")
#define PG8_WAIT_L(n) asm volatile("s_waitcnt lgkmcnt(" #n ")" ::: "memory")
#define PG8_BAR __builtin_amdgcn_s_barrier()
#define PG8_SCHED __builtin_amdgcn_sched_barrier(0)
    Unit cur, nxt; int ui = 0;
    if (!S.next(0, cur)) return;
    f32x4 acc[2][2][4][2];
#pragma unroll
    for (int a = 0; a < 2; ++a)
#pragma unroll
        for (int b = 0; b < 2; ++b)
#pragma unroll
            for (int m = 0; m < 4; ++m)
#pragma unroll
                for (int n = 0; n < 2; ++n) acc[a][b][m][n] = (f32x4){0.f, 0.f, 0.f, 0.f};
    bf16x8 At[4][2], B0[2][2], B1[2][2];
    const char* cA = (const char*)g.A + (size_t)cur.pm * tstep + (size_t)cur.koff; const char* cB = (const char*)g.Bt + (size_t)cur.pn * tstep + (size_t)cur.koff;
    S.a_ready(cur);
    PG8_STAGE(PG8_SB(0, 0), cB, voffB); PG8_STAGE(PG8_SA(0, 0), cA, voffA); PG8_STAGE(PG8_SB(0, 1), cB + hstep, voffB); PG8_STAGE(PG8_SA(0, 1), cA + hstep, voffA);
    if (wr == 1) PG8_BAR;
    PG8_WAIT_V(4); PG8_BAR;
    PG8_STAGE(PG8_SB(1, 0), cB + kstep, voffB); PG8_STAGE(PG8_SA(1, 0), cA + kstep, voffA); PG8_STAGE(PG8_SB(1, 1), cB + hstep + kstep, voffB);
    PG8_WAIT_V(6); PG8_BAR;
    PG8_STAMP();
    for (;;) {
        const bool has_next = S.next(ui + 1, nxt);
        const char* nA = has_next ? (const char*)g.A + (size_t)nxt.pm * tstep + (size_t)nxt.koff : cA; const char* nB = has_next ? (const char*)g.Bt + (size_t)nxt.pn * tstep + (size_t)nxt.koff : cB;
        const int nt = cur.nt;
        for (int t = 0; t < nt; t += 2) {
            const bool last = (t == nt - 2);
            const char* a1 = cA + (size_t)(t + 1) * kstep;
            const char* a2 = last ? nA : cA + (size_t)(t + 2) * kstep; const char* b2 = last ? nB : cB + (size_t)(t + 2) * kstep;
            const char* a3 = a2 + kstep; const char* b3 = b2 + kstep;
            if (last && has_next) S.a_ready(nxt);
            PG8_LDB(B0, 0, 0); PG8_SCHED; PG8_LDA(At, 0, 0); PG8_STAGE(PG8_SA(1, 1), a1 + hstep, voffA);
            PG8_WAIT_L(8); PG8_BAR; PG8_WAIT_L(0); PG8_MMA(0, 0, At, B0); PG8_BAR; PG8_SCHED;
            PG8_LDB(B1, 0, 1); PG8_STAGE(PG8_SB(0, 0), b2, voffB);
            PG8_BAR; PG8_WAIT_L(0); PG8_MMA(0, 1, At, B1); PG8_BAR;
            PG8_LDA(At, 0, 1); PG8_STAGE(PG8_SA(0, 0), a2, voffA);
            PG8_BAR; PG8_WAIT_L(0); PG8_MMA(1, 0, At, B0); PG8_BAR; PG8_SCHED;
            PG8_STAGE(PG8_SB(0, 1), b2 + hstep, voffB);
            PG8_WAIT_V(6); PG8_BAR; PG8_MMA(1, 1, At, B1); PG8_BAR;
            PG8_LDB(B0, 1, 0); PG8_SCHED; PG8_LDA(At, 1, 0); PG8_STAGE(PG8_SA(0, 1), a2 + hstep, voffA);
            PG8_WAIT_L(8); PG8_BAR; PG8_WAIT_L(0); PG8_MMA(0, 0, At, B0); PG8_BAR; PG8_SCHED;
            PG8_LDB(B1, 1, 1); PG8_STAGE(PG8_SB(1, 0), b3, voffB);
            PG8_BAR; PG8_WAIT_L(0); PG8_MMA(0, 1, At, B1); PG8_BAR;
            PG8_LDA(At, 1, 1); PG8_STAGE(PG8_SA(1, 0), a3, voffA);
            PG8_BAR; PG8_WAIT_L(0); PG8_MMA(1, 0, At, B0); PG8_BAR; PG8_SCHED;
            PG8_STAGE(PG8_SB(1, 1), b3 + hstep, voffB);
            PG8_WAIT_V(6); PG8_BAR; PG8_MMA(1, 1, At, B1); PG8_BAR;
        }
        PG8_STAMP();
        if constexpr (!Epi::AFTER_DRAIN) { E(acc, cur, wr, wc, fr, fq); S.done(cur); }
        PG8_STAMP();
        if (!has_next) break;
#pragma unroll
        for (int a = 0; a < 2; ++a)
#pragma unroll
            for (int b = 0; b < 2; ++b)
#pragma unroll
                for (int m = 0; m < 4; ++m)
#pragma unroll
                    for (int n = 0; n < 2; ++n) acc[a][b][m][n] = (f32x4){0.f, 0.f, 0.f, 0.f};
        cur = nxt; cA = nA; cB = nB; ++ui;
    }
    PG8_WAIT_V(0);
    if (wr == 0) PG8_BAR;
    PG8_BAR;
    if constexpr (Epi::AFTER_DRAIN) { E.fused(acc, cur, wr, wc, fr, fq, lds, wid, lane); S.done(cur); }
    PG8_STAMP();
    if (STAMP && wid == 0) { stamps[lane] = lane < nts ? (((unsigned long long)(unsigned)ts_hi << 32) | (unsigned)ts_lo) : 0ull;
        if (lane == 62) stamps[62] = rt_entry; if (lane == 63) stamps[63] = (unsigned long long)wall_clock64(); }
#undef PG8_STAMP
#undef PG8_SA
#undef PG8_SB
#undef PG8_STAGE
#undef PG8_LDA
#undef PG8_LDB
#undef PG8_MMA
#undef PG8_WAIT_V
#undef PG8_WAIT_L
#undef PG8_BAR
#undef PG8_SCHED
}
}
using pg8::bf16_t; using pg8::bf16x8; using pg8::f32x4; using pg8::u32x4; using pg8::Unit; using pg8::cvt_pk_bf16;
#define LAS __attribute__((address_space(3)))
typedef unsigned u32x2 __attribute__((ext_vector_type(2)));

constexpr int DM = 1024, DFF = 2816, MP = 16384, MS = 2048, MT = 18432, INWP = 2304, ZW = 2304;
constexpr int NTILE = 288;
constexpr float EPS = 1e-6f;
constexpr float QSCALE = 0.07216878364870322f * 1.4426950408889634f;
constexpr int ZQ = 0, ZKV = 384, ZPE = 640, ZHQ = 704, ZHF = 960, ZHI = 1216, ZHG = 1472, ZCU = 1728, ZCV = 1984;
constexpr size_t SZ_WGU = 4ull * 5632 * 1024 * 2, SZ_WDN = 4ull * 1024 * 2816 * 2, SZ_WIN = 2ull * 2304 * 1024 * 2, SZ_WQ = 2ull * 1280 * 384 * 2, SZ_WMIX = 2ull * 1024 * 1536 * 2;
constexpr size_t SKEW = 69888;
constexpr size_t OFF_WGU = 0, OFF_WDN = OFF_WGU + SZ_WGU + SKEW, OFF_WIN = OFF_WDN + SZ_WDN + SKEW, OFF_WQ = OFF_WIN + SZ_WIN + SKEW, OFF_WMIX = OFF_WQ + SZ_WQ + SKEW;
constexpr size_t OFF_X = OFF_WMIX + SZ_WMIX + SKEW, SZ_X = (size_t)MT * 1024 * 4;
constexpr size_t OFF_D = OFF_X + SZ_X + SKEW, SZ_D = (size_t)MT * 1024 * 2;
constexpr size_t OFF_H = OFF_D + SZ_D + SKEW, SZ_H = (size_t)MT * 1024 * 2;
constexpr size_t OFF_ACT = OFF_H + SZ_H + SKEW, SZ_ACT = (size_t)MT * 2816 * 2;
constexpr size_t KROWS = 16384 + 32 * 2112;
constexpr size_t OFF_KC = OFF_ACT + SZ_ACT + SKEW, SZ_KC = KROWS * 640;
constexpr size_t OFF_CT = OFF_KC + SZ_KC + SKEW, SZ_CT = KROWS * 512;
constexpr size_t OFF_MIXA = OFF_CT + SZ_CT + SKEW, SZ_MIXA = (size_t)MT * 1536 * 2;
constexpr size_t OFF_SST = OFF_MIXA + SZ_MIXA + SKEW, SZ_SST = 1024ull * 4096 * 4;
constexpr size_t OFF_ROPE = OFF_SST + SZ_SST + SKEW, SZ_ROPE = 4096ull * 32 * 8;
constexpr size_t OFF_CTL = OFF_ROPE + SZ_ROPE + SKEW, SZ_CTL = 32768;
constexpr size_t OFF_BCUM = OFF_CTL + SZ_CTL + SKEW, SZ_BCUM = (size_t)MT * 256 * 4;
constexpr size_t WS_END = OFF_BCUM + SZ_BCUM;
constexpr size_t OFF_Z = OFF_ACT, SZ_Z = (size_t)MT * ZW * 2;
constexpr size_t OFF_QN = OFF_Z + SZ_Z + SKEW;
constexpr size_t OFF_Q = OFF_X + 1048576 + SKEW;
constexpr size_t OFF_U = OFF_Q + (size_t)MT * 1280 * 2 + SKEW;
constexpr size_t OFF_DEC = OFF_U + 1152ull * 4096 * 4;
static_assert(OFF_QN + (size_t)MT * 384 * 2 <= OFF_ACT + SZ_ACT, "z/qn overlay");
static_assert(OFF_DEC + 1152ull * 64 * 4 <= OFF_X + SZ_X, "Q/U overlay");
constexpr size_t O_Y = 0, O_CKVP = 18874368, O_KPEP = 27262976, O_HGP = 29360128, O_CKVS = 29491200, O_KPES = 30539776, O_HGS = 30801920, O_CMV = 31850496;

constexpr int LDS_MAIN = 157696, LDS_BYTES = LDS_MAIN + 64;
constexpr int NPHASE = 25;

struct Args { const float* in[21]; float* out; unsigned char* ws; int ph_lo, ph_hi; };
typedef const __attribute__((address_space(4))) Args CArgs;

__device__ __forceinline__ int bid_() { int b = blockIdx.x; asm volatile("" : "+s"(b)); return b; }
__device__ __forceinline__ int gdim_() { int g = gridDim.x; asm volatile("" : "+s"(g)); return g; }
__device__ __forceinline__ float bf2f(unsigned short b) { return __uint_as_float(((unsigned)b) << 16); }
__device__ __forceinline__ float bflo(unsigned w) { return __uint_as_float(w << 16); }
__device__ __forceinline__ float bfhi(unsigned w) { return __uint_as_float(w & 0xffff0000u); }
__device__ __forceinline__ unsigned short f2bf(float f) { unsigned u = __float_as_uint(f); u += 0x7FFFu + ((u >> 16) & 1u); return (unsigned short)(u >> 16); }
__device__ __forceinline__ float wave_sum(float v) {
#pragma unroll
    for (int o = 32; o >= 1; o >>= 1) v += __shfl_xor(v, o);
    return v; }
__device__ __forceinline__ float sigmoidf_(float x) { return __builtin_amdgcn_rcpf(1.0f + __expf(-x)); }
__device__ __forceinline__ float siluf_(float x) { return x * sigmoidf_(x); }
__device__ __forceinline__ float geluf_(float x) { const float y = 0.7978845608028654f * (x + 0.044715f * x * x * x); return x - x * __builtin_amdgcn_rcpf(__expf(2.0f * y) + 1.0f); }

struct EpiBf {
    static constexpr bool PERM = true, AFTER_DRAIN = false;
    bf16_t* O; int ldc; bf16_t* O1;
    __device__ __forceinline__ void operator()(const f32x4 (&acc)[2][2][4][2], const Unit& u, int wr, int wc, int fr, int fq) const {
        const int row0 = u.pm * 256 + wr * 64 + fr, col0 = u.pn * 256 + wc * 32 + 8 * fq; bf16_t* Ob = (O1 && u.ks >= 0) ? O1 + ((long)u.ks * MS - MP) * (long)ldc : O;
#pragma unroll
        for (int ai = 0; ai < 2; ++ai)
#pragma unroll
            for (int m = 0; m < 4; ++m) { bf16_t* rowp = Ob + (size_t)(row0 + ai * 128 + m * 16) * ldc + col0;
#pragma unroll
                for (int bj = 0; bj < 2; ++bj) { const f32x4 v0 = acc[ai][bj][m][0], v1 = acc[ai][bj][m][1];
                    u32x4 w; w.x = cvt_pk_bf16(v0[0], v0[1]); w.y = cvt_pk_bf16(v0[2], v0[3]); w.z = cvt_pk_bf16(v1[0], v1[1]); w.w = cvt_pk_bf16(v1[2], v1[3]);
                    *(u32x4*)(rowp + bj * 128) = w; } }
    }
};
struct EpiSwiGLU {
    static constexpr bool PERM = true, AFTER_DRAIN = false;
    bf16_t* O;
    __device__ __forceinline__ void operator()(const f32x4 (&acc)[2][2][4][2], const Unit& u, int wr, int wc, int fr, int fq) const {
        const int row0 = u.pm * 256 + wr * 64 + fr, col0 = u.pn * 128 + wc * 32 + 8 * fq;
#pragma unroll
        for (int ai = 0; ai < 2; ++ai)
#pragma unroll
            for (int m = 0; m < 4; ++m) { bf16_t* rowp = O + (size_t)(row0 + ai * 128 + m * 16) * DFF + col0;
                const f32x4 g0 = acc[ai][0][m][0], g1 = acc[ai][0][m][1], u0 = acc[ai][1][m][0], u1 = acc[ai][1][m][1];
                u32x4 w; w.x = cvt_pk_bf16(siluf_(g0[0]) * u0[0], siluf_(g0[1]) * u0[1]); w.y = cvt_pk_bf16(siluf_(g0[2]) * u0[2], siluf_(g0[3]) * u0[3]);
                w.z = cvt_pk_bf16(siluf_(g1[0]) * u1[0], siluf_(g1[1]) * u1[1]); w.w = cvt_pk_bf16(siluf_(g1[2]) * u1[2], siluf_(g1[3]) * u1[3]);
                *(u32x4*)rowp = w; }
    }
};
struct EpiQ {
    static constexpr bool PERM = true, AFTER_DRAIN = false;
    bf16_t* Q;
    __device__ __forceinline__ void operator()(const f32x4 (&acc)[2][2][4][2], const Unit& u, int wr, int wc, int fr, int fq) const {
        const int row0 = u.pm * 256 + wr * 64 + fr;
        const int off0 = u.pn < 4 ? u.pn * 320 + wc * 32 + 8 * fq : wc * 320 + 256 + 8 * fq, bjs = u.pn < 4 ? 128 : 32;
#pragma unroll
        for (int ai = 0; ai < 2; ++ai)
#pragma unroll
            for (int m = 0; m < 4; ++m) { bf16_t* rowp = Q + (size_t)(row0 + ai * 128 + m * 16) * 1280 + off0;
#pragma unroll
                for (int bj = 0; bj < 2; ++bj) { const f32x4 v0 = acc[ai][bj][m][0], v1 = acc[ai][bj][m][1];
                    u32x4 w; w.x = cvt_pk_bf16(v0[0], v0[1]); w.y = cvt_pk_bf16(v0[2], v0[3]); w.z = cvt_pk_bf16(v1[0], v1[1]); w.w = cvt_pk_bf16(v1[2], v1[3]);
                    *(u32x4*)(rowp + bj * bjs) = w; } }
    }
};
struct TailSplitOrder {
    int G, c, nsp, nt_full, nt_sub, kb_sub;
    __device__ bool next(int i, Unit& u) const {
        const int L = i * G + c;
        if (L < 256) { const int off = L >> 3; u.pm = (L & 7) * 8 + (off >> 2); u.pn = off & 3; u.ks = -1; u.nt = nt_full; u.koff = 0; return true; }
        const int s2 = L - 256; if (s2 >= 32 * nsp) return false;
        const int pair = s2 & 31; u.pm = 64 + (pair >> 2); u.pn = pair & 3; u.ks = s2 >> 5; u.nt = nt_sub; u.koff = u.ks * kb_sub; return true;
    }
    __device__ __forceinline__ void a_ready(const Unit&) const {}
    __device__ __forceinline__ void done(const Unit&) const {}
};
template <class Epi> __device__ __forceinline__ void run_gemm(unsigned char* lds, const bf16_t* A, const bf16_t* Bt, int M, int N, int K, const Epi& E, int nsp = 0  ) {
    pg8::Gemm g{A, Bt, M, N, K, K};
    if (nsp) { TailSplitOrder S; S.G = gdim_(); S.c = bid_(); S.nsp = nsp; S.nt_full = K / 64; S.nt_sub = K / nsp / 64; S.kb_sub = K / nsp * 2; pg8::gemm_phase<Epi, TailSplitOrder, false>((PG8_LAS unsigned char*)lds, g, S, E, nullptr); }
    else { pg8::StaticOrder S; S.init(M, N, gdim_(), bid_(), 1); S.unt = K / 64; S.ukb = K * 2; pg8::gemm_phase<Epi, pg8::StaticOrder, false>((PG8_LAS unsigned char*)lds, g, S, E, nullptr); }
}
#define GAS __attribute__((address_space(1)))
#define XB_TMO      128
#define XB_XCNT(j)  (256  + 64 * (j))
#define XB_XSUB(j)  (1280 + 64 * (j))
#define XB_XGEN(j)  (2304 + 64 * (j))
#define XB_TOP      3328
#define XB_TOPGEN   3392
#define XCD_BAR_WORDS 3456
#define XB_SPIN_CAP (1u << 18)

__device__ __forceinline__ unsigned xb_ld(unsigned* p)              { return __hip_atomic_load(p, __ATOMIC_RELAXED, __HIP_MEMORY_SCOPE_AGENT); }
__device__ __forceinline__ unsigned xb_add(unsigned* p, unsigned v) { return __hip_atomic_fetch_add(p, v, __ATOMIC_RELAXED, __HIP_MEMORY_SCOPE_AGENT); }
__device__ __forceinline__ unsigned xb_xcc_id() { return (unsigned)__builtin_amdgcn_s_getreg((3 << 11) | 20) & 0xFu; }
#define XB_SPIN(cond, bar) do { unsigned _sp = 0; while (cond) { __builtin_amdgcn_s_sleep(1); \
    if ((++_sp & 255u) == 0u) { if (xb_ld(&(bar)[XB_TMO])) break; if (_sp > XB_SPIN_CAP) { atomicAdd(&(bar)[XB_TMO], 1u); break; } } } } while (0)

struct XcdBarrier {
    unsigned* bar; unsigned x;
    volatile LAS unsigned* st;
};

__device__ __forceinline__ XcdBarrier xcd_barrier_post(unsigned* bar, volatile LAS unsigned* st) {
    XcdBarrier b; b.bar = bar; b.x = xb_xcc_id(); b.st = st;
    if (threadIdx.x == 0) (void)xb_add(&bar[XB_XCNT(b.x)], 1u);
    return b;
}
__device__ __forceinline__ void xcd_barrier_complete(unsigned* bar, unsigned x, unsigned& nloc, unsigned& nx) {
    const unsigned G = gridDim.x * gridDim.y * gridDim.z;
    unsigned sum, cnt, mine, sp = 0u;
    for (;;) {
        sum = 0u; cnt = 0u; mine = 0u;
#pragma unroll
        for (unsigned j = 0; j < 16; ++j) { const unsigned c = xb_ld(&bar[XB_XCNT(j)]); sum += c; cnt += (c > 0u) ? 1u : 0u; mine = (j == x) ? c : mine; }
        if (sum == G) break;
        __builtin_amdgcn_s_sleep(1);
        if ((++sp & 255u) == 0u) { if (xb_ld(&bar[XB_TMO])) break; if (sp > XB_SPIN_CAP) { atomicAdd(&bar[XB_TMO], 1u); break; } }
    }
    nloc = mine > 0u ? mine : 1u; nx = cnt > 0u ? cnt : 1u;
}

__device__ __forceinline__ void xcd_barrier(const XcdBarrier& b) {
    asm volatile("s_waitcnt vmcnt(0)" ::: "memory");
    __syncthreads();
    if (threadIdx.x == 0) {
        unsigned* bar = b.bar; asm volatile("" : "+s"(bar));
        __builtin_amdgcn_s_waitcnt(0);
        unsigned nloc = b.st[0], nx = b.st[1];
        if (nloc == 0u) { xcd_barrier_complete(bar, b.x, nloc, nx); b.st[0] = nloc; b.st[1] = nx; }
        const unsigned old = xb_add(&bar[XB_XSUB(b.x)], 1u);
        const unsigned gen = old / nloc;
        if (old + 1u == (gen + 1u) * nloc) {
            __builtin_amdgcn_fence(__ATOMIC_RELEASE, "agent");
            asm volatile("s_waitcnt vmcnt(0)" ::: "memory");
            const unsigned og = xb_add(&bar[XB_TOP], 1u);
            const unsigned tg = og / nx;
            if (og + 1u == (tg + 1u) * nx) xb_add(&bar[XB_TOPGEN], 1u);
            else XB_SPIN(xb_ld(&bar[XB_TOPGEN]) == tg, bar);
            __builtin_amdgcn_fence(__ATOMIC_ACQUIRE, "agent");
            xb_add(&bar[XB_XGEN(b.x)], 1u);
            asm volatile("s_waitcnt vmcnt(0)" ::: "memory");
        } else {
            XB_SPIN(xb_ld(&bar[XB_XGEN(b.x)]) == gen, bar);
            __builtin_amdgcn_fence(__ATOMIC_ACQUIRE, "agent");
            asm volatile("s_waitcnt vmcnt(0)" ::: "memory");
        }
    }
    __syncthreads();
}
__device__ __forceinline__ void tr_tile(const float* __restrict__ src, int srcN, bf16_t* __restrict__ dst, int dstK, int k0, int n0, int mode, float* T) {
    int tid = threadIdx.x; asm volatile("" : "+v"(tid));
    float4 v[4];
#pragma unroll
    for (int e = 0; e < 4; ++e) { const int idx = tid + 512 * e, kk = idx >> 4, n4 = idx & 15; v[e] = *(const float4*)(src + (size_t)(k0 + kk) * srcN + n0 + 4 * n4); }
#pragma unroll
    for (int e = 0; e < 4; ++e) { const int idx = tid + 512 * e, kk = idx >> 4, n4 = idx & 15; float* t = T + kk * 65 + 4 * n4; t[0] = v[e].x; t[1] = v[e].y; t[2] = v[e].z; t[3] = v[e].w; }
    __syncthreads();
#pragma unroll
    for (int e = 0; e < 2; ++e) { const int idx = tid + 512 * e, nn = idx >> 4, kq = idx & 15; const int n = n0 + nn;
        const int row = mode == 0 ? n : ((n >> 7) * 256 + (n & 127) + (mode == 2 ? 128 : 0)); const float* t = T + (8 * kq) * 65 + nn;
        u32x4 w; w.x = cvt_pk_bf16(t[0], t[65]); w.y = cvt_pk_bf16(t[130], t[195]); w.z = cvt_pk_bf16(t[260], t[325]); w.w = cvt_pk_bf16(t[390], t[455]);
        *(u32x4*)(dst + (size_t)row * dstK + k0 + 8 * kq) = w; }
    __syncthreads();
}
__device__ __forceinline__ void tr_task(const float* src, int srcN, int K, bf16_t* dst, int dstK, int mode, float* T) {
    const int tn = srcN >> 6, nt = (K >> 7) * tn;
    for (int t = bid_(); t < nt; t += gdim_()) tr_tile(src, srcN, dst, dstK, (t / tn) * 128, (t % tn) * 64, mode, T);
}
template <bool XIN_F32, bool XOUT_F32>
__device__ __forceinline__ void ew_phase(const bf16_t* __restrict__ D, const bf16_t* D1  , int nsp, const void* xa  , const float* __restrict__ xb  , void* xout  ,
                                         const float* __restrict__ gpost, float coef, const float* __restrict__ gpre, bf16_t* hout, const float* __restrict__ gin, float* rsb  ) {
    int tid = threadIdx.x; asm volatile("" : "+v"(tid)); const int lane = tid & 63, wave = tid >> 6;
    const int rstep = gdim_() * 8;
    for (int rb = bid_() * 8 + wave; rb < MT; rb += 2 * rstep) {
        float4 xv[2][4]; float dv[2][4][4];
#pragma unroll
        for (int u = 0; u < 2; ++u) { const int r = rb + u * rstep; if (r < MT) {
            if (XIN_F32) { const float* xr = (xb && r >= MP) ? xb + (size_t)(r - MP) * DM : (const float*)xa + (size_t)r * DM;
#pragma unroll
                for (int i = 0; i < 4; ++i) xv[u][i] = *(const float4*)(xr + lane * 4 + 256 * i); }
            else {
#pragma unroll
                for (int i = 0; i < 4; ++i) { const uint2 w = *(const uint2*)((const bf16_t*)xa + (size_t)r * DM + lane * 4 + 256 * i); xv[u][i] = make_float4(bflo(w.x), bfhi(w.x), bflo(w.y), bfhi(w.y)); }
                const float ir = __builtin_amdgcn_rcpf(rsb[r]);
#pragma unroll
                for (int i = 0; i < 4; ++i) { const float4 gi = *(const float4*)(gin + lane * 4 + 256 * i);
                    xv[u][i].x *= ir * __builtin_amdgcn_rcpf(gi.x); xv[u][i].y *= ir * __builtin_amdgcn_rcpf(gi.y); xv[u][i].z *= ir * __builtin_amdgcn_rcpf(gi.z); xv[u][i].w *= ir * __builtin_amdgcn_rcpf(gi.w); } }
            if (D) {
#pragma unroll
                for (int i = 0; i < 4; ++i) { const uint2 w = *(const uint2*)(D + (size_t)r * DM + lane * 4 + 256 * i); dv[u][i][0] = bflo(w.x); dv[u][i][1] = bfhi(w.x); dv[u][i][2] = bflo(w.y); dv[u][i][3] = bfhi(w.y);
                    } } } }
        if (D1) {
#pragma unroll
            for (int u = 0; u < 2; ++u) { const int r = rb + u * rstep; if (r >= MP && r < MT) {
#pragma unroll
                for (int i = 0; i < 4; ++i) { dv[u][i][0] = 0.f; dv[u][i][1] = 0.f; dv[u][i][2] = 0.f; dv[u][i][3] = 0.f; }
                for (int ks = 0; ks < nsp; ++ks) {
#pragma unroll
                    for (int i = 0; i < 4; ++i) { const uint2 w1 = *(const uint2*)(D1 + ((size_t)ks * MS + (r - MP)) * DM + lane * 4 + 256 * i); dv[u][i][0] += bflo(w1.x); dv[u][i][1] += bfhi(w1.x); dv[u][i][2] += bflo(w1.y); dv[u][i][3] += bfhi(w1.y); } } } } }
#pragma unroll
        for (int u = 0; u < 2; ++u) { const int r = rb + u * rstep; if (r < MT) {
            if (D) { float ss = 0.f;
#pragma unroll
                for (int i = 0; i < 4; ++i) ss += dv[u][i][0] * dv[u][i][0] + dv[u][i][1] * dv[u][i][1] + dv[u][i][2] * dv[u][i][2] + dv[u][i][3] * dv[u][i][3];
                ss = wave_sum(ss); const float rs = coef * rsqrtf(ss * (1.0f / 1024.0f) + EPS);
#pragma unroll
                for (int i = 0; i < 4; ++i) { const float4 g = *(const float4*)(gpost + lane * 4 + 256 * i);
                    xv[u][i].x += dv[u][i][0] * rs * g.x; xv[u][i].y += dv[u][i][1] * rs * g.y; xv[u][i].z += dv[u][i][2] * rs * g.z; xv[u][i].w += dv[u][i][3] * rs * g.w; } }
            if (XOUT_F32) {
#pragma unroll
                for (int i = 0; i < 4; ++i) __builtin_nontemporal_store((f32x4){xv[u][i].x, xv[u][i].y, xv[u][i].z, xv[u][i].w}, (f32x4*)((float*)xout + (size_t)r * DM + lane * 4 + 256 * i)); }

            if (hout) { float ss = 0.f;
#pragma unroll
                for (int i = 0; i < 4; ++i) ss += xv[u][i].x * xv[u][i].x + xv[u][i].y * xv[u][i].y + xv[u][i].z * xv[u][i].z + xv[u][i].w * xv[u][i].w;
                ss = wave_sum(ss); const float rs = rsqrtf(ss * (1.0f / 1024.0f) + EPS); if (lane == 0) rsb[r] = rs;
#pragma unroll
                for (int i = 0; i < 4; ++i) { const float4 g = *(const float4*)(gpre + lane * 4 + 256 * i); uint2 w;
                    w.x = cvt_pk_bf16(xv[u][i].x * rs * g.x, xv[u][i].y * rs * g.y); w.y = cvt_pk_bf16(xv[u][i].z * rs * g.z, xv[u][i].w * rs * g.w);
                    *(uint2*)(hout + (size_t)r * DM + lane * 4 + 256 * i) = w; } } } }
    }
}
__device__ __forceinline__ int wtask_count(int kind) { return kind < 6 ? 352 : kind == 6 ? 281 : kind == 7 ? 64 : kind == 8 ? 256 : kind == 9 ? 96 : 192; }
__device__ void wtask_run(CArgs& a, int l, int kind, int t, unsigned char* lds) {
    unsigned char* ws = a.ws; float* T = (float*)lds; int tid = threadIdx.x; asm volatile("" : "+v"(tid));
    if (kind < 6) { const int f = kind / 3, m = kind % 3; const size_t lf = (size_t)(l * 2 + f);
        if (m < 2) tr_tile(a.in[6 + m] + lf * 1024 * 2816, 2816, (bf16_t*)(ws + OFF_WGU) + lf * 5632 * 1024, 1024, (t / 44) * 128, (t % 44) * 64, 1 + m, T);
        else tr_tile(a.in[8] + lf * 2816 * 1024, 1024, (bf16_t*)(ws + OFF_WDN) + lf * 1024 * 2816, 2816, (t / 16) * 128, (t % 16) * 64, 0, T);
    } else if (kind == 6) { bf16_t* win = (bf16_t*)(ws + OFF_WIN) + (size_t)l * 2304 * 1024;
        if (t < 280) tr_tile(a.in[9] + (size_t)l * 1024 * 2240, 2240, win, 1024, (t / 35) * 128, (t % 35) * 64, 0, T);
        else { for (int i = tid; i < 64 * 1024 / 2; i += 512) ((unsigned*)(win + 2240 * 1024))[i] = 0u; }
    } else if (kind == 7) { bf16_t* wmix = (bf16_t*)(ws + OFF_WMIX) + (size_t)l * 1024 * 1536;
        tr_tile(a.in[10] + (size_t)l * 1024 * 1024 + 512 * 1024, 1024, wmix + 1024, 1536, (t / 16) * 128, (t % 16) * 64, 0, T);
    } else if (kind == 8) {
        bf16_t* wmix = (bf16_t*)(ws + OFF_WMIX) + (size_t)l * 1024 * 1536; const float* wuv = a.in[15] + (size_t)l * 256 * 512; const float* wo = a.in[10] + (size_t)l * 1024 * 1024;
        const int i = t * 512 + tid; const int n = i & 1023, hcb = t >> 1, h = hcb >> 5, cb = hcb & 31;
        float* W = T;
        __syncthreads();
#pragma unroll
        for (int e = 0; e < 2; ++e) { const int q = tid + 512 * e, j = q >> 7, v = q & 127; W[v * 8 + j] = wuv[((8 * cb + j) * 4 + h) * 128 + v]; }
        __syncthreads();
        const float* bv = wo + (size_t)(h * 128) * 1024 + n; float acc[8];
#pragma unroll
        for (int j = 0; j < 8; ++j) acc[j] = 0.f;
#pragma unroll 1
        for (int v0 = 0; v0 < 128; v0 += 16) { float bb[16];
#pragma unroll
            for (int u = 0; u < 16; ++u) bb[u] = bv[(size_t)(v0 + u) * 1024];
#pragma unroll
            for (int u = 0; u < 16; ++u) { const float4 w0 = *(const float4*)(W + (v0 + u) * 8), w1 = *(const float4*)(W + (v0 + u) * 8 + 4);
                acc[0] += w0.x * bb[u]; acc[1] += w0.y * bb[u]; acc[2] += w0.z * bb[u]; acc[3] += w0.w * bb[u]; acc[4] += w1.x * bb[u]; acc[5] += w1.y * bb[u]; acc[6] += w1.z * bb[u]; acc[7] += w1.w * bb[u]; } }
        u32x4 w; w.x = cvt_pk_bf16(acc[0], acc[1]); w.y = cvt_pk_bf16(acc[2], acc[3]); w.z = cvt_pk_bf16(acc[4], acc[5]); w.w = cvt_pk_bf16(acc[6], acc[7]);
        *(u32x4*)(wmix + (size_t)n * 1536 + h * 256 + 8 * cb) = w;
        __syncthreads();
    } else { bf16_t* wq = (bf16_t*)(ws + OFF_WQ) + (size_t)l * 1280 * 384; const float* wuk = a.in[14] + (size_t)l * 256 * 512; const float* wqb = a.in[12] + (size_t)l * 384 * 768;
        const int i = t * 512 + tid;
        if (kind == 9) {
            const int k = i % 384, hcb = i / 384, h = hcb >> 5, cb = hcb & 31;
            const float4* bv = (const float4*)(wqb + (size_t)k * 768 + h * 192); float acc[8];
#pragma unroll
            for (int j = 0; j < 8; ++j) acc[j] = 0.f;
#pragma unroll 2
            for (int v = 0; v < 32; ++v) { const float4 y = bv[v];
#pragma unroll
                for (int j = 0; j < 8; ++j) { const float4 x = *(const float4*)(wuk + ((8 * cb + j) * 4 + h) * 128 + 4 * v); acc[j] += x.x * y.x + x.y * y.y + x.z * y.z + x.w * y.w; } }
#pragma unroll
            for (int j = 0; j < 8; ++j) wq[(size_t)(h * 256 + 8 * cb + j) * 384 + k] = f2bf(acc[j] * QSCALE);
        } else {
            const int k = i % 384, j = i / 384, half = j >> 7, jj = j & 127, h = jj >> 5, fi = jj & 31;
            wq[(size_t)(1024 + j) * 384 + k] = f2bf(wqb[(size_t)k * 768 + h * 192 + 128 + half * 32 + fi] * QSCALE); }
    }
}
__device__ void wtasks(CArgs& a, int l, int k0, int k1, int cw, unsigned char* lds) {
    unsigned* ctr = (unsigned*)(a.ws + OFF_CTL) + cw; LAS unsigned* slot = (LAS unsigned*)(lds + LDS_MAIN + 16);
    int total = 0; for (int k = k0; k < k1; ++k) total += wtask_count(k);
    for (;;) {
        __syncthreads();
        { int t0 = threadIdx.x; asm volatile("" : "+v"(t0)); if (t0 == 0) *slot = atomicAdd(ctr, 1u); }
        __syncthreads();
        int it = (int)*slot;
        if (it >= total) break;
        int k = k0; while (it >= wtask_count(k)) { it -= wtask_count(k); ++k; }
        wtask_run(a, l, k, it, lds);
    }
}
__device__ void phase_init(CArgs& a, unsigned char* lds) {
    unsigned char* ws = a.ws;
    int tid = threadIdx.x; asm volatile("" : "+v"(tid)); const size_t gtid = (size_t)bid_() * 512 + tid, gsz = (size_t)gdim_() * 512;
    for (size_t i = gtid; i < 4096 * 32; i += gsz) { const int pos = (int)(i >> 5), fi = (int)(i & 31);
        const float w = exp2f(-(float)fi * (13.287712379549449f / 32.0f)); const double ang = (double)((float)pos * w);
        const double k = rint(ang * 0.15915494309189535); const float rr = (float)(ang - k * 6.283185307179586);
        ((float2*)(ws + OFF_ROPE))[i] = make_float2(__cosf(rr), __sinf(rr)); }
    wtasks(a, 0, 0, 3, 256, lds); wtasks(a, 0, 6, 7, 272, lds);
    ew_phase<true, false>(nullptr, nullptr, 0, a.in[0], a.in[1], nullptr, nullptr, 0.f, a.in[5], (bf16_t*)(ws + OFF_H), nullptr, (float*)(ws + OFF_X));
}
__device__ void tail_wtasks(CArgs& a, int ph, unsigned char* lds) {
    switch (ph) {
    case 1:  wtasks(a, 0, 10, 11, 257, lds); wtasks(a, 0, 7, 8, 258, lds); break;
    case 2:  wtasks(a, 0, 3, 4, 259, lds); break;
    case 4:  wtasks(a, 0, 9, 10, 260, lds); wtasks(a, 0, 4, 5, 261, lds); break;
    case 6:  wtasks(a, 0, 8, 9, 262, lds); break;
    case 8:  wtasks(a, 0, 5, 6, 263, lds); break;
    case 10: wtasks(a, 1, 0, 3, 264, lds); wtasks(a, 1, 6, 7, 265, lds); wtasks(a, 1, 9, 10, 266, lds); break;
    case 11: wtasks(a, 1, 10, 11, 267, lds); wtasks(a, 1, 7, 8, 268, lds); break;
    case 14: wtasks(a, 1, 3, 4, 269, lds); break;
    case 16: wtasks(a, 1, 4, 6, 270, lds); break;
    case 18: wtasks(a, 1, 8, 9, 271, lds); break;
    default: break; }
}
__device__ __forceinline__ int keyof32(int p) { const int g = p >> 3, j = p & 7; return j < 4 ? 4 * g + j : 16 + 4 * g + (j - 4); }
__device__ __forceinline__ void ct_write(const bf16_t* ctile, bf16_t* dst  , size_t rowstride) {
    int tid = threadIdx.x; asm volatile("" : "+v"(tid)); const int c = tid >> 1, half = tid & 1;
    unsigned w[16];
#pragma unroll
    for (int p = 0; p < 32; p += 2) { const int t0 = 32 * half + keyof32(p), t1 = 32 * half + keyof32(p + 1);
        w[p >> 1] = (unsigned)ctile[t0 * 264 + c] | ((unsigned)ctile[t1 * 264 + c] << 16); }
    uint4* d = (uint4*)(dst + (size_t)c * rowstride + 32 * half);
#pragma unroll
    for (int i = 0; i < 4; ++i) d[i] = make_uint4(w[4 * i], w[4 * i + 1], w[4 * i + 2], w[4 * i + 3]);
}
__device__ __forceinline__ float lb_of(CArgs& a, int l, int e) { if (l == 0) return 0.f; const float a0 = a.in[16][e], a1 = a.in[16][256 + e]; return 1.0f / (1.0f + __expf(a0 - a1)); }
__device__ void prep_mla_tile(CArgs& a, int l, int T, unsigned char* lds) {
    unsigned char* ws = a.ws; int tid = threadIdx.x; asm volatile("" : "+v"(tid)); const int lane = tid & 63, wave = tid >> 6;
    const bf16_t* z = (const bf16_t*)(ws + OFF_Z); const int r0 = T * 64;
    const bool prm = T < 256; const int b = prm ? (T >> 6) : (T - 256), j = prm ? (T & 63) : 0; const int pos0 = prm ? j * 64 : 2048;
    bf16_t* kc = (bf16_t*)(ws + OFF_KC) + (prm ? (size_t)(b * 4096 + j * 64) : (size_t)16384 + (size_t)b * 2112 + 2048) * 320;
    bf16_t* ct = (bf16_t*)(ws + OFF_CT) + (prm ? (size_t)b * 256 * 4096 + j * 64 : (size_t)16384 * 256 + (size_t)b * 256 * 2112 + 2048);
    const size_t ctstride = prm ? 4096 : 2112;
    float* ockv = a.out + (prm ? O_CKVP + ((size_t)(l * 4 + b) * 4096 + j * 64) * 256 : O_CKVS + ((size_t)(l * 32 + b) * 64) * 256);
    float* okpe = a.out + (prm ? O_KPEP + ((size_t)(l * 4 + b) * 4096 + j * 64) * 64 : O_KPES + ((size_t)(l * 32 + b) * 64) * 64);
    bf16_t* qn = (bf16_t*)(ws + OFF_QN); const float* qag = a.in[11] + l * 384; const float* kvg = a.in[13] + l * 256;
    const float2* rope = (const float2*)(ws + OFF_ROPE);
    bf16_t* ctile = (bf16_t*)lds;
    float qg[6];
#pragma unroll
    for (int i = 0; i < 3; ++i) { qg[2 * i] = qag[2 * lane + 128 * i]; qg[2 * i + 1] = qag[2 * lane + 128 * i + 1]; }
    const float4 g4 = *(const float4*)(kvg + 4 * lane);
#pragma unroll 1
    for (int tb = 0; tb < 8; tb += 4) {
        unsigned wq[4][3]; uint2 wk[4]; bf16_t p1[4], p2[4];
#pragma unroll
        for (int u = 0; u < 4; ++u) { const bf16_t* zr = z + (size_t)(r0 + wave + 8 * (tb + u)) * ZW;
#pragma unroll
            for (int i = 0; i < 3; ++i) wq[u][i] = *(const unsigned*)(zr + ZQ + 2 * lane + 128 * i);
            wk[u] = *(const uint2*)(zr + ZKV + 4 * lane); p1[u] = zr[ZPE + (lane & 31)]; p2[u] = zr[ZPE + 32 + (lane & 31)]; }
#pragma unroll
        for (int u = 0; u < 4; ++u) { const int t = wave + 8 * (tb + u);
            { float v[6]; float ss = 0.f;
#pragma unroll
              for (int i = 0; i < 3; ++i) { v[2 * i] = bflo(wq[u][i]); v[2 * i + 1] = bfhi(wq[u][i]); ss += v[2 * i] * v[2 * i] + v[2 * i + 1] * v[2 * i + 1]; }
              ss = wave_sum(ss); const float rs = rsqrtf(ss * (1.0f / 384.0f) + EPS);
#pragma unroll
              for (int i = 0; i < 3; ++i) *(unsigned*)(qn + (size_t)(r0 + t) * 384 + 2 * lane + 128 * i) = cvt_pk_bf16(v[2 * i] * rs * qg[2 * i], v[2 * i + 1] * rs * qg[2 * i + 1]); }
            { float v0 = bflo(wk[u].x), v1 = bfhi(wk[u].x), v2 = bflo(wk[u].y), v3 = bfhi(wk[u].y);
              const float ss = wave_sum(v0 * v0 + v1 * v1 + v2 * v2 + v3 * v3); const float rs = rsqrtf(ss * (1.0f / 256.0f) + EPS);
              v0 *= rs * g4.x; v1 *= rs * g4.y; v2 *= rs * g4.z; v3 *= rs * g4.w;
              __builtin_nontemporal_store((f32x4){v0, v1, v2, v3}, (f32x4*)(ockv + (size_t)t * 256 + 4 * lane));
              uint2 o; o.x = cvt_pk_bf16(v0, v1); o.y = cvt_pk_bf16(v2, v3);
              *(uint2*)(kc + (size_t)t * 320 + 4 * lane) = o; *(uint2*)(ctile + t * 264 + 4 * lane) = o; }
            if (lane < 32) { const float x1 = bf2f(p1[u]), x2 = bf2f(p2[u]); const float2 cs = rope[(pos0 + t) * 32 + lane];
              const float o1 = x1 * cs.x - x2 * cs.y, o2 = x2 * cs.x + x1 * cs.y;
              okpe[(size_t)t * 64 + lane] = o1; okpe[(size_t)t * 64 + 32 + lane] = o2; kc[(size_t)t * 320 + 256 + lane] = f2bf(o1); kc[(size_t)t * 320 + 288 + lane] = f2bf(o2); } }
    }
    __syncthreads();
    ct_write(ctile, ct, ctstride);
    __syncthreads();
}
__device__ void prep_hgrn_tile(CArgs& a, int l, int T, unsigned char* lds) {
    unsigned char* ws = a.ws; int tid = threadIdx.x; asm volatile("" : "+v"(tid)); asm volatile("" : "+s"(l));
    const bf16_t* z = (const bf16_t*)(ws + OFF_Z); const int r0 = T * 64;
    float* lf = (float*)lds; float* vt = (float*)(lds + 65536); float* tot = (float*)(lds + 131072);
    const int ep = tid & 255, hf = tid >> 8; const float lbv = lb_of(a, l, ep);
    bf16_t zfr[32]; float pref[32];
    { bf16_t zvr[32];
#pragma unroll
      for (int i = 0; i < 32; ++i) { const bf16_t* zr = z + (size_t)(r0 + 32 * hf + i) * ZW; zfr[i] = zr[ZHF + ep]; zvr[i] = zr[ZHI + ep]; }
      float run = 0.f;
#pragma unroll
      for (int i = 0; i < 32; ++i) { const float f = lbv + (1.0f - lbv) * sigmoidf_(bf2f(zfr[i])); run += __logf(fmaxf(f, 1e-30f)); pref[i] = run; vt[(32 * hf + i) * 256 + ep] = bf2f(zvr[i]); }
      tot[hf * 256 + ep] = run; }
    __syncthreads();
    { const float t0 = tot[ep], bl = t0 + tot[256 + ep], off = hf ? t0 : 0.f;
#pragma unroll
      for (int i = 0; i < 32; ++i) { lf[(32 * hf + i) * 256 + ep] = (1.0f - lbv) * sigmoidf_(-bf2f(zfr[i])) * __expf(bl - pref[i] - off); ((float*)(ws + OFF_BCUM))[(size_t)(r0 + 32 * hf + i) * 256 + ep] = pref[i] + off; }
      if (hf == 0) ((float*)(ws + OFF_DEC))[T * 256 + ep] = __expf(bl); }
    __syncthreads();
    { const int h = tid >> 7, eb = (tid & 127) >> 3, db = tid & 7; float acc[4][8];
#pragma unroll
      for (int i = 0; i < 4; ++i)
#pragma unroll
          for (int jj = 0; jj < 8; ++jj) acc[i][jj] = 0.f;
#pragma unroll 4
      for (int s = 0; s < 64; ++s) { const float4 kv = *(const float4*)(lf + s * 256 + h * 64 + eb * 4); const float4 v0 = *(const float4*)(vt + s * 256 + h * 64 + db * 8), v1 = *(const float4*)(vt + s * 256 + h * 64 + db * 8 + 4);
          const float kk[4] = {kv.x, kv.y, kv.z, kv.w}; const float vv[8] = {v0.x, v0.y, v0.z, v0.w, v1.x, v1.y, v1.z, v1.w};
#pragma unroll
          for (int i = 0; i < 4; ++i)
#pragma unroll
              for (int jj = 0; jj < 8; ++jj) acc[i][jj] += kk[i] * vv[jj]; }
      float* U = (float*)(ws + OFF_U) + (size_t)(T * 4 + h) * 4096;
#pragma unroll
      for (int i = 0; i < 4; ++i) { *(float4*)(U + (eb * 4 + i) * 64 + db * 8) = make_float4(acc[i][0], acc[i][1], acc[i][2], acc[i][3]); *(float4*)(U + (eb * 4 + i) * 64 + db * 8 + 4) = make_float4(acc[i][4], acc[i][5], acc[i][6], acc[i][7]); } }
    __syncthreads();
}
__device__ void prep_cache_tile(CArgs& a, int l, int P, unsigned char* lds) {
    unsigned char* ws = a.ws; int tid = threadIdx.x; asm volatile("" : "+v"(tid)); const int b = P >> 5, kt = P & 31;
    const float* ckv = a.in[2] + ((size_t)(l * 32 + b) * 2048 + kt * 64) * 256; const float* kpe = a.in[3] + ((size_t)(l * 32 + b) * 2048 + kt * 64) * 64;
    bf16_t* kc = (bf16_t*)(ws + OFF_KC) + ((size_t)16384 + (size_t)b * 2112 + kt * 64) * 320;
    bf16_t* ct = (bf16_t*)(ws + OFF_CT) + (size_t)16384 * 256 + (size_t)b * 256 * 2112 + kt * 64;
    bf16_t* ctile = (bf16_t*)lds;
#pragma unroll
    for (int i = 0; i < 8; ++i) { const int q = tid + 512 * i, t = q >> 6, c4 = q & 63; const float4 v = *(const float4*)(ckv + (size_t)t * 256 + c4 * 4);
        uint2 o; o.x = cvt_pk_bf16(v.x, v.y); o.y = cvt_pk_bf16(v.z, v.w); *(uint2*)(kc + (size_t)t * 320 + c4 * 4) = o; *(uint2*)(ctile + t * 264 + c4 * 4) = o; }
#pragma unroll
    for (int i = 0; i < 2; ++i) { const int q = tid + 512 * i, t = q >> 4, c4 = q & 15; const float4 v = *(const float4*)(kpe + (size_t)t * 64 + c4 * 4);
        uint2 o; o.x = cvt_pk_bf16(v.x, v.y); o.y = cvt_pk_bf16(v.z, v.w); *(uint2*)(kc + (size_t)t * 320 + 256 + c4 * 4) = o; }
    __syncthreads();
    ct_write(ctile, ct, 2112);
    __syncthreads();
}
__device__ void phase_prep(CArgs& a, int l, unsigned char* lds, int rep = 0) {
    unsigned* ctr = (unsigned*)(a.ws + OFF_CTL) + 16 * (l + 1) + 8 + 128 * rep; LAS unsigned* slot = (LAS unsigned*)(lds + LDS_MAIN + 16);
    for (;;) {
        __syncthreads();
        { int t0 = threadIdx.x; asm volatile("" : "+v"(t0)); if (t0 == 0) *slot = atomicAdd(ctr, 1u); }
        __syncthreads();
        const int it = (int)*slot;
        if (it >= 2 * NTILE) break;
        if (it < NTILE) prep_hgrn_tile(a, l, it, lds); else prep_mla_tile(a, l, it - NTILE, lds);
    }
}
__device__ void phase_cache(CArgs& a, int l, unsigned char* lds) {
    unsigned* ctr = (unsigned*)(a.ws + OFF_CTL) + 16 * (l + 1) + 12; LAS unsigned* slot = (LAS unsigned*)(lds + LDS_MAIN + 16);
    for (;;) {
        __syncthreads();
        { int t0 = threadIdx.x; asm volatile("" : "+v"(t0)); if (t0 == 0) *slot = atomicAdd(ctr, 1u); }
        __syncthreads();
        const int it = (int)*slot;
        if (it >= 1024) break;
        prep_cache_tile(a, l, it, lds);
    }
}
__device__ void phase_scan(CArgs& a, int l) {
    unsigned char* ws = a.ws; int tid = threadIdx.x; asm volatile("" : "+v"(tid)); const size_t gtid = (size_t)bid_() * 512 + tid, gsz = (size_t)gdim_() * 512;
    const float* U = (const float*)(ws + OFF_U); const float* dec = (const float*)(ws + OFF_DEC); float* sst = (float*)(ws + OFF_SST);
    for (size_t i = gtid; i < 16 * 4096; i += gsz) { const int bh = (int)(i >> 12), ed = (int)(i & 4095), b = bh >> 2, h = bh & 3, e = ed >> 6; float S = 0.f;
#pragma unroll 16
        for (int j = 0; j < 64; ++j) { const size_t ch = (size_t)((b * 64 + j) * 4 + h); sst[ch * 4096 + ed] = S; S = dec[ch * 64 + e] * S + U[ch * 4096 + ed]; }
        a.out[O_HGP + (size_t)(l * 16 + bh) * 4096 + ed] = S; }
    for (size_t i = gtid; i < 128 * 4096; i += gsz) { const int bh = (int)(i >> 12), ed = (int)(i & 4095), b = bh >> 2, h = bh & 3, e = ed >> 6; const size_t ch = (size_t)((256 + b) * 4 + h);
        const float S0 = a.in[4][(size_t)(l * 128 + bh) * 4096 + ed];
        a.out[O_HGS + (size_t)(l * 128 + bh) * 4096 + ed] = dec[ch * 64 + e] * S0 + U[ch * 4096 + ed]; }
}
constexpr int KSTR = 656, VSTR = 144, VOFF = 64 * KSTR, ABUF = VOFF + 256 * VSTR;
__device__ __forceinline__ int swz16(int row) { return (((row & 15) + 4) >> 3) & 1; }
__device__ void attn_item(CArgs& a, int idx, unsigned char* ldsg) {
    unsigned char* ws = a.ws; LAS unsigned char* lds = (LAS unsigned char*)ldsg;
    int tid = threadIdx.x; asm volatile("" : "+v"(tid)); const int lane = tid & 63, wave = __builtin_amdgcn_readfirstlane(tid >> 6), lr = lane & 15, g = lane >> 4;
    const int gx = (g ^ swz16(lr)) * 16;
    int b, hp, nkt, r0; const unsigned char* kcb; const unsigned char* ctb; int ctstride;
    if (idx >= 256 && idx < 320) { const int s = idx - 256; b = s >> 1; hp = s & 1; nkt = 33; r0 = MP + b * 64;
        kcb = ws + OFF_KC + ((size_t)16384 + (size_t)b * 2112) * 640; ctb = ws + OFF_CT + ((size_t)16384 * 256 + (size_t)b * 256 * 2112) * 2; ctstride = 4224; }
    else { const int k = idx < 256 ? idx : idx - 64; const int j = 63 - (k >> 3), sub = k & 7; b = sub >> 1; hp = sub & 1; nkt = j + 1; r0 = b * 4096 + j * 64;
        kcb = ws + OFF_KC + (size_t)b * 4096 * 640; ctb = ws + OFF_CT + (size_t)b * 256 * 4096 * 2; ctstride = 8192; }
    const int head = hp * 2 + (wave >> 2); const int qrow = r0 + (wave & 3) * 16 + lr;
    unsigned ko[6], vo[5];
#pragma unroll
    for (int i = 0; i < 6; ++i) { const int n = i * 512 + tid, row = n / 41, pc = n - row * 41; ko[i] = (unsigned)(row * 640 + (pc < 40 ? (pc ^ swz16(row)) * 16 : 0)); }
#pragma unroll
    for (int i = 0; i < 5; ++i) { const int n = i * 512 + tid, row = n / 9, pc = n - row * 9; vo[i] = (unsigned)(row * ctstride + (pc < 8 ? (pc ^ swz16(row)) * 16 : 0)); }
#define ATT_DMA(kt, bo) do { const unsigned char* kg = kcb + (size_t)(kt) * 40960; const unsigned char* vg = ctb + (size_t)(kt) * 128; \
        _Pragma("unroll") for (int i = 0; i < 6; ++i) if (i < 5 || wave == 0) __builtin_amdgcn_global_load_lds((const unsigned*)(kg + ko[i]), (LAS unsigned*)(lds + (bo) + (i * 512 + wave * 64) * 16), 16, 0, 0); \
        _Pragma("unroll") for (int i = 0; i < 5; ++i) if (i < 4 || wave < 4) __builtin_amdgcn_global_load_lds((const unsigned*)(vg + vo[i]), (LAS unsigned*)(lds + (bo) + VOFF + (i * 512 + wave * 64) * 16), 16, 0, 0); } while (0)
    __syncthreads();
    ATT_DMA(0, 0);
    bf16x8 qf[10];
    { const bf16_t* qp = (const bf16_t*)(ws + OFF_Q) + (size_t)qrow * 1280 + head * 320 + g * 8;
#pragma unroll
      for (int ks = 0; ks < 10; ++ks) qf[ks] = *(const bf16x8*)(qp + ks * 32);
      const int pos = qrow < MP ? (qrow & 4095) : 2048 + ((qrow - MP) & 63); const float2* rp = (const float2*)(ws + OFF_ROPE) + pos * 32 + 8 * g;
      u32x4 w1 = __builtin_bit_cast(u32x4, qf[8]), w2 = __builtin_bit_cast(u32x4, qf[9]);
      float4 cs4[4];
#pragma unroll
      for (int jp = 0; jp < 4; ++jp) cs4[jp] = *(const float4*)(rp + 2 * jp);
#pragma unroll
      for (int jp = 0; jp < 4; ++jp) { const float a1 = bflo(w1[jp]), b1 = bfhi(w1[jp]), a2 = bflo(w2[jp]), b2 = bfhi(w2[jp]);
          w1[jp] = cvt_pk_bf16(a1 * cs4[jp].x - a2 * cs4[jp].y, b1 * cs4[jp].z - b2 * cs4[jp].w); w2[jp] = cvt_pk_bf16(a2 * cs4[jp].x + a1 * cs4[jp].y, b2 * cs4[jp].z + b1 * cs4[jp].w); }
      qf[8] = __builtin_bit_cast(bf16x8, w1); qf[9] = __builtin_bit_cast(bf16x8, w2); }
    f32x4 o[16];
#pragma unroll
    for (int i = 0; i < 16; ++i) o[i] = (f32x4){0.f, 0.f, 0.f, 0.f};
    float mrun = -1e30f, lsum = 0.f;
    asm volatile("s_waitcnt vmcnt(0)" ::: "memory");
    __syncthreads();
    const int koff = lr * KSTR + gx, voff = VOFF + lr * VSTR + gx;
    for (int kt = 0; kt < nkt; ++kt) {
        const int bo = (kt & 1) * ABUF;
        if (kt + 1 < nkt) ATT_DMA(kt + 1, ABUF - bo);
        const LAS unsigned char* kb = lds + bo + koff; const LAS unsigned char* vb = lds + bo + voff;
        f32x4 s[4];
#pragma unroll
        for (int i = 0; i < 4; ++i) s[i] = (f32x4){0.f, 0.f, 0.f, 0.f};
        bf16x8 kf[2][4];
#pragma unroll
        for (int k4 = 0; k4 < 4; ++k4) kf[0][k4] = *(const LAS bf16x8*)(kb + k4 * 16 * KSTR);
#pragma unroll
        for (int ks = 0; ks < 10; ++ks) {
            if (ks < 9) {
#pragma unroll
                for (int k4 = 0; k4 < 4; ++k4) kf[(ks + 1) & 1][k4] = *(const LAS bf16x8*)(kb + k4 * 16 * KSTR + (ks + 1) * 64); }
            __builtin_amdgcn_sched_barrier(0);
#pragma unroll
            for (int k4 = 0; k4 < 4; ++k4) s[k4] = __builtin_amdgcn_mfma_f32_16x16x32_bf16(kf[ks & 1][k4], qf[ks], s[k4], 0, 0, 0);
            __builtin_amdgcn_sched_barrier(0);
        }
        bf16x8 vf[2][4];
#pragma unroll
        for (int q4 = 0; q4 < 4; ++q4) vf[0][q4] = *(const LAS bf16x8*)(vb + (q4 >> 1) * 16 * VSTR + (q4 & 1) * 64);
        __builtin_amdgcn_sched_barrier(0);
        float mx = s[0][0];
#pragma unroll
        for (int k4 = 0; k4 < 4; ++k4)
#pragma unroll
            for (int i = 0; i < 4; ++i) mx = fmaxf(mx, s[k4][i]);
        mx = fmaxf(mx, __shfl_xor(mx, 16)); mx = fmaxf(mx, __shfl_xor(mx, 32));
        if (!__all(mx - mrun <= 8.0f)) {
            const float mnew = fmaxf(mrun, mx), alpha = __builtin_amdgcn_exp2f(mrun - mnew); mrun = mnew; lsum *= alpha;
#pragma unroll
            for (int i = 0; i < 16; ++i) o[i] *= alpha; }
        float ps = 0.f;
#pragma unroll
        for (int k4 = 0; k4 < 4; ++k4)
#pragma unroll
            for (int i = 0; i < 4; ++i) { s[k4][i] = __builtin_amdgcn_exp2f(s[k4][i] - mrun); ps += s[k4][i]; }
        lsum += ps;
        bf16x8 pb[2];
#pragma unroll
        for (int s2 = 0; s2 < 2; ++s2) { u32x4 w; w.x = cvt_pk_bf16(s[2 * s2][0], s[2 * s2][1]); w.y = cvt_pk_bf16(s[2 * s2][2], s[2 * s2][3]);
            w.z = cvt_pk_bf16(s[2 * s2 + 1][0], s[2 * s2 + 1][1]); w.w = cvt_pk_bf16(s[2 * s2 + 1][2], s[2 * s2 + 1][3]); pb[s2] = __builtin_bit_cast(bf16x8, w); }
#pragma unroll
        for (int cp = 0; cp < 8; ++cp) {
            if (cp < 7) {
#pragma unroll
                for (int q4 = 0; q4 < 4; ++q4) vf[(cp + 1) & 1][q4] = *(const LAS bf16x8*)(vb + (2 * (cp + 1) + (q4 >> 1)) * 16 * VSTR + (q4 & 1) * 64); }
            __builtin_amdgcn_sched_barrier(0);
#pragma unroll
            for (int q4 = 0; q4 < 4; ++q4) o[2 * cp + (q4 >> 1)] = __builtin_amdgcn_mfma_f32_16x16x32_bf16(vf[cp & 1][q4], pb[q4 & 1], o[2 * cp + (q4 >> 1)], 0, 0, 0);
            __builtin_amdgcn_sched_barrier(0);
        }
        asm volatile("s_waitcnt vmcnt(0)" ::: "memory");
        __syncthreads();
    }
#undef ATT_DMA
    lsum += __shfl_xor(lsum, 16); lsum += __shfl_xor(lsum, 32);
    const float inv = 1.0f / lsum;
    bf16_t* op = (bf16_t*)(ws + OFF_MIXA) + (size_t)qrow * 1536 + head * 256 + 4 * g;
#pragma unroll
    for (int ct = 0; ct < 16; ++ct) { uint2 w; w.x = cvt_pk_bf16(o[ct][0] * inv, o[ct][1] * inv); w.y = cvt_pk_bf16(o[ct][2] * inv, o[ct][3] * inv); *(uint2*)(op + 16 * ct) = w; }
}
constexpr int HS = 72;
constexpr int H_BC = 0, H_QT = 2 * 16640, H_KT = H_QT + 2 * 64 * HS * 2, H_QH = H_KT + 2 * 64 * HS * 2, H_VT = H_QH + 2 * 64 * HS * 2, H_ST = H_VT + 2 * 64 * HS * 2, H_END = H_ST + 2 * 64 * HS * 2;
static_assert(H_END <= LDS_MAIN, "hgrn lds");
__device__ __forceinline__ int posof64(int t) { const int u = t & 31; const int p = u < 16 ? 8 * (u >> 2) + (u & 3) : 8 * ((u - 16) >> 2) + 4 + ((u - 16) & 3); return (t & 32) + p; }
__device__ void hgrn_out_tile(CArgs& a, int l, int T, unsigned char* ldsg) {
    unsigned char* ws = a.ws; int tid = threadIdx.x; asm volatile("" : "+v"(tid)); asm volatile("" : "+s"(l)); const int lane = tid & 63, wave = tid >> 6, lr = lane & 15, g = lane >> 4;
    LAS unsigned char* lds = (LAS unsigned char*)ldsg;
    const bf16_t* z = (const bf16_t*)(ws + OFF_Z); const int r0 = T * 64;
    const int c = tid & 127, hh = c >> 6, e = c & 63, tq = tid >> 7;
    LAS float* bc = (LAS float*)(lds + H_BC) + hh * 4160;
    LAS bf16_t* QT = (LAS bf16_t*)(lds + H_QT) + hh * 64 * HS; LAS bf16_t* KT = (LAS bf16_t*)(lds + H_KT) + hh * 64 * HS; LAS bf16_t* QH = (LAS bf16_t*)(lds + H_QH) + hh * 64 * HS; LAS bf16_t* VT = (LAS bf16_t*)(lds + H_VT) + hh * 64 * HS;
    const float lbv0 = lb_of(a, l, hh * 64 + e), lbv1 = lb_of(a, l, (2 + hh) * 64 + e);
    for (int hp = 0; hp < 2; ++hp) {
        const int h = 2 * hp + hh; const float lbv = hp ? lbv1 : lbv0;
        { const float* bcum = (const float*)(ws + OFF_BCUM) + (size_t)r0 * 256 + h * 64 + e; const float rr = bcum[31 * 256];
          float s0v[16];
#pragma unroll
          for (int i = 0; i < 16; ++i) { const int idx = tid + 512 * i, h2 = idx >> 12, ed = idx & 4095; const int hg = 2 * hp + h2;
              const float* S0 = T < 256 ? (const float*)(ws + OFF_SST) + (size_t)(T * 4 + hg) * 4096 : a.in[4] + (size_t)(l * 128 + (T - 256) * 4 + hg) * 4096;
              s0v[i] = S0[ed]; }
#pragma unroll 1
          for (int i0 = 0; i0 < 16; i0 += 8) {
          bf16_t zq[8], zf16[8], zv[8]; float bbv[8];
#pragma unroll
          for (int i = 0; i < 8; ++i) { const bf16_t* zr = z + (size_t)(r0 + tq * 16 + i0 + i) * ZW + h * 64 + e; zq[i] = zr[ZHQ]; zf16[i] = zr[ZHF]; zv[i] = zr[ZHI]; bbv[i] = bcum[(tq * 16 + i0 + i) * 256]; }
#pragma unroll
          for (int i = 0; i < 8; ++i) { const int t = tq * 16 + i0 + i; const float bb = bbv[i];
              const float q = bf2f(zq[i]), zf = bf2f(zf16[i]); const float k = (1.0f - lbv) * sigmoidf_(-zf);
              QH[t * HS + e] = f2bf(q * __expf(bb)); QT[t * HS + e] = f2bf(q * __expf(fminf(bb - rr, 80.f))); KT[t * HS + e] = f2bf(k * __expf(fminf(rr - bb, 80.f)));
              VT[e * HS + posof64(t)] = zv[i]; } }
#pragma unroll
          for (int i = 0; i < 16; ++i) { const int idx = tid + 512 * i, h2 = idx >> 12, ed = idx & 4095; ((LAS bf16_t*)(lds + H_ST))[h2 * 64 * HS + (ed & 63) * HS + (ed >> 6)] = f2bf(s0v[i]); } }
        __syncthreads();
        { const int wh = wave >> 2, tb = wave & 3; const int hw = 2 * hp + wh;
          const LAS unsigned char* qt = lds + H_QT + wh * 64 * HS * 2; const LAS unsigned char* kt = lds + H_KT + wh * 64 * HS * 2; const LAS unsigned char* qh = lds + H_QH + wh * 64 * HS * 2;
          const LAS unsigned char* vt = lds + H_VT + wh * 64 * HS * 2; const LAS unsigned char* st = lds + H_ST + wh * 64 * HS * 2;
          const int trow = 16 * tb + lr;
          float4 ogv[4]; uint2 gwv[4];
#pragma unroll
          for (int db = 0; db < 4; ++db) { const int d0 = hw * 64 + 16 * db + 4 * g; ogv[db] = *(const float4*)(a.in[17] + l * 256 + d0); gwv[db] = *(const uint2*)(z + (size_t)(r0 + trow) * ZW + ZHG + d0); }
          bf16x8 qtf[2], qhf[2];
#pragma unroll
          for (int ks = 0; ks < 2; ++ks) { qtf[ks] = *(const LAS bf16x8*)(qt + trow * (HS * 2) + (32 * ks + 8 * g) * 2); qhf[ks] = *(const LAS bf16x8*)(qh + trow * (HS * 2) + (32 * ks + 8 * g) * 2); }
          f32x4 aT[4];
#pragma unroll
          for (int sb = 0; sb < 4; ++sb) { aT[sb] = (f32x4){0.f, 0.f, 0.f, 0.f};
#pragma unroll
              for (int ks = 0; ks < 2; ++ks) { const bf16x8 kf = *(const LAS bf16x8*)(kt + (16 * sb + lr) * (HS * 2) + (32 * ks + 8 * g) * 2); aT[sb] = __builtin_amdgcn_mfma_f32_16x16x32_bf16(kf, qtf[ks], aT[sb], 0, 0, 0); }
#pragma unroll
              for (int i = 0; i < 4; ++i) aT[sb][i] = (16 * sb + 4 * g + i <= trow) ? aT[sb][i] : 0.f; }
          bf16x8 pb[2];
#pragma unroll
          for (int s2 = 0; s2 < 2; ++s2) { u32x4 w; w.x = cvt_pk_bf16(aT[2 * s2][0], aT[2 * s2][1]); w.y = cvt_pk_bf16(aT[2 * s2][2], aT[2 * s2][3]);
              w.z = cvt_pk_bf16(aT[2 * s2 + 1][0], aT[2 * s2 + 1][1]); w.w = cvt_pk_bf16(aT[2 * s2 + 1][2], aT[2 * s2 + 1][3]); pb[s2] = __builtin_bit_cast(bf16x8, w); }
          f32x4 o[4]; float ss = 0.f;
#pragma unroll
          for (int db = 0; db < 4; ++db) { o[db] = (f32x4){0.f, 0.f, 0.f, 0.f};
#pragma unroll
              for (int ks = 0; ks < 2; ++ks) { const bf16x8 sf = *(const LAS bf16x8*)(st + (16 * db + lr) * (HS * 2) + (32 * ks + 8 * g) * 2); o[db] = __builtin_amdgcn_mfma_f32_16x16x32_bf16(sf, qhf[ks], o[db], 0, 0, 0); }
#pragma unroll
              for (int s2 = 0; s2 < 2; ++s2) { const bf16x8 vf = *(const LAS bf16x8*)(vt + (16 * db + lr) * (HS * 2) + (32 * s2 + 8 * g) * 2); o[db] = __builtin_amdgcn_mfma_f32_16x16x32_bf16(vf, pb[s2], o[db], 0, 0, 0); }
              ss += o[db][0] * o[db][0] + o[db][1] * o[db][1] + o[db][2] * o[db][2] + o[db][3] * o[db][3]; }
          ss += __shfl_xor(ss, 16); ss += __shfl_xor(ss, 32);
          const float rs = rsqrtf(ss * (1.0f / 64.0f) + EPS);
#pragma unroll
          for (int db = 0; db < 4; ++db) { const int d0 = hw * 64 + 16 * db + 4 * g; const float4 og = ogv[db]; const uint2 gw = gwv[db];
              uint2 w; w.x = cvt_pk_bf16(o[db][0] * rs * og.x * siluf_(bflo(gw.x)), o[db][1] * rs * og.y * siluf_(bfhi(gw.x)));
              w.y = cvt_pk_bf16(o[db][2] * rs * og.z * siluf_(bflo(gw.y)), o[db][3] * rs * og.w * siluf_(bfhi(gw.y)));
              *(uint2*)((bf16_t*)(ws + OFF_MIXA) + (size_t)(r0 + trow) * 1536 + 1024 + d0) = w; } }
        __syncthreads();
    }
}
template <bool PRM> __device__ __forceinline__ void cmlp_item_t(CArgs& a, int l, int it, unsigned char* ldsg) {
    int tid = threadIdx.x; asm volatile("" : "+v"(tid)); asm volatile("" : "+s"(l)); const int lane = tid & 63, wave = tid >> 6, lr = lane & 15, lg = lane >> 4; const int ci = it >> 2, g = it & 3;
    constexpr int L = PRM ? 128 : 64, WS = L + 8;
    const int r0 = PRM ? ci * 128 : MP + (ci - 128) * 64;
    LAS unsigned char* lds = (LAS unsigned char*)ldsg; LAS bf16_t* Wb = (LAS bf16_t*)lds; LAS bf16_t* vT = (LAS bf16_t*)(lds + 128 * 136 * 2);
    const bf16_t* z = (const bf16_t*)(a.ws + OFF_Z); const float* wsrc = a.in[19] + (size_t)(l * 4 + g) * 128 * 128;
    const float vg = a.in[18][l * 256 + g * 64 + lane];
    bf16_t zc[L / 8];
#pragma unroll
    for (int i = 0; i < L / 8; ++i) zc[i] = z[(size_t)(r0 + wave + 8 * i) * ZW + ZCV + g * 64 + lane];
    { constexpr int NQ = L * L / 4 / 512, SH = PRM ? 5 : 4; float4 wv[NQ];
#pragma unroll
      for (int i = 0; i < NQ; ++i) { const int idx = tid + 512 * i, t = idx >> SH, s4 = idx & ((1 << SH) - 1); wv[i] = *(const float4*)(wsrc + t * 128 + 4 * s4); }
#pragma unroll
      for (int i = 0; i < NQ; ++i) { const int idx = tid + 512 * i, t = idx >> SH, s0 = 4 * (idx & ((1 << SH) - 1));
          u32x2 w; w.x = cvt_pk_bf16(s0 <= t ? wv[i].x : 0.f, s0 + 1 <= t ? wv[i].y : 0.f); w.y = cvt_pk_bf16(s0 + 2 <= t ? wv[i].z : 0.f, s0 + 3 <= t ? wv[i].w : 0.f);
          *(LAS u32x2*)(Wb + t * WS + s0) = w; } }
    {
#pragma unroll
      for (int i = 0; i < L / 8; ++i) { const int t = wave + 8 * i; const float x = geluf_(bf2f(zc[i])); const float ss = wave_sum(x * x);
          const float vv = x * rsqrtf(ss * (1.0f / 64.0f) + EPS) * vg; vT[lane * WS + t] = f2bf(vv);
          if (!PRM) a.out[O_CMV + ((size_t)(l * 32 + (ci - 128)) * 64 + t) * 256 + g * 64 + lane] = vv; } }
    __syncthreads();
    { constexpr int NT = PRM ? 4 : 2;
      const int tt = PRM ? wave : (wave & 3); const int t = 16 * tt + lr; const float bs = a.in[20][(size_t)(l * 4 + g) * 128 + t];
      uint2 cwv[NT];
#pragma unroll
      for (int n = 0; n < NT; ++n) { const int dt = PRM ? n : 2 * (wave >> 2) + n; cwv[n] = *(const uint2*)(z + (size_t)(r0 + t) * ZW + ZCU + g * 64 + 16 * dt + 4 * lg); }
#pragma unroll
      for (int n = 0; n < NT; ++n) { const int dt = PRM ? n : 2 * (wave >> 2) + n; f32x4 acc = (f32x4){0.f, 0.f, 0.f, 0.f};
#pragma unroll
          for (int ks = 0; ks < L / 32; ++ks) { if (32 * ks <= 16 * tt + 15) {
              const bf16x8 vf = *(const LAS bf16x8*)(vT + (16 * dt + lr) * WS + 32 * ks + 8 * lg); const bf16x8 wf = *(const LAS bf16x8*)(Wb + t * WS + 32 * ks + 8 * lg);
              acc = __builtin_amdgcn_mfma_f32_16x16x32_bf16(vf, wf, acc, 0, 0, 0); } }
          const int d0 = g * 64 + 16 * dt + 4 * lg; const uint2 cw = cwv[n];
          uint2 o; o.x = cvt_pk_bf16(geluf_(bflo(cw.x)) * (acc[0] + bs), geluf_(bfhi(cw.x)) * (acc[1] + bs)); o.y = cvt_pk_bf16(geluf_(bflo(cw.y)) * (acc[2] + bs), geluf_(bfhi(cw.y)) * (acc[3] + bs));
          *(uint2*)((bf16_t*)(a.ws + OFF_MIXA) + (size_t)(r0 + t) * 1536 + 1280 + d0) = o; } }
    __syncthreads();
}
__device__ void cmlp_item(CArgs& a, int l, int it, unsigned char* lds) { if ((it >> 2) < 128) cmlp_item_t<true>(a, l, it, lds); else cmlp_item_t<false>(a, l, it, lds); }
__device__ void phase_mix(CArgs& a, int l, unsigned char* lds, int rep) {
    unsigned* ctr = (unsigned*)(a.ws + OFF_CTL) + 16 * (l + 1) + 128 * rep; LAS unsigned* slot = (LAS unsigned*)(lds + LDS_MAIN + 16);
    for (;;) {
        __syncthreads();
        { int t0 = threadIdx.x; asm volatile("" : "+v"(t0)); if (t0 == 0) *slot = atomicAdd(ctr, 1u); }
        __syncthreads();
        const int it = (int)*slot;
        if (it >= 576 + NTILE + 640) break;
        if (it < 576) { attn_item(a, it, lds); if (PROBE_MIX & 1) { __syncthreads(); attn_item(a, it, lds); } }
        else if (it < 576 + NTILE) { hgrn_out_tile(a, l, it - 576, lds); if (PROBE_MIX & 2) { __syncthreads(); hgrn_out_tile(a, l, it - 576, lds); } }
        else { cmlp_item(a, l, it - 576 - NTILE, lds); if (PROBE_MIX & 4) { __syncthreads(); cmlp_item(a, l, it - 576 - NTILE, lds); } }
    }
}
__global__ void __launch_bounds__(512) mk_fwd(Args a_) {
    extern __shared__ __attribute__((aligned(16))) unsigned char lds[];
    if (threadIdx.x < 16) ((LAS unsigned*)(lds + LDS_MAIN))[threadIdx.x] = 0u;
    __syncthreads();
    XcdBarrier bar = xcd_barrier_post((unsigned*)(a_.ws + OFF_CTL) + 1024, (volatile LAS unsigned*)(lds + LDS_MAIN));
    const int ph_lo = a_.ph_lo, ph_hi = a_.ph_hi;
    for (int ph = ph_lo; ph < ph_hi; ++ph) {
        CArgs* ap = (CArgs*)__builtin_amdgcn_kernarg_segment_ptr(); asm volatile("" : "+s"(ap)); CArgs& a = *ap;
        unsigned char* ws = a.ws;
        if (ph == 0) { phase_init(a, lds); if ((PROBE_DUP >> 12) & 1) { __syncthreads(); phase_init(a, lds); } }
        else { const int l = (ph - 1) / 12, p = (ph - 1) % 12; const float* ng = a.in[5] + (size_t)l * 6 * 1024;
            bf16_t* H = (bf16_t*)(ws + OFF_H); bf16_t* ACT = (bf16_t*)(ws + OFF_ACT); bf16_t* D = (bf16_t*)(ws + OFF_D); bf16_t* D1 = (bf16_t*)(ws + ((p == 7 || p == 8) ? OFF_ACT : OFF_MIXA));   float* RS = (float*)(ws + OFF_X);
            const int reps = ((PROBE_DUP >> p) & 1) ? 2 : 1;
            for (int rep = 0; rep < reps; ++rep) {
            if (rep) __syncthreads();
            switch (p) {
            case 0: case 9: { const int f = p == 0 ? 0 : 1; EpiSwiGLU E{ACT}; run_gemm(lds, H, (const bf16_t*)(ws + OFF_WGU) + (size_t)(l * 2 + f) * 5632 * 1024, MT, 5632, 1024, E);
                if (p == 0 && !rep) phase_cache(a, l, lds); } break;
            case 1: case 10: { const int f = p == 1 ? 0 : 1; EpiBf E{D, 1024, D1}; run_gemm(lds, ACT, (const bf16_t*)(ws + OFF_WDN) + (size_t)(l * 2 + f) * 1024 * 2816, MT, 1024, 2816, E, 11); } break;
            case 2: ew_phase<false, false>(D, D1, 11, H, nullptr, nullptr, ng + 1024, 0.5f, ng + 2048, H, ng, RS); break;
            case 3: { EpiBf E{(bf16_t*)(ws + OFF_Z), ZW, nullptr}; run_gemm(lds, H, (const bf16_t*)(ws + OFF_WIN) + (size_t)l * 2304 * 1024, MT, 2304, 1024, E); } break;
            case 4: phase_prep(a, l, lds, rep); break;
            case 5: { phase_scan(a, l); EpiQ E{(bf16_t*)(ws + OFF_Q)}; run_gemm(lds, (const bf16_t*)(ws + OFF_QN), (const bf16_t*)(ws + OFF_WQ) + (size_t)l * 1280 * 384, MT, 1280, 384, E); } break;
            case 6: phase_mix(a, l, lds, rep); break;
            case 7: { EpiBf E{D, 1024, D1}; run_gemm(lds, (const bf16_t*)(ws + OFF_MIXA), (const bf16_t*)(ws + OFF_WMIX) + (size_t)l * 1024 * 1536, MT, 1024, 1536, E, 6); } break;
            case 8: ew_phase<false, false>(D, D1, 6, H, nullptr, nullptr, ng + 3 * 1024, 1.0f, ng + 4 * 1024, H, ng + 2048, RS); break;
            case 11: if (l == 0) ew_phase<false, false>(D, D1, 11, H, nullptr, nullptr, ng + 5 * 1024, 0.5f, ng + 6 * 1024, H, ng + 4 * 1024, RS); else ew_phase<false, true>(D, D1, 11, H, nullptr, a.out + O_Y, ng + 5 * 1024, 0.5f, nullptr, nullptr, ng + 4 * 1024, RS); break;
            }
            }
            tail_wtasks(a, ph, lds);
        }
        if (ph + 1 < ph_hi) {
            if (ph_lo < 0) { __threadfence(); cg::this_grid().sync(); }
            xcd_barrier(bar); }
    }
}

extern "C" void kernel_launch(void* const* d_in, const int* in_sizes, int n_in, void* d_out, int out_size, void* d_ws, size_t ws_size, hipStream_t stream) {
    static int grid = 0;
    if (grid == 0) {
        if (n_in != 21 || ws_size < WS_END) { fprintf(stderr, "kernel_launch: bad inputs n_in %d ws %zu need %zu\n", n_in, ws_size, (size_t)WS_END); grid = -1; return; }
        int dev = 0, cus = 0, per_cu = 0;
        hipGetDevice(&dev); hipDeviceGetAttribute(&cus, hipDeviceAttributeMultiprocessorCount, dev);
        if (hipFuncSetAttribute((const void*)mk_fwd, hipFuncAttributeMaxDynamicSharedMemorySize, LDS_BYTES) != hipSuccess) { fprintf(stderr, "hipFuncSetAttribute failed\n"); grid = -1; return; }
        if (hipOccupancyMaxActiveBlocksPerMultiprocessor(&per_cu, (const void*)mk_fwd, 512, LDS_BYTES) != hipSuccess || per_cu < 1) per_cu = 1;
        (void)hipGetLastError();
        grid = cus * 1;
    }
    if (grid < 0) return;
    if (hipMemsetAsync((char*)d_ws + OFF_CTL, 0, SZ_CTL, stream) != hipSuccess) { fprintf(stderr, "memset failed\n"); return; }
    Args a{};
    for (int i = 0; i < 21; ++i) a.in[i] = (const float*)d_in[i];
    a.out = (float*)d_out; a.ws = (unsigned char*)d_ws;
#if ONE_LAUNCH
    a.ph_lo = 0; a.ph_hi = NPHASE;
    void* args[] = {&a};
    hipError_t e = hipLaunchCooperativeKernel((const void*)mk_fwd, dim3(grid), dim3(512), args, LDS_BYTES, stream);
    if (e != hipSuccess) fprintf(stderr, "cooperative launch failed: %s (grid %d)\n", hipGetErrorString(e), grid);
#else
    for (int ph = 0; ph < NPHASE; ++ph) { a.ph_lo = ph; a.ph_hi = ph + 1; hipLaunchKernelGGL(mk_fwd, dim3(grid), dim3(512), LDS_BYTES, stream, a); }
#endif
}
```

```cpp
#include <hip/hip_runtime.h>
#include <hip/hip_cooperative_groups.h>
#include <cstdio>
namespace cg = cooperative_groups;
#ifndef ONE_LAUNCH
#define ONE_LAUNCH 1
#endif
#ifndef PROBE_DUP
#define PROBE_DUP 0
#endif
#ifndef PROBE_MIX
#define PROBE_MIX 0
#endif
namespace pg8 {
#define PG8_LAS __attribute__((address_space(3)))
typedef unsigned short bf16_t;
typedef short bf16x8 __attribute__((ext_vector_type(8)));
typedef float f32x4 __attribute__((ext_vector_type(4)));
typedef unsigned u32x4 __attribute__((ext_vector_type(4)));
constexpr int BM = 256, BK = 64, HALF = 128, HTB = HALF * BK * 2  , STAGE_BYTES = 8 * HTB, NXCD = 8, WGM = 8;

__host__ __device__ __forceinline__ int lds_byte(int r, int c) { const int st = (r >> 4) * 2 + (c >> 5), rr = r & 15, cc = c & 31, ob = rr * 64 + cc * 2; return st * 1024 + (ob ^ (((ob >> 9) & 1) << 5)); }
__host__ __device__ __forceinline__ void stage_rc(int b, int& R, int& C) { const int st = b / 1024, sb = b % 1024, swz = sb ^ (((sb >> 9) & 1) << 5); R = (st >> 1) * 16 + swz / 64; C = (st & 1) * 32 + (swz % 64) / 2; }
__host__ __device__ __forceinline__ int perm32(int rho) { const int n = rho >> 4, i = rho & 15; return 8 * (i >> 2) + 4 * n + (i & 3); }

struct Unit { int pm, pn, ks, nt, koff; };
struct Gemm { const bf16_t* A; const bf16_t* Bt; int M, N, K, ld; };

struct StaticOrder {
    int nM, nN, nwg, G, c, nN0, unt, ukb;
    __host__ __device__ void init(int M, int N, int G_, int c_, int nsplit = 1) { nM = M / BM; nN0 = N / BM; nN = nN0 * nsplit; nwg = nM * nN; G = G_; c = c_; }
    __host__ __device__ bool next(int i, Unit& u) const {
        const long L = (long)i * G + c; if (L >= nwg) return false;
        int wgid = (int)L; { const int q = nwg / NXCD, r = nwg % NXCD, xcd = wgid % NXCD, off = wgid / NXCD; wgid = (xcd < r ? xcd * (q + 1) : r * (q + 1) + (xcd - r) * q) + off; }
        const int nig = WGM * nN, gid = wgid / nig, fm = gid * WGM, gsz = (nM - fm) < WGM ? (nM - fm) : WGM;
        u.pm = fm + ((wgid % nig) % gsz); const int pn = (wgid % nig) / gsz; u.ks = pn / nN0; u.pn = pn - u.ks * nN0; u.nt = unt; u.koff = u.ks * ukb; return true;
    }
    __device__ __forceinline__ void a_ready(const Unit&) const {}
    __device__ __forceinline__ void done(const Unit&) const {}
};
__device__ __forceinline__ unsigned cvt_pk_bf16(float lo, float hi) { unsigned r; asm volatile("v_cvt_pk_bf16_f32 %0, %1, %2" : "=v"(r) : "v"(lo), "v"(hi)); return r; }
typedef float f32x2 __attribute__((ext_vector_type(2)));
template <class Epi, class Sched, bool STAMP = false>
__device__ __forceinline__ void gemm_phase(PG8_LAS unsigned char* lds, const Gemm g, const Sched& S, const Epi& E, unsigned long long* stamps) {
    int tid = threadIdx.x; asm volatile("" : "+v"(tid)); const int wid = __builtin_amdgcn_readfirstlane(tid >> 6), lane = tid & 63, wr = wid >> 2, wc = wid & 3, fr = lane & 15, fq = lane >> 4;
    const int K = g.ld;
    int ts_lo = 0, ts_hi = 0, nts = 0; const unsigned long long rt_entry = STAMP ? (unsigned long long)wall_clock64() : 0ull;
#define PG8_STAMP() do { if (STAMP && wid == 0 && nts < 64) { const unsigned long long _c = (unsigned long long)clock64(); \
        ts_lo = (lane == nts) ? (int)(unsigned)_c : ts_lo; ts_hi = (lane == nts) ? (int)(unsigned)(_c >> 32) : ts_hi; ++nts; } } while (0)
    PG8_STAMP();
    unsigned voffA[2], voffB[2];
#pragma unroll
    for (int i = 0; i < 2; ++i) { int R, C; stage_rc(tid * 16 + i * 8192, R, C); const int Rb = Epi::PERM ? ((R & ~31) + perm32(R & 31)) : R;
        voffA[i] = (unsigned)(R * K + C) * 2u; voffB[i] = (unsigned)(Rb * K + C) * 2u; }
    const size_t kstep = (size_t)(BK * 2);
    const size_t hstep = (size_t)HALF * K * 2;
    const size_t tstep = 2 * hstep;
    const unsigned ldsw = (unsigned)wid * 1024u;
    const int aoff = lds_byte(wr * 64 + fr, fq * 8), boff = lds_byte(wc * 32 + fr, fq * 8);
#define PG8_SA(b, h) (((b) * 2 + (h)) * HTB)
#define PG8_SB(b, h) ((4 + (b) * 2 + (h)) * HTB)
#define PG8_STAGE(bufoff, gbase, voff) do { _Pragma("unroll") for (int _i = 0; _i < 2; ++_i) \
        __builtin_amdgcn_global_load_lds((const unsigned*)((const char*)(gbase) + (voff)[_i]), (PG8_LAS unsigned*)(lds + (bufoff) + ldsw + _i * 8192), 16, 0, 0); } while (0)
#define PG8_LDA(dst, b, h) do { _Pragma("unroll") for (int m = 0; m < 4; ++m) _Pragma("unroll") for (int k = 0; k < 2; ++k) dst[m][k] = *(const PG8_LAS bf16x8*)(lds + PG8_SA(b, h) + aoff + m * 2048 + k * 1024); } while (0)
#define PG8_LDB(dst, b, h) do { _Pragma("unroll") for (int n = 0; n < 2; ++n) _Pragma("unroll") for (int k = 0; k < 2; ++k) dst[n][k] = *(const PG8_LAS bf16x8*)(lds + PG8_SB(b, h) + boff + n * 2048 + k * 1024); } while (0)
#define PG8_MMA(ai, bj, At, Bt) do { __builtin_amdgcn_s_setprio(1); _Pragma("unroll") for (int m = 0; m < 4; ++m) _Pragma("unroll") for (int n = 0; n < 2; ++n) _Pragma("unroll") for (int k = 0; k < 2; ++k) \
        acc[ai][bj][m][n] = __builtin_amdgcn_mfma_f32_16x16x32_bf16(Bt[n][k], At[m][k], acc[ai][bj][m][n], 0, 0, 0); __builtin_amdgcn_s_setprio(0); } while (0)
#define PG8_WAIT_V(n) asm volatile("s_waitcnt vmcnt(" #n ")" ::: "memory")
#define PG8_WAIT_L(n) asm volatile("s_waitcnt lgkmcnt(" #n ")" ::: "memory")
#define PG8_BAR __builtin_amdgcn_s_barrier()
#define PG8_SCHED __builtin_amdgcn_sched_barrier(0)
    Unit cur, nxt; int ui = 0;
    if (!S.next(0, cur)) return;
    f32x4 acc[2][2][4][2];
#pragma unroll
    for (int a = 0; a < 2; ++a)
#pragma unroll
        for (int b = 0; b < 2; ++b)
#pragma unroll
            for (int m = 0; m < 4; ++m)
#pragma unroll
                for (int n = 0; n < 2; ++n) acc[a][b][m][n] = (f32x4){0.f, 0.f, 0.f, 0.f};
    bf16x8 At[4][2], B0[2][2], B1[2][2];
    const char* cA = (const char*)g.A + (size_t)cur.pm * tstep + (size_t)cur.koff; const char* cB = (const char*)g.Bt + (size_t)cur.pn * tstep + (size_t)cur.koff;
    S.a_ready(cur);
    PG8_STAGE(PG8_SB(0, 0), cB, voffB); PG8_STAGE(PG8_SA(0, 0), cA, voffA); PG8_STAGE(PG8_SB(0, 1), cB + hstep, voffB); PG8_STAGE(PG8_SA(0, 1), cA + hstep, voffA);
    if (wr == 1) PG8_BAR;
    PG8_WAIT_V(4); PG8_BAR;
    PG8_STAGE(PG8_SB(1, 0), cB + kstep, voffB); PG8_STAGE(PG8_SA(1, 0), cA + kstep, voffA); PG8_STAGE(PG8_SB(1, 1), cB + hstep + kstep, voffB);
    PG8_WAIT_V(6); PG8_BAR;
    PG8_STAMP();
    for (;;) {
        const bool has_next = S.next(ui + 1, nxt);
        const char* nA = has_next ? (const char*)g.A + (size_t)nxt.pm * tstep + (size_t)nxt.koff : cA; const char* nB = has_next ? (const char*)g.Bt + (size_t)nxt.pn * tstep + (size_t)nxt.koff : cB;
        const int nt = cur.nt;
        for (int t = 0; t < nt; t += 2) {
            const bool last = (t == nt - 2);
            const char* a1 = cA + (size_t)(t + 1) * kstep;
            const char* a2 = last ? nA : cA + (size_t)(t + 2) * kstep; const char* b2 = last ? nB : cB + (size_t)(t + 2) * kstep;
            const char* a3 = a2 + kstep; const char* b3 = b2 + kstep;
            if (last && has_next) S.a_ready(nxt);
            PG8_LDB(B0, 0, 0); PG8_SCHED; PG8_LDA(At, 0, 0); PG8_STAGE(PG8_SA(1, 1), a1 + hstep, voffA);
            PG8_WAIT_L(8); PG8_BAR; PG8_WAIT_L(0); PG8_MMA(0, 0, At, B0); PG8_BAR; PG8_SCHED;
            PG8_LDB(B1, 0, 1); PG8_STAGE(PG8_SB(0, 0), b2, voffB);
            PG8_BAR; PG8_WAIT_L(0); PG8_MMA(0, 1, At, B1); PG8_BAR;
            PG8_LDA(At, 0, 1); PG8_STAGE(PG8_SA(0, 0), a2, voffA);
            PG8_BAR; PG8_WAIT_L(0); PG8_MMA(1, 0, At, B0); PG8_BAR; PG8_SCHED;
            PG8_STAGE(PG8_SB(0, 1), b2 + hstep, voffB);
            PG8_WAIT_V(6); PG8_BAR; PG8_MMA(1, 1, At, B1); PG8_BAR;
            PG8_LDB(B0, 1, 0); PG8_SCHED; PG8_LDA(At, 1, 0); PG8_STAGE(PG8_SA(0, 1), a2 + hstep, voffA);
            PG8_WAIT_L(8); PG8_BAR; PG8_WAIT_L(0); PG8_MMA(0, 0, At, B0); PG8_BAR; PG8_SCHED;
            PG8_LDB(B1, 1, 1); PG8_STAGE(PG8_SB(1, 0), b3, voffB);
            PG8_BAR; PG8_WAIT_L(0); PG8_MMA(0, 1, At, B1); PG8_BAR;
            PG8_LDA(At, 1, 1); PG8_STAGE(PG8_SA(1, 0), a3, voffA);
            PG8_BAR; PG8_WAIT_L(0); PG8_MMA(1, 0, At, B0); PG8_BAR; PG8_SCHED;
            PG8_STAGE(PG8_SB(1, 1), b3 + hstep, voffB);
            PG8_WAIT_V(6); PG8_BAR; PG8_MMA(1, 1, At, B1); PG8_BAR;
        }
        PG8_STAMP();
        if constexpr (!Epi::AFTER_DRAIN) { E(acc, cur, wr, wc, fr, fq); S.done(cur); }
        PG8_STAMP();
        if (!has_next) break;
#pragma unroll
        for (int a = 0; a < 2; ++a)
#pragma unroll
            for (int b = 0; b < 2; ++b)
#pragma unroll
                for (int m = 0; m < 4; ++m)
#pragma unroll
                    for (int n = 0; n < 2; ++n) acc[a][b][m][n] = (f32x4){0.f, 0.f, 0.f, 0.f};
        cur = nxt; cA = nA; cB = nB; ++ui;
    }
    PG8_WAIT_V(0);
    if (wr == 0) PG8_BAR;
    PG8_BAR;
    if constexpr (Epi::AFTER_DRAIN) { E.fused(acc, cur, wr, wc, fr, fq, lds, wid, lane); S.done(cur); }
    PG8_STAMP();
    if (STAMP && wid == 0) { stamps[lane] = lane < nts ? (((unsigned long long)(unsigned)ts_hi << 32) | (unsigned)ts_lo) : 0ull;
        if (lane == 62) stamps[62] = rt_entry; if (lane == 63) stamps[63] = (unsigned long long)wall_clock64(); }
#undef PG8_STAMP
#undef PG8_SA
#undef PG8_SB
#undef PG8_STAGE
#undef PG8_LDA
#undef PG8_LDB
#undef PG8_MMA
#undef PG8_WAIT_V
#undef PG8_WAIT_L
#undef PG8_BAR
#undef PG8_SCHED
}
}
using pg8::bf16_t; using pg8::bf16x8; using pg8::f32x4; using pg8::u32x4; using pg8::Unit; using pg8::cvt_pk_bf16;
#define LAS __attribute__((address_space(3)))
typedef unsigned u32x2 __attribute__((ext_vector_type(2)));

constexpr int DM = 1024, DFF = 2816, MP = 16384, MS = 2048, MT = 18432, INWP = 2304, ZW = 2304;
constexpr int NTILE = 288;
constexpr float EPS = 1e-6f;
constexpr float QSCALE = 0.07216878364870322f * 1.4426950408889634f;
constexpr int ZQ = 0, ZKV = 384, ZPE = 640, ZHQ = 704, ZHF = 960, ZHI = 1216, ZHG = 1472, ZCU = 1728, ZCV = 1984;
constexpr size_t SZ_WGU = 4ull * 5632 * 1024 * 2, SZ_WDN = 4ull * 1024 * 2816 * 2, SZ_WIN = 2ull * 2304 * 1024 * 2, SZ_WQ = 2ull * 1280 * 384 * 2, SZ_WMIX = 2ull * 1024 * 1536 * 2;
constexpr size_t SKEW = 69888;
constexpr size_t OFF_WGU = 0, OFF_WDN = OFF_WGU + SZ_WGU + SKEW, OFF_WIN = OFF_WDN + SZ_WDN + SKEW, OFF_WQ = OFF_WIN + SZ_WIN + SKEW, OFF_WMIX = OFF_WQ + SZ_WQ + SKEW;
constexpr size_t OFF_X = OFF_WMIX + SZ_WMIX + SKEW, SZ_X = (size_t)MT * 1024 * 4;
constexpr size_t OFF_D = OFF_X + SZ_X + SKEW, SZ_D = (size_t)MT * 1024 * 2;
constexpr size_t OFF_H = OFF_D + SZ_D + SKEW, SZ_H = (size_t)MT * 1024 * 2;
constexpr size_t OFF_ACT = OFF_H + SZ_H + SKEW, SZ_ACT = (size_t)MT * 2816 * 2;
constexpr size_t KROWS = 16384 + 32 * 2112;
constexpr size_t OFF_KC = OFF_ACT + SZ_ACT + SKEW, SZ_KC = KROWS * 640;
constexpr size_t OFF_CT = OFF_KC + SZ_KC + SKEW, SZ_CT = KROWS * 512;
constexpr size_t OFF_MIXA = OFF_CT + SZ_CT + SKEW, SZ_MIXA = (size_t)MT * 1536 * 2;
constexpr size_t OFF_SST = OFF_MIXA + SZ_MIXA + SKEW, SZ_SST = 1024ull * 4096 * 4;
constexpr size_t OFF_ROPE = OFF_SST + SZ_SST + SKEW, SZ_ROPE = 4096ull * 32 * 8;
constexpr size_t OFF_CTL = OFF_ROPE + SZ_ROPE + SKEW, SZ_CTL = 32768;
constexpr size_t OFF_BCUM = OFF_CTL + SZ_CTL + SKEW, SZ_BCUM = (size_t)MT * 256 * 4;
constexpr size_t WS_END = OFF_BCUM + SZ_BCUM;
constexpr size_t OFF_Z = OFF_ACT, SZ_Z = (size_t)MT * ZW * 2;
constexpr size_t OFF_QN = OFF_Z + SZ_Z + SKEW;
constexpr size_t OFF_Q = OFF_X + 1048576 + SKEW;
constexpr size_t OFF_U = OFF_Q + (size_t)MT * 1280 * 2 + SKEW;
constexpr size_t OFF_DEC = OFF_U + 1152ull * 4096 * 4;
static_assert(OFF_QN + (size_t)MT * 384 * 2 <= OFF_ACT + SZ_ACT, "z/qn overlay");
static_assert(OFF_DEC + 1152ull * 64 * 4 <= OFF_X + SZ_X, "Q/U overlay");
constexpr size_t O_Y = 0, O_CKVP = 18874368, O_KPEP = 27262976, O_HGP = 29360128, O_CKVS = 29491200, O_KPES = 30539776, O_HGS = 30801920, O_CMV = 31850496;

constexpr int LDS_MAIN = 157696, LDS_BYTES = LDS_MAIN + 64;
constexpr int NPHASE = 25;

struct Args { const float* in[21]; float* out; unsigned char* ws; int ph_lo, ph_hi; };
typedef const __attribute__((address_space(4))) Args CArgs;

__device__ __forceinline__ int bid_() { int b = blockIdx.x; asm volatile("" : "+s"(b)); return b; }
__device__ __forceinline__ int gdim_() { int g = gridDim.x; asm volatile("" : "+s"(g)); return g; }
__device__ __forceinline__ float bf2f(unsigned short b) { return __uint_as_float(((unsigned)b) << 16); }
__device__ __forceinline__ float bflo(unsigned w) { return __uint_as_float(w << 16); }
__device__ __forceinline__ float bfhi(unsigned w) { return __uint_as_float(w & 0xffff0000u); }
__device__ __forceinline__ unsigned short f2bf(float f) { unsigned u = __float_as_uint(f); u += 0x7FFFu + ((u >> 16) & 1u); return (unsigned short)(u >> 16); }
__device__ __forceinline__ float wave_sum(float v) {
#pragma unroll
    for (int o = 32; o >= 1; o >>= 1) v += __shfl_xor(v, o);
    return v; }
__device__ __forceinline__ float sigmoidf_(float x) { return __builtin_amdgcn_rcpf(1.0f + __expf(-x)); }
__device__ __forceinline__ float siluf_(float x) { return x * sigmoidf_(x); }
__device__ __forceinline__ float geluf_(float x) { const float y = 0.7978845608028654f * (x + 0.044715f * x * x * x); return x - x * __builtin_amdgcn_rcpf(__expf(2.0f * y) + 1.0f); }

struct EpiBf {
    static constexpr bool PERM = true, AFTER_DRAIN = false;
    bf16_t* O; int ldc; bf16_t* O1;
    __device__ __forceinline__ void operator()(const f32x4 (&acc)[2][2][4][2], const Unit& u, int wr, int wc, int fr, int fq) const {
        const int row0 = u.pm * 256 + wr * 64 + fr, col0 = u.pn * 256 + wc * 32 + 8 * fq; bf16_t* Ob = (O1 && u.ks >= 0) ? O1 + ((long)u.ks * MS - MP) * (long)ldc : O;
#pragma unroll
        for (int ai = 0; ai < 2; ++ai)
#pragma unroll
            for (int m = 0; m < 4; ++m) { bf16_t* rowp = Ob + (size_t)(row0 + ai * 128 + m * 16) * ldc + col0;
#pragma unroll
                for (int bj = 0; bj < 2; ++bj) { const f32x4 v0 = acc[ai][bj][m][0], v1 = acc[ai][bj][m][1];
                    u32x4 w; w.x = cvt_pk_bf16(v0[0], v0[1]); w.y = cvt_pk_bf16(v0[2], v0[3]); w.z = cvt_pk_bf16(v1[0], v1[1]); w.w = cvt_pk_bf16(v1[2], v1[3]);
                    *(u32x4*)(rowp + bj * 128) = w; } }
    }
};
struct EpiSwiGLU {
    static constexpr bool PERM = true, AFTER_DRAIN = false;
    bf16_t* O;
    __device__ __forceinline__ void operator()(const f32x4 (&acc)[2][2][4][2], const Unit& u, int wr, int wc, int fr, int fq) const {
        const int row0 = u.pm * 256 + wr * 64 + fr, col0 = u.pn * 128 + wc * 32 + 8 * fq;
#pragma unroll
        for (int ai = 0; ai < 2; ++ai)
#pragma unroll
            for (int m = 0; m < 4; ++m) { bf16_t* rowp = O + (size_t)(row0 + ai * 128 + m * 16) * DFF + col0;
                const f32x4 g0 = acc[ai][0][m][0], g1 = acc[ai][0][m][1], u0 = acc[ai][1][m][0], u1 = acc[ai][1][m][1];
                u32x4 w; w.x = cvt_pk_bf16(siluf_(g0[0]) * u0[0], siluf_(g0[1]) * u0[1]); w.y = cvt_pk_bf16(siluf_(g0[2]) * u0[2], siluf_(g0[3]) * u0[3]);
                w.z = cvt_pk_bf16(siluf_(g1[0]) * u1[0], siluf_(g1[1]) * u1[1]); w.w = cvt_pk_bf16(siluf_(g1[2]) * u1[2], siluf_(g1[3]) * u1[3]);
                *(u32x4*)rowp = w; }
    }
};
struct EpiQ {
    static constexpr bool PERM = true, AFTER_DRAIN = false;
    bf16_t* Q;
    __device__ __forceinline__ void operator()(const f32x4 (&acc)[2][2][4][2], const Unit& u, int wr, int wc, int fr, int fq) const {
        const int row0 = u.pm * 256 + wr * 64 + fr;
        const int off0 = u.pn < 4 ? u.pn * 320 + wc * 32 + 8 * fq : wc * 320 + 256 + 8 * fq, bjs = u.pn < 4 ? 128 : 32;
#pragma unroll
        for (int ai = 0; ai < 2; ++ai)
#pragma unroll
            for (int m = 0; m < 4; ++m) { bf16_t* rowp = Q + (size_t)(row0 + ai * 128 + m * 16) * 1280 + off0;
#pragma unroll
                for (int bj = 0; bj < 2; ++bj) { const f32x4 v0 = acc[ai][bj][m][0], v1 = acc[ai][bj][m][1];
                    u32x4 w; w.x = cvt_pk_bf16(v0[0], v0[1]); w.y = cvt_pk_bf16(v0[2], v0[3]); w.z = cvt_pk_bf16(v1[0], v1[1]); w.w = cvt_pk_bf16(v1[2], v1[3]);
                    *(u32x4*)(rowp + bj * bjs) = w; } }
    }
};
struct TailSplitOrder {
    int G, c, nsp, nt_full, nt_sub, kb_sub;
    __device__ bool next(int i, Unit& u) const {
        const int L = i * G + c;
        if (L < 256) { const int off = L >> 3; u.pm = (L & 7) * 8 + (off >> 2); u.pn = off & 3; u.ks = -1; u.nt = nt_full; u.koff = 0; return true; }
        const int s2 = L - 256; if (s2 >= 32 * nsp) return false;
        const int pair = s2 & 31; u.pm = 64 + (pair >> 2); u.pn = pair & 3; u.ks = s2 >> 5; u.nt = nt_sub; u.koff = u.ks * kb_sub; return true;
    }
    __device__ __forceinline__ void a_ready(const Unit&) const {}
    __device__ __forceinline__ void done(const Unit&) const {}
};
template <class Epi> __device__ __forceinline__ void run_gemm(unsigned char* lds, const bf16_t* A, const bf16_t* Bt, int M, int N, int K, const Epi& E, int nsp = 0  ) {
    pg8::Gemm g{A, Bt, M, N, K, K};
    if (nsp) { TailSplitOrder S; S.G = gdim_(); S.c = bid_(); S.nsp = nsp; S.nt_full = K / 64; S.nt_sub = K / nsp / 64; S.kb_sub = K / nsp * 2; pg8::gemm_phase<Epi, TailSplitOrder, false>((PG8_LAS unsigned char*)lds, g, S, E, nullptr); }
    else { pg8::StaticOrder S; S.init(M, N, gdim_(), bid_(), 1); S.unt = K / 64; S.ukb = K * 2; pg8::gemm_phase<Epi, pg8::StaticOrder, false>((PG8_LAS unsigned char*)lds, g, S, E, nullptr); }
}
#define GAS __attribute__((address_space(1)))
#define XB_TMO      128
#define XB_XCNT(j)  (256  + 64 * (j))
#define XB_XSUB(j)  (1280 + 64 * (j))
#define XB_XGEN(j)  (2304 + 64 * (j))
#define XB_TOP      3328
#define XB_TOPGEN   3392
#define XCD_BAR_WORDS 3456
#define XB_SPIN_CAP (1u << 18)

__device__ __forceinline__ unsigned xb_ld(unsigned* p)              { return __hip_atomic_load(p, __ATOMIC_RELAXED, __HIP_MEMORY_SCOPE_AGENT); }
__device__ __forceinline__ unsigned xb_add(unsigned* p, unsigned v) { return __hip_atomic_fetch_add(p, v, __ATOMIC_RELAXED, __HIP_MEMORY_SCOPE_AGENT); }
__device__ __forceinline__ unsigned xb_xcc_id() { return (unsigned)__builtin_amdgcn_s_getreg((3 << 11) | 20) & 0xFu; }
#define XB_SPIN(cond, bar) do { unsigned _sp = 0; while (cond) { __builtin_amdgcn_s_sleep(1); \
    if ((++_sp & 255u) == 0u) { if (xb_ld(&(bar)[XB_TMO])) break; if (_sp > XB_SPIN_CAP) { atomicAdd(&(bar)[XB_TMO], 1u); break; } } } } while (0)

struct XcdBarrier {
    unsigned* bar; unsigned x;
    volatile LAS unsigned* st;
};

__device__ __forceinline__ XcdBarrier xcd_barrier_post(unsigned* bar, volatile LAS unsigned* st) {
    XcdBarrier b; b.bar = bar; b.x = xb_xcc_id(); b.st = st;
    if (threadIdx.x == 0) (void)xb_add(&bar[XB_XCNT(b.x)], 1u);
    return b;
}
__device__ __forceinline__ void xcd_barrier_complete(unsigned* bar, unsigned x, unsigned& nloc, unsigned& nx) {
    const unsigned G = gridDim.x * gridDim.y * gridDim.z;
    unsigned sum, cnt, mine, sp = 0u;
    for (;;) {
        sum = 0u; cnt = 0u; mine = 0u;
#pragma unroll
        for (unsigned j = 0; j < 16; ++j) { const unsigned c = xb_ld(&bar[XB_XCNT(j)]); sum += c; cnt += (c > 0u) ? 1u : 0u; mine = (j == x) ? c : mine; }
        if (sum == G) break;
        __builtin_amdgcn_s_sleep(1);
        if ((++sp & 255u) == 0u) { if (xb_ld(&bar[XB_TMO])) break; if (sp > XB_SPIN_CAP) { atomicAdd(&bar[XB_TMO], 1u); break; } }
    }
    nloc = mine > 0u ? mine : 1u; nx = cnt > 0u ? cnt : 1u;
}

__device__ __forceinline__ void xcd_barrier(const XcdBarrier& b) {
    asm volatile("s_waitcnt vmcnt(0)" ::: "memory");
    __syncthreads();
    if (threadIdx.x == 0) {
        unsigned* bar = b.bar; asm volatile("" : "+s"(bar));
        __builtin_amdgcn_s_waitcnt(0);
        unsigned nloc = b.st[0], nx = b.st[1];
        if (nloc == 0u) { xcd_barrier_complete(bar, b.x, nloc, nx); b.st[0] = nloc; b.st[1] = nx; }
        const unsigned old = xb_add(&bar[XB_XSUB(b.x)], 1u);
        const unsigned gen = old / nloc;
        if (old + 1u == (gen + 1u) * nloc) {
            __builtin_amdgcn_fence(__ATOMIC_RELEASE, "agent");
            asm volatile("s_waitcnt vmcnt(0)" ::: "memory");
            const unsigned og = xb_add(&bar[XB_TOP], 1u);
            const unsigned tg = og / nx;
            if (og + 1u == (tg + 1u) * nx) xb_add(&bar[XB_TOPGEN], 1u);
            else XB_SPIN(xb_ld(&bar[XB_TOPGEN]) == tg, bar);
            __builtin_amdgcn_fence(__ATOMIC_ACQUIRE, "agent");
            xb_add(&bar[XB_XGEN(b.x)], 1u);
            asm volatile("s_waitcnt vmcnt(0)" ::: "memory");
        } else {
            XB_SPIN(xb_ld(&bar[XB_XGEN(b.x)]) == gen, bar);
            __builtin_amdgcn_fence(__ATOMIC_ACQUIRE, "agent");
            asm volatile("s_waitcnt vmcnt(0)" ::: "memory");
        }
    }
    __syncthreads();
}
__device__ __forceinline__ void tr_tile(const float* __restrict__ src, int srcN, bf16_t* __restrict__ dst, int dstK, int k0, int n0, int mode, float* T) {
    int tid = threadIdx.x; asm volatile("" : "+v"(tid));
    float4 v[4];
#pragma unroll
    for (int e = 0; e < 4; ++e) { const int idx = tid + 512 * e, kk = idx >> 4, n4 = idx & 15; { const f32x4 q4 = __builtin_nontemporal_load((const f32x4*)(src + (size_t)(k0 + kk) * srcN + n0 + 4 * n4)); v[e] = make_float4(q4[0], q4[1], q4[2], q4[3]); } }
#pragma unroll
    for (int e = 0; e < 4; ++e) { const int idx = tid + 512 * e, kk = idx >> 4, n4 = idx & 15; float* t = T + kk * 65 + 4 * n4; t[0] = v[e].x; t[1] = v[e].y; t[2] = v[e].z; t[3] = v[e].w; }
    __syncthreads();
#pragma unroll
    for (int e = 0; e < 2; ++e) { const int idx = tid + 512 * e, nn = idx >> 4, kq = idx & 15; const int n = n0 + nn;
        const int row = mode == 0 ? n : ((n >> 7) * 256 + (n & 127) + (mode == 2 ? 128 : 0)); const float* t = T + (8 * kq) * 65 + nn;
        u32x4 w; w.x = cvt_pk_bf16(t[0], t[65]); w.y = cvt_pk_bf16(t[130], t[195]); w.z = cvt_pk_bf16(t[260], t[325]); w.w = cvt_pk_bf16(t[390], t[455]);
        *(u32x4*)(dst + (size_t)row * dstK + k0 + 8 * kq) = w; }
    __syncthreads();
}
__device__ __forceinline__ void tr_task(const float* src, int srcN, int K, bf16_t* dst, int dstK, int mode, float* T) {
    const int tn = srcN >> 6, nt = (K >> 7) * tn;
    for (int t = bid_(); t < nt; t += gdim_()) tr_tile(src, srcN, dst, dstK, (t / tn) * 128, (t % tn) * 64, mode, T);
}
template <bool XIN_F32, bool XOUT_F32>
__device__ __forceinline__ void ew_phase(const bf16_t* __restrict__ D, const bf16_t* D1  , int nsp, const void* xa  , const float* __restrict__ xb  , void* xout  ,
                                         const float* __restrict__ gpost, float coef, const float* __restrict__ gpre, bf16_t* hout, const float* __restrict__ gin, float* rsb  ) {
    int tid = threadIdx.x; asm volatile("" : "+v"(tid)); const int lane = tid & 63, wave = tid >> 6;
    const int rstep = gdim_() * 8;
    for (int rb = bid_() * 8 + wave; rb < MT; rb += 2 * rstep) {
        float4 xv[2][4]; float dv[2][4][4];
#pragma unroll
        for (int u = 0; u < 2; ++u) { const int r = rb + u * rstep; if (r < MT) {
            if (XIN_F32) { const float* xr = (xb && r >= MP) ? xb + (size_t)(r - MP) * DM : (const float*)xa + (size_t)r * DM;
#pragma unroll
                for (int i = 0; i < 4; ++i) { const f32x4 q4 = __builtin_nontemporal_load((const f32x4*)(xr + lane * 4 + 256 * i)); xv[u][i] = make_float4(q4[0], q4[1], q4[2], q4[3]); } }
            else {
#pragma unroll
                for (int i = 0; i < 4; ++i) { const uint2 w = *(const uint2*)((const bf16_t*)xa + (size_t)r * DM + lane * 4 + 256 * i); xv[u][i] = make_float4(bflo(w.x), bfhi(w.x), bflo(w.y), bfhi(w.y)); }
                const float ir = __builtin_amdgcn_rcpf(rsb[r]);
#pragma unroll
                for (int i = 0; i < 4; ++i) { const float4 gi = *(const float4*)(gin + lane * 4 + 256 * i);
                    xv[u][i].x *= ir * __builtin_amdgcn_rcpf(gi.x); xv[u][i].y *= ir * __builtin_amdgcn_rcpf(gi.y); xv[u][i].z *= ir * __builtin_amdgcn_rcpf(gi.z); xv[u][i].w *= ir * __builtin_amdgcn_rcpf(gi.w); } }
            if (D) {
#pragma unroll
                for (int i = 0; i < 4; ++i) { const uint2 w = *(const uint2*)(D + (size_t)r * DM + lane * 4 + 256 * i); dv[u][i][0] = bflo(w.x); dv[u][i][1] = bfhi(w.x); dv[u][i][2] = bflo(w.y); dv[u][i][3] = bfhi(w.y);
                    } } } }
        if (D1) {
#pragma unroll
            for (int u = 0; u < 2; ++u) { const int r = rb + u * rstep; if (r >= MP && r < MT) {
#pragma unroll
                for (int i = 0; i < 4; ++i) { dv[u][i][0] = 0.f; dv[u][i][1] = 0.f; dv[u][i][2] = 0.f; dv[u][i][3] = 0.f; }
                for (int ks = 0; ks < nsp; ++ks) {
#pragma unroll
                    for (int i = 0; i < 4; ++i) { const uint2 w1 = *(const uint2*)(D1 + ((size_t)ks * MS + (r - MP)) * DM + lane * 4 + 256 * i); dv[u][i][0] += bflo(w1.x); dv[u][i][1] += bfhi(w1.x); dv[u][i][2] += bflo(w1.y); dv[u][i][3] += bfhi(w1.y); } } } } }
#pragma unroll
        for (int u = 0; u < 2; ++u) { const int r = rb + u * rstep; if (r < MT) {
            if (D) { float ss = 0.f;
#pragma unroll
                for (int i = 0; i < 4; ++i) ss += dv[u][i][0] * dv[u][i][0] + dv[u][i][1] * dv[u][i][1] + dv[u][i][2] * dv[u][i][2] + dv[u][i][3] * dv[u][i][3];
                ss = wave_sum(ss); const float rs = coef * rsqrtf(ss * (1.0f / 1024.0f) + EPS);
#pragma unroll
                for (int i = 0; i < 4; ++i) { const float4 g = *(const float4*)(gpost + lane * 4 + 256 * i);
                    xv[u][i].x += dv[u][i][0] * rs * g.x; xv[u][i].y += dv[u][i][1] * rs * g.y; xv[u][i].z += dv[u][i][2] * rs * g.z; xv[u][i].w += dv[u][i][3] * rs * g.w; } }
            if (XOUT_F32) {
#pragma unroll
                for (int i = 0; i < 4; ++i) __builtin_nontemporal_store((f32x4){xv[u][i].x, xv[u][i].y, xv[u][i].z, xv[u][i].w}, (f32x4*)((float*)xout + (size_t)r * DM + lane * 4 + 256 * i)); }

            if (hout) { float ss = 0.f;
#pragma unroll
                for (int i = 0; i < 4; ++i) ss += xv[u][i].x * xv[u][i].x + xv[u][i].y * xv[u][i].y + xv[u][i].z * xv[u][i].z + xv[u][i].w * xv[u][i].w;
                ss = wave_sum(ss); const float rs = rsqrtf(ss * (1.0f / 1024.0f) + EPS); if (lane == 0) rsb[r] = rs;
#pragma unroll
                for (int i = 0; i < 4; ++i) { const float4 g = *(const float4*)(gpre + lane * 4 + 256 * i); uint2 w;
                    w.x = cvt_pk_bf16(xv[u][i].x * rs * g.x, xv[u][i].y * rs * g.y); w.y = cvt_pk_bf16(xv[u][i].z * rs * g.z, xv[u][i].w * rs * g.w);
                    *(uint2*)(hout + (size_t)r * DM + lane * 4 + 256 * i) = w; } } } }
    }
}
__device__ __forceinline__ int wtask_count(int kind) { return kind < 6 ? 352 : kind == 6 ? 281 : kind == 7 ? 64 : kind == 8 ? 256 : kind == 9 ? 96 : 192; }
__device__ void wtask_run(CArgs& a, int l, int kind, int t, unsigned char* lds) {
    unsigned char* ws = a.ws; float* T = (float*)lds; int tid = threadIdx.x; asm volatile("" : "+v"(tid));
    if (kind < 6) { const int f = kind / 3, m = kind % 3; const size_t lf = (size_t)(l * 2 + f);
        if (m < 2) tr_tile(a.in[6 + m] + lf * 1024 * 2816, 2816, (bf16_t*)(ws + OFF_WGU) + lf * 5632 * 1024, 1024, (t / 44) * 128, (t % 44) * 64, 1 + m, T);
        else tr_tile(a.in[8] + lf * 2816 * 1024, 1024, (bf16_t*)(ws + OFF_WDN) + lf * 1024 * 2816, 2816, (t / 16) * 128, (t % 16) * 64, 0, T);
    } else if (kind == 6) { bf16_t* win = (bf16_t*)(ws + OFF_WIN) + (size_t)l * 2304 * 1024;
        if (t < 280) tr_tile(a.in[9] + (size_t)l * 1024 * 2240, 2240, win, 1024, (t / 35) * 128, (t % 35) * 64, 0, T);
        else { for (int i = tid; i < 64 * 1024 / 2; i += 512) ((unsigned*)(win + 2240 * 1024))[i] = 0u; }
    } else if (kind == 7) { bf16_t* wmix = (bf16_t*)(ws + OFF_WMIX) + (size_t)l * 1024 * 1536;
        tr_tile(a.in[10] + (size_t)l * 1024 * 1024 + 512 * 1024, 1024, wmix + 1024, 1536, (t / 16) * 128, (t % 16) * 64, 0, T);
    } else if (kind == 8) {
        bf16_t* wmix = (bf16_t*)(ws + OFF_WMIX) + (size_t)l * 1024 * 1536; const float* wuv = a.in[15] + (size_t)l * 256 * 512; const float* wo = a.in[10] + (size_t)l * 1024 * 1024;
        const int i = t * 512 + tid; const int n = i & 1023, hcb = t >> 1, h = hcb >> 5, cb = hcb & 31;
        float* W = T;
        __syncthreads();
#pragma unroll
        for (int e = 0; e < 2; ++e) { const int q = tid + 512 * e, j = q >> 7, v = q & 127; W[v * 8 + j] = wuv[((8 * cb + j) * 4 + h) * 128 + v]; }
        __syncthreads();
        const float* bv = wo + (size_t)(h * 128) * 1024 + n; float acc[8];
#pragma unroll
        for (int j = 0; j < 8; ++j) acc[j] = 0.f;
#pragma unroll 1
        for (int v0 = 0; v0 < 128; v0 += 16) { float bb[16];
#pragma unroll
            for (int u = 0; u < 16; ++u) bb[u] = bv[(size_t)(v0 + u) * 1024];
#pragma unroll
            for (int u = 0; u < 16; ++u) { const float4 w0 = *(const float4*)(W + (v0 + u) * 8), w1 = *(const float4*)(W + (v0 + u) * 8 + 4);
                acc[0] += w0.x * bb[u]; acc[1] += w0.y * bb[u]; acc[2] += w0.z * bb[u]; acc[3] += w0.w * bb[u]; acc[4] += w1.x * bb[u]; acc[5] += w1.y * bb[u]; acc[6] += w1.z * bb[u]; acc[7] += w1.w * bb[u]; } }
        u32x4 w; w.x = cvt_pk_bf16(acc[0], acc[1]); w.y = cvt_pk_bf16(acc[2], acc[3]); w.z = cvt_pk_bf16(acc[4], acc[5]); w.w = cvt_pk_bf16(acc[6], acc[7]);
        *(u32x4*)(wmix + (size_t)n * 1536 + h * 256 + 8 * cb) = w;
        __syncthreads();
    } else { bf16_t* wq = (bf16_t*)(ws + OFF_WQ) + (size_t)l * 1280 * 384; const float* wuk = a.in[14] + (size_t)l * 256 * 512; const float* wqb = a.in[12] + (size_t)l * 384 * 768;
        const int i = t * 512 + tid;
        if (kind == 9) {
            const int k = i % 384, hcb = i / 384, h = hcb >> 5, cb = hcb & 31;
            const float4* bv = (const float4*)(wqb + (size_t)k * 768 + h * 192); float acc[8];
#pragma unroll
            for (int j = 0; j < 8; ++j) acc[j] = 0.f;
#pragma unroll 2
            for (int v = 0; v < 32; ++v) { const float4 y = bv[v];
#pragma unroll
                for (int j = 0; j < 8; ++j) { const float4 x = *(const float4*)(wuk + ((8 * cb + j) * 4 + h) * 128 + 4 * v); acc[j] += x.x * y.x + x.y * y.y + x.z * y.z + x.w * y.w; } }
#pragma unroll
            for (int j = 0; j < 8; ++j) wq[(size_t)(h * 256 + 8 * cb + j) * 384 + k] = f2bf(acc[j] * QSCALE);
        } else {
            const int k = i % 384, j = i / 384, half = j >> 7, jj = j & 127, h = jj >> 5, fi = jj & 31;
            wq[(size_t)(1024 + j) * 384 + k] = f2bf(wqb[(size_t)k * 768 + h * 192 + 128 + half * 32 + fi] * QSCALE); }
    }
}
__device__ void wtasks(CArgs& a, int l, int k0, int k1, int cw, unsigned char* lds) {
    unsigned* ctr = (unsigned*)(a.ws + OFF_CTL) + cw; LAS unsigned* slot = (LAS unsigned*)(lds + LDS_MAIN + 16);
    int total = 0; for (int k = k0; k < k1; ++k) total += wtask_count(k);
    for (;;) {
        __syncthreads();
        { int t0 = threadIdx.x; asm volatile("" : "+v"(t0)); if (t0 == 0) *slot = atomicAdd(ctr, 1u); }
        __syncthreads();
        int it = (int)*slot;
        if (it >= total) break;
        int k = k0; while (it >= wtask_count(k)) { it -= wtask_count(k); ++k; }
        wtask_run(a, l, k, it, lds);
    }
}
__device__ void phase_init(CArgs& a, unsigned char* lds) {
    unsigned char* ws = a.ws;
    int tid = threadIdx.x; asm volatile("" : "+v"(tid)); const size_t gtid = (size_t)bid_() * 512 + tid, gsz = (size_t)gdim_() * 512;
    for (size_t i = gtid; i < 4096 * 32; i += gsz) { const int pos = (int)(i >> 5), fi = (int)(i & 31);
        const float w = exp2f(-(float)fi * (13.287712379549449f / 32.0f)); const double ang = (double)((float)pos * w);
        const double k = rint(ang * 0.15915494309189535); const float rr = (float)(ang - k * 6.283185307179586);
        ((float2*)(ws + OFF_ROPE))[i] = make_float2(__cosf(rr), __sinf(rr)); }
    wtasks(a, 0, 0, 3, 256, lds); wtasks(a, 0, 6, 7, 272, lds);
    ew_phase<true, false>(nullptr, nullptr, 0, a.in[0], a.in[1], nullptr, nullptr, 0.f, a.in[5], (bf16_t*)(ws + OFF_H), nullptr, (float*)(ws + OFF_X));
}
__device__ void tail_wtasks(CArgs& a, int ph, unsigned char* lds) {
    switch (ph) {
    case 1:  wtasks(a, 0, 10, 11, 257, lds); wtasks(a, 0, 7, 8, 258, lds); break;
    case 2:  wtasks(a, 0, 3, 4, 259, lds); break;
    case 4:  wtasks(a, 0, 9, 10, 260, lds); wtasks(a, 0, 4, 5, 261, lds); break;
    case 6:  wtasks(a, 0, 8, 9, 262, lds); break;
    case 8:  wtasks(a, 0, 5, 6, 263, lds); break;
    case 10: wtasks(a, 1, 0, 3, 264, lds); wtasks(a, 1, 6, 7, 265, lds); wtasks(a, 1, 9, 10, 266, lds); break;
    case 11: wtasks(a, 1, 10, 11, 267, lds); wtasks(a, 1, 7, 8, 268, lds); break;
    case 14: wtasks(a, 1, 3, 4, 269, lds); break;
    case 16: wtasks(a, 1, 4, 6, 270, lds); break;
    case 18: wtasks(a, 1, 8, 9, 271, lds); break;
    default: break; }
}
__device__ __forceinline__ int keyof32(int p) { const int g = p >> 3, j = p & 7; return j < 4 ? 4 * g + j : 16 + 4 * g + (j - 4); }
__device__ __forceinline__ void ct_write(const bf16_t* ctile, bf16_t* dst  , size_t rowstride) {
    int tid = threadIdx.x; asm volatile("" : "+v"(tid)); const int c = tid >> 1, half = tid & 1;
    unsigned w[16];
#pragma unroll
    for (int p = 0; p < 32; p += 2) { const int t0 = 32 * half + keyof32(p), t1 = 32 * half + keyof32(p + 1);
        w[p >> 1] = (unsigned)ctile[t0 * 264 + c] | ((unsigned)ctile[t1 * 264 + c] << 16); }
    uint4* d = (uint4*)(dst + (size_t)c * rowstride + 32 * half);
#pragma unroll
    for (int i = 0; i < 4; ++i) d[i] = make_uint4(w[4 * i], w[4 * i + 1], w[4 * i + 2], w[4 * i + 3]);
}
__device__ __forceinline__ float lb_of(CArgs& a, int l, int e) { if (l == 0) return 0.f; const float a0 = a.in[16][e], a1 = a.in[16][256 + e]; return 1.0f / (1.0f + __expf(a0 - a1)); }
__device__ void prep_mla_tile(CArgs& a, int l, int T, unsigned char* lds) {
    unsigned char* ws = a.ws; int tid = threadIdx.x; asm volatile("" : "+v"(tid)); const int lane = tid & 63, wave = tid >> 6;
    const bf16_t* z = (const bf16_t*)(ws + OFF_Z); const int r0 = T * 64;
    const bool prm = T < 256; const int b = prm ? (T >> 6) : (T - 256), j = prm ? (T & 63) : 0; const int pos0 = prm ? j * 64 : 2048;
    bf16_t* kc = (bf16_t*)(ws + OFF_KC) + (prm ? (size_t)(b * 4096 + j * 64) : (size_t)16384 + (size_t)b * 2112 + 2048) * 320;
    bf16_t* ct = (bf16_t*)(ws + OFF_CT) + (prm ? (size_t)b * 256 * 4096 + j * 64 : (size_t)16384 * 256 + (size_t)b * 256 * 2112 + 2048);
    const size_t ctstride = prm ? 4096 : 2112;
    float* ockv = a.out + (prm ? O_CKVP + ((size_t)(l * 4 + b) * 4096 + j * 64) * 256 : O_CKVS + ((size_t)(l * 32 + b) * 64) * 256);
    float* okpe = a.out + (prm ? O_KPEP + ((size_t)(l * 4 + b) * 4096 + j * 64) * 64 : O_KPES + ((size_t)(l * 32 + b) * 64) * 64);
    bf16_t* qn = (bf16_t*)(ws + OFF_QN); const float* qag = a.in[11] + l * 384; const float* kvg = a.in[13] + l * 256;
    const float2* rope = (const float2*)(ws + OFF_ROPE);
    bf16_t* ctile = (bf16_t*)lds;
    float qg[6];
#pragma unroll
    for (int i = 0; i < 3; ++i) { qg[2 * i] = qag[2 * lane + 128 * i]; qg[2 * i + 1] = qag[2 * lane + 128 * i + 1]; }
    const float4 g4 = *(const float4*)(kvg + 4 * lane);
#pragma unroll 1
    for (int tb = 0; tb < 8; tb += 4) {
        unsigned wq[4][3]; uint2 wk[4]; bf16_t p1[4], p2[4];
#pragma unroll
        for (int u = 0; u < 4; ++u) { const bf16_t* zr = z + (size_t)(r0 + wave + 8 * (tb + u)) * ZW;
#pragma unroll
            for (int i = 0; i < 3; ++i) wq[u][i] = *(const unsigned*)(zr + ZQ + 2 * lane + 128 * i);
            wk[u] = *(const uint2*)(zr + ZKV + 4 * lane); p1[u] = zr[ZPE + (lane & 31)]; p2[u] = zr[ZPE + 32 + (lane & 31)]; }
#pragma unroll
        for (int u = 0; u < 4; ++u) { const int t = wave + 8 * (tb + u);
            { float v[6]; float ss = 0.f;
#pragma unroll
              for (int i = 0; i < 3; ++i) { v[2 * i] = bflo(wq[u][i]); v[2 * i + 1] = bfhi(wq[u][i]); ss += v[2 * i] * v[2 * i] + v[2 * i + 1] * v[2 * i + 1]; }
              ss = wave_sum(ss); const float rs = rsqrtf(ss * (1.0f / 384.0f) + EPS);
#pragma unroll
              for (int i = 0; i < 3; ++i) *(unsigned*)(qn + (size_t)(r0 + t) * 384 + 2 * lane + 128 * i) = cvt_pk_bf16(v[2 * i] * rs * qg[2 * i], v[2 * i + 1] * rs * qg[2 * i + 1]); }
            { float v0 = bflo(wk[u].x), v1 = bfhi(wk[u].x), v2 = bflo(wk[u].y), v3 = bfhi(wk[u].y);
              const float ss = wave_sum(v0 * v0 + v1 * v1 + v2 * v2 + v3 * v3); const float rs = rsqrtf(ss * (1.0f / 256.0f) + EPS);
              v0 *= rs * g4.x; v1 *= rs * g4.y; v2 *= rs * g4.z; v3 *= rs * g4.w;
              __builtin_nontemporal_store((f32x4){v0, v1, v2, v3}, (f32x4*)(ockv + (size_t)t * 256 + 4 * lane));
              uint2 o; o.x = cvt_pk_bf16(v0, v1); o.y = cvt_pk_bf16(v2, v3);
              *(uint2*)(kc + (size_t)t * 320 + 4 * lane) = o; *(uint2*)(ctile + t * 264 + 4 * lane) = o; }
            if (lane < 32) { const float x1 = bf2f(p1[u]), x2 = bf2f(p2[u]); const float2 cs = rope[(pos0 + t) * 32 + lane];
              const float o1 = x1 * cs.x - x2 * cs.y, o2 = x2 * cs.x + x1 * cs.y;
              okpe[(size_t)t * 64 + lane] = o1; okpe[(size_t)t * 64 + 32 + lane] = o2; kc[(size_t)t * 320 + 256 + lane] = f2bf(o1); kc[(size_t)t * 320 + 288 + lane] = f2bf(o2); } }
    }
    __syncthreads();
    ct_write(ctile, ct, ctstride);
    __syncthreads();
}
__device__ void prep_hgrn_tile(CArgs& a, int l, int T, unsigned char* lds) {
    unsigned char* ws = a.ws; int tid = threadIdx.x; asm volatile("" : "+v"(tid)); asm volatile("" : "+s"(l));
    const bf16_t* z = (const bf16_t*)(ws + OFF_Z); const int r0 = T * 64;
    float* lf = (float*)lds; float* vt = (float*)(lds + 65536); float* tot = (float*)(lds + 131072);
    const int ep = tid & 255, hf = tid >> 8; const float lbv = lb_of(a, l, ep);
    bf16_t zfr[32]; float pref[32];
    { bf16_t zvr[32];
#pragma unroll
      for (int i = 0; i < 32; ++i) { const bf16_t* zr = z + (size_t)(r0 + 32 * hf + i) * ZW; zfr[i] = zr[ZHF + ep]; zvr[i] = zr[ZHI + ep]; }
      float run = 0.f;
#pragma unroll
      for (int i = 0; i < 32; ++i) { const float f = lbv + (1.0f - lbv) * sigmoidf_(bf2f(zfr[i])); run += __logf(fmaxf(f, 1e-30f)); pref[i] = run; vt[(32 * hf + i) * 256 + ep] = bf2f(zvr[i]); }
      tot[hf * 256 + ep] = run; }
    __syncthreads();
    { const float t0 = tot[ep], bl = t0 + tot[256 + ep], off = hf ? t0 : 0.f;
#pragma unroll
      for (int i = 0; i < 32; ++i) { lf[(32 * hf + i) * 256 + ep] = (1.0f - lbv) * sigmoidf_(-bf2f(zfr[i])) * __expf(bl - pref[i] - off); ((float*)(ws + OFF_BCUM))[(size_t)(r0 + 32 * hf + i) * 256 + ep] = pref[i] + off; }
      if (hf == 0) ((float*)(ws + OFF_DEC))[T * 256 + ep] = __expf(bl); }
    __syncthreads();
    { const int h = tid >> 7, eb = (tid & 127) >> 3, db = tid & 7; float acc[4][8];
#pragma unroll
      for (int i = 0; i < 4; ++i)
#pragma unroll
          for (int jj = 0; jj < 8; ++jj) acc[i][jj] = 0.f;
#pragma unroll 4
      for (int s = 0; s < 64; ++s) { const float4 kv = *(const float4*)(lf + s * 256 + h * 64 + eb * 4); const float4 v0 = *(const float4*)(vt + s * 256 + h * 64 + db * 8), v1 = *(const float4*)(vt + s * 256 + h * 64 + db * 8 + 4);
          const float kk[4] = {kv.x, kv.y, kv.z, kv.w}; const float vv[8] = {v0.x, v0.y, v0.z, v0.w, v1.x, v1.y, v1.z, v1.w};
#pragma unroll
          for (int i = 0; i < 4; ++i)
#pragma unroll
              for (int jj = 0; jj < 8; ++jj) acc[i][jj] += kk[i] * vv[jj]; }
      float* U = (float*)(ws + OFF_U) + (size_t)(T * 4 + h) * 4096;
#pragma unroll
      for (int i = 0; i < 4; ++i) { *(float4*)(U + (eb * 4 + i) * 64 + db * 8) = make_float4(acc[i][0], acc[i][1], acc[i][2], acc[i][3]); *(float4*)(U + (eb * 4 + i) * 64 + db * 8 + 4) = make_float4(acc[i][4], acc[i][5], acc[i][6], acc[i][7]); } }
    __syncthreads();
}
__device__ void prep_cache_tile(CArgs& a, int l, int P, unsigned char* lds) {
    unsigned char* ws = a.ws; int tid = threadIdx.x; asm volatile("" : "+v"(tid)); const int b = P >> 5, kt = P & 31;
    const float* ckv = a.in[2] + ((size_t)(l * 32 + b) * 2048 + kt * 64) * 256; const float* kpe = a.in[3] + ((size_t)(l * 32 + b) * 2048 + kt * 64) * 64;
    bf16_t* kc = (bf16_t*)(ws + OFF_KC) + ((size_t)16384 + (size_t)b * 2112 + kt * 64) * 320;
    bf16_t* ct = (bf16_t*)(ws + OFF_CT) + (size_t)16384 * 256 + (size_t)b * 256 * 2112 + kt * 64;
    bf16_t* ctile = (bf16_t*)lds;
#pragma unroll
    for (int i = 0; i < 8; ++i) { const int q = tid + 512 * i, t = q >> 6, c4 = q & 63; const f32x4 q4 = __builtin_nontemporal_load((const f32x4*)(ckv + (size_t)t * 256 + c4 * 4)); const float4 v = make_float4(q4[0], q4[1], q4[2], q4[3]);
        uint2 o; o.x = cvt_pk_bf16(v.x, v.y); o.y = cvt_pk_bf16(v.z, v.w); *(uint2*)(kc + (size_t)t * 320 + c4 * 4) = o; *(uint2*)(ctile + t * 264 + c4 * 4) = o; }
#pragma unroll
    for (int i = 0; i < 2; ++i) { const int q = tid + 512 * i, t = q >> 4, c4 = q & 15; const f32x4 q4 = __builtin_nontemporal_load((const f32x4*)(kpe + (size_t)t * 64 + c4 * 4)); const float4 v = make_float4(q4[0], q4[1], q4[2], q4[3]);
        uint2 o; o.x = cvt_pk_bf16(v.x, v.y); o.y = cvt_pk_bf16(v.z, v.w); *(uint2*)(kc + (size_t)t * 320 + 256 + c4 * 4) = o; }
    __syncthreads();
    ct_write(ctile, ct, 2112);
    __syncthreads();
}
__device__ void phase_prep(CArgs& a, int l, unsigned char* lds, int rep = 0) {
    unsigned* ctr = (unsigned*)(a.ws + OFF_CTL) + 16 * (l + 1) + 8 + 128 * rep; LAS unsigned* slot = (LAS unsigned*)(lds + LDS_MAIN + 16);
    for (;;) {
        __syncthreads();
        { int t0 = threadIdx.x; asm volatile("" : "+v"(t0)); if (t0 == 0) *slot = atomicAdd(ctr, 1u); }
        __syncthreads();
        const int it = (int)*slot;
        if (it >= 2 * NTILE) break;
        if (it < NTILE) prep_hgrn_tile(a, l, it, lds); else prep_mla_tile(a, l, it - NTILE, lds);
    }
}
__device__ void phase_cache(CArgs& a, int l, unsigned char* lds) {
    unsigned* ctr = (unsigned*)(a.ws + OFF_CTL) + 16 * (l + 1) + 12; LAS unsigned* slot = (LAS unsigned*)(lds + LDS_MAIN + 16);
    for (;;) {
        __syncthreads();
        { int t0 = threadIdx.x; asm volatile("" : "+v"(t0)); if (t0 == 0) *slot = atomicAdd(ctr, 1u); }
        __syncthreads();
        const int it = (int)*slot;
        if (it >= 1024) break;
        prep_cache_tile(a, l, it, lds);
    }
}
__device__ void phase_scan(CArgs& a, int l) {
    unsigned char* ws = a.ws; int tid = threadIdx.x; asm volatile("" : "+v"(tid)); const size_t gtid = (size_t)bid_() * 512 + tid, gsz = (size_t)gdim_() * 512;
    const float* U = (const float*)(ws + OFF_U); const float* dec = (const float*)(ws + OFF_DEC); float* sst = (float*)(ws + OFF_SST);
    for (size_t i = gtid; i < 16 * 4096; i += gsz) { const int bh = (int)(i >> 12), ed = (int)(i & 4095), b = bh >> 2, h = bh & 3, e = ed >> 6; float S = 0.f;
#pragma unroll 16
        for (int j = 0; j < 64; ++j) { const size_t ch = (size_t)((b * 64 + j) * 4 + h); sst[ch * 4096 + ed] = S; S = dec[ch * 64 + e] * S + U[ch * 4096 + ed]; }
        a.out[O_HGP + (size_t)(l * 16 + bh) * 4096 + ed] = S; }
    for (size_t i = gtid; i < 128 * 4096; i += gsz) { const int bh = (int)(i >> 12), ed = (int)(i & 4095), b = bh >> 2, h = bh & 3, e = ed >> 6; const size_t ch = (size_t)((256 + b) * 4 + h);
        const float S0 = a.in[4][(size_t)(l * 128 + bh) * 4096 + ed];
        a.out[O_HGS + (size_t)(l * 128 + bh) * 4096 + ed] = dec[ch * 64 + e] * S0 + U[ch * 4096 + ed]; }
}
constexpr int KSTR = 656, VSTR = 144, VOFF = 64 * KSTR, ABUF = VOFF + 256 * VSTR;
__device__ __forceinline__ int swz16(int row) { return (((row & 15) + 4) >> 3) & 1; }
__device__ void attn_item(CArgs& a, int idx, unsigned char* ldsg) {
    unsigned char* ws = a.ws; LAS unsigned char* lds = (LAS unsigned char*)ldsg;
    int tid = threadIdx.x; asm volatile("" : "+v"(tid)); const int lane = tid & 63, wave = __builtin_amdgcn_readfirstlane(tid >> 6), lr = lane & 15, g = lane >> 4;
    const int gx = (g ^ swz16(lr)) * 16;
    int b, hp, nkt, r0; const unsigned char* kcb; const unsigned char* ctb; int ctstride;
    if (idx >= 256 && idx < 320) { const int s = idx - 256; b = s >> 1; hp = s & 1; nkt = 33; r0 = MP + b * 64;
        kcb = ws + OFF_KC + ((size_t)16384 + (size_t)b * 2112) * 640; ctb = ws + OFF_CT + ((size_t)16384 * 256 + (size_t)b * 256 * 2112) * 2; ctstride = 4224; }
    else { const int k = idx < 256 ? idx : idx - 64; const int j = 63 - (k >> 3), sub = k & 7; b = sub >> 1; hp = sub & 1; nkt = j + 1; r0 = b * 4096 + j * 64;
        kcb = ws + OFF_KC + (size_t)b * 4096 * 640; ctb = ws + OFF_CT + (size_t)b * 256 * 4096 * 2; ctstride = 8192; }
    const int head = hp * 2 + (wave >> 2); const int qrow = r0 + (wave & 3) * 16 + lr;
    unsigned ko[6], vo[5];
#pragma unroll
    for (int i = 0; i < 6; ++i) { const int n = i * 512 + tid, row = n / 41, pc = n - row * 41; ko[i] = (unsigned)(row * 640 + (pc < 40 ? (pc ^ swz16(row)) * 16 : 0)); }
#pragma unroll
    for (int i = 0; i < 5; ++i) { const int n = i * 512 + tid, row = n / 9, pc = n - row * 9; vo[i] = (unsigned)(row * ctstride + (pc < 8 ? (pc ^ swz16(row)) * 16 : 0)); }
#define ATT_DMA(kt, bo) do { const unsigned char* kg = kcb + (size_t)(kt) * 40960; const unsigned char* vg = ctb + (size_t)(kt) * 128; \
        _Pragma("unroll") for (int i = 0; i < 6; ++i) if (i < 5 || wave == 0) __builtin_amdgcn_global_load_lds((const unsigned*)(kg + ko[i]), (LAS unsigned*)(lds + (bo) + (i * 512 + wave * 64) * 16), 16, 0, 0); \
        _Pragma("unroll") for (int i = 0; i < 5; ++i) if (i < 4 || wave < 4) __builtin_amdgcn_global_load_lds((const unsigned*)(vg + vo[i]), (LAS unsigned*)(lds + (bo) + VOFF + (i * 512 + wave * 64) * 16), 16, 0, 0); } while (0)
    __syncthreads();
    ATT_DMA(0, 0);
    bf16x8 qf[10];
    { const bf16_t* qp = (const bf16_t*)(ws + OFF_Q) + (size_t)qrow * 1280 + head * 320 + g * 8;
#pragma unroll
      for (int ks = 0; ks < 10; ++ks) qf[ks] = *(const bf16x8*)(qp + ks * 32);
      const int pos = qrow < MP ? (qrow & 4095) : 2048 + ((qrow - MP) & 63); const float2* rp = (const float2*)(ws + OFF_ROPE) + pos * 32 + 8 * g;
      u32x4 w1 = __builtin_bit_cast(u32x4, qf[8]), w2 = __builtin_bit_cast(u32x4, qf[9]);
      float4 cs4[4];
#pragma unroll
      for (int jp = 0; jp < 4; ++jp) cs4[jp] = *(const float4*)(rp + 2 * jp);
#pragma unroll
      for (int jp = 0; jp < 4; ++jp) { const float a1 = bflo(w1[jp]), b1 = bfhi(w1[jp]), a2 = bflo(w2[jp]), b2 = bfhi(w2[jp]);
          w1[jp] = cvt_pk_bf16(a1 * cs4[jp].x - a2 * cs4[jp].y, b1 * cs4[jp].z - b2 * cs4[jp].w); w2[jp] = cvt_pk_bf16(a2 * cs4[jp].x + a1 * cs4[jp].y, b2 * cs4[jp].z + b1 * cs4[jp].w); }
      qf[8] = __builtin_bit_cast(bf16x8, w1); qf[9] = __builtin_bit_cast(bf16x8, w2); }
    f32x4 o[16];
#pragma unroll
    for (int i = 0; i < 16; ++i) o[i] = (f32x4){0.f, 0.f, 0.f, 0.f};
    float mrun = -1e30f, lsum = 0.f;
    asm volatile("s_waitcnt vmcnt(0)" ::: "memory");
    __syncthreads();
    const int koff = lr * KSTR + gx, voff = VOFF + lr * VSTR + gx;
    for (int kt = 0; kt < nkt; ++kt) {
        const int bo = (kt & 1) * ABUF;
        if (kt + 1 < nkt) ATT_DMA(kt + 1, ABUF - bo);
        const LAS unsigned char* kb = lds + bo + koff; const LAS unsigned char* vb = lds + bo + voff;
        f32x4 s[4];
#pragma unroll
        for (int i = 0; i < 4; ++i) s[i] = (f32x4){0.f, 0.f, 0.f, 0.f};
        bf16x8 kf[2][4];
#pragma unroll
        for (int k4 = 0; k4 < 4; ++k4) kf[0][k4] = *(const LAS bf16x8*)(kb + k4 * 16 * KSTR);
#pragma unroll
        for (int ks = 0; ks < 10; ++ks) {
            if (ks < 9) {
#pragma unroll
                for (int k4 = 0; k4 < 4; ++k4) kf[(ks + 1) & 1][k4] = *(const LAS bf16x8*)(kb + k4 * 16 * KSTR + (ks + 1) * 64); }
            __builtin_amdgcn_sched_barrier(0);
#pragma unroll
            for (int k4 = 0; k4 < 4; ++k4) s[k4] = __builtin_amdgcn_mfma_f32_16x16x32_bf16(kf[ks & 1][k4], qf[ks], s[k4], 0, 0, 0);
            __builtin_amdgcn_sched_barrier(0);
        }
        bf16x8 vf[2][4];
#pragma unroll
        for (int q4 = 0; q4 < 4; ++q4) vf[0][q4] = *(const LAS bf16x8*)(vb + (q4 >> 1) * 16 * VSTR + (q4 & 1) * 64);
        __builtin_amdgcn_sched_barrier(0);
        float mx = s[0][0];
#pragma unroll
        for (int k4 = 0; k4 < 4; ++k4)
#pragma unroll
            for (int i = 0; i < 4; ++i) mx = fmaxf(mx, s[k4][i]);
        mx = fmaxf(mx, __shfl_xor(mx, 16)); mx = fmaxf(mx, __shfl_xor(mx, 32));
        if (!__all(mx - mrun <= 8.0f)) {
            const float mnew = fmaxf(mrun, mx), alpha = __builtin_amdgcn_exp2f(mrun - mnew); mrun = mnew; lsum *= alpha;
#pragma unroll
            for (int i = 0; i < 16; ++i) o[i] *= alpha; }
        float ps = 0.f;
#pragma unroll
        for (int k4 = 0; k4 < 4; ++k4)
#pragma unroll
            for (int i = 0; i < 4; ++i) { s[k4][i] = __builtin_amdgcn_exp2f(s[k4][i] - mrun); ps += s[k4][i]; }
        lsum += ps;
        bf16x8 pb[2];
#pragma unroll
        for (int s2 = 0; s2 < 2; ++s2) { u32x4 w; w.x = cvt_pk_bf16(s[2 * s2][0], s[2 * s2][1]); w.y = cvt_pk_bf16(s[2 * s2][2], s[2 * s2][3]);
            w.z = cvt_pk_bf16(s[2 * s2 + 1][0], s[2 * s2 + 1][1]); w.w = cvt_pk_bf16(s[2 * s2 + 1][2], s[2 * s2 + 1][3]); pb[s2] = __builtin_bit_cast(bf16x8, w); }
#pragma unroll
        for (int cp = 0; cp < 8; ++cp) {
            if (cp < 7) {
#pragma unroll
                for (int q4 = 0; q4 < 4; ++q4) vf[(cp + 1) & 1][q4] = *(const LAS bf16x8*)(vb + (2 * (cp + 1) + (q4 >> 1)) * 16 * VSTR + (q4 & 1) * 64); }
            __builtin_amdgcn_sched_barrier(0);
#pragma unroll
            for (int q4 = 0; q4 < 4; ++q4) o[2 * cp + (q4 >> 1)] = __builtin_amdgcn_mfma_f32_16x16x32_bf16(vf[cp & 1][q4], pb[q4 & 1], o[2 * cp + (q4 >> 1)], 0, 0, 0);
            __builtin_amdgcn_sched_barrier(0);
        }
        asm volatile("s_waitcnt vmcnt(0)" ::: "memory");
        __syncthreads();
    }
#undef ATT_DMA
    lsum += __shfl_xor(lsum, 16); lsum += __shfl_xor(lsum, 32);
    const float inv = 1.0f / lsum;
    bf16_t* op = (bf16_t*)(ws + OFF_MIXA) + (size_t)qrow * 1536 + head * 256 + 4 * g;
#pragma unroll
    for (int ct = 0; ct < 16; ++ct) { uint2 w; w.x = cvt_pk_bf16(o[ct][0] * inv, o[ct][1] * inv); w.y = cvt_pk_bf16(o[ct][2] * inv, o[ct][3] * inv); *(uint2*)(op + 16 * ct) = w; }
}
constexpr int HS = 72;
constexpr int H_BC = 0, H_QT = 2 * 16640, H_KT = H_QT + 2 * 64 * HS * 2, H_QH = H_KT + 2 * 64 * HS * 2, H_VT = H_QH + 2 * 64 * HS * 2, H_ST = H_VT + 2 * 64 * HS * 2, H_END = H_ST + 2 * 64 * HS * 2;
static_assert(H_END <= LDS_MAIN, "hgrn lds");
__device__ __forceinline__ int posof64(int t) { const int u = t & 31; const int p = u < 16 ? 8 * (u >> 2) + (u & 3) : 8 * ((u - 16) >> 2) + 4 + ((u - 16) & 3); return (t & 32) + p; }
__device__ void hgrn_out_tile(CArgs& a, int l, int T, unsigned char* ldsg) {
    unsigned char* ws = a.ws; int tid = threadIdx.x; asm volatile("" : "+v"(tid)); asm volatile("" : "+s"(l)); const int lane = tid & 63, wave = tid >> 6, lr = lane & 15, g = lane >> 4;
    LAS unsigned char* lds = (LAS unsigned char*)ldsg;
    const bf16_t* z = (const bf16_t*)(ws + OFF_Z); const int r0 = T * 64;
    const int c = tid & 127, hh = c >> 6, e = c & 63, tq = tid >> 7;
    LAS float* bc = (LAS float*)(lds + H_BC) + hh * 4160;
    LAS bf16_t* QT = (LAS bf16_t*)(lds + H_QT) + hh * 64 * HS; LAS bf16_t* KT = (LAS bf16_t*)(lds + H_KT) + hh * 64 * HS; LAS bf16_t* QH = (LAS bf16_t*)(lds + H_QH) + hh * 64 * HS; LAS bf16_t* VT = (LAS bf16_t*)(lds + H_VT) + hh * 64 * HS;
    const float lbv0 = lb_of(a, l, hh * 64 + e), lbv1 = lb_of(a, l, (2 + hh) * 64 + e);
    for (int hp = 0; hp < 2; ++hp) {
        const int h = 2 * hp + hh; const float lbv = hp ? lbv1 : lbv0;
        { const float* bcum = (const float*)(ws + OFF_BCUM) + (size_t)r0 * 256 + h * 64 + e; const float rr = bcum[31 * 256];
          float s0v[16];
#pragma unroll
          for (int i = 0; i < 16; ++i) { const int idx = tid + 512 * i, h2 = idx >> 12, ed = idx & 4095; const int hg = 2 * hp + h2;
              const float* S0 = T < 256 ? (const float*)(ws + OFF_SST) + (size_t)(T * 4 + hg) * 4096 : a.in[4] + (size_t)(l * 128 + (T - 256) * 4 + hg) * 4096;
              s0v[i] = S0[ed]; }
#pragma unroll 1
          for (int i0 = 0; i0 < 16; i0 += 8) {
          bf16_t zq[8], zf16[8], zv[8]; float bbv[8];
#pragma unroll
          for (int i = 0; i < 8; ++i) { const bf16_t* zr = z + (size_t)(r0 + tq * 16 + i0 + i) * ZW + h * 64 + e; zq[i] = zr[ZHQ]; zf16[i] = zr[ZHF]; zv[i] = zr[ZHI]; bbv[i] = bcum[(tq * 16 + i0 + i) * 256]; }
#pragma unroll
          for (int i = 0; i < 8; ++i) { const int t = tq * 16 + i0 + i; const float bb = bbv[i];
              const float q = bf2f(zq[i]), zf = bf2f(zf16[i]); const float k = (1.0f - lbv) * sigmoidf_(-zf);
              QH[t * HS + e] = f2bf(q * __expf(bb)); QT[t * HS + e] = f2bf(q * __expf(fminf(bb - rr, 80.f))); KT[t * HS + e] = f2bf(k * __expf(fminf(rr - bb, 80.f)));
              VT[e * HS + posof64(t)] = zv[i]; } }
#pragma unroll
          for (int i = 0; i < 16; ++i) { const int idx = tid + 512 * i, h2 = idx >> 12, ed = idx & 4095; ((LAS bf16_t*)(lds + H_ST))[h2 * 64 * HS + (ed & 63) * HS + (ed >> 6)] = f2bf(s0v[i]); } }
        __syncthreads();
        { const int wh = wave >> 2, tb = wave & 3; const int hw = 2 * hp + wh;
          const LAS unsigned char* qt = lds + H_QT + wh * 64 * HS * 2; const LAS unsigned char* kt = lds + H_KT + wh * 64 * HS * 2; const LAS unsigned char* qh = lds + H_QH + wh * 64 * HS * 2;
          const LAS unsigned char* vt = lds + H_VT + wh * 64 * HS * 2; const LAS unsigned char* st = lds + H_ST + wh * 64 * HS * 2;
          const int trow = 16 * tb + lr;
          float4 ogv[4]; uint2 gwv[4];
#pragma unroll
          for (int db = 0; db < 4; ++db) { const int d0 = hw * 64 + 16 * db + 4 * g; ogv[db] = *(const float4*)(a.in[17] + l * 256 + d0); gwv[db] = *(const uint2*)(z + (size_t)(r0 + trow) * ZW + ZHG + d0); }
          bf16x8 qtf[2], qhf[2];
#pragma unroll
          for (int ks = 0; ks < 2; ++ks) { qtf[ks] = *(const LAS bf16x8*)(qt + trow * (HS * 2) + (32 * ks + 8 * g) * 2); qhf[ks] = *(const LAS bf16x8*)(qh + trow * (HS * 2) + (32 * ks + 8 * g) * 2); }
          f32x4 aT[4];
#pragma unroll
          for (int sb = 0; sb < 4; ++sb) { aT[sb] = (f32x4){0.f, 0.f, 0.f, 0.f};
#pragma unroll
              for (int ks = 0; ks < 2; ++ks) { const bf16x8 kf = *(const LAS bf16x8*)(kt + (16 * sb + lr) * (HS * 2) + (32 * ks + 8 * g) * 2); aT[sb] = __builtin_amdgcn_mfma_f32_16x16x32_bf16(kf, qtf[ks], aT[sb], 0, 0, 0); }
#pragma unroll
              for (int i = 0; i < 4; ++i) aT[sb][i] = (16 * sb + 4 * g + i <= trow) ? aT[sb][i] : 0.f; }
          bf16x8 pb[2];
#pragma unroll
          for (int s2 = 0; s2 < 2; ++s2) { u32x4 w; w.x = cvt_pk_bf16(aT[2 * s2][0], aT[2 * s2][1]); w.y = cvt_pk_bf16(aT[2 * s2][2], aT[2 * s2][3]);
              w.z = cvt_pk_bf16(aT[2 * s2 + 1][0], aT[2 * s2 + 1][1]); w.w = cvt_pk_bf16(aT[2 * s2 + 1][2], aT[2 * s2 + 1][3]); pb[s2] = __builtin_bit_cast(bf16x8, w); }
          f32x4 o[4]; float ss = 0.f;
#pragma unroll
          for (int db = 0; db < 4; ++db) { o[db] = (f32x4){0.f, 0.f, 0.f, 0.f};
#pragma unroll
              for (int ks = 0; ks < 2; ++ks) { const bf16x8 sf = *(const LAS bf16x8*)(st + (16 * db + lr) * (HS * 2) + (32 * ks + 8 * g) * 2); o[db] = __builtin_amdgcn_mfma_f32_16x16x32_bf16(sf, qhf[ks], o[db], 0, 0, 0); }
#pragma unroll
              for (int s2 = 0; s2 < 2; ++s2) { const bf16x8 vf = *(const LAS bf16x8*)(vt + (16 * db + lr) * (HS * 2) + (32 * s2 + 8 * g) * 2); o[db] = __builtin_amdgcn_mfma_f32_16x16x32_bf16(vf, pb[s2], o[db], 0, 0, 0); }
              ss += o[db][0] * o[db][0] + o[db][1] * o[db][1] + o[db][2] * o[db][2] + o[db][3] * o[db][3]; }
          ss += __shfl_xor(ss, 16); ss += __shfl_xor(ss, 32);
          const float rs = rsqrtf(ss * (1.0f / 64.0f) + EPS);
#pragma unroll
          for (int db = 0; db < 4; ++db) { const int d0 = hw * 64 + 16 * db + 4 * g; const float4 og = ogv[db]; const uint2 gw = gwv[db];
              uint2 w; w.x = cvt_pk_bf16(o[db][0] * rs * og.x * siluf_(bflo(gw.x)), o[db][1] * rs * og.y * siluf_(bfhi(gw.x)));
              w.y = cvt_pk_bf16(o[db][2] * rs * og.z * siluf_(bflo(gw.y)), o[db][3] * rs * og.w * siluf_(bfhi(gw.y)));
              *(uint2*)((bf16_t*)(ws + OFF_MIXA) + (size_t)(r0 + trow) * 1536 + 1024 + d0) = w; } }
        __syncthreads();
    }
}
template <bool PRM> __device__ __forceinline__ void cmlp_item_t(CArgs& a, int l, int it, unsigned char* ldsg) {
    int tid = threadIdx.x; asm volatile("" : "+v"(tid)); asm volatile("" : "+s"(l)); const int lane = tid & 63, wave = tid >> 6, lr = lane & 15, lg = lane >> 4; const int ci = it >> 2, g = it & 3;
    constexpr int L = PRM ? 128 : 64, WS = L + 8;
    const int r0 = PRM ? ci * 128 : MP + (ci - 128) * 64;
    LAS unsigned char* lds = (LAS unsigned char*)ldsg; LAS bf16_t* Wb = (LAS bf16_t*)lds; LAS bf16_t* vT = (LAS bf16_t*)(lds + 128 * 136 * 2);
    const bf16_t* z = (const bf16_t*)(a.ws + OFF_Z); const float* wsrc = a.in[19] + (size_t)(l * 4 + g) * 128 * 128;
    const float vg = a.in[18][l * 256 + g * 64 + lane];
    bf16_t zc[L / 8];
#pragma unroll
    for (int i = 0; i < L / 8; ++i) zc[i] = z[(size_t)(r0 + wave + 8 * i) * ZW + ZCV + g * 64 + lane];
    { constexpr int NQ = L * L / 4 / 512, SH = PRM ? 5 : 4; float4 wv[NQ];
#pragma unroll
      for (int i = 0; i < NQ; ++i) { const int idx = tid + 512 * i, t = idx >> SH, s4 = idx & ((1 << SH) - 1); wv[i] = *(const float4*)(wsrc + t * 128 + 4 * s4); }
#pragma unroll
      for (int i = 0; i < NQ; ++i) { const int idx = tid + 512 * i, t = idx >> SH, s0 = 4 * (idx & ((1 << SH) - 1));
          u32x2 w; w.x = cvt_pk_bf16(s0 <= t ? wv[i].x : 0.f, s0 + 1 <= t ? wv[i].y : 0.f); w.y = cvt_pk_bf16(s0 + 2 <= t ? wv[i].z : 0.f, s0 + 3 <= t ? wv[i].w : 0.f);
          *(LAS u32x2*)(Wb + t * WS + s0) = w; } }
    {
#pragma unroll
      for (int i = 0; i < L / 8; ++i) { const int t = wave + 8 * i; const float x = geluf_(bf2f(zc[i])); const float ss = wave_sum(x * x);
          const float vv = x * rsqrtf(ss * (1.0f / 64.0f) + EPS) * vg; vT[lane * WS + t] = f2bf(vv);
          if (!PRM) a.out[O_CMV + ((size_t)(l * 32 + (ci - 128)) * 64 + t) * 256 + g * 64 + lane] = vv; } }
    __syncthreads();
    { constexpr int NT = PRM ? 4 : 2;
      const int tt = PRM ? wave : (wave & 3); const int t = 16 * tt + lr; const float bs = a.in[20][(size_t)(l * 4 + g) * 128 + t];
      uint2 cwv[NT];
#pragma unroll
      for (int n = 0; n < NT; ++n) { const int dt = PRM ? n : 2 * (wave >> 2) + n; cwv[n] = *(const uint2*)(z + (size_t)(r0 + t) * ZW + ZCU + g * 64 + 16 * dt + 4 * lg); }
#pragma unroll
      for (int n = 0; n < NT; ++n) { const int dt = PRM ? n : 2 * (wave >> 2) + n; f32x4 acc = (f32x4){0.f, 0.f, 0.f, 0.f};
#pragma unroll
          for (int ks = 0; ks < L / 32; ++ks) { if (32 * ks <= 16 * tt + 15) {
              const bf16x8 vf = *(const LAS bf16x8*)(vT + (16 * dt + lr) * WS + 32 * ks + 8 * lg); const bf16x8 wf = *(const LAS bf16x8*)(Wb + t * WS + 32 * ks + 8 * lg);
              acc = __builtin_amdgcn_mfma_f32_16x16x32_bf16(vf, wf, acc, 0, 0, 0); } }
          const int d0 = g * 64 + 16 * dt + 4 * lg; const uint2 cw = cwv[n];
          uint2 o; o.x = cvt_pk_bf16(geluf_(bflo(cw.x)) * (acc[0] + bs), geluf_(bfhi(cw.x)) * (acc[1] + bs)); o.y = cvt_pk_bf16(geluf_(bflo(cw.y)) * (acc[2] + bs), geluf_(bfhi(cw.y)) * (acc[3] + bs));
          *(uint2*)((bf16_t*)(a.ws + OFF_MIXA) + (size_t)(r0 + t) * 1536 + 1280 + d0) = o; } }
    __syncthreads();
}
__device__ void cmlp_item(CArgs& a, int l, int it, unsigned char* lds) { if ((it >> 2) < 128) cmlp_item_t<true>(a, l, it, lds); else cmlp_item_t<false>(a, l, it, lds); }
__device__ void phase_mix(CArgs& a, int l, unsigned char* lds, int rep) {
    unsigned* ctr = (unsigned*)(a.ws + OFF_CTL) + 16 * (l + 1) + 128 * rep; LAS unsigned* slot = (LAS unsigned*)(lds + LDS_MAIN + 16);
    for (;;) {
        __syncthreads();
        { int t0 = threadIdx.x; asm volatile("" : "+v"(t0)); if (t0 == 0) *slot = atomicAdd(ctr, 1u); }
        __syncthreads();
        const int it = (int)*slot;
        if (it >= 576 + NTILE + 640) break;
        if (it < 576) { attn_item(a, it, lds); if (PROBE_MIX & 1) { __syncthreads(); attn_item(a, it, lds); } }
        else if (it < 576 + NTILE) { hgrn_out_tile(a, l, it - 576, lds); if (PROBE_MIX & 2) { __syncthreads(); hgrn_out_tile(a, l, it - 576, lds); } }
        else { cmlp_item(a, l, it - 576 - NTILE, lds); if (PROBE_MIX & 4) { __syncthreads(); cmlp_item(a, l, it - 576 - NTILE, lds); } }
    }
}
__global__ void __launch_bounds__(512) mk_fwd(Args a_) {
    extern __shared__ __attribute__((aligned(16))) unsigned char lds[];
    if (threadIdx.x < 16) ((LAS unsigned*)(lds + LDS_MAIN))[threadIdx.x] = 0u;
    __syncthreads();
    XcdBarrier bar = xcd_barrier_post((unsigned*)(a_.ws + OFF_CTL) + 1024, (volatile LAS unsigned*)(lds + LDS_MAIN));
    const int ph_lo = a_.ph_lo, ph_hi = a_.ph_hi;
    for (int ph = ph_lo; ph < ph_hi; ++ph) {
        CArgs* ap = (CArgs*)__builtin_amdgcn_kernarg_segment_ptr(); asm volatile("" : "+s"(ap)); CArgs& a = *ap;
        unsigned char* ws = a.ws;
        if (ph == 0) { phase_init(a, lds); if ((PROBE_DUP >> 12) & 1) { __syncthreads(); phase_init(a, lds); } }
        else { const int l = (ph - 1) / 12, p = (ph - 1) % 12; const float* ng = a.in[5] + (size_t)l * 6 * 1024;
            bf16_t* H = (bf16_t*)(ws + OFF_H); bf16_t* ACT = (bf16_t*)(ws + OFF_ACT); bf16_t* D = (bf16_t*)(ws + OFF_D); bf16_t* D1 = (bf16_t*)(ws + ((p == 7 || p == 8) ? OFF_ACT : OFF_MIXA));   float* RS = (float*)(ws + OFF_X);
            const int reps = ((PROBE_DUP >> p) & 1) ? 2 : 1;
            for (int rep = 0; rep < reps; ++rep) {
            if (rep) __syncthreads();
            switch (p) {
            case 0: case 9: { const int f = p == 0 ? 0 : 1; EpiSwiGLU E{ACT}; run_gemm(lds, H, (const bf16_t*)(ws + OFF_WGU) + (size_t)(l * 2 + f) * 5632 * 1024, MT, 5632, 1024, E);
                if (p == 0 && !rep) phase_cache(a, l, lds); } break;
            case 1: case 10: { const int f = p == 1 ? 0 : 1; EpiBf E{D, 1024, D1}; run_gemm(lds, ACT, (const bf16_t*)(ws + OFF_WDN) + (size_t)(l * 2 + f) * 1024 * 2816, MT, 1024, 2816, E, 11); } break;
            case 2: ew_phase<false, false>(D, D1, 11, H, nullptr, nullptr, ng + 1024, 0.5f, ng + 2048, H, ng, RS); break;
            case 3: { EpiBf E{(bf16_t*)(ws + OFF_Z), ZW, nullptr}; run_gemm(lds, H, (const bf16_t*)(ws + OFF_WIN) + (size_t)l * 2304 * 1024, MT, 2304, 1024, E); } break;
            case 4: phase_prep(a, l, lds, rep); break;
            case 5: { phase_scan(a, l); EpiQ E{(bf16_t*)(ws + OFF_Q)}; run_gemm(lds, (const bf16_t*)(ws + OFF_QN), (const bf16_t*)(ws + OFF_WQ) + (size_t)l * 1280 * 384, MT, 1280, 384, E); } break;
            case 6: phase_mix(a, l, lds, rep); break;
            case 7: { EpiBf E{D, 1024, D1}; run_gemm(lds, (const bf16_t*)(ws + OFF_MIXA), (const bf16_t*)(ws + OFF_WMIX) + (size_t)l * 1024 * 1536, MT, 1024, 1536, E, 6); } break;
            case 8: ew_phase<false, false>(D, D1, 6, H, nullptr, nullptr, ng + 3 * 1024, 1.0f, ng + 4 * 1024, H, ng + 2048, RS); break;
            case 11: if (l == 0) ew_phase<false, false>(D, D1, 11, H, nullptr, nullptr, ng + 5 * 1024, 0.5f, ng + 6 * 1024, H, ng + 4 * 1024, RS); else ew_phase<false, true>(D, D1, 11, H, nullptr, a.out + O_Y, ng + 5 * 1024, 0.5f, nullptr, nullptr, ng + 4 * 1024, RS); break;
            }
            }
            tail_wtasks(a, ph, lds);
        }
        if (ph + 1 < ph_hi) {
            if (ph_lo < 0) { __threadfence(); cg::this_grid().sync(); }
            xcd_barrier(bar); }
    }
}

extern "C" void kernel_launch(void* const* d_in, const int* in_sizes, int n_in, void* d_out, int out_size, void* d_ws, size_t ws_size, hipStream_t stream) {
    static int grid = 0;
    if (grid == 0) {
        if (n_in != 21 || ws_size < WS_END) { fprintf(stderr, "kernel_launch: bad inputs n_in %d ws %zu need %zu\n", n_in, ws_size, (size_t)WS_END); grid = -1; return; }
        int dev = 0, cus = 0, per_cu = 0;
        hipGetDevice(&dev); hipDeviceGetAttribute(&cus, hipDeviceAttributeMultiprocessorCount, dev);
        if (hipFuncSetAttribute((const void*)mk_fwd, hipFuncAttributeMaxDynamicSharedMemorySize, LDS_BYTES) != hipSuccess) { fprintf(stderr, "hipFuncSetAttribute failed\n"); grid = -1; return; }
        if (hipOccupancyMaxActiveBlocksPerMultiprocessor(&per_cu, (const void*)mk_fwd, 512, LDS_BYTES) != hipSuccess || per_cu < 1) per_cu = 1;
        (void)hipGetLastError();
        grid = cus * 1;
    }
    if (grid < 0) return;
    if (hipMemsetAsync((char*)d_ws + OFF_CTL, 0, SZ_CTL, stream) != hipSuccess) { fprintf(stderr, "memset failed\n"); return; }
    Args a{};
    for (int i = 0; i < 21; ++i) a.in[i] = (const float*)d_in[i];
    a.out = (float*)d_out; a.ws = (unsigned char*)d_ws;
#if ONE_LAUNCH
    a.ph_lo = 0; a.ph_hi = NPHASE;
    void* args[] = {&a};
    hipError_t e = hipLaunchCooperativeKernel((const void*)mk_fwd, dim3(grid), dim3(512), args, LDS_BYTES, stream);
    if (e != hipSuccess) fprintf(stderr, "cooperative launch failed: %s (grid %d)\n", hipGetErrorString(e), grid);
#else
    for (int ph = 0; ph < NPHASE; ++ph) { a.ph_lo = ph; a.ph_hi = ph + 1; hipLaunchKernelGGL(mk_fwd, dim3(grid), dim3(512), LDS_BYTES, stream, a); }
#endif
}
```

```cpp
#include <hip/hip_runtime.h>
#include <hip/hip_cooperative_groups.h>
#include <cstdio>
namespace cg = cooperative_groups;
#ifndef ONE_LAUNCH
#define ONE_LAUNCH 1
#endif
#ifndef PROBE_DUP
#define PROBE_DUP 0
#endif
#ifndef PROBE_MIX
#define PROBE_MIX 0
#endif
namespace pg8 {
#define PG8_LAS __attribute__((address_space(3)))
typedef unsigned short bf16_t;
typedef short bf16x8 __attribute__((ext_vector_type(8)));
typedef float f32x4 __attribute__((ext_vector_type(4)));
typedef unsigned u32x4 __attribute__((ext_vector_type(4)));
constexpr int BM = 256, BK = 64, HALF = 128, HTB = HALF * BK * 2  , STAGE_BYTES = 8 * HTB, NXCD = 8, WGM = 8;

__host__ __device__ __forceinline__ int lds_byte(int r, int c) { const int st = (r >> 4) * 2 + (c >> 5), rr = r & 15, cc = c & 31, ob = rr * 64 + cc * 2; return st * 1024 + (ob ^ (((ob >> 9) & 1) << 5)); }
__host__ __device__ __forceinline__ void stage_rc(int b, int& R, int& C) { const int st = b / 1024, sb = b % 1024, swz = sb ^ (((sb >> 9) & 1) << 5); R = (st >> 1) * 16 + swz / 64; C = (st & 1) * 32 + (swz % 64) / 2; }
__host__ __device__ __forceinline__ int perm32(int rho) { const int n = rho >> 4, i = rho & 15; return 8 * (i >> 2) + 4 * n + (i & 3); }

struct Unit { int pm, pn, ks, nt, koff; };
struct Gemm { const bf16_t* A; const bf16_t* Bt; int M, N, K, ld; };

struct StaticOrder {
    int nM, nN, nwg, G, c, nN0, unt, ukb;
    __host__ __device__ void init(int M, int N, int G_, int c_, int nsplit = 1) { nM = M / BM; nN0 = N / BM; nN = nN0 * nsplit; nwg = nM * nN; G = G_; c = c_; }
    __host__ __device__ bool next(int i, Unit& u) const {
        const long L = (long)i * G + c; if (L >= nwg) return false;
        int wgid = (int)L; { const int q = nwg / NXCD, r = nwg % NXCD, xcd = wgid % NXCD, off = wgid / NXCD; wgid = (xcd < r ? xcd * (q + 1) : r * (q + 1) + (xcd - r) * q) + off; }
        const int nig = WGM * nN, gid = wgid / nig, fm = gid * WGM, gsz = (nM - fm) < WGM ? (nM - fm) : WGM;
        u.pm = fm + ((wgid % nig) % gsz); const int pn = (wgid % nig) / gsz; u.ks = pn / nN0; u.pn = pn - u.ks * nN0; u.nt = unt; u.koff = u.ks * ukb; return true;
    }
    __device__ __forceinline__ void a_ready(const Unit&) const {}
    __device__ __forceinline__ void done(const Unit&) const {}
};
__device__ __forceinline__ unsigned cvt_pk_bf16(float lo, float hi) { unsigned r; asm volatile("v_cvt_pk_bf16_f32 %0, %1, %2" : "=v"(r) : "v"(lo), "v"(hi)); return r; }
typedef float f32x2 __attribute__((ext_vector_type(2)));
template <class Epi, class Sched, bool STAMP = false>
__device__ __forceinline__ void gemm_phase(PG8_LAS unsigned char* lds, const Gemm g, const Sched& S, const Epi& E, unsigned long long* stamps) {
    int tid = threadIdx.x; asm volatile("" : "+v"(tid)); const int wid = __builtin_amdgcn_readfirstlane(tid >> 6), lane = tid & 63, wr = wid >> 2, wc = wid & 3, fr = lane & 15, fq = lane >> 4;
    const int K = g.ld;
    int ts_lo = 0, ts_hi = 0, nts = 0; const unsigned long long rt_entry = STAMP ? (unsigned long long)wall_clock64() : 0ull;
#define PG8_STAMP() do { if (STAMP && wid == 0 && nts < 64) { const unsigned long long _c = (unsigned long long)clock64(); \
        ts_lo = (lane == nts) ? (int)(unsigned)_c : ts_lo; ts_hi = (lane == nts) ? (int)(unsigned)(_c >> 32) : ts_hi; ++nts; } } while (0)
    PG8_STAMP();
    unsigned voffA[2], voffB[2];
#pragma unroll
    for (int i = 0; i < 2; ++i) { int R, C; stage_rc(tid * 16 + i * 8192, R, C); const int Rb = Epi::PERM ? ((R & ~31) + perm32(R & 31)) : R;
        voffA[i] = (unsigned)(R * K + C) * 2u; voffB[i] = (unsigned)(Rb * K + C) * 2u; }
    const size_t kstep = (size_t)(BK * 2);
    const size_t hstep = (size_t)HALF * K * 2;
    const size_t tstep = 2 * hstep;
    const unsigned ldsw = (unsigned)wid * 1024u;
    const int aoff = lds_byte(wr * 64 + fr, fq * 8), boff = lds_byte(wc * 32 + fr, fq * 8);
#define PG8_SA(b, h) (((b) * 2 + (h)) * HTB)
#define PG8_SB(b, h) ((4 + (b) * 2 + (h)) * HTB)
#define PG8_STAGE(bufoff, gbase, voff) do { _Pragma("unroll") for (int _i = 0; _i < 2; ++_i) \
        __builtin_amdgcn_global_load_lds((const unsigned*)((const char*)(gbase) + (voff)[_i]), (PG8_LAS unsigned*)(lds + (bufoff) + ldsw + _i * 8192), 16, 0, 0); } while (0)
#define PG8_LDA(dst, b, h) do { _Pragma("unroll") for (int m = 0; m < 4; ++m) _Pragma("unroll") for (int k = 0; k < 2; ++k) dst[m][k] = *(const PG8_LAS bf16x8*)(lds + PG8_SA(b, h) + aoff + m * 2048 + k * 1024); } while (0)
#define PG8_LDB(dst, b, h) do { _Pragma("unroll") for (int n = 0; n < 2; ++n) _Pragma("unroll") for (int k = 0; k < 2; ++k) dst[n][k] = *(const PG8_LAS bf16x8*)(lds + PG8_SB(b, h) + boff + n * 2048 + k * 1024); } while (0)
#define PG8_MMA(ai, bj, At, Bt) do { __builtin_amdgcn_s_setprio(1); _Pragma("unroll") for (int m = 0; m < 4; ++m) _Pragma("unroll") for (int n = 0; n < 2; ++n) _Pragma("unroll") for (int k = 0; k < 2; ++k) \
        acc[ai][bj][m][n] = __builtin_amdgcn_mfma_f32_16x16x32_bf16(Bt[n][k], At[m][k], acc[ai][bj][m][n], 0, 0, 0); __builtin_amdgcn_s_setprio(0); } while (0)
#define PG8_WAIT_V(n) asm volatile("s_waitcnt vmcnt(" #n ")" ::: "memory")
#define PG8_WAIT_L(n) asm volatile("s_waitcnt lgkmcnt(" #n ")" ::: "memory")
#define PG8_BAR __builtin_amdgcn_s_barrier()
#define PG8_SCHED __builtin_amdgcn_sched_barrier(0)
    Unit cur, nxt; int ui = 0;
    if (!S.next(0, cur)) return;
    f32x4 acc[2][2][4][2];
#pragma unroll
    for (int a = 0; a < 2; ++a)
#pragma unroll
        for (int b = 0; b < 2; ++b)
#pragma unroll
            for (int m = 0; m < 4; ++m)
#pragma unroll
                for (int n = 0; n < 2; ++n) acc[a][b][m][n] = (f32x4){0.f, 0.f, 0.f, 0.f};
    bf16x8 At[4][2], B0[2][2], B1[2][2];
    const char* cA = (const char*)g.A + (size_t)cur.pm * tstep + (size_t)cur.koff; const char* cB = (const char*)g.Bt + (size_t)cur.pn * tstep + (size_t)cur.koff;
    S.a_ready(cur);
    PG8_STAGE(PG8_SB(0, 0), cB, voffB); PG8_STAGE(PG8_SA(0, 0), cA, voffA); PG8_STAGE(PG8_SB(0, 1), cB + hstep, voffB); PG8_STAGE(PG8_SA(0, 1), cA + hstep, voffA);
    if (wr == 1) PG8_BAR;
    PG8_WAIT_V(4); PG8_BAR;
    PG8_STAGE(PG8_SB(1, 0), cB + kstep, voffB); PG8_STAGE(PG8_SA(1, 0), cA + kstep, voffA); PG8_STAGE(PG8_SB(1, 1), cB + hstep + kstep, voffB);
    PG8_WAIT_V(6); PG8_BAR;
    PG8_STAMP();
    for (;;) {
        const bool has_next = S.next(ui + 1, nxt);
        const char* nA = has_next ? (const char*)g.A + (size_t)nxt.pm * tstep + (size_t)nxt.koff : cA; const char* nB = has_next ? (const char*)g.Bt + (size_t)nxt.pn * tstep + (size_t)nxt.koff : cB;
        const int nt = cur.nt;
        for (int t = 0; t < nt; t += 2) {
            const bool last = (t == nt - 2);
            const char* a1 = cA + (size_t)(t + 1) * kstep;
            const char* a2 = last ? nA : cA + (size_t)(t + 2) * kstep; const char* b2 = last ? nB : cB + (size_t)(t + 2) * kstep;
            const char* a3 = a2 + kstep; const char* b3 = b2 + kstep;
            if (last && has_next) S.a_ready(nxt);
            PG8_LDB(B0, 0, 0); PG8_SCHED; PG8_LDA(At, 0, 0); PG8_STAGE(PG8_SA(1, 1), a1 + hstep, voffA);
            PG8_WAIT_L(8); PG8_BAR; PG8_WAIT_L(0); PG8_MMA(0, 0, At, B0); PG8_BAR; PG8_SCHED;
            PG8_LDB(B1, 0, 1); PG8_STAGE(PG8_SB(0, 0), b2, voffB);
            PG8_BAR; PG8_WAIT_L(0); PG8_MMA(0, 1, At, B1); PG8_BAR;
            PG8_LDA(At, 0, 1); PG8_STAGE(PG8_SA(0, 0), a2, voffA);
            PG8_BAR; PG8_WAIT_L(0); PG8_MMA(1, 0, At, B0); PG8_BAR; PG8_SCHED;
            PG8_STAGE(PG8_SB(0, 1), b2 + hstep, voffB);
            PG8_WAIT_V(6); PG8_BAR; PG8_MMA(1, 1, At, B1); PG8_BAR;
            PG8_LDB(B0, 1, 0); PG8_SCHED; PG8_LDA(At, 1, 0); PG8_STAGE(PG8_SA(0, 1), a2 + hstep, voffA);
            PG8_WAIT_L(8); PG8_BAR; PG8_WAIT_L(0); PG8_MMA(0, 0, At, B0); PG8_BAR; PG8_SCHED;
            PG8_LDB(B1, 1, 1); PG8_STAGE(PG8_SB(1, 0), b3, voffB);
            PG8_BAR; PG8_WAIT_L(0); PG8_MMA(0, 1, At, B1); PG8_BAR;
            PG8_LDA(At, 1, 1); PG8_STAGE(PG8_SA(1, 0), a3, voffA);
            PG8_BAR; PG8_WAIT_L(0); PG8_MMA(1, 0, At, B0); PG8_BAR; PG8_SCHED;
            PG8_STAGE(PG8_SB(1, 1), b3 + hstep, voffB);
            PG8_WAIT_V(6); PG8_BAR; PG8_MMA(1, 1, At, B1); PG8_BAR;
        }
        PG8_STAMP();
        if constexpr (!Epi::AFTER_DRAIN) { E(acc, cur, wr, wc, fr, fq); S.done(cur); }
        PG8_STAMP();
        if (!has_next) break;
#pragma unroll
        for (int a = 0; a < 2; ++a)
#pragma unroll
            for (int b = 0; b < 2; ++b)
#pragma unroll
                for (int m = 0; m < 4; ++m)
#pragma unroll
                    for (int n = 0; n < 2; ++n) acc[a][b][m][n] = (f32x4){0.f, 0.f, 0.f, 0.f};
        cur = nxt; cA = nA; cB = nB; ++ui;
    }
    PG8_WAIT_V(0);
    if (wr == 0) PG8_BAR;
    PG8_BAR;
    if constexpr (Epi::AFTER_DRAIN) { E.fused(acc, cur, wr, wc, fr, fq, lds, wid, lane); S.done(cur); }
    PG8_STAMP();
    if (STAMP && wid == 0) { stamps[lane] = lane < nts ? (((unsigned long long)(unsigned)ts_hi << 32) | (unsigned)ts_lo) : 0ull;
        if (lane == 62) stamps[62] = rt_entry; if (lane == 63) stamps[63] = (unsigned long long)wall_clock64(); }
#undef PG8_STAMP
#undef PG8_SA
#undef PG8_SB
#undef PG8_STAGE
#undef PG8_LDA
#undef PG8_LDB
#undef PG8_MMA
#undef PG8_WAIT_V
#undef PG8_WAIT_L
#undef PG8_BAR
#undef PG8_SCHED
}
}
using pg8::bf16_t; using pg8::bf16x8; using pg8::f32x4; using pg8::u32x4; using pg8::Unit; using pg8::cvt_pk_bf16;
#define LAS __attribute__((address_space(3)))
typedef unsigned u32x2 __attribute__((ext_vector_type(2)));

constexpr int DM = 1024, DFF = 2816, MP = 16384, MS = 2048, MT = 18432, INWP = 2304, ZW = 2304;
constexpr int NTILE = 288;
constexpr float EPS = 1e-6f;
constexpr float QSCALE = 0.07216878364870322f * 1.4426950408889634f;
constexpr int ZQ = 0, ZKV = 384, ZPE = 640, ZHQ = 704, ZHF = 960, ZHI = 1216, ZHG = 1472, ZCU = 1728, ZCV = 1984;
constexpr size_t SZ_WGU = 4ull * 5632 * 1024 * 2, SZ_WDN = 4ull * 1024 * 2816 * 2, SZ_WIN = 2ull * 2304 * 1024 * 2, SZ_WQ = 2ull * 1280 * 384 * 2, SZ_WMIX = 2ull * 1024 * 1536 * 2;
constexpr size_t SKEW = 69888;
constexpr size_t OFF_WGU = 0, OFF_WDN = OFF_WGU + SZ_WGU + SKEW, OFF_WIN = OFF_WDN + SZ_WDN + SKEW, OFF_WQ = OFF_WIN + SZ_WIN + SKEW, OFF_WMIX = OFF_WQ + SZ_WQ + SKEW;
constexpr size_t OFF_X = OFF_WMIX + SZ_WMIX + SKEW, SZ_X = (size_t)MT * 1024 * 4;
constexpr size_t OFF_D = OFF_X + SZ_X + SKEW, SZ_D = (size_t)MT * 1024 * 2;
constexpr size_t OFF_H = OFF_D + SZ_D + SKEW, SZ_H = (size_t)MT * 1024 * 2;
constexpr size_t OFF_ACT = OFF_H + SZ_H + SKEW, SZ_ACT = (size_t)MT * 2816 * 2;
constexpr size_t KROWS = 16384 + 32 * 2112;
constexpr size_t OFF_KC = OFF_ACT + SZ_ACT + SKEW, SZ_KC = KROWS * 640;
constexpr size_t OFF_CT = OFF_KC + SZ_KC + SKEW, SZ_CT = KROWS * 512;
constexpr size_t OFF_MIXA = OFF_CT + SZ_CT + SKEW, SZ_MIXA = (size_t)MT * 1536 * 2;
constexpr size_t OFF_SST = OFF_MIXA + SZ_MIXA + SKEW, SZ_SST = 1024ull * 4096 * 4;
constexpr size_t OFF_ROPE = OFF_SST + SZ_SST + SKEW, SZ_ROPE = 4096ull * 32 * 8;
constexpr size_t OFF_CTL = OFF_ROPE + SZ_ROPE + SKEW, SZ_CTL = 32768;
constexpr size_t OFF_BCUM = OFF_CTL + SZ_CTL + SKEW, SZ_BCUM = (size_t)MT * 256 * 4;
constexpr size_t WS_END = OFF_BCUM + SZ_BCUM;
constexpr size_t OFF_Z = OFF_ACT, SZ_Z = (size_t)MT * ZW * 2;
constexpr size_t OFF_QN = OFF_Z + SZ_Z + SKEW;
constexpr size_t OFF_Q = OFF_X + 1048576 + SKEW;
constexpr size_t OFF_U = OFF_Q + (size_t)MT * 1280 * 2 + SKEW;
constexpr size_t OFF_DEC = OFF_U + 1152ull * 4096 * 4;
static_assert(OFF_QN + (size_t)MT * 384 * 2 <= OFF_ACT + SZ_ACT, "z/qn overlay");
static_assert(OFF_DEC + 1152ull * 64 * 4 <= OFF_X + SZ_X, "Q/U overlay");
constexpr size_t O_Y = 0, O_CKVP = 18874368, O_KPEP = 27262976, O_HGP = 29360128, O_CKVS = 29491200, O_KPES = 30539776, O_HGS = 30801920, O_CMV = 31850496;

constexpr int LDS_MAIN = 157696, LDS_BYTES = LDS_MAIN + 64;
constexpr int NPHASE = 25;

struct Args { const float* in[21]; float* out; unsigned char* ws; int ph_lo, ph_hi; };
typedef const __attribute__((address_space(4))) Args CArgs;

__device__ __forceinline__ int bid_() { int b = blockIdx.x; asm volatile("" : "+s"(b)); return b; }
__device__ __forceinline__ int gdim_() { int g = gridDim.x; asm volatile("" : "+s"(g)); return g; }
__device__ __forceinline__ float bf2f(unsigned short b) { return __uint_as_float(((unsigned)b) << 16); }
__device__ __forceinline__ float bflo(unsigned w) { return __uint_as_float(w << 16); }
__device__ __forceinline__ float bfhi(unsigned w) { return __uint_as_float(w & 0xffff0000u); }
__device__ __forceinline__ unsigned short f2bf(float f) { unsigned u = __float_as_uint(f); u += 0x7FFFu + ((u >> 16) & 1u); return (unsigned short)(u >> 16); }
__device__ __forceinline__ float wave_sum(float v) {
#pragma unroll
    for (int o = 32; o >= 1; o >>= 1) v += __shfl_xor(v, o);
    return v; }
__device__ __forceinline__ float sigmoidf_(float x) { return __builtin_amdgcn_rcpf(1.0f + __expf(-x)); }
__device__ __forceinline__ float siluf_(float x) { return x * sigmoidf_(x); }
__device__ __forceinline__ float geluf_(float x) { const float y = 0.7978845608028654f * (x + 0.044715f * x * x * x); return x - x * __builtin_amdgcn_rcpf(__expf(2.0f * y) + 1.0f); }

struct EpiBf {
    static constexpr bool PERM = true, AFTER_DRAIN = false;
    bf16_t* O; int ldc; bf16_t* O1;
    __device__ __forceinline__ void operator()(const f32x4 (&acc)[2][2][4][2], const Unit& u, int wr, int wc, int fr, int fq) const {
        const int row0 = u.pm * 256 + wr * 64 + fr, col0 = u.pn * 256 + wc * 32 + 8 * fq; bf16_t* Ob = (O1 && u.ks >= 0) ? O1 + ((long)u.ks * MS - MP) * (long)ldc : O;
#pragma unroll
        for (int ai = 0; ai < 2; ++ai)
#pragma unroll
            for (int m = 0; m < 4; ++m) { bf16_t* rowp = Ob + (size_t)(row0 + ai * 128 + m * 16) * ldc + col0;
#pragma unroll
                for (int bj = 0; bj < 2; ++bj) { const f32x4 v0 = acc[ai][bj][m][0], v1 = acc[ai][bj][m][1];
                    u32x4 w; w.x = cvt_pk_bf16(v0[0], v0[1]); w.y = cvt_pk_bf16(v0[2], v0[3]); w.z = cvt_pk_bf16(v1[0], v1[1]); w.w = cvt_pk_bf16(v1[2], v1[3]);
                    *(u32x4*)(rowp + bj * 128) = w; } }
    }
};
struct EpiSwiGLU {
    static constexpr bool PERM = true, AFTER_DRAIN = false;
    bf16_t* O;
    __device__ __forceinline__ void operator()(const f32x4 (&acc)[2][2][4][2], const Unit& u, int wr, int wc, int fr, int fq) const {
        const int row0 = u.pm * 256 + wr * 64 + fr, col0 = u.pn * 128 + wc * 32 + 8 * fq;
#pragma unroll
        for (int ai = 0; ai < 2; ++ai)
#pragma unroll
            for (int m = 0; m < 4; ++m) { bf16_t* rowp = O + (size_t)(row0 + ai * 128 + m * 16) * DFF + col0;
                const f32x4 g0 = acc[ai][0][m][0], g1 = acc[ai][0][m][1], u0 = acc[ai][1][m][0], u1 = acc[ai][1][m][1];
                u32x4 w; w.x = cvt_pk_bf16(siluf_(g0[0]) * u0[0], siluf_(g0[1]) * u0[1]); w.y = cvt_pk_bf16(siluf_(g0[2]) * u0[2], siluf_(g0[3]) * u0[3]);
                w.z = cvt_pk_bf16(siluf_(g1[0]) * u1[0], siluf_(g1[1]) * u1[1]); w.w = cvt_pk_bf16(siluf_(g1[2]) * u1[2], siluf_(g1[3]) * u1[3]);
                *(u32x4*)rowp = w; }
    }
};
struct EpiQ {
    static constexpr bool PERM = true, AFTER_DRAIN = false;
    bf16_t* Q;
    __device__ __forceinline__ void operator()(const f32x4 (&acc)[2][2][4][2], const Unit& u, int wr, int wc, int fr, int fq) const {
        const int row0 = u.pm * 256 + wr * 64 + fr;
        const int off0 = u.pn < 4 ? u.pn * 320 + wc * 32 + 8 * fq : wc * 320 + 256 + 8 * fq, bjs = u.pn < 4 ? 128 : 32;
#pragma unroll
        for (int ai = 0; ai < 2; ++ai)
#pragma unroll
            for (int m = 0; m < 4; ++m) { bf16_t* rowp = Q + (size_t)(row0 + ai * 128 + m * 16) * 1280 + off0;
#pragma unroll
                for (int bj = 0; bj < 2; ++bj) { const f32x4 v0 = acc[ai][bj][m][0], v1 = acc[ai][bj][m][1];
                    u32x4 w; w.x = cvt_pk_bf16(v0[0], v0[1]); w.y = cvt_pk_bf16(v0[2], v0[3]); w.z = cvt_pk_bf16(v1[0], v1[1]); w.w = cvt_pk_bf16(v1[2], v1[3]);
                    *(u32x4*)(rowp + bj * bjs) = w; } }
    }
};
struct TailSplitOrder {
    int G, c, nsp, nt_full, nt_sub, kb_sub;
    __device__ bool next(int i, Unit& u) const {
        const int L = i * G + c;
        if (L < 256) { const int off = L >> 3; u.pm = (L & 7) * 8 + (off >> 2); u.pn = off & 3; u.ks = -1; u.nt = nt_full; u.koff = 0; return true; }
        const int s2 = L - 256; if (s2 >= 32 * nsp) return false;
        const int pair = s2 & 31; u.pm = 64 + (pair >> 2); u.pn = pair & 3; u.ks = s2 >> 5; u.nt = nt_sub; u.koff = u.ks * kb_sub; return true;
    }
    __device__ __forceinline__ void a_ready(const Unit&) const {}
    __device__ __forceinline__ void done(const Unit&) const {}
};
template <class Epi> __device__ __forceinline__ void run_gemm(unsigned char* lds, const bf16_t* A, const bf16_t* Bt, int M, int N, int K, const Epi& E, int nsp = 0  ) {
    pg8::Gemm g{A, Bt, M, N, K, K};
    if (nsp) { TailSplitOrder S; S.G = gdim_(); S.c = bid_(); S.nsp = nsp; S.nt_full = K / 64; S.nt_sub = K / nsp / 64; S.kb_sub = K / nsp * 2; pg8::gemm_phase<Epi, TailSplitOrder, false>((PG8_LAS unsigned char*)lds, g, S, E, nullptr); }
    else { pg8::StaticOrder S; S.init(M, N, gdim_(), bid_(), 1); S.unt = K / 64; S.ukb = K * 2; pg8::gemm_phase<Epi, pg8::StaticOrder, false>((PG8_LAS unsigned char*)lds, g, S, E, nullptr); }
}
#define GAS __attribute__((address_space(1)))
#define XB_TMO      128
#define XB_XCNT(j)  (256  + 64 * (j))
#define XB_XSUB(j)  (1280 + 64 * (j))
#define XB_XGEN(j)  (2304 + 64 * (j))
#define XB_TOP      3328
#define XB_TOPGEN   3392
#define XCD_BAR_WORDS 3456
#define XB_SPIN_CAP (1u << 18)

__device__ __forceinline__ unsigned xb_ld(unsigned* p)              { return __hip_atomic_load(p, __ATOMIC_RELAXED, __HIP_MEMORY_SCOPE_AGENT); }
__device__ __forceinline__ unsigned xb_add(unsigned* p, unsigned v) { return __hip_atomic_fetch_add(p, v, __ATOMIC_RELAXED, __HIP_MEMORY_SCOPE_AGENT); }
__device__ __forceinline__ unsigned xb_xcc_id() { return (unsigned)__builtin_amdgcn_s_getreg((3 << 11) | 20) & 0xFu; }
#define XB_SPIN(cond, bar) do { unsigned _sp = 0; while (cond) { __builtin_amdgcn_s_sleep(1); \
    if ((++_sp & 255u) == 0u) { if (xb_ld(&(bar)[XB_TMO])) break; if (_sp > XB_SPIN_CAP) { atomicAdd(&(bar)[XB_TMO], 1u); break; } } } } while (0)

struct XcdBarrier {
    unsigned* bar; unsigned x;
    volatile LAS unsigned* st;
};

__device__ __forceinline__ XcdBarrier xcd_barrier_post(unsigned* bar, volatile LAS unsigned* st) {
    XcdBarrier b; b.bar = bar; b.x = xb_xcc_id(); b.st = st;
    if (threadIdx.x == 0) (void)xb_add(&bar[XB_XCNT(b.x)], 1u);
    return b;
}
__device__ __forceinline__ void xcd_barrier_complete(unsigned* bar, unsigned x, unsigned& nloc, unsigned& nx) {
    const unsigned G = gridDim.x * gridDim.y * gridDim.z;
    unsigned sum, cnt, mine, sp = 0u;
    for (;;) {
        sum = 0u; cnt = 0u; mine = 0u;
#pragma unroll
        for (unsigned j = 0; j < 16; ++j) { const unsigned c = xb_ld(&bar[XB_XCNT(j)]); sum += c; cnt += (c > 0u) ? 1u : 0u; mine = (j == x) ? c : mine; }
        if (sum == G) break;
        __builtin_amdgcn_s_sleep(1);
        if ((++sp & 255u) == 0u) { if (xb_ld(&bar[XB_TMO])) break; if (sp > XB_SPIN_CAP) { atomicAdd(&bar[XB_TMO], 1u); break; } }
    }
    nloc = mine > 0u ? mine : 1u; nx = cnt > 0u ? cnt : 1u;
}

__device__ __forceinline__ void xcd_barrier(const XcdBarrier& b) {
    asm volatile("s_waitcnt vmcnt(0)" ::: "memory");
    __syncthreads();
    if (threadIdx.x == 0) {
        unsigned* bar = b.bar; asm volatile("" : "+s"(bar));
        __builtin_amdgcn_s_waitcnt(0);
        unsigned nloc = b.st[0], nx = b.st[1];
        if (nloc == 0u) { xcd_barrier_complete(bar, b.x, nloc, nx); b.st[0] = nloc; b.st[1] = nx; }
        const unsigned old = xb_add(&bar[XB_XSUB(b.x)], 1u);
        const unsigned gen = old / nloc;
        if (old + 1u == (gen + 1u) * nloc) {
            __builtin_amdgcn_fence(__ATOMIC_RELEASE, "agent");
            asm volatile("s_waitcnt vmcnt(0)" ::: "memory");
            const unsigned og = xb_add(&bar[XB_TOP], 1u);
            const unsigned tg = og / nx;
            if (og + 1u == (tg + 1u) * nx) xb_add(&bar[XB_TOPGEN], 1u);
            else XB_SPIN(xb_ld(&bar[XB_TOPGEN]) == tg, bar);
            __builtin_amdgcn_fence(__ATOMIC_ACQUIRE, "agent");
            xb_add(&bar[XB_XGEN(b.x)], 1u);
            asm volatile("s_waitcnt vmcnt(0)" ::: "memory");
        } else {
            XB_SPIN(xb_ld(&bar[XB_XGEN(b.x)]) == gen, bar);
            __builtin_amdgcn_fence(__ATOMIC_ACQUIRE, "agent");
            asm volatile("s_waitcnt vmcnt(0)" ::: "memory");
        }
    }
    __syncthreads();
}
__device__ __forceinline__ void tr_tile(const float* __restrict__ src, int srcN, bf16_t* __restrict__ dst, int dstK, int k0, int n0, int mode, float* T) {
    int tid = threadIdx.x; asm volatile("" : "+v"(tid));
    float4 v[4];
#pragma unroll
    for (int e = 0; e < 4; ++e) { const int idx = tid + 512 * e, kk = idx >> 4, n4 = idx & 15; { const f32x4 q4 = __builtin_nontemporal_load((const f32x4*)(src + (size_t)(k0 + kk) * srcN + n0 + 4 * n4)); v[e] = make_float4(q4[0], q4[1], q4[2], q4[3]); } }
#pragma unroll
    for (int e = 0; e < 4; ++e) { const int idx = tid + 512 * e, kk = idx >> 4, n4 = idx & 15; float* t = T + kk * 65 + 4 * n4; t[0] = v[e].x; t[1] = v[e].y; t[2] = v[e].z; t[3] = v[e].w; }
    __syncthreads();
#pragma unroll
    for (int e = 0; e < 2; ++e) { const int idx = tid + 512 * e, nn = idx >> 4, kq = idx & 15; const int n = n0 + nn;
        const int row = mode == 0 ? n : ((n >> 7) * 256 + (n & 127) + (mode == 2 ? 128 : 0)); const float* t = T + (8 * kq) * 65 + nn;
        u32x4 w; w.x = cvt_pk_bf16(t[0], t[65]); w.y = cvt_pk_bf16(t[130], t[195]); w.z = cvt_pk_bf16(t[260], t[325]); w.w = cvt_pk_bf16(t[390], t[455]);
        *(u32x4*)(dst + (size_t)row * dstK + k0 + 8 * kq) = w; }
    __syncthreads();
}
__device__ __forceinline__ void tr_task(const float* src, int srcN, int K, bf16_t* dst, int dstK, int mode, float* T) {
    const int tn = srcN >> 6, nt = (K >> 7) * tn;
    for (int t = bid_(); t < nt; t += gdim_()) tr_tile(src, srcN, dst, dstK, (t / tn) * 128, (t % tn) * 64, mode, T);
}
template <bool XIN_F32, bool XOUT_F32>
__device__ __forceinline__ void ew_phase(const bf16_t* __restrict__ D, const bf16_t* D1  , int nsp, const void* xa  , const float* __restrict__ xb  , void* xout  ,
                                         const float* __restrict__ gpost, float coef, const float* __restrict__ gpre, bf16_t* hout, const float* __restrict__ gin, float* rsb  ) {
    int tid = threadIdx.x; asm volatile("" : "+v"(tid)); const int lane = tid & 63, wave = tid >> 6;
    const int rstep = gdim_() * 8;
    for (int rb = bid_() * 8 + wave; rb < MT; rb += 2 * rstep) {
        float4 xv[2][4]; float dv[2][4][4];
#pragma unroll
        for (int u = 0; u < 2; ++u) { const int r = rb + u * rstep; if (r < MT) {
            if (XIN_F32) { const float* xr = (xb && r >= MP) ? xb + (size_t)(r - MP) * DM : (const float*)xa + (size_t)r * DM;
#pragma unroll
                for (int i = 0; i < 4; ++i) { const f32x4 q4 = __builtin_nontemporal_load((const f32x4*)(xr + lane * 4 + 256 * i)); xv[u][i] = make_float4(q4[0], q4[1], q4[2], q4[3]); } }
            else {
#pragma unroll
                for (int i = 0; i < 4; ++i) { const u32x2 w = __builtin_nontemporal_load((const u32x2*)((const bf16_t*)xa + (size_t)r * DM + lane * 4 + 256 * i)); xv[u][i] = make_float4(bflo(w.x), bfhi(w.x), bflo(w.y), bfhi(w.y)); }
                const float ir = __builtin_amdgcn_rcpf(rsb[r]);
#pragma unroll
                for (int i = 0; i < 4; ++i) { const float4 gi = *(const float4*)(gin + lane * 4 + 256 * i);
                    xv[u][i].x *= ir * __builtin_amdgcn_rcpf(gi.x); xv[u][i].y *= ir * __builtin_amdgcn_rcpf(gi.y); xv[u][i].z *= ir * __builtin_amdgcn_rcpf(gi.z); xv[u][i].w *= ir * __builtin_amdgcn_rcpf(gi.w); } }
            if (D) {
#pragma unroll
                for (int i = 0; i < 4; ++i) { const u32x2 w = __builtin_nontemporal_load((const u32x2*)(D + (size_t)r * DM + lane * 4 + 256 * i)); dv[u][i][0] = bflo(w.x); dv[u][i][1] = bfhi(w.x); dv[u][i][2] = bflo(w.y); dv[u][i][3] = bfhi(w.y);
                    } } } }
        if (D1) {
#pragma unroll
            for (int u = 0; u < 2; ++u) { const int r = rb + u * rstep; if (r >= MP && r < MT) {
#pragma unroll
                for (int i = 0; i < 4; ++i) { dv[u][i][0] = 0.f; dv[u][i][1] = 0.f; dv[u][i][2] = 0.f; dv[u][i][3] = 0.f; }
                for (int ks = 0; ks < nsp; ++ks) {
#pragma unroll
                    for (int i = 0; i < 4; ++i) { const u32x2 w1 = __builtin_nontemporal_load((const u32x2*)(D1 + ((size_t)ks * MS + (r - MP)) * DM + lane * 4 + 256 * i)); dv[u][i][0] += bflo(w1.x); dv[u][i][1] += bfhi(w1.x); dv[u][i][2] += bflo(w1.y); dv[u][i][3] += bfhi(w1.y); } } } } }
#pragma unroll
        for (int u = 0; u < 2; ++u) { const int r = rb + u * rstep; if (r < MT) {
            if (D) { float ss = 0.f;
#pragma unroll
                for (int i = 0; i < 4; ++i) ss += dv[u][i][0] * dv[u][i][0] + dv[u][i][1] * dv[u][i][1] + dv[u][i][2] * dv[u][i][2] + dv[u][i][3] * dv[u][i][3];
                ss = wave_sum(ss); const float rs = coef * rsqrtf(ss * (1.0f / 1024.0f) + EPS);
#pragma unroll
                for (int i = 0; i < 4; ++i) { const float4 g = *(const float4*)(gpost + lane * 4 + 256 * i);
                    xv[u][i].x += dv[u][i][0] * rs * g.x; xv[u][i].y += dv[u][i][1] * rs * g.y; xv[u][i].z += dv[u][i][2] * rs * g.z; xv[u][i].w += dv[u][i][3] * rs * g.w; } }
            if (XOUT_F32) {
#pragma unroll
                for (int i = 0; i < 4; ++i) __builtin_nontemporal_store((f32x4){xv[u][i].x, xv[u][i].y, xv[u][i].z, xv[u][i].w}, (f32x4*)((float*)xout + (size_t)r * DM + lane * 4 + 256 * i)); }

            if (hout) { float ss = 0.f;
#pragma unroll
                for (int i = 0; i < 4; ++i) ss += xv[u][i].x * xv[u][i].x + xv[u][i].y * xv[u][i].y + xv[u][i].z * xv[u][i].z + xv[u][i].w * xv[u][i].w;
                ss = wave_sum(ss); const float rs = rsqrtf(ss * (1.0f / 1024.0f) + EPS); if (lane == 0) rsb[r] = rs;
#pragma unroll
                for (int i = 0; i < 4; ++i) { const float4 g = *(const float4*)(gpre + lane * 4 + 256 * i); uint2 w;
                    w.x = cvt_pk_bf16(xv[u][i].x * rs * g.x, xv[u][i].y * rs * g.y); w.y = cvt_pk_bf16(xv[u][i].z * rs * g.z, xv[u][i].w * rs * g.w);
                    *(uint2*)(hout + (size_t)r * DM + lane * 4 + 256 * i) = w; } } } }
    }
}
__device__ __forceinline__ int wtask_count(int kind) { return kind < 6 ? 352 : kind == 6 ? 281 : kind == 7 ? 64 : kind == 8 ? 256 : kind == 9 ? 96 : 192; }
__device__ void wtask_run(CArgs& a, int l, int kind, int t, unsigned char* lds) {
    unsigned char* ws = a.ws; float* T = (float*)lds; int tid = threadIdx.x; asm volatile("" : "+v"(tid));
    if (kind < 6) { const int f = kind / 3, m = kind % 3; const size_t lf = (size_t)(l * 2 + f);
        if (m < 2) tr_tile(a.in[6 + m] + lf * 1024 * 2816, 2816, (bf16_t*)(ws + OFF_WGU) + lf * 5632 * 1024, 1024, (t / 44) * 128, (t % 44) * 64, 1 + m, T);
        else tr_tile(a.in[8] + lf * 2816 * 1024, 1024, (bf16_t*)(ws + OFF_WDN) + lf * 1024 * 2816, 2816, (t / 16) * 128, (t % 16) * 64, 0, T);
    } else if (kind == 6) { bf16_t* win = (bf16_t*)(ws + OFF_WIN) + (size_t)l * 2304 * 1024;
        if (t < 280) tr_tile(a.in[9] + (size_t)l * 1024 * 2240, 2240, win, 1024, (t / 35) * 128, (t % 35) * 64, 0, T);
        else { for (int i = tid; i < 64 * 1024 / 2; i += 512) ((unsigned*)(win + 2240 * 1024))[i] = 0u; }
    } else if (kind == 7) { bf16_t* wmix = (bf16_t*)(ws + OFF_WMIX) + (size_t)l * 1024 * 1536;
        tr_tile(a.in[10] + (size_t)l * 1024 * 1024 + 512 * 1024, 1024, wmix + 1024, 1536, (t / 16) * 128, (t % 16) * 64, 0, T);
    } else if (kind == 8) {
        bf16_t* wmix = (bf16_t*)(ws + OFF_WMIX) + (size_t)l * 1024 * 1536; const float* wuv = a.in[15] + (size_t)l * 256 * 512; const float* wo = a.in[10] + (size_t)l * 1024 * 1024;
        const int i = t * 512 + tid; const int n = i & 1023, hcb = t >> 1, h = hcb >> 5, cb = hcb & 31;
        float* W = T;
        __syncthreads();
#pragma unroll
        for (int e = 0; e < 2; ++e) { const int q = tid + 512 * e, j = q >> 7, v = q & 127; W[v * 8 + j] = wuv[((8 * cb + j) * 4 + h) * 128 + v]; }
        __syncthreads();
        const float* bv = wo + (size_t)(h * 128) * 1024 + n; float acc[8];
#pragma unroll
        for (int j = 0; j < 8; ++j) acc[j] = 0.f;
#pragma unroll 1
        for (int v0 = 0; v0 < 128; v0 += 16) { float bb[16];
#pragma unroll
            for (int u = 0; u < 16; ++u) bb[u] = bv[(size_t)(v0 + u) * 1024];
#pragma unroll
            for (int u = 0; u < 16; ++u) { const float4 w0 = *(const float4*)(W + (v0 + u) * 8), w1 = *(const float4*)(W + (v0 + u) * 8 + 4);
                acc[0] += w0.x * bb[u]; acc[1] += w0.y * bb[u]; acc[2] += w0.z * bb[u]; acc[3] += w0.w * bb[u]; acc[4] += w1.x * bb[u]; acc[5] += w1.y * bb[u]; acc[6] += w1.z * bb[u]; acc[7] += w1.w * bb[u]; } }
        u32x4 w; w.x = cvt_pk_bf16(acc[0], acc[1]); w.y = cvt_pk_bf16(acc[2], acc[3]); w.z = cvt_pk_bf16(acc[4], acc[5]); w.w = cvt_pk_bf16(acc[6], acc[7]);
        *(u32x4*)(wmix + (size_t)n * 1536 + h * 256 + 8 * cb) = w;
        __syncthreads();
    } else { bf16_t* wq = (bf16_t*)(ws + OFF_WQ) + (size_t)l * 1280 * 384; const float* wuk = a.in[14] + (size_t)l * 256 * 512; const float* wqb = a.in[12] + (size_t)l * 384 * 768;
        const int i = t * 512 + tid;
        if (kind == 9) {
            const int k = i % 384, hcb = i / 384, h = hcb >> 5, cb = hcb & 31;
            const float4* bv = (const float4*)(wqb + (size_t)k * 768 + h * 192); float acc[8];
#pragma unroll
            for (int j = 0; j < 8; ++j) acc[j] = 0.f;
#pragma unroll 2
            for (int v = 0; v < 32; ++v) { const float4 y = bv[v];
#pragma unroll
                for (int j = 0; j < 8; ++j) { const float4 x = *(const float4*)(wuk + ((8 * cb + j) * 4 + h) * 128 + 4 * v); acc[j] += x.x * y.x + x.y * y.y + x.z * y.z + x.w * y.w; } }
#pragma unroll
            for (int j = 0; j < 8; ++j) wq[(size_t)(h * 256 + 8 * cb + j) * 384 + k] = f2bf(acc[j] * QSCALE);
        } else {
            const int k = i % 384, j = i / 384, half = j >> 7, jj = j & 127, h = jj >> 5, fi = jj & 31;
            wq[(size_t)(1024 + j) * 384 + k] = f2bf(wqb[(size_t)k * 768 + h * 192 + 128 + half * 32 + fi] * QSCALE); }
    }
}
__device__ void wtasks(CArgs& a, int l, int k0, int k1, int cw, unsigned char* lds) {
    unsigned* ctr = (unsigned*)(a.ws + OFF_CTL) + cw; LAS unsigned* slot = (LAS unsigned*)(lds + LDS_MAIN + 16);
    int total = 0; for (int k = k0; k < k1; ++k) total += wtask_count(k);
    for (;;) {
        __syncthreads();
        { int t0 = threadIdx.x; asm volatile("" : "+v"(t0)); if (t0 == 0) *slot = atomicAdd(ctr, 1u); }
        __syncthreads();
        int it = (int)*slot;
        if (it >= total) break;
        int k = k0; while (it >= wtask_count(k)) { it -= wtask_count(k); ++k; }
        wtask_run(a, l, k, it, lds);
    }
}
__device__ void phase_init(CArgs& a, unsigned char* lds) {
    unsigned char* ws = a.ws;
    int tid = threadIdx.x; asm volatile("" : "+v"(tid)); const size_t gtid = (size_t)bid_() * 512 + tid, gsz = (size_t)gdim_() * 512;
    for (size_t i = gtid; i < 4096 * 32; i += gsz) { const int pos = (int)(i >> 5), fi = (int)(i & 31);
        const float w = exp2f(-(float)fi * (13.287712379549449f / 32.0f)); const double ang = (double)((float)pos * w);
        const double k = rint(ang * 0.15915494309189535); const float rr = (float)(ang - k * 6.283185307179586);
        ((float2*)(ws + OFF_ROPE))[i] = make_float2(__cosf(rr), __sinf(rr)); }
    wtasks(a, 0, 0, 3, 256, lds); wtasks(a, 0, 6, 7, 272, lds);
    ew_phase<true, false>(nullptr, nullptr, 0, a.in[0], a.in[1], nullptr, nullptr, 0.f, a.in[5], (bf16_t*)(ws + OFF_H), nullptr, (float*)(ws + OFF_X));
}
__device__ void tail_wtasks(CArgs& a, int ph, unsigned char* lds) {
    switch (ph) {
    case 1:  wtasks(a, 0, 10, 11, 257, lds); wtasks(a, 0, 7, 8, 258, lds); break;
    case 2:  wtasks(a, 0, 3, 4, 259, lds); break;
    case 4:  wtasks(a, 0, 9, 10, 260, lds); wtasks(a, 0, 4, 5, 261, lds); break;
    case 6:  wtasks(a, 0, 8, 9, 262, lds); break;
    case 8:  wtasks(a, 0, 5, 6, 263, lds); break;
    case 10: wtasks(a, 1, 0, 3, 264, lds); wtasks(a, 1, 6, 7, 265, lds); wtasks(a, 1, 9, 10, 266, lds); break;
    case 11: wtasks(a, 1, 10, 11, 267, lds); wtasks(a, 1, 7, 8, 268, lds); break;
    case 14: wtasks(a, 1, 3, 4, 269, lds); break;
    case 16: wtasks(a, 1, 4, 6, 270, lds); break;
    case 18: wtasks(a, 1, 8, 9, 271, lds); break;
    default: break; }
}
__device__ __forceinline__ int keyof32(int p) { const int g = p >> 3, j = p & 7; return j < 4 ? 4 * g + j : 16 + 4 * g + (j - 4); }
__device__ __forceinline__ void ct_write(const bf16_t* ctile, bf16_t* dst  , size_t rowstride) {
    int tid = threadIdx.x; asm volatile("" : "+v"(tid)); const int c = tid >> 1, half = tid & 1;
    unsigned w[16];
#pragma unroll
    for (int p = 0; p < 32; p += 2) { const int t0 = 32 * half + keyof32(p), t1 = 32 * half + keyof32(p + 1);
        w[p >> 1] = (unsigned)ctile[t0 * 264 + c] | ((unsigned)ctile[t1 * 264 + c] << 16); }
    uint4* d = (uint4*)(dst + (size_t)c * rowstride + 32 * half);
#pragma unroll
    for (int i = 0; i < 4; ++i) d[i] = make_uint4(w[4 * i], w[4 * i + 1], w[4 * i + 2], w[4 * i + 3]);
}
__device__ __forceinline__ float lb_of(CArgs& a, int l, int e) { if (l == 0) return 0.f; const float a0 = a.in[16][e], a1 = a.in[16][256 + e]; return 1.0f / (1.0f + __expf(a0 - a1)); }
__device__ void prep_mla_tile(CArgs& a, int l, int T, unsigned char* lds) {
    unsigned char* ws = a.ws; int tid = threadIdx.x; asm volatile("" : "+v"(tid)); const int lane = tid & 63, wave = tid >> 6;
    const bf16_t* z = (const bf16_t*)(ws + OFF_Z); const int r0 = T * 64;
    const bool prm = T < 256; const int b = prm ? (T >> 6) : (T - 256), j = prm ? (T & 63) : 0; const int pos0 = prm ? j * 64 : 2048;
    bf16_t* kc = (bf16_t*)(ws + OFF_KC) + (prm ? (size_t)(b * 4096 + j * 64) : (size_t)16384 + (size_t)b * 2112 + 2048) * 320;
    bf16_t* ct = (bf16_t*)(ws + OFF_CT) + (prm ? (size_t)b * 256 * 4096 + j * 64 : (size_t)16384 * 256 + (size_t)b * 256 * 2112 + 2048);
    const size_t ctstride = prm ? 4096 : 2112;
    float* ockv = a.out + (prm ? O_CKVP + ((size_t)(l * 4 + b) * 4096 + j * 64) * 256 : O_CKVS + ((size_t)(l * 32 + b) * 64) * 256);
    float* okpe = a.out + (prm ? O_KPEP + ((size_t)(l * 4 + b) * 4096 + j * 64) * 64 : O_KPES + ((size_t)(l * 32 + b) * 64) * 64);
    bf16_t* qn = (bf16_t*)(ws + OFF_QN); const float* qag = a.in[11] + l * 384; const float* kvg = a.in[13] + l * 256;
    const float2* rope = (const float2*)(ws + OFF_ROPE);
    bf16_t* ctile = (bf16_t*)lds;
    float qg[6];
#pragma unroll
    for (int i = 0; i < 3; ++i) { qg[2 * i] = qag[2 * lane + 128 * i]; qg[2 * i + 1] = qag[2 * lane + 128 * i + 1]; }
    const float4 g4 = *(const float4*)(kvg + 4 * lane);
#pragma unroll 1
    for (int tb = 0; tb < 8; tb += 4) {
        unsigned wq[4][3]; uint2 wk[4]; bf16_t p1[4], p2[4];
#pragma unroll
        for (int u = 0; u < 4; ++u) { const bf16_t* zr = z + (size_t)(r0 + wave + 8 * (tb + u)) * ZW;
#pragma unroll
            for (int i = 0; i < 3; ++i) wq[u][i] = *(const unsigned*)(zr + ZQ + 2 * lane + 128 * i);
            wk[u] = *(const uint2*)(zr + ZKV + 4 * lane); p1[u] = zr[ZPE + (lane & 31)]; p2[u] = zr[ZPE + 32 + (lane & 31)]; }
#pragma unroll
        for (int u = 0; u < 4; ++u) { const int t = wave + 8 * (tb + u);
            { float v[6]; float ss = 0.f;
#pragma unroll
              for (int i = 0; i < 3; ++i) { v[2 * i] = bflo(wq[u][i]); v[2 * i + 1] = bfhi(wq[u][i]); ss += v[2 * i] * v[2 * i] + v[2 * i + 1] * v[2 * i + 1]; }
              ss = wave_sum(ss); const float rs = rsqrtf(ss * (1.0f / 384.0f) + EPS);
#pragma unroll
              for (int i = 0; i < 3; ++i) *(unsigned*)(qn + (size_t)(r0 + t) * 384 + 2 * lane + 128 * i) = cvt_pk_bf16(v[2 * i] * rs * qg[2 * i], v[2 * i + 1] * rs * qg[2 * i + 1]); }
            { float v0 = bflo(wk[u].x), v1 = bfhi(wk[u].x), v2 = bflo(wk[u].y), v3 = bfhi(wk[u].y);
              const float ss = wave_sum(v0 * v0 + v1 * v1 + v2 * v2 + v3 * v3); const float rs = rsqrtf(ss * (1.0f / 256.0f) + EPS);
              v0 *= rs * g4.x; v1 *= rs * g4.y; v2 *= rs * g4.z; v3 *= rs * g4.w;
              __builtin_nontemporal_store((f32x4){v0, v1, v2, v3}, (f32x4*)(ockv + (size_t)t * 256 + 4 * lane));
              uint2 o; o.x = cvt_pk_bf16(v0, v1); o.y = cvt_pk_bf16(v2, v3);
              *(uint2*)(kc + (size_t)t * 320 + 4 * lane) = o; *(uint2*)(ctile + t * 264 + 4 * lane) = o; }
            if (lane < 32) { const float x1 = bf2f(p1[u]), x2 = bf2f(p2[u]); const float2 cs = rope[(pos0 + t) * 32 + lane];
              const float o1 = x1 * cs.x - x2 * cs.y, o2 = x2 * cs.x + x1 * cs.y;
              okpe[(size_t)t * 64 + lane] = o1; okpe[(size_t)t * 64 + 32 + lane] = o2; kc[(size_t)t * 320 + 256 + lane] = f2bf(o1); kc[(size_t)t * 320 + 288 + lane] = f2bf(o2); } }
    }
    __syncthreads();
    ct_write(ctile, ct, ctstride);
    __syncthreads();
}
__device__ void prep_hgrn_tile(CArgs& a, int l, int T, unsigned char* lds) {
    unsigned char* ws = a.ws; int tid = threadIdx.x; asm volatile("" : "+v"(tid)); asm volatile("" : "+s"(l));
    const bf16_t* z = (const bf16_t*)(ws + OFF_Z); const int r0 = T * 64;
    float* lf = (float*)lds; float* vt = (float*)(lds + 65536); float* tot = (float*)(lds + 131072);
    const int ep = tid & 255, hf = tid >> 8; const float lbv = lb_of(a, l, ep);
    bf16_t zfr[32]; float pref[32];
    { bf16_t zvr[32];
#pragma unroll
      for (int i = 0; i < 32; ++i) { const bf16_t* zr = z + (size_t)(r0 + 32 * hf + i) * ZW; zfr[i] = zr[ZHF + ep]; zvr[i] = zr[ZHI + ep]; }
      float run = 0.f;
#pragma unroll
      for (int i = 0; i < 32; ++i) { const float f = lbv + (1.0f - lbv) * sigmoidf_(bf2f(zfr[i])); run += __logf(fmaxf(f, 1e-30f)); pref[i] = run; vt[(32 * hf + i) * 256 + ep] = bf2f(zvr[i]); }
      tot[hf * 256 + ep] = run; }
    __syncthreads();
    { const float t0 = tot[ep], bl = t0 + tot[256 + ep], off = hf ? t0 : 0.f;
#pragma unroll
      for (int i = 0; i < 32; ++i) { lf[(32 * hf + i) * 256 + ep] = (1.0f - lbv) * sigmoidf_(-bf2f(zfr[i])) * __expf(bl - pref[i] - off); ((float*)(ws + OFF_BCUM))[(size_t)(r0 + 32 * hf + i) * 256 + ep] = pref[i] + off; }
      if (hf == 0) ((float*)(ws + OFF_DEC))[T * 256 + ep] = __expf(bl); }
    __syncthreads();
    { const int h = tid >> 7, eb = (tid & 127) >> 3, db = tid & 7; float acc[4][8];
#pragma unroll
      for (int i = 0; i < 4; ++i)
#pragma unroll
          for (int jj = 0; jj < 8; ++jj) acc[i][jj] = 0.f;
#pragma unroll 4
      for (int s = 0; s < 64; ++s) { const float4 kv = *(const float4*)(lf + s * 256 + h * 64 + eb * 4); const float4 v0 = *(const float4*)(vt + s * 256 + h * 64 + db * 8), v1 = *(const float4*)(vt + s * 256 + h * 64 + db * 8 + 4);
          const float kk[4] = {kv.x, kv.y, kv.z, kv.w}; const float vv[8] = {v0.x, v0.y, v0.z, v0.w, v1.x, v1.y, v1.z, v1.w};
#pragma unroll
          for (int i = 0; i < 4; ++i)
#pragma unroll
              for (int jj = 0; jj < 8; ++jj) acc[i][jj] += kk[i] * vv[jj]; }
      float* U = (float*)(ws + OFF_U) + (size_t)(T * 4 + h) * 4096;
#pragma unroll
      for (int i = 0; i < 4; ++i) { *(float4*)(U + (eb * 4 + i) * 64 + db * 8) = make_float4(acc[i][0], acc[i][1], acc[i][2], acc[i][3]); *(float4*)(U + (eb * 4 + i) * 64 + db * 8 + 4) = make_float4(acc[i][4], acc[i][5], acc[i][6], acc[i][7]); } }
    __syncthreads();
}
__device__ void prep_cache_tile(CArgs& a, int l, int P, unsigned char* lds) {
    unsigned char* ws = a.ws; int tid = threadIdx.x; asm volatile("" : "+v"(tid)); const int b = P >> 5, kt = P & 31;
    const float* ckv = a.in[2] + ((size_t)(l * 32 + b) * 2048 + kt * 64) * 256; const float* kpe = a.in[3] + ((size_t)(l * 32 + b) * 2048 + kt * 64) * 64;
    bf16_t* kc = (bf16_t*)(ws + OFF_KC) + ((size_t)16384 + (size_t)b * 2112 + kt * 64) * 320;
    bf16_t* ct = (bf16_t*)(ws + OFF_CT) + (size_t)16384 * 256 + (size_t)b * 256 * 2112 + kt * 64;
    bf16_t* ctile = (bf16_t*)lds;
#pragma unroll
    for (int i = 0; i < 8; ++i) { const int q = tid + 512 * i, t = q >> 6, c4 = q & 63; const f32x4 q4 = __builtin_nontemporal_load((const f32x4*)(ckv + (size_t)t * 256 + c4 * 4)); const float4 v = make_float4(q4[0], q4[1], q4[2], q4[3]);
        uint2 o; o.x = cvt_pk_bf16(v.x, v.y); o.y = cvt_pk_bf16(v.z, v.w); *(uint2*)(kc + (size_t)t * 320 + c4 * 4) = o; *(uint2*)(ctile + t * 264 + c4 * 4) = o; }
#pragma unroll
    for (int i = 0; i < 2; ++i) { const int q = tid + 512 * i, t = q >> 4, c4 = q & 15; const f32x4 q4 = __builtin_nontemporal_load((const f32x4*)(kpe + (size_t)t * 64 + c4 * 4)); const float4 v = make_float4(q4[0], q4[1], q4[2], q4[3]);
        uint2 o; o.x = cvt_pk_bf16(v.x, v.y); o.y = cvt_pk_bf16(v.z, v.w); *(uint2*)(kc + (size_t)t * 320 + 256 + c4 * 4) = o; }
    __syncthreads();
    ct_write(ctile, ct, 2112);
    __syncthreads();
}
__device__ void phase_prep(CArgs& a, int l, unsigned char* lds, int rep = 0) {
    unsigned* ctr = (unsigned*)(a.ws + OFF_CTL) + 16 * (l + 1) + 8 + 128 * rep; LAS unsigned* slot = (LAS unsigned*)(lds + LDS_MAIN + 16);
    for (;;) {
        __syncthreads();
        { int t0 = threadIdx.x; asm volatile("" : "+v"(t0)); if (t0 == 0) *slot = atomicAdd(ctr, 1u); }
        __syncthreads();
        const int it = (int)*slot;
        if (it >= 2 * NTILE) break;
        if (it < NTILE) prep_hgrn_tile(a, l, it, lds); else prep_mla_tile(a, l, it - NTILE, lds);
    }
}
__device__ void phase_cache(CArgs& a, int l, unsigned char* lds) {
    unsigned* ctr = (unsigned*)(a.ws + OFF_CTL) + 16 * (l + 1) + 12; LAS unsigned* slot = (LAS unsigned*)(lds + LDS_MAIN + 16);
    for (;;) {
        __syncthreads();
        { int t0 = threadIdx.x; asm volatile("" : "+v"(t0)); if (t0 == 0) *slot = atomicAdd(ctr, 1u); }
        __syncthreads();
        const int it = (int)*slot;
        if (it >= 1024) break;
        prep_cache_tile(a, l, it, lds);
    }
}
__device__ void phase_scan(CArgs& a, int l) {
    unsigned char* ws = a.ws; int tid = threadIdx.x; asm volatile("" : "+v"(tid)); const size_t gtid = (size_t)bid_() * 512 + tid, gsz = (size_t)gdim_() * 512;
    const float* U = (const float*)(ws + OFF_U); const float* dec = (const float*)(ws + OFF_DEC); float* sst = (float*)(ws + OFF_SST);
    for (size_t i = gtid; i < 16 * 4096; i += gsz) { const int bh = (int)(i >> 12), ed = (int)(i & 4095), b = bh >> 2, h = bh & 3, e = ed >> 6; float S = 0.f;
#pragma unroll 16
        for (int j = 0; j < 64; ++j) { const size_t ch = (size_t)((b * 64 + j) * 4 + h); sst[ch * 4096 + ed] = S; S = dec[ch * 64 + e] * S + U[ch * 4096 + ed]; }
        a.out[O_HGP + (size_t)(l * 16 + bh) * 4096 + ed] = S; }
    for (size_t i = gtid; i < 128 * 4096; i += gsz) { const int bh = (int)(i >> 12), ed = (int)(i & 4095), b = bh >> 2, h = bh & 3, e = ed >> 6; const size_t ch = (size_t)((256 + b) * 4 + h);
        const float S0 = a.in[4][(size_t)(l * 128 + bh) * 4096 + ed];
        a.out[O_HGS + (size_t)(l * 128 + bh) * 4096 + ed] = dec[ch * 64 + e] * S0 + U[ch * 4096 + ed]; }
}
constexpr int KSTR = 656, VSTR = 144, VOFF = 64 * KSTR, ABUF = VOFF + 256 * VSTR;
__device__ __forceinline__ int swz16(int row) { return (((row & 15) + 4) >> 3) & 1; }
__device__ void attn_item(CArgs& a, int idx, unsigned char* ldsg) {
    unsigned char* ws = a.ws; LAS unsigned char* lds = (LAS unsigned char*)ldsg;
    int tid = threadIdx.x; asm volatile("" : "+v"(tid)); const int lane = tid & 63, wave = __builtin_amdgcn_readfirstlane(tid >> 6), lr = lane & 15, g = lane >> 4;
    const int gx = (g ^ swz16(lr)) * 16;
    int b, hp, nkt, r0; const unsigned char* kcb; const unsigned char* ctb; int ctstride;
    if (idx >= 256 && idx < 320) { const int s = idx - 256; b = s >> 1; hp = s & 1; nkt = 33; r0 = MP + b * 64;
        kcb = ws + OFF_KC + ((size_t)16384 + (size_t)b * 2112) * 640; ctb = ws + OFF_CT + ((size_t)16384 * 256 + (size_t)b * 256 * 2112) * 2; ctstride = 4224; }
    else { const int k = idx < 256 ? idx : idx - 64; const int j = 63 - (k >> 3), sub = k & 7; b = sub >> 1; hp = sub & 1; nkt = j + 1; r0 = b * 4096 + j * 64;
        kcb = ws + OFF_KC + (size_t)b * 4096 * 640; ctb = ws + OFF_CT + (size_t)b * 256 * 4096 * 2; ctstride = 8192; }
    const int head = hp * 2 + (wave >> 2); const int qrow = r0 + (wave & 3) * 16 + lr;
    unsigned ko[6], vo[5];
#pragma unroll
    for (int i = 0; i < 6; ++i) { const int n = i * 512 + tid, row = n / 41, pc = n - row * 41; ko[i] = (unsigned)(row * 640 + (pc < 40 ? (pc ^ swz16(row)) * 16 : 0)); }
#pragma unroll
    for (int i = 0; i < 5; ++i) { const int n = i * 512 + tid, row = n / 9, pc = n - row * 9; vo[i] = (unsigned)(row * ctstride + (pc < 8 ? (pc ^ swz16(row)) * 16 : 0)); }
#define ATT_DMA(kt, bo) do { const unsigned char* kg = kcb + (size_t)(kt) * 40960; const unsigned char* vg = ctb + (size_t)(kt) * 128; \
        _Pragma("unroll") for (int i = 0; i < 6; ++i) if (i < 5 || wave == 0) __builtin_amdgcn_global_load_lds((const unsigned*)(kg + ko[i]), (LAS unsigned*)(lds + (bo) + (i * 512 + wave * 64) * 16), 16, 0, 0); \
        _Pragma("unroll") for (int i = 0; i < 5; ++i) if (i < 4 || wave < 4) __builtin_amdgcn_global_load_lds((const unsigned*)(vg + vo[i]), (LAS unsigned*)(lds + (bo) + VOFF + (i * 512 + wave * 64) * 16), 16, 0, 0); } while (0)
    __syncthreads();
    ATT_DMA(0, 0);
    bf16x8 qf[10];
    { const bf16_t* qp = (const bf16_t*)(ws + OFF_Q) + (size_t)qrow * 1280 + head * 320 + g * 8;
#pragma unroll
      for (int ks = 0; ks < 10; ++ks) qf[ks] = __builtin_nontemporal_load((const bf16x8*)(qp + ks * 32));
      const int pos = qrow < MP ? (qrow & 4095) : 2048 + ((qrow - MP) & 63); const float2* rp = (const float2*)(ws + OFF_ROPE) + pos * 32 + 8 * g;
      u32x4 w1 = __builtin_bit_cast(u32x4, qf[8]), w2 = __builtin_bit_cast(u32x4, qf[9]);
      float4 cs4[4];
#pragma unroll
      for (int jp = 0; jp < 4; ++jp) cs4[jp] = *(const float4*)(rp + 2 * jp);
#pragma unroll
      for (int jp = 0; jp < 4; ++jp) { const float a1 = bflo(w1[jp]), b1 = bfhi(w1[jp]), a2 = bflo(w2[jp]), b2 = bfhi(w2[jp]);
          w1[jp] = cvt_pk_bf16(a1 * cs4[jp].x - a2 * cs4[jp].y, b1 * cs4[jp].z - b2 * cs4[jp].w); w2[jp] = cvt_pk_bf16(a2 * cs4[jp].x + a1 * cs4[jp].y, b2 * cs4[jp].z + b1 * cs4[jp].w); }
      qf[8] = __builtin_bit_cast(bf16x8, w1); qf[9] = __builtin_bit_cast(bf16x8, w2); }
    f32x4 o[16];
#pragma unroll
    for (int i = 0; i < 16; ++i) o[i] = (f32x4){0.f, 0.f, 0.f, 0.f};
    float mrun = -1e30f, lsum = 0.f;
    asm volatile("s_waitcnt vmcnt(0)" ::: "memory");
    __syncthreads();
    const int koff = lr * KSTR + gx, voff = VOFF + lr * VSTR + gx;
    for (int kt = 0; kt < nkt; ++kt) {
        const int bo = (kt & 1) * ABUF;
        if (kt + 1 < nkt) ATT_DMA(kt + 1, ABUF - bo);
        const LAS unsigned char* kb = lds + bo + koff; const LAS unsigned char* vb = lds + bo + voff;
        f32x4 s[4];
#pragma unroll
        for (int i = 0; i < 4; ++i) s[i] = (f32x4){0.f, 0.f, 0.f, 0.f};
        bf16x8 kf[2][4];
#pragma unroll
        for (int k4 = 0; k4 < 4; ++k4) kf[0][k4] = *(const LAS bf16x8*)(kb + k4 * 16 * KSTR);
#pragma unroll
        for (int ks = 0; ks < 10; ++ks) {
            if (ks < 9) {
#pragma unroll
                for (int k4 = 0; k4 < 4; ++k4) kf[(ks + 1) & 1][k4] = *(const LAS bf16x8*)(kb + k4 * 16 * KSTR + (ks + 1) * 64); }
            __builtin_amdgcn_sched_barrier(0);
#pragma unroll
            for (int k4 = 0; k4 < 4; ++k4) s[k4] = __builtin_amdgcn_mfma_f32_16x16x32_bf16(kf[ks & 1][k4], qf[ks], s[k4], 0, 0, 0);
            __builtin_amdgcn_sched_barrier(0);
        }
        bf16x8 vf[2][4];
#pragma unroll
        for (int q4 = 0; q4 < 4; ++q4) vf[0][q4] = *(const LAS bf16x8*)(vb + (q4 >> 1) * 16 * VSTR + (q4 & 1) * 64);
        __builtin_amdgcn_sched_barrier(0);
        float mx = s[0][0];
#pragma unroll
        for (int k4 = 0; k4 < 4; ++k4)
#pragma unroll
            for (int i = 0; i < 4; ++i) mx = fmaxf(mx, s[k4][i]);
        mx = fmaxf(mx, __shfl_xor(mx, 16)); mx = fmaxf(mx, __shfl_xor(mx, 32));
        if (!__all(mx - mrun <= 8.0f)) {
            const float mnew = fmaxf(mrun, mx), alpha = __builtin_amdgcn_exp2f(mrun - mnew); mrun = mnew; lsum *= alpha;
#pragma unroll
            for (int i = 0; i < 16; ++i) o[i] *= alpha; }
        float ps = 0.f;
#pragma unroll
        for (int k4 = 0; k4 < 4; ++k4)
#pragma unroll
            for (int i = 0; i < 4; ++i) { s[k4][i] = __builtin_amdgcn_exp2f(s[k4][i] - mrun); ps += s[k4][i]; }
        lsum += ps;
        bf16x8 pb[2];
#pragma unroll
        for (int s2 = 0; s2 < 2; ++s2) { u32x4 w; w.x = cvt_pk_bf16(s[2 * s2][0], s[2 * s2][1]); w.y = cvt_pk_bf16(s[2 * s2][2], s[2 * s2][3]);
            w.z = cvt_pk_bf16(s[2 * s2 + 1][0], s[2 * s2 + 1][1]); w.w = cvt_pk_bf16(s[2 * s2 + 1][2], s[2 * s2 + 1][3]); pb[s2] = __builtin_bit_cast(bf16x8, w); }
#pragma unroll
        for (int cp = 0; cp < 8; ++cp) {
            if (cp < 7) {
#pragma unroll
                for (int q4 = 0; q4 < 4; ++q4) vf[(cp + 1) & 1][q4] = *(const LAS bf16x8*)(vb + (2 * (cp + 1) + (q4 >> 1)) * 16 * VSTR + (q4 & 1) * 64); }
            __builtin_amdgcn_sched_barrier(0);
#pragma unroll
            for (int q4 = 0; q4 < 4; ++q4) o[2 * cp + (q4 >> 1)] = __builtin_amdgcn_mfma_f32_16x16x32_bf16(vf[cp & 1][q4], pb[q4 & 1], o[2 * cp + (q4 >> 1)], 0, 0, 0);
            __builtin_amdgcn_sched_barrier(0);
        }
        asm volatile("s_waitcnt vmcnt(0)" ::: "memory");
        __syncthreads();
    }
#undef ATT_DMA
    lsum += __shfl_xor(lsum, 16); lsum += __shfl_xor(lsum, 32);
    const float inv = 1.0f / lsum;
    bf16_t* op = (bf16_t*)(ws + OFF_MIXA) + (size_t)qrow * 1536 + head * 256 + 4 * g;
#pragma unroll
    for (int ct = 0; ct < 16; ++ct) { uint2 w; w.x = cvt_pk_bf16(o[ct][0] * inv, o[ct][1] * inv); w.y = cvt_pk_bf16(o[ct][2] * inv, o[ct][3] * inv); *(uint2*)(op + 16 * ct) = w; }
}
constexpr int HS = 72;
constexpr int H_BC = 0, H_QT = 2 * 16640, H_KT = H_QT + 2 * 64 * HS * 2, H_QH = H_KT + 2 * 64 * HS * 2, H_VT = H_QH + 2 * 64 * HS * 2, H_ST = H_VT + 2 * 64 * HS * 2, H_END = H_ST + 2 * 64 * HS * 2;
static_assert(H_END <= LDS_MAIN, "hgrn lds");
__device__ __forceinline__ int posof64(int t) { const int u = t & 31; const int p = u < 16 ? 8 * (u >> 2) + (u & 3) : 8 * ((u - 16) >> 2) + 4 + ((u - 16) & 3); return (t & 32) + p; }
__device__ void hgrn_out_tile(CArgs& a, int l, int T, unsigned char* ldsg) {
    unsigned char* ws = a.ws; int tid = threadIdx.x; asm volatile("" : "+v"(tid)); asm volatile("" : "+s"(l)); const int lane = tid & 63, wave = tid >> 6, lr = lane & 15, g = lane >> 4;
    LAS unsigned char* lds = (LAS unsigned char*)ldsg;
    const bf16_t* z = (const bf16_t*)(ws + OFF_Z); const int r0 = T * 64;
    const int c = tid & 127, hh = c >> 6, e = c & 63, tq = tid >> 7;
    LAS float* bc = (LAS float*)(lds + H_BC) + hh * 4160;
    LAS bf16_t* QT = (LAS bf16_t*)(lds + H_QT) + hh * 64 * HS; LAS bf16_t* KT = (LAS bf16_t*)(lds + H_KT) + hh * 64 * HS; LAS bf16_t* QH = (LAS bf16_t*)(lds + H_QH) + hh * 64 * HS; LAS bf16_t* VT = (LAS bf16_t*)(lds + H_VT) + hh * 64 * HS;
    const float lbv0 = lb_of(a, l, hh * 64 + e), lbv1 = lb_of(a, l, (2 + hh) * 64 + e);
    for (int hp = 0; hp < 2; ++hp) {
        const int h = 2 * hp + hh; const float lbv = hp ? lbv1 : lbv0;
        { const float* bcum = (const float*)(ws + OFF_BCUM) + (size_t)r0 * 256 + h * 64 + e; const float rr = bcum[31 * 256];
          float s0v[16];
#pragma unroll
          for (int i = 0; i < 16; ++i) { const int idx = tid + 512 * i, h2 = idx >> 12, ed = idx & 4095; const int hg = 2 * hp + h2;
              const float* S0 = T < 256 ? (const float*)(ws + OFF_SST) + (size_t)(T * 4 + hg) * 4096 : a.in[4] + (size_t)(l * 128 + (T - 256) * 4 + hg) * 4096;
              s0v[i] = __builtin_nontemporal_load(S0 + ed); }
#pragma unroll 1
          for (int i0 = 0; i0 < 16; i0 += 8) {
          bf16_t zq[8], zf16[8], zv[8]; float bbv[8];
#pragma unroll
          for (int i = 0; i < 8; ++i) { const bf16_t* zr = z + (size_t)(r0 + tq * 16 + i0 + i) * ZW + h * 64 + e; zq[i] = zr[ZHQ]; zf16[i] = zr[ZHF]; zv[i] = zr[ZHI]; bbv[i] = bcum[(tq * 16 + i0 + i) * 256]; }
#pragma unroll
          for (int i = 0; i < 8; ++i) { const int t = tq * 16 + i0 + i; const float bb = bbv[i];
              const float q = bf2f(zq[i]), zf = bf2f(zf16[i]); const float k = (1.0f - lbv) * sigmoidf_(-zf);
              QH[t * HS + e] = f2bf(q * __expf(bb)); QT[t * HS + e] = f2bf(q * __expf(fminf(bb - rr, 80.f))); KT[t * HS + e] = f2bf(k * __expf(fminf(rr - bb, 80.f)));
              VT[e * HS + posof64(t)] = zv[i]; } }
#pragma unroll
          for (int i = 0; i < 16; ++i) { const int idx = tid + 512 * i, h2 = idx >> 12, ed = idx & 4095; ((LAS bf16_t*)(lds + H_ST))[h2 * 64 * HS + (ed & 63) * HS + (ed >> 6)] = f2bf(s0v[i]); } }
        __syncthreads();
        { const int wh = wave >> 2, tb = wave & 3; const int hw = 2 * hp + wh;
          const LAS unsigned char* qt = lds + H_QT + wh * 64 * HS * 2; const LAS unsigned char* kt = lds + H_KT + wh * 64 * HS * 2; const LAS unsigned char* qh = lds + H_QH + wh * 64 * HS * 2;
          const LAS unsigned char* vt = lds + H_VT + wh * 64 * HS * 2; const LAS unsigned char* st = lds + H_ST + wh * 64 * HS * 2;
          const int trow = 16 * tb + lr;
          float4 ogv[4]; uint2 gwv[4];
#pragma unroll
          for (int db = 0; db < 4; ++db) { const int d0 = hw * 64 + 16 * db + 4 * g; ogv[db] = *(const float4*)(a.in[17] + l * 256 + d0); gwv[db] = *(const uint2*)(z + (size_t)(r0 + trow) * ZW + ZHG + d0); }
          bf16x8 qtf[2], qhf[2];
#pragma unroll
          for (int ks = 0; ks < 2; ++ks) { qtf[ks] = *(const LAS bf16x8*)(qt + trow * (HS * 2) + (32 * ks + 8 * g) * 2); qhf[ks] = *(const LAS bf16x8*)(qh + trow * (HS * 2) + (32 * ks + 8 * g) * 2); }
          f32x4 aT[4];
#pragma unroll
          for (int sb = 0; sb < 4; ++sb) { aT[sb] = (f32x4){0.f, 0.f, 0.f, 0.f};
#pragma unroll
              for (int ks = 0; ks < 2; ++ks) { const bf16x8 kf = *(const LAS bf16x8*)(kt + (16 * sb + lr) * (HS * 2) + (32 * ks + 8 * g) * 2); aT[sb] = __builtin_amdgcn_mfma_f32_16x16x32_bf16(kf, qtf[ks], aT[sb], 0, 0, 0); }
#pragma unroll
              for (int i = 0; i < 4; ++i) aT[sb][i] = (16 * sb + 4 * g + i <= trow) ? aT[sb][i] : 0.f; }
          bf16x8 pb[2];
#pragma unroll
          for (int s2 = 0; s2 < 2; ++s2) { u32x4 w; w.x = cvt_pk_bf16(aT[2 * s2][0], aT[2 * s2][1]); w.y = cvt_pk_bf16(aT[2 * s2][2], aT[2 * s2][3]);
              w.z = cvt_pk_bf16(aT[2 * s2 + 1][0], aT[2 * s2 + 1][1]); w.w = cvt_pk_bf16(aT[2 * s2 + 1][2], aT[2 * s2 + 1][3]); pb[s2] = __builtin_bit_cast(bf16x8, w); }
          f32x4 o[4]; float ss = 0.f;
#pragma unroll
          for (int db = 0; db < 4; ++db) { o[db] = (f32x4){0.f, 0.f, 0.f, 0.f};
#pragma unroll
              for (int ks = 0; ks < 2; ++ks) { const bf16x8 sf = *(const LAS bf16x8*)(st + (16 * db + lr) * (HS * 2) + (32 * ks + 8 * g) * 2); o[db] = __builtin_amdgcn_mfma_f32_16x16x32_bf16(sf, qhf[ks], o[db], 0, 0, 0); }
#pragma unroll
              for (int s2 = 0; s2 < 2; ++s2) { const bf16x8 vf = *(const LAS bf16x8*)(vt + (16 * db + lr) * (HS * 2) + (32 * s2 + 8 * g) * 2); o[db] = __builtin_amdgcn_mfma_f32_16x16x32_bf16(vf, pb[s2], o[db], 0, 0, 0); }
              ss += o[db][0] * o[db][0] + o[db][1] * o[db][1] + o[db][2] * o[db][2] + o[db][3] * o[db][3]; }
          ss += __shfl_xor(ss, 16); ss += __shfl_xor(ss, 32);
          const float rs = rsqrtf(ss * (1.0f / 64.0f) + EPS);
#pragma unroll
          for (int db = 0; db < 4; ++db) { const int d0 = hw * 64 + 16 * db + 4 * g; const float4 og = ogv[db]; const uint2 gw = gwv[db];
              uint2 w; w.x = cvt_pk_bf16(o[db][0] * rs * og.x * siluf_(bflo(gw.x)), o[db][1] * rs * og.y * siluf_(bfhi(gw.x)));
              w.y = cvt_pk_bf16(o[db][2] * rs * og.z * siluf_(bflo(gw.y)), o[db][3] * rs * og.w * siluf_(bfhi(gw.y)));
              *(uint2*)((bf16_t*)(ws + OFF_MIXA) + (size_t)(r0 + trow) * 1536 + 1024 + d0) = w; } }
        __syncthreads();
    }
}
template <bool PRM> __device__ __forceinline__ void cmlp_item_t(CArgs& a, int l, int it, unsigned char* ldsg) {
    int tid = threadIdx.x; asm volatile("" : "+v"(tid)); asm volatile("" : "+s"(l)); const int lane = tid & 63, wave = tid >> 6, lr = lane & 15, lg = lane >> 4; const int ci = it >> 2, g = it & 3;
    constexpr int L = PRM ? 128 : 64, WS = L + 8;
    const int r0 = PRM ? ci * 128 : MP + (ci - 128) * 64;
    LAS unsigned char* lds = (LAS unsigned char*)ldsg; LAS bf16_t* Wb = (LAS bf16_t*)lds; LAS bf16_t* vT = (LAS bf16_t*)(lds + 128 * 136 * 2);
    const bf16_t* z = (const bf16_t*)(a.ws + OFF_Z); const float* wsrc = a.in[19] + (size_t)(l * 4 + g) * 128 * 128;
    const float vg = a.in[18][l * 256 + g * 64 + lane];
    bf16_t zc[L / 8];
#pragma unroll
    for (int i = 0; i < L / 8; ++i) zc[i] = z[(size_t)(r0 + wave + 8 * i) * ZW + ZCV + g * 64 + lane];
    { constexpr int NQ = L * L / 4 / 512, SH = PRM ? 5 : 4; float4 wv[NQ];
#pragma unroll
      for (int i = 0; i < NQ; ++i) { const int idx = tid + 512 * i, t = idx >> SH, s4 = idx & ((1 << SH) - 1); wv[i] = *(const float4*)(wsrc + t * 128 + 4 * s4); }
#pragma unroll
      for (int i = 0; i < NQ; ++i) { const int idx = tid + 512 * i, t = idx >> SH, s0 = 4 * (idx & ((1 << SH) - 1));
          u32x2 w; w.x = cvt_pk_bf16(s0 <= t ? wv[i].x : 0.f, s0 + 1 <= t ? wv[i].y : 0.f); w.y = cvt_pk_bf16(s0 + 2 <= t ? wv[i].z : 0.f, s0 + 3 <= t ? wv[i].w : 0.f);
          *(LAS u32x2*)(Wb + t * WS + s0) = w; } }
    {
#pragma unroll
      for (int i = 0; i < L / 8; ++i) { const int t = wave + 8 * i; const float x = geluf_(bf2f(zc[i])); const float ss = wave_sum(x * x);
          const float vv = x * rsqrtf(ss * (1.0f / 64.0f) + EPS) * vg; vT[lane * WS + t] = f2bf(vv);
          if (!PRM) a.out[O_CMV + ((size_t)(l * 32 + (ci - 128)) * 64 + t) * 256 + g * 64 + lane] = vv; } }
    __syncthreads();
    { constexpr int NT = PRM ? 4 : 2;
      const int tt = PRM ? wave : (wave & 3); const int t = 16 * tt + lr; const float bs = a.in[20][(size_t)(l * 4 + g) * 128 + t];
      uint2 cwv[NT];
#pragma unroll
      for (int n = 0; n < NT; ++n) { const int dt = PRM ? n : 2 * (wave >> 2) + n; cwv[n] = *(const uint2*)(z + (size_t)(r0 + t) * ZW + ZCU + g * 64 + 16 * dt + 4 * lg); }
#pragma unroll
      for (int n = 0; n < NT; ++n) { const int dt = PRM ? n : 2 * (wave >> 2) + n; f32x4 acc = (f32x4){0.f, 0.f, 0.f, 0.f};
#pragma unroll
          for (int ks = 0; ks < L / 32; ++ks) { if (32 * ks <= 16 * tt + 15) {
              const bf16x8 vf = *(const LAS bf16x8*)(vT + (16 * dt + lr) * WS + 32 * ks + 8 * lg); const bf16x8 wf = *(const LAS bf16x8*)(Wb + t * WS + 32 * ks + 8 * lg);
              acc = __builtin_amdgcn_mfma_f32_16x16x32_bf16(vf, wf, acc, 0, 0, 0); } }
          const int d0 = g * 64 + 16 * dt + 4 * lg; const uint2 cw = cwv[n];
          uint2 o; o.x = cvt_pk_bf16(geluf_(bflo(cw.x)) * (acc[0] + bs), geluf_(bfhi(cw.x)) * (acc[1] + bs)); o.y = cvt_pk_bf16(geluf_(bflo(cw.y)) * (acc[2] + bs), geluf_(bfhi(cw.y)) * (acc[3] + bs));
          *(uint2*)((bf16_t*)(a.ws + OFF_MIXA) + (size_t)(r0 + t) * 1536 + 1280 + d0) = o; } }
    __syncthreads();
}
__device__ void cmlp_item(CArgs& a, int l, int it, unsigned char* lds) { if ((it >> 2) < 128) cmlp_item_t<true>(a, l, it, lds); else cmlp_item_t<false>(a, l, it, lds); }
__device__ void phase_mix(CArgs& a, int l, unsigned char* lds, int rep) {
    unsigned* ctr = (unsigned*)(a.ws + OFF_CTL) + 16 * (l + 1) + 128 * rep; LAS unsigned* slot = (LAS unsigned*)(lds + LDS_MAIN + 16);
    for (;;) {
        __syncthreads();
        { int t0 = threadIdx.x; asm volatile("" : "+v"(t0)); if (t0 == 0) *slot = atomicAdd(ctr, 1u); }
        __syncthreads();
        const int it = (int)*slot;
        if (it >= 576 + NTILE + 640) break;
        if (it < 576) { attn_item(a, it, lds); if (PROBE_MIX & 1) { __syncthreads(); attn_item(a, it, lds); } }
        else if (it < 576 + NTILE) { hgrn_out_tile(a, l, it - 576, lds); if (PROBE_MIX & 2) { __syncthreads(); hgrn_out_tile(a, l, it - 576, lds); } }
        else { cmlp_item(a, l, it - 576 - NTILE, lds); if (PROBE_MIX & 4) { __syncthreads(); cmlp_item(a, l, it - 576 - NTILE, lds); } }
    }
}
__global__ void __launch_bounds__(512) mk_fwd(Args a_) {
    extern __shared__ __attribute__((aligned(16))) unsigned char lds[];
    if (threadIdx.x < 16) ((LAS unsigned*)(lds + LDS_MAIN))[threadIdx.x] = 0u;
    __syncthreads();
    XcdBarrier bar = xcd_barrier_post((unsigned*)(a_.ws + OFF_CTL) + 1024, (volatile LAS unsigned*)(lds + LDS_MAIN));
    const int ph_lo = a_.ph_lo, ph_hi = a_.ph_hi;
    for (int ph = ph_lo; ph < ph_hi; ++ph) {
        CArgs* ap = (CArgs*)__builtin_amdgcn_kernarg_segment_ptr(); asm volatile("" : "+s"(ap)); CArgs& a = *ap;
        unsigned char* ws = a.ws;
        if (ph == 0) { phase_init(a, lds); if ((PROBE_DUP >> 12) & 1) { __syncthreads(); phase_init(a, lds); } }
        else { const int l = (ph - 1) / 12, p = (ph - 1) % 12; const float* ng = a.in[5] + (size_t)l * 6 * 1024;
            bf16_t* H = (bf16_t*)(ws + OFF_H); bf16_t* ACT = (bf16_t*)(ws + OFF_ACT); bf16_t* D = (bf16_t*)(ws + OFF_D); bf16_t* D1 = (bf16_t*)(ws + ((p == 7 || p == 8) ? OFF_ACT : OFF_MIXA));   float* RS = (float*)(ws + OFF_X);
            const int reps = ((PROBE_DUP >> p) & 1) ? 2 : 1;
            for (int rep = 0; rep < reps; ++rep) {
            if (rep) __syncthreads();
            switch (p) {
            case 0: case 9: { const int f = p == 0 ? 0 : 1; EpiSwiGLU E{ACT}; run_gemm(lds, H, (const bf16_t*)(ws + OFF_WGU) + (size_t)(l * 2 + f) * 5632 * 1024, MT, 5632, 1024, E);
                if (p == 0 && !rep) phase_cache(a, l, lds); } break;
            case 1: case 10: { const int f = p == 1 ? 0 : 1; EpiBf E{D, 1024, D1}; run_gemm(lds, ACT, (const bf16_t*)(ws + OFF_WDN) + (size_t)(l * 2 + f) * 1024 * 2816, MT, 1024, 2816, E, 11); } break;
            case 2: ew_phase<false, false>(D, D1, 11, H, nullptr, nullptr, ng + 1024, 0.5f, ng + 2048, H, ng, RS); break;
            case 3: { EpiBf E{(bf16_t*)(ws + OFF_Z), ZW, nullptr}; run_gemm(lds, H, (const bf16_t*)(ws + OFF_WIN) + (size_t)l * 2304 * 1024, MT, 2304, 1024, E); } break;
            case 4: phase_prep(a, l, lds, rep); break;
            case 5: { phase_scan(a, l); EpiQ E{(bf16_t*)(ws + OFF_Q)}; run_gemm(lds, (const bf16_t*)(ws + OFF_QN), (const bf16_t*)(ws + OFF_WQ) + (size_t)l * 1280 * 384, MT, 1280, 384, E); } break;
            case 6: phase_mix(a, l, lds, rep); break;
            case 7: { EpiBf E{D, 1024, D1}; run_gemm(lds, (const bf16_t*)(ws + OFF_MIXA), (const bf16_t*)(ws + OFF_WMIX) + (size_t)l * 1024 * 1536, MT, 1024, 1536, E, 6); } break;
            case 8: ew_phase<false, false>(D, D1, 6, H, nullptr, nullptr, ng + 3 * 1024, 1.0f, ng + 4 * 1024, H, ng + 2048, RS); break;
            case 11: if (l == 0) ew_phase<false, false>(D, D1, 11, H, nullptr, nullptr, ng + 5 * 1024, 0.5f, ng + 6 * 1024, H, ng + 4 * 1024, RS); else ew_phase<false, true>(D, D1, 11, H, nullptr, a.out + O_Y, ng + 5 * 1024, 0.5f, nullptr, nullptr, ng + 4 * 1024, RS); break;
            }
            }
            tail_wtasks(a, ph, lds);
        }
        if (ph + 1 < ph_hi) {
            if (ph_lo < 0) { __threadfence(); cg::this_grid().sync(); }
            xcd_barrier(bar); }
    }
}

extern "C" void kernel_launch(void* const* d_in, const int* in_sizes, int n_in, void* d_out, int out_size, void* d_ws, size_t ws_size, hipStream_t stream) {
    static int grid = 0;
    if (grid == 0) {
        if (n_in != 21 || ws_size < WS_END) { fprintf(stderr, "kernel_launch: bad inputs n_in %d ws %zu need %zu\n", n_in, ws_size, (size_t)WS_END); grid = -1; return; }
        int dev = 0, cus = 0, per_cu = 0;
        hipGetDevice(&dev); hipDeviceGetAttribute(&cus, hipDeviceAttributeMultiprocessorCount, dev);
        if (hipFuncSetAttribute((const void*)mk_fwd, hipFuncAttributeMaxDynamicSharedMemorySize, LDS_BYTES) != hipSuccess) { fprintf(stderr, "hipFuncSetAttribute failed\n"); grid = -1; return; }
        if (hipOccupancyMaxActiveBlocksPerMultiprocessor(&per_cu, (const void*)mk_fwd, 512, LDS_BYTES) != hipSuccess || per_cu < 1) per_cu = 1;
        (void)hipGetLastError();
        grid = cus * 1;
    }
    if (grid < 0) return;
    if (hipMemsetAsync((char*)d_ws + OFF_CTL, 0, SZ_CTL, stream) != hipSuccess) { fprintf(stderr, "memset failed\n"); return; }
    Args a{};
    for (int i = 0; i < 21; ++i) a.in[i] = (const float*)d_in[i];
    a.out = (float*)d_out; a.ws = (unsigned char*)d_ws;
#if ONE_LAUNCH
    a.ph_lo = 0; a.ph_hi = NPHASE;
    void* args[] = {&a};
    hipError_t e = hipLaunchCooperativeKernel((const void*)mk_fwd, dim3(grid), dim3(512), args, LDS_BYTES, stream);
    if (e != hipSuccess) fprintf(stderr, "cooperative launch failed: %s (grid %d)\n", hipGetErrorString(e), grid);
#else
    for (int ph = 0; ph < NPHASE; ++ph) { a.ph_lo = ph; a.ph_hi = ph + 1; hipLaunchKernelGGL(mk_fwd, dim3(grid), dim3(512), LDS_BYTES, stream, a); }
#endif
}
```

```cpp
#include <hip/hip_runtime.h>
#include <hip/hip_cooperative_groups.h>
#include <cstdio>
namespace cg = cooperative_groups;
#ifndef ONE_LAUNCH
#define ONE_LAUNCH 1
#endif
#ifndef PROBE_DUP
#define PROBE_DUP 0
#endif
#ifndef PROBE_MIX
#define PROBE_MIX 0
#endif
namespace pg8 {
#define PG8_LAS __attribute__((address_space(3)))
typedef unsigned short bf16_t;
typedef short bf16x8 __attribute__((ext_vector_type(8)));
typedef float f32x4 __attribute__((ext_vector_type(4)));
typedef unsigned u32x4 __attribute__((ext_vector_type(4)));
constexpr int BM = 256, BK = 64, HALF = 128, HTB = HALF * BK * 2  , STAGE_BYTES = 8 * HTB, NXCD = 8, WGM = 8;

__host__ __device__ __forceinline__ int lds_byte(int r, int c) { const int st = (r >> 4) * 2 + (c >> 5), rr = r & 15, cc = c & 31, ob = rr * 64 + cc * 2; return st * 1024 + (ob ^ (((ob >> 9) & 1) << 5)); }
__host__ __device__ __forceinline__ void stage_rc(int b, int& R, int& C) { const int st = b / 1024, sb = b % 1024, swz = sb ^ (((sb >> 9) & 1) << 5); R = (st >> 1) * 16 + swz / 64; C = (st & 1) * 32 + (swz % 64) / 2; }
__host__ __device__ __forceinline__ int perm32(int rho) { const int n = rho >> 4, i = rho & 15; return 8 * (i >> 2) + 4 * n + (i & 3); }

struct Unit { int pm, pn, ks, nt, koff; };
struct Gemm { const bf16_t* A; const bf16_t* Bt; int M, N, K, ld; };

struct StaticOrder {
    int nM, nN, nwg, G, c, nN0, unt, ukb;
    __host__ __device__ void init(int M, int N, int G_, int c_, int nsplit = 1) { nM = M / BM; nN0 = N / BM; nN = nN0 * nsplit; nwg = nM * nN; G = G_; c = c_; }
    __host__ __device__ bool next(int i, Unit& u) const {
        const long L = (long)i * G + c; if (L >= nwg) return false;
        int wgid = (int)L; { const int q = nwg / NXCD, r = nwg % NXCD, xcd = wgid % NXCD, off = wgid / NXCD; wgid = (xcd < r ? xcd * (q + 1) : r * (q + 1) + (xcd - r) * q) + off; }
        const int nig = WGM * nN, gid = wgid / nig, fm = gid * WGM, gsz = (nM - fm) < WGM ? (nM - fm) : WGM;
        u.pm = fm + ((wgid % nig) % gsz); const int pn = (wgid % nig) / gsz; u.ks = pn / nN0; u.pn = pn - u.ks * nN0; u.nt = unt; u.koff = u.ks * ukb; return true;
    }
    __device__ __forceinline__ void a_ready(const Unit&) const {}
    __device__ __forceinline__ void done(const Unit&) const {}
};
__device__ __forceinline__ unsigned cvt_pk_bf16(float lo, float hi) { unsigned r; asm volatile("v_cvt_pk_bf16_f32 %0, %1, %2" : "=v"(r) : "v"(lo), "v"(hi)); return r; }
typedef float f32x2 __attribute__((ext_vector_type(2)));
template <class Epi, class Sched, bool STAMP = false>
__device__ __forceinline__ void gemm_phase(PG8_LAS unsigned char* lds, const Gemm g, const Sched& S, const Epi& E, unsigned long long* stamps) {
    int tid = threadIdx.x; asm volatile("" : "+v"(tid)); const int wid = __builtin_amdgcn_readfirstlane(tid >> 6), lane = tid & 63, wr = wid >> 2, wc = wid & 3, fr = lane & 15, fq = lane >> 4;
    const int K = g.ld;
    int ts_lo = 0, ts_hi = 0, nts = 0; const unsigned long long rt_entry = STAMP ? (unsigned long long)wall_clock64() : 0ull;
#define PG8_STAMP() do { if (STAMP && wid == 0 && nts < 64) { const unsigned long long _c = (unsigned long long)clock64(); \
        ts_lo = (lane == nts) ? (int)(unsigned)_c : ts_lo; ts_hi = (lane == nts) ? (int)(unsigned)(_c >> 32) : ts_hi; ++nts; } } while (0)
    PG8_STAMP();
    unsigned voffA[2], voffB[2];
#pragma unroll
    for (int i = 0; i < 2; ++i) { int R, C; stage_rc(tid * 16 + i * 8192, R, C); const int Rb = Epi::PERM ? ((R & ~31) + perm32(R & 31)) : R;
        voffA[i] = (unsigned)(R * K + C) * 2u; voffB[i] = (unsigned)(Rb * K + C) * 2u; }
    const size_t kstep = (size_t)(BK * 2);
    const size_t hstep = (size_t)HALF * K * 2;
    const size_t tstep = 2 * hstep;
    const unsigned ldsw = (unsigned)wid * 1024u;
    const int aoff = lds_byte(wr * 64 + fr, fq * 8), boff = lds_byte(wc * 32 + fr, fq * 8);
#define PG8_SA(b, h) (((b) * 2 + (h)) * HTB)
#define PG8_SB(b, h) ((4 + (b) * 2 + (h)) * HTB)
#define PG8_STAGE(bufoff, gbase, voff) do { _Pragma("unroll") for (int _i = 0; _i < 2; ++_i) \
        __builtin_amdgcn_global_load_lds((const unsigned*)((const char*)(gbase) + (voff)[_i]), (PG8_LAS unsigned*)(lds + (bufoff) + ldsw + _i * 8192), 16, 0, 0); } while (0)
#define PG8_LDA(dst, b, h) do { _Pragma("unroll") for (int m = 0; m < 4; ++m) _Pragma("unroll") for (int k = 0; k < 2; ++k) dst[m][k] = *(const PG8_LAS bf16x8*)(lds + PG8_SA(b, h) + aoff + m * 2048 + k * 1024); } while (0)
#define PG8_LDB(dst, b, h) do { _Pragma("unroll") for (int n = 0; n < 2; ++n) _Pragma("unroll") for (int k = 0; k < 2; ++k) dst[n][k] = *(const PG8_LAS bf16x8*)(lds + PG8_SB(b, h) + boff + n * 2048 + k * 1024); } while (0)
#define PG8_MMA(ai, bj, At, Bt) do { __builtin_amdgcn_s_setprio(1); _Pragma("unroll") for (int m = 0; m < 4; ++m) _Pragma("unroll") for (int n = 0; n < 2; ++n) _Pragma("unroll") for (int k = 0; k < 2; ++k) \
        acc[ai][bj][m][n] = __builtin_amdgcn_mfma_f32_16x16x32_bf16(Bt[n][k], At[m][k], acc[ai][bj][m][n], 0, 0, 0); __builtin_amdgcn_s_setprio(0); } while (0)
#define PG8_WAIT_V(n) asm volatile("s_waitcnt vmcnt(" #n ")" ::: "memory")
#define PG8_WAIT_L(n) asm volatile("s_waitcnt lgkmcnt(" #n ")" ::: "memory")
#define PG8_BAR __builtin_amdgcn_s_barrier()
#define PG8_SCHED __builtin_amdgcn_sched_barrier(0)
    Unit cur, nxt; int ui = 0;
    if (!S.next(0, cur)) return;
    f32x4 acc[2][2][4][2];
#pragma unroll
    for (int a = 0; a < 2; ++a)
#pragma unroll
        for (int b = 0; b < 2; ++b)
#pragma unroll
            for (int m = 0; m < 4; ++m)
#pragma unroll
                for (int n = 0; n < 2; ++n) acc[a][b][m][n] = (f32x4){0.f, 0.f, 0.f, 0.f};
    bf16x8 At[4][2], B0[2][2], B1[2][2];
    const char* cA = (const char*)g.A + (size_t)cur.pm * tstep + (size_t)cur.koff; const char* cB = (const char*)g.Bt + (size_t)cur.pn * tstep + (size_t)cur.koff;
    S.a_ready(cur);
    PG8_STAGE(PG8_SB(0, 0), cB, voffB); PG8_STAGE(PG8_SA(0, 0), cA, voffA); PG8_STAGE(PG8_SB(0, 1), cB + hstep, voffB); PG8_STAGE(PG8_SA(0, 1), cA + hstep, voffA);
    if (wr == 1) PG8_BAR;
    PG8_WAIT_V(4); PG8_BAR;
    PG8_STAGE(PG8_SB(1, 0), cB + kstep, voffB); PG8_STAGE(PG8_SA(1, 0), cA + kstep, voffA); PG8_STAGE(PG8_SB(1, 1), cB + hstep + kstep, voffB);
    PG8_WAIT_V(6); PG8_BAR;
    PG8_STAMP();
    for (;;) {
        const bool has_next = S.next(ui + 1, nxt);
        const char* nA = has_next ? (const char*)g.A + (size_t)nxt.pm * tstep + (size_t)nxt.koff : cA; const char* nB = has_next ? (const char*)g.Bt + (size_t)nxt.pn * tstep + (size_t)nxt.koff : cB;
        const int nt = cur.nt;
        for (int t = 0; t < nt; t += 2) {
            const bool last = (t == nt - 2);
            const char* a1 = cA + (size_t)(t + 1) * kstep;
            const char* a2 = last ? nA : cA + (size_t)(t + 2) * kstep; const char* b2 = last ? nB : cB + (size_t)(t + 2) * kstep;
            const char* a3 = a2 + kstep; const char* b3 = b2 + kstep;
            if (last && has_next) S.a_ready(nxt);
            PG8_LDB(B0, 0, 0); PG8_SCHED; PG8_LDA(At, 0, 0); PG8_STAGE(PG8_SA(1, 1), a1 + hstep, voffA);
            PG8_WAIT_L(8); PG8_BAR; PG8_WAIT_L(0); PG8_MMA(0, 0, At, B0); PG8_BAR; PG8_SCHED;
            PG8_LDB(B1, 0, 1); PG8_STAGE(PG8_SB(0, 0), b2, voffB);
            PG8_BAR; PG8_WAIT_L(0); PG8_MMA(0, 1, At, B1); PG8_BAR;
            PG8_LDA(At, 0, 1); PG8_STAGE(PG8_SA(0, 0), a2, voffA);
            PG8_BAR; PG8_WAIT_L(0); PG8_MMA(1, 0, At, B0); PG8_BAR; PG8_SCHED;
            PG8_STAGE(PG8_SB(0, 1), b2 + hstep, voffB);
            PG8_WAIT_V(6); PG8_BAR; PG8_MMA(1, 1, At, B1); PG8_BAR;
            PG8_LDB(B0, 1, 0); PG8_SCHED; PG8_LDA(At, 1, 0); PG8_STAGE(PG8_SA(0, 1), a2 + hstep, voffA);
            PG8_WAIT_L(8); PG8_BAR; PG8_WAIT_L(0); PG8_MMA(0, 0, At, B0); PG8_BAR; PG8_SCHED;
            PG8_LDB(B1, 1, 1); PG8_STAGE(PG8_SB(1, 0), b3, voffB);
            PG8_BAR; PG8_WAIT_L(0); PG8_MMA(0, 1, At, B1); PG8_BAR;
            PG8_LDA(At, 1, 1); PG8_STAGE(PG8_SA(1, 0), a3, voffA);
            PG8_BAR; PG8_WAIT_L(0); PG8_MMA(1, 0, At, B0); PG8_BAR; PG8_SCHED;
            PG8_STAGE(PG8_SB(1, 1), b3 + hstep, voffB);
            PG8_WAIT_V(6); PG8_BAR; PG8_MMA(1, 1, At, B1); PG8_BAR;
        }
        PG8_STAMP();
        if constexpr (!Epi::AFTER_DRAIN) { E(acc, cur, wr, wc, fr, fq); S.done(cur); }
        PG8_STAMP();
        if (!has_next) break;
#pragma unroll
        for (int a = 0; a < 2; ++a)
#pragma unroll
            for (int b = 0; b < 2; ++b)
#pragma unroll
                for (int m = 0; m < 4; ++m)
#pragma unroll
                    for (int n = 0; n < 2; ++n) acc[a][b][m][n] = (f32x4){0.f, 0.f, 0.f, 0.f};
        cur = nxt; cA = nA; cB = nB; ++ui;
    }
    PG8_WAIT_V(0);
    if (wr == 0) PG8_BAR;
    PG8_BAR;
    if constexpr (Epi::AFTER_DRAIN) { E.fused(acc, cur, wr, wc, fr, fq, lds, wid, lane); S.done(cur); }
    PG8_STAMP();
    if (STAMP && wid == 0) { stamps[lane] = lane < nts ? (((unsigned long long)(unsigned)ts_hi << 32) | (unsigned)ts_lo) : 0ull;
        if (lane == 62) stamps[62] = rt_entry; if (lane == 63) stamps[63] = (unsigned long long)wall_clock64(); }
#undef PG8_STAMP
#undef PG8_SA
#undef PG8_SB
#undef PG8_STAGE
#undef PG8_LDA
#undef PG8_LDB
#undef PG8_MMA
#undef PG8_WAIT_V
#undef PG8_WAIT_L
#undef PG8_BAR
#undef PG8_SCHED
}
}
using pg8::bf16_t; using pg8::bf16x8; using pg8::f32x4; using pg8::u32x4; using pg8::Unit; using pg8::cvt_pk_bf16;
#define LAS __attribute__((address_space(3)))
typedef unsigned u32x2 __attribute__((ext_vector_type(2)));

constexpr int DM = 1024, DFF = 2816, MP = 16384, MS = 2048, MT = 18432, INWP = 2304, ZW = 2304;
constexpr int NTILE = 288;
constexpr float EPS = 1e-6f;
constexpr float QSCALE = 0.07216878364870322f * 1.4426950408889634f;
constexpr int ZQ = 0, ZKV = 384, ZPE = 640, ZHQ = 704, ZHF = 960, ZHI = 1216, ZHG = 1472, ZCU = 1728, ZCV = 1984;
constexpr size_t SZ_WGU = 4ull * 5632 * 1024 * 2, SZ_WDN = 4ull * 1024 * 2816 * 2, SZ_WIN = 2ull * 2304 * 1024 * 2, SZ_WQ = 2ull * 1280 * 384 * 2, SZ_WMIX = 2ull * 1024 * 1536 * 2;
constexpr size_t SKEW = 69888;
constexpr size_t OFF_WGU = 0, OFF_WDN = OFF_WGU + SZ_WGU + SKEW, OFF_WIN = OFF_WDN + SZ_WDN + SKEW, OFF_WQ = OFF_WIN + SZ_WIN + SKEW, OFF_WMIX = OFF_WQ + SZ_WQ + SKEW;
constexpr size_t OFF_X = OFF_WMIX + SZ_WMIX + SKEW, SZ_X = (size_t)MT * 1024 * 4;
constexpr size_t OFF_D = OFF_X + SZ_X + SKEW, SZ_D = (size_t)MT * 1024 * 2;
constexpr size_t OFF_H = OFF_D + SZ_D + SKEW, SZ_H = (size_t)MT * 1024 * 2;
constexpr size_t OFF_ACT = OFF_H + SZ_H + SKEW, SZ_ACT = (size_t)MT * 2816 * 2;
constexpr size_t KROWS = 16384 + 32 * 2112;
constexpr size_t OFF_KC = OFF_ACT + SZ_ACT + SKEW, SZ_KC = KROWS * 640;
constexpr size_t OFF_CT = OFF_KC + SZ_KC + SKEW, SZ_CT = KROWS * 512;
constexpr size_t OFF_MIXA = OFF_CT + SZ_CT + SKEW, SZ_MIXA = (size_t)MT * 1536 * 2;
constexpr size_t OFF_SST = OFF_MIXA + SZ_MIXA + SKEW, SZ_SST = 1024ull * 4096 * 4;
constexpr size_t OFF_ROPE = OFF_SST + SZ_SST + SKEW, SZ_ROPE = 4096ull * 32 * 8;
constexpr size_t OFF_CTL = OFF_ROPE + SZ_ROPE + SKEW, SZ_CTL = 32768;
constexpr size_t OFF_BCUM = OFF_CTL + SZ_CTL + SKEW, SZ_BCUM = (size_t)MT * 256 * 4;
constexpr size_t WS_END = OFF_BCUM + SZ_BCUM;
constexpr size_t OFF_Z = OFF_ACT, SZ_Z = (size_t)MT * ZW * 2;
constexpr size_t OFF_QN = OFF_Z + SZ_Z + SKEW;
constexpr size_t OFF_Q = OFF_X + 1048576 + SKEW;
constexpr size_t OFF_U = OFF_Q + (size_t)MT * 1280 * 2 + SKEW;
constexpr size_t OFF_DEC = OFF_U + 1152ull * 4096 * 4;
static_assert(OFF_QN + (size_t)MT * 384 * 2 <= OFF_ACT + SZ_ACT, "z/qn overlay");
static_assert(OFF_DEC + 1152ull * 64 * 4 <= OFF_X + SZ_X, "Q/U overlay");
constexpr size_t O_Y = 0, O_CKVP = 18874368, O_KPEP = 27262976, O_HGP = 29360128, O_CKVS = 29491200, O_KPES = 30539776, O_HGS = 30801920, O_CMV = 31850496;

constexpr int LDS_MAIN = 157696, LDS_BYTES = LDS_MAIN + 64;
constexpr int NPHASE = 25;

struct Args { const float* in[21]; float* out; unsigned char* ws; int ph_lo, ph_hi; };
typedef const __attribute__((address_space(4))) Args CArgs;

__device__ __forceinline__ int bid_() { int b = blockIdx.x; asm volatile("" : "+s"(b)); return b; }
__device__ __forceinline__ int gdim_() { int g = gridDim.x; asm volatile("" : "+s"(g)); return g; }
__device__ __forceinline__ float bf2f(unsigned short b) { return __uint_as_float(((unsigned)b) << 16); }
__device__ __forceinline__ float bflo(unsigned w) { return __uint_as_float(w << 16); }
__device__ __forceinline__ float bfhi(unsigned w) { return __uint_as_float(w & 0xffff0000u); }
__device__ __forceinline__ unsigned short f2bf(float f) { unsigned u = __float_as_uint(f); u += 0x7FFFu + ((u >> 16) & 1u); return (unsigned short)(u >> 16); }
__device__ __forceinline__ float wave_sum(float v) {
#pragma unroll
    for (int o = 32; o >= 1; o >>= 1) v += __shfl_xor(v, o);
    return v; }
__device__ __forceinline__ float sigmoidf_(float x) { return __builtin_amdgcn_rcpf(1.0f + __expf(-x)); }
__device__ __forceinline__ float siluf_(float x) { return x * sigmoidf_(x); }
__device__ __forceinline__ float geluf_(float x) { const float y = 0.7978845608028654f * (x + 0.044715f * x * x * x); return x - x * __builtin_amdgcn_rcpf(__expf(2.0f * y) + 1.0f); }

struct EpiBf {
    static constexpr bool PERM = true, AFTER_DRAIN = false;
    bf16_t* O; int ldc; bf16_t* O1;
    __device__ __forceinline__ void operator()(const f32x4 (&acc)[2][2][4][2], const Unit& u, int wr, int wc, int fr, int fq) const {
        const int row0 = u.pm * 256 + wr * 64 + fr, col0 = u.pn * 256 + wc * 32 + 8 * fq; bf16_t* Ob = (O1 && u.ks >= 0) ? O1 + ((long)u.ks * MS - MP) * (long)ldc : O;
#pragma unroll
        for (int ai = 0; ai < 2; ++ai)
#pragma unroll
            for (int m = 0; m < 4; ++m) { bf16_t* rowp = Ob + (size_t)(row0 + ai * 128 + m * 16) * ldc + col0;
#pragma unroll
                for (int bj = 0; bj < 2; ++bj) { const f32x4 v0 = acc[ai][bj][m][0], v1 = acc[ai][bj][m][1];
                    u32x4 w; w.x = cvt_pk_bf16(v0[0], v0[1]); w.y = cvt_pk_bf16(v0[2], v0[3]); w.z = cvt_pk_bf16(v1[0], v1[1]); w.w = cvt_pk_bf16(v1[2], v1[3]);
                    *(u32x4*)(rowp + bj * 128) = w; } }
    }
};
struct EpiSwiGLU {
    static constexpr bool PERM = true, AFTER_DRAIN = false;
    bf16_t* O;
    __device__ __forceinline__ void operator()(const f32x4 (&acc)[2][2][4][2], const Unit& u, int wr, int wc, int fr, int fq) const {
        const int row0 = u.pm * 256 + wr * 64 + fr, col0 = u.pn * 128 + wc * 32 + 8 * fq;
#pragma unroll
        for (int ai = 0; ai < 2; ++ai)
#pragma unroll
            for (int m = 0; m < 4; ++m) { bf16_t* rowp = O + (size_t)(row0 + ai * 128 + m * 16) * DFF + col0;
                const f32x4 g0 = acc[ai][0][m][0], g1 = acc[ai][0][m][1], u0 = acc[ai][1][m][0], u1 = acc[ai][1][m][1];
                u32x4 w; w.x = cvt_pk_bf16(siluf_(g0[0]) * u0[0], siluf_(g0[1]) * u0[1]); w.y = cvt_pk_bf16(siluf_(g0[2]) * u0[2], siluf_(g0[3]) * u0[3]);
                w.z = cvt_pk_bf16(siluf_(g1[0]) * u1[0], siluf_(g1[1]) * u1[1]); w.w = cvt_pk_bf16(siluf_(g1[2]) * u1[2], siluf_(g1[3]) * u1[3]);
                *(u32x4*)rowp = w; }
    }
};
struct EpiQ {
    static constexpr bool PERM = true, AFTER_DRAIN = false;
    bf16_t* Q;
    __device__ __forceinline__ void operator()(const f32x4 (&acc)[2][2][4][2], const Unit& u, int wr, int wc, int fr, int fq) const {
        const int row0 = u.pm * 256 + wr * 64 + fr;
        const int off0 = u.pn < 4 ? u.pn * 320 + wc * 32 + 8 * fq : wc * 320 + 256 + 8 * fq, bjs = u.pn < 4 ? 128 : 32;
#pragma unroll
        for (int ai = 0; ai < 2; ++ai)
#pragma unroll
            for (int m = 0; m < 4; ++m) { bf16_t* rowp = Q + (size_t)(row0 + ai * 128 + m * 16) * 1280 + off0;
#pragma unroll
                for (int bj = 0; bj < 2; ++bj) { const f32x4 v0 = acc[ai][bj][m][0], v1 = acc[ai][bj][m][1];
                    u32x4 w; w.x = cvt_pk_bf16(v0[0], v0[1]); w.y = cvt_pk_bf16(v0[2], v0[3]); w.z = cvt_pk_bf16(v1[0], v1[1]); w.w = cvt_pk_bf16(v1[2], v1[3]);
                    *(u32x4*)(rowp + bj * bjs) = w; } }
    }
};
struct TailSplitOrder {
    int G, c, nsp, nt_full, nt_sub, kb_sub;
    __device__ bool next(int i, Unit& u) const {
        const int L = i * G + c;
        if (L < 256) { const int off = L >> 3; u.pm = (L & 7) * 8 + (off >> 2); u.pn = off & 3; u.ks = -1; u.nt = nt_full; u.koff = 0; return true; }
        const int s2 = L - 256; if (s2 >= 32 * nsp) return false;
        const int pair = s2 & 31; u.pm = 64 + (pair >> 2); u.pn = pair & 3; u.ks = s2 >> 5; u.nt = nt_sub; u.koff = u.ks * kb_sub; return true;
    }
    __device__ __forceinline__ void a_ready(const Unit&) const {}
    __device__ __forceinline__ void done(const Unit&) const {}
};
template <class Epi> __device__ __forceinline__ void run_gemm(unsigned char* lds, const bf16_t* A, const bf16_t* Bt, int M, int N, int K, const Epi& E, int nsp = 0  ) {
    pg8::Gemm g{A, Bt, M, N, K, K};
    if (nsp) { TailSplitOrder S; S.G = gdim_(); S.c = bid_(); S.nsp = nsp; S.nt_full = K / 64; S.nt_sub = K / nsp / 64; S.kb_sub = K / nsp * 2; pg8::gemm_phase<Epi, TailSplitOrder, false>((PG8_LAS unsigned char*)lds, g, S, E, nullptr); }
    else { pg8::StaticOrder S; S.init(M, N, gdim_(), bid_(), 1); S.unt = K / 64; S.ukb = K * 2; pg8::gemm_phase<Epi, pg8::StaticOrder, false>((PG8_LAS unsigned char*)lds, g, S, E, nullptr); }
}
#define GAS __attribute__((address_space(1)))
#define XB_TMO      128
#define XB_XCNT(j)  (256  + 64 * (j))
#define XB_XSUB(j)  (1280 + 64 * (j))
#define XB_XGEN(j)  (2304 + 64 * (j))
#define XB_TOP      3328
#define XB_TOPGEN   3392
#define XCD_BAR_WORDS 3456
#define XB_SPIN_CAP (1u << 18)

__device__ __forceinline__ unsigned xb_ld(unsigned* p)              { return __hip_atomic_load(p, __ATOMIC_RELAXED, __HIP_MEMORY_SCOPE_AGENT); }
__device__ __forceinline__ unsigned xb_add(unsigned* p, unsigned v) { return __hip_atomic_fetch_add(p, v, __ATOMIC_RELAXED, __HIP_MEMORY_SCOPE_AGENT); }
__device__ __forceinline__ unsigned xb_xcc_id() { return (unsigned)__builtin_amdgcn_s_getreg((3 << 11) | 20) & 0xFu; }
#define XB_SPIN(cond, bar) do { unsigned _sp = 0; while (cond) { __builtin_amdgcn_s_sleep(1); \
    if ((++_sp & 255u) == 0u) { if (xb_ld(&(bar)[XB_TMO])) break; if (_sp > XB_SPIN_CAP) { atomicAdd(&(bar)[XB_TMO], 1u); break; } } } } while (0)

struct XcdBarrier {
    unsigned* bar; unsigned x;
    volatile LAS unsigned* st;
};

__device__ __forceinline__ XcdBarrier xcd_barrier_post(unsigned* bar, volatile LAS unsigned* st) {
    XcdBarrier b; b.bar = bar; b.x = xb_xcc_id(); b.st = st;
    if (threadIdx.x == 0) (void)xb_add(&bar[XB_XCNT(b.x)], 1u);
    return b;
}
__device__ __forceinline__ void xcd_barrier_complete(unsigned* bar, unsigned x, unsigned& nloc, unsigned& nx) {
    const unsigned G = gridDim.x * gridDim.y * gridDim.z;
    unsigned sum, cnt, mine, sp = 0u;
    for (;;) {
        sum = 0u; cnt = 0u; mine = 0u;
#pragma unroll
        for (unsigned j = 0; j < 16; ++j) { const unsigned c = xb_ld(&bar[XB_XCNT(j)]); sum += c; cnt += (c > 0u) ? 1u : 0u; mine = (j == x) ? c : mine; }
        if (sum == G) break;
        __builtin_amdgcn_s_sleep(1);
        if ((++sp & 255u) == 0u) { if (xb_ld(&bar[XB_TMO])) break; if (sp > XB_SPIN_CAP) { atomicAdd(&bar[XB_TMO], 1u); break; } }
    }
    nloc = mine > 0u ? mine : 1u; nx = cnt > 0u ? cnt : 1u;
}

__device__ __forceinline__ void xcd_barrier(const XcdBarrier& b) {
    asm volatile("s_waitcnt vmcnt(0)" ::: "memory");
    __syncthreads();
    if (threadIdx.x == 0) {
        unsigned* bar = b.bar; asm volatile("" : "+s"(bar));
        __builtin_amdgcn_s_waitcnt(0);
        unsigned nloc = b.st[0], nx = b.st[1];
        if (nloc == 0u) { xcd_barrier_complete(bar, b.x, nloc, nx); b.st[0] = nloc; b.st[1] = nx; }
        const unsigned old = xb_add(&bar[XB_XSUB(b.x)], 1u);
        const unsigned gen = old / nloc;
        if (old + 1u == (gen + 1u) * nloc) {
            __builtin_amdgcn_fence(__ATOMIC_RELEASE, "agent");
            asm volatile("s_waitcnt vmcnt(0)" ::: "memory");
            const unsigned og = xb_add(&bar[XB_TOP], 1u);
            const unsigned tg = og / nx;
            if (og + 1u == (tg + 1u) * nx) xb_add(&bar[XB_TOPGEN], 1u);
            else XB_SPIN(xb_ld(&bar[XB_TOPGEN]) == tg, bar);
            __builtin_amdgcn_fence(__ATOMIC_ACQUIRE, "agent");
            xb_add(&bar[XB_XGEN(b.x)], 1u);
            asm volatile("s_waitcnt vmcnt(0)" ::: "memory");
        } else {
            XB_SPIN(xb_ld(&bar[XB_XGEN(b.x)]) == gen, bar);
            __builtin_amdgcn_fence(__ATOMIC_ACQUIRE, "agent");
            asm volatile("s_waitcnt vmcnt(0)" ::: "memory");
        }
    }
    __syncthreads();
}
__device__ __forceinline__ void tr_tile(const float* __restrict__ src, int srcN, bf16_t* __restrict__ dst, int dstK, int k0, int n0, int mode, float* T) {
    int tid = threadIdx.x; asm volatile("" : "+v"(tid));
    float4 v[4];
#pragma unroll
    for (int e = 0; e < 4; ++e) { const int idx = tid + 512 * e, kk = idx >> 4, n4 = idx & 15; { const f32x4 q4 = __builtin_nontemporal_load((const f32x4*)(src + (size_t)(k0 + kk) * srcN + n0 + 4 * n4)); v[e] = make_float4(q4[0], q4[1], q4[2], q4[3]); } }
#pragma unroll
    for (int e = 0; e < 4; ++e) { const int idx = tid + 512 * e, kk = idx >> 4, n4 = idx & 15; float* t = T + kk * 65 + 4 * n4; t[0] = v[e].x; t[1] = v[e].y; t[2] = v[e].z; t[3] = v[e].w; }
    __syncthreads();
#pragma unroll
    for (int e = 0; e < 2; ++e) { const int idx = tid + 512 * e, nn = idx >> 4, kq = idx & 15; const int n = n0 + nn;
        const int row = mode == 0 ? n : ((n >> 7) * 256 + (n & 127) + (mode == 2 ? 128 : 0)); const float* t = T + (8 * kq) * 65 + nn;
        u32x4 w; w.x = cvt_pk_bf16(t[0], t[65]); w.y = cvt_pk_bf16(t[130], t[195]); w.z = cvt_pk_bf16(t[260], t[325]); w.w = cvt_pk_bf16(t[390], t[455]);
        *(u32x4*)(dst + (size_t)row * dstK + k0 + 8 * kq) = w; }
    __syncthreads();
}
__device__ __forceinline__ void tr_task(const float* src, int srcN, int K, bf16_t* dst, int dstK, int mode, float* T) {
    const int tn = srcN >> 6, nt = (K >> 7) * tn;
    for (int t = bid_(); t < nt; t += gdim_()) tr_tile(src, srcN, dst, dstK, (t / tn) * 128, (t % tn) * 64, mode, T);
}
template <bool XIN_F32, bool XOUT_F32>
__device__ __forceinline__ void ew_phase(const bf16_t* __restrict__ D, const bf16_t* D1  , int nsp, const void* xa  , const float* __restrict__ xb  , void* xout  ,
                                         const float* __restrict__ gpost, float coef, const float* __restrict__ gpre, bf16_t* hout, const float* __restrict__ gin, float* rsb  ) {
    int tid = threadIdx.x; asm volatile("" : "+v"(tid)); const int lane = tid & 63, wave = tid >> 6;
    const int rstep = gdim_() * 8;
    for (int rb = bid_() * 8 + wave; rb < MT; rb += 2 * rstep) {
        float4 xv[2][4]; float dv[2][4][4];
#pragma unroll
        for (int u = 0; u < 2; ++u) { const int r = rb + u * rstep; if (r < MT) {
            if (XIN_F32) { const float* xr = (xb && r >= MP) ? xb + (size_t)(r - MP) * DM : (const float*)xa + (size_t)r * DM;
#pragma unroll
                for (int i = 0; i < 4; ++i) { const f32x4 q4 = __builtin_nontemporal_load((const f32x4*)(xr + lane * 4 + 256 * i)); xv[u][i] = make_float4(q4[0], q4[1], q4[2], q4[3]); } }
            else {
#pragma unroll
                for (int i = 0; i < 4; ++i) { const u32x2 w = __builtin_nontemporal_load((const u32x2*)((const bf16_t*)xa + (size_t)r * DM + lane * 4 + 256 * i)); xv[u][i] = make_float4(bflo(w.x), bfhi(w.x), bflo(w.y), bfhi(w.y)); }
                const float ir = __builtin_amdgcn_rcpf(rsb[r]);
#pragma unroll
                for (int i = 0; i < 4; ++i) { const float4 gi = *(const float4*)(gin + lane * 4 + 256 * i);
                    xv[u][i].x *= ir * __builtin_amdgcn_rcpf(gi.x); xv[u][i].y *= ir * __builtin_amdgcn_rcpf(gi.y); xv[u][i].z *= ir * __builtin_amdgcn_rcpf(gi.z); xv[u][i].w *= ir * __builtin_amdgcn_rcpf(gi.w); } }
            if (D) {
#pragma unroll
                for (int i = 0; i < 4; ++i) { const u32x2 w = __builtin_nontemporal_load((const u32x2*)(D + (size_t)r * DM + lane * 4 + 256 * i)); dv[u][i][0] = bflo(w.x); dv[u][i][1] = bfhi(w.x); dv[u][i][2] = bflo(w.y); dv[u][i][3] = bfhi(w.y);
                    } } } }
        if (D1) {
#pragma unroll
            for (int u = 0; u < 2; ++u) { const int r = rb + u * rstep; if (r >= MP && r < MT) {
#pragma unroll
                for (int i = 0; i < 4; ++i) { dv[u][i][0] = 0.f; dv[u][i][1] = 0.f; dv[u][i][2] = 0.f; dv[u][i][3] = 0.f; }
                for (int ks = 0; ks < nsp; ++ks) {
#pragma unroll
                    for (int i = 0; i < 4; ++i) { const u32x2 w1 = __builtin_nontemporal_load((const u32x2*)(D1 + ((size_t)ks * MS + (r - MP)) * DM + lane * 4 + 256 * i)); dv[u][i][0] += bflo(w1.x); dv[u][i][1] += bfhi(w1.x); dv[u][i][2] += bflo(w1.y); dv[u][i][3] += bfhi(w1.y); } } } } }
#pragma unroll
        for (int u = 0; u < 2; ++u) { const int r = rb + u * rstep; if (r < MT) {
            if (D) { float ss = 0.f;
#pragma unroll
                for (int i = 0; i < 4; ++i) ss += dv[u][i][0] * dv[u][i][0] + dv[u][i][1] * dv[u][i][1] + dv[u][i][2] * dv[u][i][2] + dv[u][i][3] * dv[u][i][3];
                ss = wave_sum(ss); const float rs = coef * rsqrtf(ss * (1.0f / 1024.0f) + EPS);
#pragma unroll
                for (int i = 0; i < 4; ++i) { const float4 g = *(const float4*)(gpost + lane * 4 + 256 * i);
                    xv[u][i].x += dv[u][i][0] * rs * g.x; xv[u][i].y += dv[u][i][1] * rs * g.y; xv[u][i].z += dv[u][i][2] * rs * g.z; xv[u][i].w += dv[u][i][3] * rs * g.w; } }
            if (XOUT_F32) {
#pragma unroll
                for (int i = 0; i < 4; ++i) __builtin_nontemporal_store((f32x4){xv[u][i].x, xv[u][i].y, xv[u][i].z, xv[u][i].w}, (f32x4*)((float*)xout + (size_t)r * DM + lane * 4 + 256 * i)); }

            if (hout) { float ss = 0.f;
#pragma unroll
                for (int i = 0; i < 4; ++i) ss += xv[u][i].x * xv[u][i].x + xv[u][i].y * xv[u][i].y + xv[u][i].z * xv[u][i].z + xv[u][i].w * xv[u][i].w;
                ss = wave_sum(ss); const float rs = rsqrtf(ss * (1.0f / 1024.0f) + EPS); if (lane == 0) rsb[r] = rs;
#pragma unroll
                for (int i = 0; i < 4; ++i) { const float4 g = *(const float4*)(gpre + lane * 4 + 256 * i); uint2 w;
                    w.x = cvt_pk_bf16(xv[u][i].x * rs * g.x, xv[u][i].y * rs * g.y); w.y = cvt_pk_bf16(xv[u][i].z * rs * g.z, xv[u][i].w * rs * g.w);
                    *(uint2*)(hout + (size_t)r * DM + lane * 4 + 256 * i) = w; } } } }
    }
}
__device__ __forceinline__ int wtask_count(int kind) { return kind < 6 ? 352 : kind == 6 ? 281 : kind == 7 ? 64 : kind == 8 ? 256 : kind == 9 ? 96 : 192; }
__device__ void wtask_run(CArgs& a, int l, int kind, int t, unsigned char* lds) {
    unsigned char* ws = a.ws; float* T = (float*)lds; int tid = threadIdx.x; asm volatile("" : "+v"(tid));
    if (kind < 6) { const int f = kind / 3, m = kind % 3; const size_t lf = (size_t)(l * 2 + f);
        if (m < 2) tr_tile(a.in[6 + m] + lf * 1024 * 2816, 2816, (bf16_t*)(ws + OFF_WGU) + lf * 5632 * 1024, 1024, (t / 44) * 128, (t % 44) * 64, 1 + m, T);
        else tr_tile(a.in[8] + lf * 2816 * 1024, 1024, (bf16_t*)(ws + OFF_WDN) + lf * 1024 * 2816, 2816, (t / 16) * 128, (t % 16) * 64, 0, T);
    } else if (kind == 6) { bf16_t* win = (bf16_t*)(ws + OFF_WIN) + (size_t)l * 2304 * 1024;
        if (t < 280) tr_tile(a.in[9] + (size_t)l * 1024 * 2240, 2240, win, 1024, (t / 35) * 128, (t % 35) * 64, 0, T);
        else { for (int i = tid; i < 64 * 1024 / 2; i += 512) ((unsigned*)(win + 2240 * 1024))[i] = 0u; }
    } else if (kind == 7) { bf16_t* wmix = (bf16_t*)(ws + OFF_WMIX) + (size_t)l * 1024 * 1536;
        tr_tile(a.in[10] + (size_t)l * 1024 * 1024 + 512 * 1024, 1024, wmix + 1024, 1536, (t / 16) * 128, (t % 16) * 64, 0, T);
    } else if (kind == 8) {
        bf16_t* wmix = (bf16_t*)(ws + OFF_WMIX) + (size_t)l * 1024 * 1536; const float* wuv = a.in[15] + (size_t)l * 256 * 512; const float* wo = a.in[10] + (size_t)l * 1024 * 1024;
        const int i = t * 512 + tid; const int n = i & 1023, hcb = t >> 1, h = hcb >> 5, cb = hcb & 31;
        float* W = T;
        __syncthreads();
#pragma unroll
        for (int e = 0; e < 2; ++e) { const int q = tid + 512 * e, j = q >> 7, v = q & 127; W[v * 8 + j] = wuv[((8 * cb + j) * 4 + h) * 128 + v]; }
        __syncthreads();
        const float* bv = wo + (size_t)(h * 128) * 1024 + n; float acc[8];
#pragma unroll
        for (int j = 0; j < 8; ++j) acc[j] = 0.f;
#pragma unroll 1
        for (int v0 = 0; v0 < 128; v0 += 16) { float bb[16];
#pragma unroll
            for (int u = 0; u < 16; ++u) bb[u] = bv[(size_t)(v0 + u) * 1024];
#pragma unroll
            for (int u = 0; u < 16; ++u) { const float4 w0 = *(const float4*)(W + (v0 + u) * 8), w1 = *(const float4*)(W + (v0 + u) * 8 + 4);
                acc[0] += w0.x * bb[u]; acc[1] += w0.y * bb[u]; acc[2] += w0.z * bb[u]; acc[3] += w0.w * bb[u]; acc[4] += w1.x * bb[u]; acc[5] += w1.y * bb[u]; acc[6] += w1.z * bb[u]; acc[7] += w1.w * bb[u]; } }
        u32x4 w; w.x = cvt_pk_bf16(acc[0], acc[1]); w.y = cvt_pk_bf16(acc[2], acc[3]); w.z = cvt_pk_bf16(acc[4], acc[5]); w.w = cvt_pk_bf16(acc[6], acc[7]);
        *(u32x4*)(wmix + (size_t)n * 1536 + h * 256 + 8 * cb) = w;
        __syncthreads();
    } else { bf16_t* wq = (bf16_t*)(ws + OFF_WQ) + (size_t)l * 1280 * 384; const float* wuk = a.in[14] + (size_t)l * 256 * 512; const float* wqb = a.in[12] + (size_t)l * 384 * 768;
        const int i = t * 512 + tid;
        if (kind == 9) {
            const int k = i % 384, hcb = i / 384, h = hcb >> 5, cb = hcb & 31;
            const float4* bv = (const float4*)(wqb + (size_t)k * 768 + h * 192); float acc[8];
#pragma unroll
            for (int j = 0; j < 8; ++j) acc[j] = 0.f;
#pragma unroll 2
            for (int v = 0; v < 32; ++v) { const float4 y = bv[v];
#pragma unroll
                for (int j = 0; j < 8; ++j) { const float4 x = *(const float4*)(wuk + ((8 * cb + j) * 4 + h) * 128 + 4 * v); acc[j] += x.x * y.x + x.y * y.y + x.z * y.z + x.w * y.w; } }
#pragma unroll
            for (int j = 0; j < 8; ++j) wq[(size_t)(h * 256 + 8 * cb + j) * 384 + k] = f2bf(acc[j] * QSCALE);
        } else {
            const int k = i % 384, j = i / 384, half = j >> 7, jj = j & 127, h = jj >> 5, fi = jj & 31;
            wq[(size_t)(1024 + j) * 384 + k] = f2bf(wqb[(size_t)k * 768 + h * 192 + 128 + half * 32 + fi] * QSCALE); }
    }
}
__device__ void wtasks(CArgs& a, int l, int k0, int k1, int cw, unsigned char* lds) {
    unsigned* ctr = (unsigned*)(a.ws + OFF_CTL) + cw; LAS unsigned* slot = (LAS unsigned*)(lds + LDS_MAIN + 16);
    int total = 0; for (int k = k0; k < k1; ++k) total += wtask_count(k);
    for (;;) {
        __syncthreads();
        { int t0 = threadIdx.x; asm volatile("" : "+v"(t0)); if (t0 == 0) *slot = atomicAdd(ctr, 1u); }
        __syncthreads();
        int it = (int)*slot;
        if (it >= total) break;
        int k = k0; while (it >= wtask_count(k)) { it -= wtask_count(k); ++k; }
        wtask_run(a, l, k, it, lds);
    }
}
__device__ void phase_init(CArgs& a, unsigned char* lds) {
    unsigned char* ws = a.ws;
    int tid = threadIdx.x; asm volatile("" : "+v"(tid)); const size_t gtid = (size_t)bid_() * 512 + tid, gsz = (size_t)gdim_() * 512;
    for (size_t i = gtid; i < 4096 * 32; i += gsz) { const int pos = (int)(i >> 5), fi = (int)(i & 31);
        const float w = exp2f(-(float)fi * (13.287712379549449f / 32.0f)); const double ang = (double)((float)pos * w);
        const double k = rint(ang * 0.15915494309189535); const float rr = (float)(ang - k * 6.283185307179586);
        ((float2*)(ws + OFF_ROPE))[i] = make_float2(__cosf(rr), __sinf(rr)); }
    wtasks(a, 0, 0, 3, 256, lds); wtasks(a, 0, 6, 7, 272, lds);
    ew_phase<true, false>(nullptr, nullptr, 0, a.in[0], a.in[1], nullptr, nullptr, 0.f, a.in[5], (bf16_t*)(ws + OFF_H), nullptr, (float*)(ws + OFF_X));
}
__device__ void tail_wtasks(CArgs& a, int ph, unsigned char* lds) {
    switch (ph) {
    case 1:  wtasks(a, 0, 10, 11, 257, lds); wtasks(a, 0, 7, 8, 258, lds); break;
    case 2:  wtasks(a, 0, 3, 4, 259, lds); break;
    case 4:  wtasks(a, 0, 9, 10, 260, lds); wtasks(a, 0, 4, 5, 261, lds); break;
    case 6:  wtasks(a, 0, 8, 9, 262, lds); break;
    case 8:  wtasks(a, 0, 5, 6, 263, lds); break;
    case 10: wtasks(a, 1, 0, 3, 264, lds); wtasks(a, 1, 6, 7, 265, lds); wtasks(a, 1, 9, 10, 266, lds); break;
    case 11: wtasks(a, 1, 10, 11, 267, lds); wtasks(a, 1, 7, 8, 268, lds); break;
    case 14: wtasks(a, 1, 3, 4, 269, lds); break;
    case 16: wtasks(a, 1, 4, 6, 270, lds); break;
    case 18: wtasks(a, 1, 8, 9, 271, lds); break;
    default: break; }
}
__device__ __forceinline__ int keyof32(int p) { const int g = p >> 3, j = p & 7; return j < 4 ? 4 * g + j : 16 + 4 * g + (j - 4); }
__device__ __forceinline__ void ct_write(const bf16_t* ctile, bf16_t* dst  , size_t rowstride) {
    int tid = threadIdx.x; asm volatile("" : "+v"(tid)); const int c = tid >> 1, half = tid & 1;
    unsigned w[16];
#pragma unroll
    for (int p = 0; p < 32; p += 2) { const int t0 = 32 * half + keyof32(p), t1 = 32 * half + keyof32(p + 1);
        w[p >> 1] = (unsigned)ctile[t0 * 264 + c] | ((unsigned)ctile[t1 * 264 + c] << 16); }
    uint4* d = (uint4*)(dst + (size_t)c * rowstride + 32 * half);
#pragma unroll
    for (int i = 0; i < 4; ++i) d[i] = make_uint4(w[4 * i], w[4 * i + 1], w[4 * i + 2], w[4 * i + 3]);
}
__device__ __forceinline__ float lb_of(CArgs& a, int l, int e) { if (l == 0) return 0.f; const float a0 = a.in[16][e], a1 = a.in[16][256 + e]; return 1.0f / (1.0f + __expf(a0 - a1)); }
__device__ void prep_mla_tile(CArgs& a, int l, int T, unsigned char* lds) {
    unsigned char* ws = a.ws; int tid = threadIdx.x; asm volatile("" : "+v"(tid)); const int lane = tid & 63, wave = tid >> 6;
    const bf16_t* z = (const bf16_t*)(ws + OFF_Z); const int r0 = T * 64;
    const bool prm = T < 256; const int b = prm ? (T >> 6) : (T - 256), j = prm ? (T & 63) : 0; const int pos0 = prm ? j * 64 : 2048;
    bf16_t* kc = (bf16_t*)(ws + OFF_KC) + (prm ? (size_t)(b * 4096 + j * 64) : (size_t)16384 + (size_t)b * 2112 + 2048) * 320;
    bf16_t* ct = (bf16_t*)(ws + OFF_CT) + (prm ? (size_t)b * 256 * 4096 + j * 64 : (size_t)16384 * 256 + (size_t)b * 256 * 2112 + 2048);
    const size_t ctstride = prm ? 4096 : 2112;
    float* ockv = a.out + (prm ? O_CKVP + ((size_t)(l * 4 + b) * 4096 + j * 64) * 256 : O_CKVS + ((size_t)(l * 32 + b) * 64) * 256);
    float* okpe = a.out + (prm ? O_KPEP + ((size_t)(l * 4 + b) * 4096 + j * 64) * 64 : O_KPES + ((size_t)(l * 32 + b) * 64) * 64);
    bf16_t* qn = (bf16_t*)(ws + OFF_QN); const float* qag = a.in[11] + l * 384; const float* kvg = a.in[13] + l * 256;
    const float2* rope = (const float2*)(ws + OFF_ROPE);
    bf16_t* ctile = (bf16_t*)lds;
    float qg[6];
#pragma unroll
    for (int i = 0; i < 3; ++i) { qg[2 * i] = qag[2 * lane + 128 * i]; qg[2 * i + 1] = qag[2 * lane + 128 * i + 1]; }
    const float4 g4 = *(const float4*)(kvg + 4 * lane);
#pragma unroll 1
    for (int tb = 0; tb < 8; tb += 4) {
        unsigned wq[4][3]; uint2 wk[4]; bf16_t p1[4], p2[4];
#pragma unroll
        for (int u = 0; u < 4; ++u) { const bf16_t* zr = z + (size_t)(r0 + wave + 8 * (tb + u)) * ZW;
#pragma unroll
            for (int i = 0; i < 3; ++i) wq[u][i] = *(const unsigned*)(zr + ZQ + 2 * lane + 128 * i);
            wk[u] = *(const uint2*)(zr + ZKV + 4 * lane); p1[u] = zr[ZPE + (lane & 31)]; p2[u] = zr[ZPE + 32 + (lane & 31)]; }
#pragma unroll
        for (int u = 0; u < 4; ++u) { const int t = wave + 8 * (tb + u);
            { float v[6]; float ss = 0.f;
#pragma unroll
              for (int i = 0; i < 3; ++i) { v[2 * i] = bflo(wq[u][i]); v[2 * i + 1] = bfhi(wq[u][i]); ss += v[2 * i] * v[2 * i] + v[2 * i + 1] * v[2 * i + 1]; }
              ss = wave_sum(ss); const float rs = rsqrtf(ss * (1.0f / 384.0f) + EPS);
#pragma unroll
              for (int i = 0; i < 3; ++i) *(unsigned*)(qn + (size_t)(r0 + t) * 384 + 2 * lane + 128 * i) = cvt_pk_bf16(v[2 * i] * rs * qg[2 * i], v[2 * i + 1] * rs * qg[2 * i + 1]); }
            { float v0 = bflo(wk[u].x), v1 = bfhi(wk[u].x), v2 = bflo(wk[u].y), v3 = bfhi(wk[u].y);
              const float ss = wave_sum(v0 * v0 + v1 * v1 + v2 * v2 + v3 * v3); const float rs = rsqrtf(ss * (1.0f / 256.0f) + EPS);
              v0 *= rs * g4.x; v1 *= rs * g4.y; v2 *= rs * g4.z; v3 *= rs * g4.w;
              __builtin_nontemporal_store((f32x4){v0, v1, v2, v3}, (f32x4*)(ockv + (size_t)t * 256 + 4 * lane));
              uint2 o; o.x = cvt_pk_bf16(v0, v1); o.y = cvt_pk_bf16(v2, v3);
              *(uint2*)(kc + (size_t)t * 320 + 4 * lane) = o; *(uint2*)(ctile + t * 264 + 4 * lane) = o; }
            if (lane < 32) { const float x1 = bf2f(p1[u]), x2 = bf2f(p2[u]); const float2 cs = rope[(pos0 + t) * 32 + lane];
              const float o1 = x1 * cs.x - x2 * cs.y, o2 = x2 * cs.x + x1 * cs.y;
              okpe[(size_t)t * 64 + lane] = o1; okpe[(size_t)t * 64 + 32 + lane] = o2; kc[(size_t)t * 320 + 256 + lane] = f2bf(o1); kc[(size_t)t * 320 + 288 + lane] = f2bf(o2); } }
    }
    __syncthreads();
    ct_write(ctile, ct, ctstride);
    __syncthreads();
}
__device__ void prep_hgrn_tile(CArgs& a, int l, int T, unsigned char* lds) {
    unsigned char* ws = a.ws; int tid = threadIdx.x; asm volatile("" : "+v"(tid)); asm volatile("" : "+s"(l));
    const bf16_t* z = (const bf16_t*)(ws + OFF_Z); const int r0 = T * 64;
    float* lf = (float*)lds; float* vt = (float*)(lds + 65536); float* tot = (float*)(lds + 131072);
    const int ep = tid & 255, hf = tid >> 8; const float lbv = lb_of(a, l, ep);
    bf16_t zfr[32]; float pref[32];
    { bf16_t zvr[32];
#pragma unroll
      for (int i = 0; i < 32; ++i) { const bf16_t* zr = z + (size_t)(r0 + 32 * hf + i) * ZW; zfr[i] = zr[ZHF + ep]; zvr[i] = zr[ZHI + ep]; }
      float run = 0.f;
#pragma unroll
      for (int i = 0; i < 32; ++i) { const float f = lbv + (1.0f - lbv) * sigmoidf_(bf2f(zfr[i])); run += __logf(fmaxf(f, 1e-30f)); pref[i] = run; vt[(32 * hf + i) * 256 + ep] = bf2f(zvr[i]); }
      tot[hf * 256 + ep] = run; }
    __syncthreads();
    { const float t0 = tot[ep], bl = t0 + tot[256 + ep], off = hf ? t0 : 0.f;
#pragma unroll
      for (int i = 0; i < 32; ++i) { lf[(32 * hf + i) * 256 + ep] = (1.0f - lbv) * sigmoidf_(-bf2f(zfr[i])) * __expf(bl - pref[i] - off); ((float*)(ws + OFF_BCUM))[(size_t)(r0 + 32 * hf + i) * 256 + ep] = pref[i] + off; }
      if (hf == 0) ((float*)(ws + OFF_DEC))[T * 256 + ep] = __expf(bl); }
    __syncthreads();
    { const int h = tid >> 7, eb = (tid & 127) >> 3, db = tid & 7; float acc[4][8];
#pragma unroll
      for (int i = 0; i < 4; ++i)
#pragma unroll
          for (int jj = 0; jj < 8; ++jj) acc[i][jj] = 0.f;
#pragma unroll 4
      for (int s = 0; s < 64; ++s) { const float4 kv = *(const float4*)(lf + s * 256 + h * 64 + eb * 4); const float4 v0 = *(const float4*)(vt + s * 256 + h * 64 + db * 8), v1 = *(const float4*)(vt + s * 256 + h * 64 + db * 8 + 4);
          const float kk[4] = {kv.x, kv.y, kv.z, kv.w}; const float vv[8] = {v0.x, v0.y, v0.z, v0.w, v1.x, v1.y, v1.z, v1.w};
#pragma unroll
          for (int i = 0; i < 4; ++i)
#pragma unroll
              for (int jj = 0; jj < 8; ++jj) acc[i][jj] += kk[i] * vv[jj]; }
      float* U = (float*)(ws + OFF_U) + (size_t)(T * 4 + h) * 4096;
#pragma unroll
      for (int i = 0; i < 4; ++i) { *(float4*)(U + (eb * 4 + i) * 64 + db * 8) = make_float4(acc[i][0], acc[i][1], acc[i][2], acc[i][3]); *(float4*)(U + (eb * 4 + i) * 64 + db * 8 + 4) = make_float4(acc[i][4], acc[i][5], acc[i][6], acc[i][7]); } }
    __syncthreads();
}
__device__ void prep_cache_tile(CArgs& a, int l, int P, unsigned char* lds) {
    unsigned char* ws = a.ws; int tid = threadIdx.x; asm volatile("" : "+v"(tid)); const int b = P >> 5, kt = P & 31;
    const float* ckv = a.in[2] + ((size_t)(l * 32 + b) * 2048 + kt * 64) * 256; const float* kpe = a.in[3] + ((size_t)(l * 32 + b) * 2048 + kt * 64) * 64;
    bf16_t* kc = (bf16_t*)(ws + OFF_KC) + ((size_t)16384 + (size_t)b * 2112 + kt * 64) * 320;
    bf16_t* ct = (bf16_t*)(ws + OFF_CT) + (size_t)16384 * 256 + (size_t)b * 256 * 2112 + kt * 64;
    bf16_t* ctile = (bf16_t*)lds;
#pragma unroll
    for (int i = 0; i < 8; ++i) { const int q = tid + 512 * i, t = q >> 6, c4 = q & 63; const f32x4 q4 = __builtin_nontemporal_load((const f32x4*)(ckv + (size_t)t * 256 + c4 * 4)); const float4 v = make_float4(q4[0], q4[1], q4[2], q4[3]);
        uint2 o; o.x = cvt_pk_bf16(v.x, v.y); o.y = cvt_pk_bf16(v.z, v.w); *(uint2*)(kc + (size_t)t * 320 + c4 * 4) = o; *(uint2*)(ctile + t * 264 + c4 * 4) = o; }
#pragma unroll
    for (int i = 0; i < 2; ++i) { const int q = tid + 512 * i, t = q >> 4, c4 = q & 15; const f32x4 q4 = __builtin_nontemporal_load((const f32x4*)(kpe + (size_t)t * 64 + c4 * 4)); const float4 v = make_float4(q4[0], q4[1], q4[2], q4[3]);
        uint2 o; o.x = cvt_pk_bf16(v.x, v.y); o.y = cvt_pk_bf16(v.z, v.w); *(uint2*)(kc + (size_t)t * 320 + 256 + c4 * 4) = o; }
    __syncthreads();
    ct_write(ctile, ct, 2112);
    __syncthreads();
}
__device__ void phase_prep(CArgs& a, int l, unsigned char* lds, int rep = 0) {
    unsigned* ctr = (unsigned*)(a.ws + OFF_CTL) + 16 * (l + 1) + 8 + 128 * rep; LAS unsigned* slot = (LAS unsigned*)(lds + LDS_MAIN + 16);
    for (;;) {
        __syncthreads();
        { int t0 = threadIdx.x; asm volatile("" : "+v"(t0)); if (t0 == 0) *slot = atomicAdd(ctr, 1u); }
        __syncthreads();
        const int it = (int)*slot;
        if (it >= 2 * NTILE) break;
        if (it < NTILE) prep_hgrn_tile(a, l, it, lds); else prep_mla_tile(a, l, it - NTILE, lds);
    }
}
__device__ void phase_cache(CArgs& a, int l, unsigned char* lds) {
    unsigned* ctr = (unsigned*)(a.ws + OFF_CTL) + 16 * (l + 1) + 12; LAS unsigned* slot = (LAS unsigned*)(lds + LDS_MAIN + 16);
    for (;;) {
        __syncthreads();
        { int t0 = threadIdx.x; asm volatile("" : "+v"(t0)); if (t0 == 0) *slot = atomicAdd(ctr, 1u); }
        __syncthreads();
        const int it = (int)*slot;
        if (it >= 1024) break;
        prep_cache_tile(a, l, it, lds);
    }
}
__device__ void phase_scan(CArgs& a, int l) {
    unsigned char* ws = a.ws; int tid = threadIdx.x; asm volatile("" : "+v"(tid)); const size_t gtid = (size_t)bid_() * 512 + tid, gsz = (size_t)gdim_() * 512;
    const float* U = (const float*)(ws + OFF_U); const float* dec = (const float*)(ws + OFF_DEC); float* sst = (float*)(ws + OFF_SST);
    for (size_t i = gtid; i < 16 * 4096; i += gsz) { const int bh = (int)(i >> 12), ed = (int)(i & 4095), b = bh >> 2, h = bh & 3, e = ed >> 6; float S = 0.f;
#pragma unroll 16
        for (int j = 0; j < 64; ++j) { const size_t ch = (size_t)((b * 64 + j) * 4 + h); sst[ch * 4096 + ed] = S; S = dec[ch * 64 + e] * S + __builtin_nontemporal_load(U + ch * 4096 + ed); }
        a.out[O_HGP + (size_t)(l * 16 + bh) * 4096 + ed] = S; }
    for (size_t i = gtid; i < 128 * 4096; i += gsz) { const int bh = (int)(i >> 12), ed = (int)(i & 4095), b = bh >> 2, h = bh & 3, e = ed >> 6; const size_t ch = (size_t)((256 + b) * 4 + h);
        const float S0 = a.in[4][(size_t)(l * 128 + bh) * 4096 + ed];
        a.out[O_HGS + (size_t)(l * 128 + bh) * 4096 + ed] = dec[ch * 64 + e] * S0 + U[ch * 4096 + ed]; }
}
constexpr int KSTR = 656, VSTR = 144, VOFF = 64 * KSTR, ABUF = VOFF + 256 * VSTR;
__device__ __forceinline__ int swz16(int row) { return (((row & 15) + 4) >> 3) & 1; }
__device__ void attn_item(CArgs& a, int idx, unsigned char* ldsg) {
    unsigned char* ws = a.ws; LAS unsigned char* lds = (LAS unsigned char*)ldsg;
    int tid = threadIdx.x; asm volatile("" : "+v"(tid)); const int lane = tid & 63, wave = __builtin_amdgcn_readfirstlane(tid >> 6), lr = lane & 15, g = lane >> 4;
    const int gx = (g ^ swz16(lr)) * 16;
    int b, hp, nkt, r0; const unsigned char* kcb; const unsigned char* ctb; int ctstride;
    if (idx >= 256 && idx < 320) { const int s = idx - 256; b = s >> 1; hp = s & 1; nkt = 33; r0 = MP + b * 64;
        kcb = ws + OFF_KC + ((size_t)16384 + (size_t)b * 2112) * 640; ctb = ws + OFF_CT + ((size_t)16384 * 256 + (size_t)b * 256 * 2112) * 2; ctstride = 4224; }
    else { const int k = idx < 256 ? idx : idx - 64; const int j = 63 - (k >> 3), sub = k & 7; b = sub >> 1; hp = sub & 1; nkt = j + 1; r0 = b * 4096 + j * 64;
        kcb = ws + OFF_KC + (size_t)b * 4096 * 640; ctb = ws + OFF_CT + (size_t)b * 256 * 4096 * 2; ctstride = 8192; }
    const int head = hp * 2 + (wave >> 2); const int qrow = r0 + (wave & 3) * 16 + lr;
    unsigned ko[6], vo[5];
#pragma unroll
    for (int i = 0; i < 6; ++i) { const int n = i * 512 + tid, row = n / 41, pc = n - row * 41; ko[i] = (unsigned)(row * 640 + (pc < 40 ? (pc ^ swz16(row)) * 16 : 0)); }
#pragma unroll
    for (int i = 0; i < 5; ++i) { const int n = i * 512 + tid, row = n / 9, pc = n - row * 9; vo[i] = (unsigned)(row * ctstride + (pc < 8 ? (pc ^ swz16(row)) * 16 : 0)); }
#define ATT_DMA(kt, bo) do { const unsigned char* kg = kcb + (size_t)(kt) * 40960; const unsigned char* vg = ctb + (size_t)(kt) * 128; \
        _Pragma("unroll") for (int i = 0; i < 6; ++i) if (i < 5 || wave == 0) __builtin_amdgcn_global_load_lds((const unsigned*)(kg + ko[i]), (LAS unsigned*)(lds + (bo) + (i * 512 + wave * 64) * 16), 16, 0, 0); \
        _Pragma("unroll") for (int i = 0; i < 5; ++i) if (i < 4 || wave < 4) __builtin_amdgcn_global_load_lds((const unsigned*)(vg + vo[i]), (LAS unsigned*)(lds + (bo) + VOFF + (i * 512 + wave * 64) * 16), 16, 0, 0); } while (0)
    __syncthreads();
    ATT_DMA(0, 0);
    bf16x8 qf[10];
    { const bf16_t* qp = (const bf16_t*)(ws + OFF_Q) + (size_t)qrow * 1280 + head * 320 + g * 8;
#pragma unroll
      for (int ks = 0; ks < 10; ++ks) qf[ks] = __builtin_nontemporal_load((const bf16x8*)(qp + ks * 32));
      const int pos = qrow < MP ? (qrow & 4095) : 2048 + ((qrow - MP) & 63); const float2* rp = (const float2*)(ws + OFF_ROPE) + pos * 32 + 8 * g;
      u32x4 w1 = __builtin_bit_cast(u32x4, qf[8]), w2 = __builtin_bit_cast(u32x4, qf[9]);
      float4 cs4[4];
#pragma unroll
      for (int jp = 0; jp < 4; ++jp) cs4[jp] = *(const float4*)(rp + 2 * jp);
#pragma unroll
      for (int jp = 0; jp < 4; ++jp) { const float a1 = bflo(w1[jp]), b1 = bfhi(w1[jp]), a2 = bflo(w2[jp]), b2 = bfhi(w2[jp]);
          w1[jp] = cvt_pk_bf16(a1 * cs4[jp].x - a2 * cs4[jp].y, b1 * cs4[jp].z - b2 * cs4[jp].w); w2[jp] = cvt_pk_bf16(a2 * cs4[jp].x + a1 * cs4[jp].y, b2 * cs4[jp].z + b1 * cs4[jp].w); }
      qf[8] = __builtin_bit_cast(bf16x8, w1); qf[9] = __builtin_bit_cast(bf16x8, w2); }
    f32x4 o[16];
#pragma unroll
    for (int i = 0; i < 16; ++i) o[i] = (f32x4){0.f, 0.f, 0.f, 0.f};
    float mrun = -1e30f, lsum = 0.f;
    asm volatile("s_waitcnt vmcnt(0)" ::: "memory");
    __syncthreads();
    const int koff = lr * KSTR + gx, voff = VOFF + lr * VSTR + gx;
    for (int kt = 0; kt < nkt; ++kt) {
        const int bo = (kt & 1) * ABUF;
        if (kt + 1 < nkt) ATT_DMA(kt + 1, ABUF - bo);
        const LAS unsigned char* kb = lds + bo + koff; const LAS unsigned char* vb = lds + bo + voff;
        f32x4 s[4];
#pragma unroll
        for (int i = 0; i < 4; ++i) s[i] = (f32x4){0.f, 0.f, 0.f, 0.f};
        bf16x8 kf[2][4];
#pragma unroll
        for (int k4 = 0; k4 < 4; ++k4) kf[0][k4] = *(const LAS bf16x8*)(kb + k4 * 16 * KSTR);
#pragma unroll
        for (int ks = 0; ks < 10; ++ks) {
            if (ks < 9) {
#pragma unroll
                for (int k4 = 0; k4 < 4; ++k4) kf[(ks + 1) & 1][k4] = *(const LAS bf16x8*)(kb + k4 * 16 * KSTR + (ks + 1) * 64); }
            __builtin_amdgcn_sched_barrier(0);
#pragma unroll
            for (int k4 = 0; k4 < 4; ++k4) s[k4] = __builtin_amdgcn_mfma_f32_16x16x32_bf16(kf[ks & 1][k4], qf[ks], s[k4], 0, 0, 0);
            __builtin_amdgcn_sched_barrier(0);
        }
        bf16x8 vf[2][4];
#pragma unroll
        for (int q4 = 0; q4 < 4; ++q4) vf[0][q4] = *(const LAS bf16x8*)(vb + (q4 >> 1) * 16 * VSTR + (q4 & 1) * 64);
        __builtin_amdgcn_sched_barrier(0);
        float mx = s[0][0];
#pragma unroll
        for (int k4 = 0; k4 < 4; ++k4)
#pragma unroll
            for (int i = 0; i < 4; ++i) mx = fmaxf(mx, s[k4][i]);
        mx = fmaxf(mx, __shfl_xor(mx, 16)); mx = fmaxf(mx, __shfl_xor(mx, 32));
        if (!__all(mx - mrun <= 8.0f)) {
            const float mnew = fmaxf(mrun, mx), alpha = __builtin_amdgcn_exp2f(mrun - mnew); mrun = mnew; lsum *= alpha;
#pragma unroll
            for (int i = 0; i < 16; ++i) o[i] *= alpha; }
        float ps = 0.f;
#pragma unroll
        for (int k4 = 0; k4 < 4; ++k4)
#pragma unroll
            for (int i = 0; i < 4; ++i) { s[k4][i] = __builtin_amdgcn_exp2f(s[k4][i] - mrun); ps += s[k4][i]; }
        lsum += ps;
        bf16x8 pb[2];
#pragma unroll
        for (int s2 = 0; s2 < 2; ++s2) { u32x4 w; w.x = cvt_pk_bf16(s[2 * s2][0], s[2 * s2][1]); w.y = cvt_pk_bf16(s[2 * s2][2], s[2 * s2][3]);
            w.z = cvt_pk_bf16(s[2 * s2 + 1][0], s[2 * s2 + 1][1]); w.w = cvt_pk_bf16(s[2 * s2 + 1][2], s[2 * s2 + 1][3]); pb[s2] = __builtin_bit_cast(bf16x8, w); }
#pragma unroll
        for (int cp = 0; cp < 8; ++cp) {
            if (cp < 7) {
#pragma unroll
                for (int q4 = 0; q4 < 4; ++q4) vf[(cp + 1) & 1][q4] = *(const LAS bf16x8*)(vb + (2 * (cp + 1) + (q4 >> 1)) * 16 * VSTR + (q4 & 1) * 64); }
            __builtin_amdgcn_sched_barrier(0);
#pragma unroll
            for (int q4 = 0; q4 < 4; ++q4) o[2 * cp + (q4 >> 1)] = __builtin_amdgcn_mfma_f32_16x16x32_bf16(vf[cp & 1][q4], pb[q4 & 1], o[2 * cp + (q4 >> 1)], 0, 0, 0);
            __builtin_amdgcn_sched_barrier(0);
        }
        asm volatile("s_waitcnt vmcnt(0)" ::: "memory");
        __syncthreads();
    }
#undef ATT_DMA
    lsum += __shfl_xor(lsum, 16); lsum += __shfl_xor(lsum, 32);
    const float inv = 1.0f / lsum;
    bf16_t* op = (bf16_t*)(ws + OFF_MIXA) + (size_t)qrow * 1536 + head * 256 + 4 * g;
#pragma unroll
    for (int ct = 0; ct < 16; ++ct) { uint2 w; w.x = cvt_pk_bf16(o[ct][0] * inv, o[ct][1] * inv); w.y = cvt_pk_bf16(o[ct][2] * inv, o[ct][3] * inv); *(uint2*)(op + 16 * ct) = w; }
}
constexpr int HS = 72;
constexpr int H_BC = 0, H_QT = 2 * 16640, H_KT = H_QT + 2 * 64 * HS * 2, H_QH = H_KT + 2 * 64 * HS * 2, H_VT = H_QH + 2 * 64 * HS * 2, H_ST = H_VT + 2 * 64 * HS * 2, H_END = H_ST + 2 * 64 * HS * 2;
static_assert(H_END <= LDS_MAIN, "hgrn lds");
__device__ __forceinline__ int posof64(int t) { const int u = t & 31; const int p = u < 16 ? 8 * (u >> 2) + (u & 3) : 8 * ((u - 16) >> 2) + 4 + ((u - 16) & 3); return (t & 32) + p; }
__device__ void hgrn_out_tile(CArgs& a, int l, int T, unsigned char* ldsg) {
    unsigned char* ws = a.ws; int tid = threadIdx.x; asm volatile("" : "+v"(tid)); asm volatile("" : "+s"(l)); const int lane = tid & 63, wave = tid >> 6, lr = lane & 15, g = lane >> 4;
    LAS unsigned char* lds = (LAS unsigned char*)ldsg;
    const bf16_t* z = (const bf16_t*)(ws + OFF_Z); const int r0 = T * 64;
    const int c = tid & 127, hh = c >> 6, e = c & 63, tq = tid >> 7;
    LAS float* bc = (LAS float*)(lds + H_BC) + hh * 4160;
    LAS bf16_t* QT = (LAS bf16_t*)(lds + H_QT) + hh * 64 * HS; LAS bf16_t* KT = (LAS bf16_t*)(lds + H_KT) + hh * 64 * HS; LAS bf16_t* QH = (LAS bf16_t*)(lds + H_QH) + hh * 64 * HS; LAS bf16_t* VT = (LAS bf16_t*)(lds + H_VT) + hh * 64 * HS;
    const float lbv0 = lb_of(a, l, hh * 64 + e), lbv1 = lb_of(a, l, (2 + hh) * 64 + e);
    for (int hp = 0; hp < 2; ++hp) {
        const int h = 2 * hp + hh; const float lbv = hp ? lbv1 : lbv0;
        { const float* bcum = (const float*)(ws + OFF_BCUM) + (size_t)r0 * 256 + h * 64 + e; const float rr = bcum[31 * 256];
          float s0v[16];
#pragma unroll
          for (int i = 0; i < 16; ++i) { const int idx = tid + 512 * i, h2 = idx >> 12, ed = idx & 4095; const int hg = 2 * hp + h2;
              const float* S0 = T < 256 ? (const float*)(ws + OFF_SST) + (size_t)(T * 4 + hg) * 4096 : a.in[4] + (size_t)(l * 128 + (T - 256) * 4 + hg) * 4096;
              s0v[i] = __builtin_nontemporal_load(S0 + ed); }
#pragma unroll 1
          for (int i0 = 0; i0 < 16; i0 += 8) {
          bf16_t zq[8], zf16[8], zv[8]; float bbv[8];
#pragma unroll
          for (int i = 0; i < 8; ++i) { const bf16_t* zr = z + (size_t)(r0 + tq * 16 + i0 + i) * ZW + h * 64 + e; zq[i] = __builtin_nontemporal_load(zr + ZHQ); zf16[i] = __builtin_nontemporal_load(zr + ZHF); zv[i] = __builtin_nontemporal_load(zr + ZHI); bbv[i] = __builtin_nontemporal_load(bcum + (tq * 16 + i0 + i) * 256); }
#pragma unroll
          for (int i = 0; i < 8; ++i) { const int t = tq * 16 + i0 + i; const float bb = bbv[i];
              const float q = bf2f(zq[i]), zf = bf2f(zf16[i]); const float k = (1.0f - lbv) * sigmoidf_(-zf);
              QH[t * HS + e] = f2bf(q * __expf(bb)); QT[t * HS + e] = f2bf(q * __expf(fminf(bb - rr, 80.f))); KT[t * HS + e] = f2bf(k * __expf(fminf(rr - bb, 80.f)));
              VT[e * HS + posof64(t)] = zv[i]; } }
#pragma unroll
          for (int i = 0; i < 16; ++i) { const int idx = tid + 512 * i, h2 = idx >> 12, ed = idx & 4095; ((LAS bf16_t*)(lds + H_ST))[h2 * 64 * HS + (ed & 63) * HS + (ed >> 6)] = f2bf(s0v[i]); } }
        __syncthreads();
        { const int wh = wave >> 2, tb = wave & 3; const int hw = 2 * hp + wh;
          const LAS unsigned char* qt = lds + H_QT + wh * 64 * HS * 2; const LAS unsigned char* kt = lds + H_KT + wh * 64 * HS * 2; const LAS unsigned char* qh = lds + H_QH + wh * 64 * HS * 2;
          const LAS unsigned char* vt = lds + H_VT + wh * 64 * HS * 2; const LAS unsigned char* st = lds + H_ST + wh * 64 * HS * 2;
          const int trow = 16 * tb + lr;
          float4 ogv[4]; uint2 gwv[4];
#pragma unroll
          for (int db = 0; db < 4; ++db) { const int d0 = hw * 64 + 16 * db + 4 * g; ogv[db] = *(const float4*)(a.in[17] + l * 256 + d0); { const u32x2 q2 = __builtin_nontemporal_load((const u32x2*)(z + (size_t)(r0 + trow) * ZW + ZHG + d0)); gwv[db] = make_uint2(q2.x, q2.y); } }
          bf16x8 qtf[2], qhf[2];
#pragma unroll
          for (int ks = 0; ks < 2; ++ks) { qtf[ks] = *(const LAS bf16x8*)(qt + trow * (HS * 2) + (32 * ks + 8 * g) * 2); qhf[ks] = *(const LAS bf16x8*)(qh + trow * (HS * 2) + (32 * ks + 8 * g) * 2); }
          f32x4 aT[4];
#pragma unroll
          for (int sb = 0; sb < 4; ++sb) { aT[sb] = (f32x4){0.f, 0.f, 0.f, 0.f};
#pragma unroll
              for (int ks = 0; ks < 2; ++ks) { const bf16x8 kf = *(const LAS bf16x8*)(kt + (16 * sb + lr) * (HS * 2) + (32 * ks + 8 * g) * 2); aT[sb] = __builtin_amdgcn_mfma_f32_16x16x32_bf16(kf, qtf[ks], aT[sb], 0, 0, 0); }
#pragma unroll
              for (int i = 0; i < 4; ++i) aT[sb][i] = (16 * sb + 4 * g + i <= trow) ? aT[sb][i] : 0.f; }
          bf16x8 pb[2];
#pragma unroll
          for (int s2 = 0; s2 < 2; ++s2) { u32x4 w; w.x = cvt_pk_bf16(aT[2 * s2][0], aT[2 * s2][1]); w.y = cvt_pk_bf16(aT[2 * s2][2], aT[2 * s2][3]);
              w.z = cvt_pk_bf16(aT[2 * s2 + 1][0], aT[2 * s2 + 1][1]); w.w = cvt_pk_bf16(aT[2 * s2 + 1][2], aT[2 * s2 + 1][3]); pb[s2] = __builtin_bit_cast(bf16x8, w); }
          f32x4 o[4]; float ss = 0.f;
#pragma unroll
          for (int db = 0; db < 4; ++db) { o[db] = (f32x4){0.f, 0.f, 0.f, 0.f};
#pragma unroll
              for (int ks = 0; ks < 2; ++ks) { const bf16x8 sf = *(const LAS bf16x8*)(st + (16 * db + lr) * (HS * 2) + (32 * ks + 8 * g) * 2); o[db] = __builtin_amdgcn_mfma_f32_16x16x32_bf16(sf, qhf[ks], o[db], 0, 0, 0); }
#pragma unroll
              for (int s2 = 0; s2 < 2; ++s2) { const bf16x8 vf = *(const LAS bf16x8*)(vt + (16 * db + lr) * (HS * 2) + (32 * s2 + 8 * g) * 2); o[db] = __builtin_amdgcn_mfma_f32_16x16x32_bf16(vf, pb[s2], o[db], 0, 0, 0); }
              ss += o[db][0] * o[db][0] + o[db][1] * o[db][1] + o[db][2] * o[db][2] + o[db][3] * o[db][3]; }
          ss += __shfl_xor(ss, 16); ss += __shfl_xor(ss, 32);
          const float rs = rsqrtf(ss * (1.0f / 64.0f) + EPS);
#pragma unroll
          for (int db = 0; db < 4; ++db) { const int d0 = hw * 64 + 16 * db + 4 * g; const float4 og = ogv[db]; const uint2 gw = gwv[db];
              uint2 w; w.x = cvt_pk_bf16(o[db][0] * rs * og.x * siluf_(bflo(gw.x)), o[db][1] * rs * og.y * siluf_(bfhi(gw.x)));
              w.y = cvt_pk_bf16(o[db][2] * rs * og.z * siluf_(bflo(gw.y)), o[db][3] * rs * og.w * siluf_(bfhi(gw.y)));
              *(uint2*)((bf16_t*)(ws + OFF_MIXA) + (size_t)(r0 + trow) * 1536 + 1024 + d0) = w; } }
        __syncthreads();
    }
}
template <bool PRM> __device__ __forceinline__ void cmlp_item_t(CArgs& a, int l, int it, unsigned char* ldsg) {
    int tid = threadIdx.x; asm volatile("" : "+v"(tid)); asm volatile("" : "+s"(l)); const int lane = tid & 63, wave = tid >> 6, lr = lane & 15, lg = lane >> 4; const int ci = it >> 2, g = it & 3;
    constexpr int L = PRM ? 128 : 64, WS = L + 8;
    const int r0 = PRM ? ci * 128 : MP + (ci - 128) * 64;
    LAS unsigned char* lds = (LAS unsigned char*)ldsg; LAS bf16_t* Wb = (LAS bf16_t*)lds; LAS bf16_t* vT = (LAS bf16_t*)(lds + 128 * 136 * 2);
    const bf16_t* z = (const bf16_t*)(a.ws + OFF_Z); const float* wsrc = a.in[19] + (size_t)(l * 4 + g) * 128 * 128;
    const float vg = a.in[18][l * 256 + g * 64 + lane];
    bf16_t zc[L / 8];
#pragma unroll
    for (int i = 0; i < L / 8; ++i) zc[i] = __builtin_nontemporal_load(z + (size_t)(r0 + wave + 8 * i) * ZW + ZCV + g * 64 + lane);
    { constexpr int NQ = L * L / 4 / 512, SH = PRM ? 5 : 4; float4 wv[NQ];
#pragma unroll
      for (int i = 0; i < NQ; ++i) { const int idx = tid + 512 * i, t = idx >> SH, s4 = idx & ((1 << SH) - 1); wv[i] = *(const float4*)(wsrc + t * 128 + 4 * s4); }
#pragma unroll
      for (int i = 0; i < NQ; ++i) { const int idx = tid + 512 * i, t = idx >> SH, s0 = 4 * (idx & ((1 << SH) - 1));
          u32x2 w; w.x = cvt_pk_bf16(s0 <= t ? wv[i].x : 0.f, s0 + 1 <= t ? wv[i].y : 0.f); w.y = cvt_pk_bf16(s0 + 2 <= t ? wv[i].z : 0.f, s0 + 3 <= t ? wv[i].w : 0.f);
          *(LAS u32x2*)(Wb + t * WS + s0) = w; } }
    {
#pragma unroll
      for (int i = 0; i < L / 8; ++i) { const int t = wave + 8 * i; const float x = geluf_(bf2f(zc[i])); const float ss = wave_sum(x * x);
          const float vv = x * rsqrtf(ss * (1.0f / 64.0f) + EPS) * vg; vT[lane * WS + t] = f2bf(vv);
          if (!PRM) a.out[O_CMV + ((size_t)(l * 32 + (ci - 128)) * 64 + t) * 256 + g * 64 + lane] = vv; } }
    __syncthreads();
    { constexpr int NT = PRM ? 4 : 2;
      const int tt = PRM ? wave : (wave & 3); const int t = 16 * tt + lr; const float bs = a.in[20][(size_t)(l * 4 + g) * 128 + t];
      uint2 cwv[NT];
#pragma unroll
      for (int n = 0; n < NT; ++n) { const int dt = PRM ? n : 2 * (wave >> 2) + n; { const u32x2 q2 = __builtin_nontemporal_load((const u32x2*)(z + (size_t)(r0 + t) * ZW + ZCU + g * 64 + 16 * dt + 4 * lg)); cwv[n] = make_uint2(q2.x, q2.y); } }
#pragma unroll
      for (int n = 0; n < NT; ++n) { const int dt = PRM ? n : 2 * (wave >> 2) + n; f32x4 acc = (f32x4){0.f, 0.f, 0.f, 0.f};
#pragma unroll
          for (int ks = 0; ks < L / 32; ++ks) { if (32 * ks <= 16 * tt + 15) {
              const bf16x8 vf = *(const LAS bf16x8*)(vT + (16 * dt + lr) * WS + 32 * ks + 8 * lg); const bf16x8 wf = *(const LAS bf16x8*)(Wb + t * WS + 32 * ks + 8 * lg);
              acc = __builtin_amdgcn_mfma_f32_16x16x32_bf16(vf, wf, acc, 0, 0, 0); } }
          const int d0 = g * 64 + 16 * dt + 4 * lg; const uint2 cw = cwv[n];
          uint2 o; o.x = cvt_pk_bf16(geluf_(bflo(cw.x)) * (acc[0] + bs), geluf_(bfhi(cw.x)) * (acc[1] + bs)); o.y = cvt_pk_bf16(geluf_(bflo(cw.y)) * (acc[2] + bs), geluf_(bfhi(cw.y)) * (acc[3] + bs));
          *(uint2*)((bf16_t*)(a.ws + OFF_MIXA) + (size_t)(r0 + t) * 1536 + 1280 + d0) = o; } }
    __syncthreads();
}
__device__ void cmlp_item(CArgs& a, int l, int it, unsigned char* lds) { if ((it >> 2) < 128) cmlp_item_t<true>(a, l, it, lds); else cmlp_item_t<false>(a, l, it, lds); }
__device__ void phase_mix(CArgs& a, int l, unsigned char* lds, int rep) {
    unsigned* ctr = (unsigned*)(a.ws + OFF_CTL) + 16 * (l + 1) + 128 * rep; LAS unsigned* slot = (LAS unsigned*)(lds + LDS_MAIN + 16);
    for (;;) {
        __syncthreads();
        { int t0 = threadIdx.x; asm volatile("" : "+v"(t0)); if (t0 == 0) *slot = atomicAdd(ctr, 1u); }
        __syncthreads();
        const int it = (int)*slot;
        if (it >= 576 + NTILE + 640) break;
        if (it < 576) { attn_item(a, it, lds); if (PROBE_MIX & 1) { __syncthreads(); attn_item(a, it, lds); } }
        else if (it < 576 + NTILE) { hgrn_out_tile(a, l, it - 576, lds); if (PROBE_MIX & 2) { __syncthreads(); hgrn_out_tile(a, l, it - 576, lds); } }
        else { cmlp_item(a, l, it - 576 - NTILE, lds); if (PROBE_MIX & 4) { __syncthreads(); cmlp_item(a, l, it - 576 - NTILE, lds); } }
    }
}
__global__ void __launch_bounds__(512) mk_fwd(Args a_) {
    extern __shared__ __attribute__((aligned(16))) unsigned char lds[];
    if (threadIdx.x < 16) ((LAS unsigned*)(lds + LDS_MAIN))[threadIdx.x] = 0u;
    __syncthreads();
    XcdBarrier bar = xcd_barrier_post((unsigned*)(a_.ws + OFF_CTL) + 1024, (volatile LAS unsigned*)(lds + LDS_MAIN));
    const int ph_lo = a_.ph_lo, ph_hi = a_.ph_hi;
    for (int ph = ph_lo; ph < ph_hi; ++ph) {
        CArgs* ap = (CArgs*)__builtin_amdgcn_kernarg_segment_ptr(); asm volatile("" : "+s"(ap)); CArgs& a = *ap;
        unsigned char* ws = a.ws;
        if (ph == 0) { phase_init(a, lds); if ((PROBE_DUP >> 12) & 1) { __syncthreads(); phase_init(a, lds); } }
        else { const int l = (ph - 1) / 12, p = (ph - 1) % 12; const float* ng = a.in[5] + (size_t)l * 6 * 1024;
            bf16_t* H = (bf16_t*)(ws + OFF_H); bf16_t* ACT = (bf16_t*)(ws + OFF_ACT); bf16_t* D = (bf16_t*)(ws + OFF_D); bf16_t* D1 = (bf16_t*)(ws + ((p == 7 || p == 8) ? OFF_ACT : OFF_MIXA));   float* RS = (float*)(ws + OFF_X);
            const int reps = ((PROBE_DUP >> p) & 1) ? 2 : 1;
            for (int rep = 0; rep < reps; ++rep) {
            if (rep) __syncthreads();
            switch (p) {
            case 0: case 9: { const int f = p == 0 ? 0 : 1; EpiSwiGLU E{ACT}; run_gemm(lds, H, (const bf16_t*)(ws + OFF_WGU) + (size_t)(l * 2 + f) * 5632 * 1024, MT, 5632, 1024, E);
                if (p == 0 && !rep) phase_cache(a, l, lds); } break;
            case 1: case 10: { const int f = p == 1 ? 0 : 1; EpiBf E{D, 1024, D1}; run_gemm(lds, ACT, (const bf16_t*)(ws + OFF_WDN) + (size_t)(l * 2 + f) * 1024 * 2816, MT, 1024, 2816, E, 11); } break;
            case 2: ew_phase<false, false>(D, D1, 11, H, nullptr, nullptr, ng + 1024, 0.5f, ng + 2048, H, ng, RS); break;
            case 3: { EpiBf E{(bf16_t*)(ws + OFF_Z), ZW, nullptr}; run_gemm(lds, H, (const bf16_t*)(ws + OFF_WIN) + (size_t)l * 2304 * 1024, MT, 2304, 1024, E); } break;
            case 4: phase_prep(a, l, lds, rep); break;
            case 5: { phase_scan(a, l); EpiQ E{(bf16_t*)(ws + OFF_Q)}; run_gemm(lds, (const bf16_t*)(ws + OFF_QN), (const bf16_t*)(ws + OFF_WQ) + (size_t)l * 1280 * 384, MT, 1280, 384, E); } break;
            case 6: phase_mix(a, l, lds, rep); break;
            case 7: { EpiBf E{D, 1024, D1}; run_gemm(lds, (const bf16_t*)(ws + OFF_MIXA), (const bf16_t*)(ws + OFF_WMIX) + (size_t)l * 1024 * 1536, MT, 1024, 1536, E, 6); } break;
            case 8: ew_phase<false, false>(D, D1, 6, H, nullptr, nullptr, ng + 3 * 1024, 1.0f, ng + 4 * 1024, H, ng + 2048, RS); break;
            case 11: if (l == 0) ew_phase<false, false>(D, D1, 11, H, nullptr, nullptr, ng + 5 * 1024, 0.5f, ng + 6 * 1024, H, ng + 4 * 1024, RS); else ew_phase<false, true>(D, D1, 11, H, nullptr, a.out + O_Y, ng + 5 * 1024, 0.5f, nullptr, nullptr, ng + 4 * 1024, RS); break;
            }
            }
            tail_wtasks(a, ph, lds);
        }
        if (ph + 1 < ph_hi) {
            if (ph_lo < 0) { __threadfence(); cg::this_grid().sync(); }
            xcd_barrier(bar); }
    }
}

extern "C" void kernel_launch(void* const* d_in, const int* in_sizes, int n_in, void* d_out, int out_size, void* d_ws, size_t ws_size, hipStream_t stream) {
    static int grid = 0;
    if (grid == 0) {
        if (n_in != 21 || ws_size < WS_END) { fprintf(stderr, "kernel_launch: bad inputs n_in %d ws %zu need %zu\n", n_in, ws_size, (size_t)WS_END); grid = -1; return; }
        int dev = 0, cus = 0, per_cu = 0;
        hipGetDevice(&dev); hipDeviceGetAttribute(&cus, hipDeviceAttributeMultiprocessorCount, dev);
        if (hipFuncSetAttribute((const void*)mk_fwd, hipFuncAttributeMaxDynamicSharedMemorySize, LDS_BYTES) != hipSuccess) { fprintf(stderr, "hipFuncSetAttribute failed\n"); grid = -1; return; }
        if (hipOccupancyMaxActiveBlocksPerMultiprocessor(&per_cu, (const void*)mk_fwd, 512, LDS_BYTES) != hipSuccess || per_cu < 1) per_cu = 1;
        (void)hipGetLastError();
        grid = cus * 1;
    }
    if (grid < 0) return;
    if (hipMemsetAsync((char*)d_ws + OFF_CTL, 0, SZ_CTL, stream) != hipSuccess) { fprintf(stderr, "memset failed\n"); return; }
    Args a{};
    for (int i = 0; i < 21; ++i) a.in[i] = (const float*)d_in[i];
    a.out = (float*)d_out; a.ws = (unsigned char*)d_ws;
#if ONE_LAUNCH
    a.ph_lo = 0; a.ph_hi = NPHASE;
    void* args[] = {&a};
    hipError_t e = hipLaunchCooperativeKernel((const void*)mk_fwd, dim3(grid), dim3(512), args, LDS_BYTES, stream);
    if (e != hipSuccess) fprintf(stderr, "cooperative launch failed: %s (grid %d)\n", hipGetErrorString(e), grid);
#else
    for (int ph = 0; ph < NPHASE; ++ph) { a.ph_lo = ph; a.ph_hi = ph + 1; hipLaunchKernelGGL(mk_fwd, dim3(grid), dim3(512), LDS_BYTES, stream, a); }
#endif
}
```

```cpp
#include <hip/hip_runtime.h>
#include <hip/hip_cooperative_groups.h>
#include <cstdio>
namespace cg = cooperative_groups;
#ifndef ONE_LAUNCH
#define ONE_LAUNCH 1
#endif
#ifndef PROBE_DUP
#define PROBE_DUP 0
#endif
#ifndef PROBE_MIX
#define PROBE_MIX 0
#endif
namespace pg8 {
#define PG8_LAS __attribute__((address_space(3)))
typedef unsigned short bf16_t;
typedef short bf16x8 __attribute__((ext_vector_type(8)));
typedef float f32x4 __attribute__((ext_vector_type(4)));
typedef unsigned u32x4 __attribute__((ext_vector_type(4)));
constexpr int BM = 256, BK = 64, HALF = 128, HTB = HALF * BK * 2  , STAGE_BYTES = 8 * HTB, NXCD = 8, WGM = 8;

__host__ __device__ __forceinline__ int lds_byte(int r, int c) { const int st = (r >> 4) * 2 + (c >> 5), rr = r & 15, cc = c & 31, ob = rr * 64 + cc * 2; return st * 1024 + (ob ^ (((ob >> 9) & 1) << 5)); }
__host__ __device__ __forceinline__ void stage_rc(int b, int& R, int& C) { const int st = b / 1024, sb = b % 1024, swz = sb ^ (((sb >> 9) & 1) << 5); R = (st >> 1) * 16 + swz / 64; C = (st & 1) * 32 + (swz % 64) / 2; }
__host__ __device__ __forceinline__ int perm32(int rho) { const int n = rho >> 4, i = rho & 15; return 8 * (i >> 2) + 4 * n + (i & 3); }

struct Unit { int pm, pn, ks, nt, koff; };
struct Gemm { const bf16_t* A; const bf16_t* Bt; int M, N, K, ld; };

struct StaticOrder {
    int nM, nN, nwg, G, c, nN0, unt, ukb;
    __host__ __device__ void init(int M, int N, int G_, int c_, int nsplit = 1) { nM = M / BM; nN0 = N / BM; nN = nN0 * nsplit; nwg = nM * nN; G = G_; c = c_; }
    __host__ __device__ bool next(int i, Unit& u) const {
        const long L = (long)i * G + c; if (L >= nwg) return false;
        int wgid = (int)L; { const int q = nwg / NXCD, r = nwg % NXCD, xcd = wgid % NXCD, off = wgid / NXCD; wgid = (xcd < r ? xcd * (q + 1) : r * (q + 1) + (xcd - r) * q) + off; }
        const int nig = WGM * nN, gid = wgid / nig, fm = gid * WGM, gsz = (nM - fm) < WGM ? (nM - fm) : WGM;
        u.pm = fm + ((wgid % nig) % gsz); const int pn = (wgid % nig) / gsz; u.ks = pn / nN0; u.pn = pn - u.ks * nN0; u.nt = unt; u.koff = u.ks * ukb; return true;
    }
    __device__ __forceinline__ void a_ready(const Unit&) const {}
    __device__ __forceinline__ void done(const Unit&) const {}
};
__device__ __forceinline__ unsigned cvt_pk_bf16(float lo, float hi) { unsigned r; asm volatile("v_cvt_pk_bf16_f32 %0, %1, %2" : "=v"(r) : "v"(lo), "v"(hi)); return r; }
typedef float f32x2 __attribute__((ext_vector_type(2)));
template <class Epi, class Sched, bool STAMP = false>
__device__ __forceinline__ void gemm_phase(PG8_LAS unsigned char* lds, const Gemm g, const Sched& S, const Epi& E, unsigned long long* stamps) {
    int tid = threadIdx.x; asm volatile("" : "+v"(tid)); const int wid = __builtin_amdgcn_readfirstlane(tid >> 6), lane = tid & 63, wr = wid >> 2, wc = wid & 3, fr = lane & 15, fq = lane >> 4;
    const int K = g.ld;
    int ts_lo = 0, ts_hi = 0, nts = 0; const unsigned long long rt_entry = STAMP ? (unsigned long long)wall_clock64() : 0ull;
#define PG8_STAMP() do { if (STAMP && wid == 0 && nts < 64) { const unsigned long long _c = (unsigned long long)clock64(); \
        ts_lo = (lane == nts) ? (int)(unsigned)_c : ts_lo; ts_hi = (lane == nts) ? (int)(unsigned)(_c >> 32) : ts_hi; ++nts; } } while (0)
    PG8_STAMP();
    unsigned voffA[2], voffB[2];
#pragma unroll
    for (int i = 0; i < 2; ++i) { int R, C; stage_rc(tid * 16 + i * 8192, R, C); const int Rb = Epi::PERM ? ((R & ~31) + perm32(R & 31)) : R;
        voffA[i] = (unsigned)(R * K + C) * 2u; voffB[i] = (unsigned)(Rb * K + C) * 2u; }
    const size_t kstep = (size_t)(BK * 2);
    const size_t hstep = (size_t)HALF * K * 2;
    const size_t tstep = 2 * hstep;
    const unsigned ldsw = (unsigned)wid * 1024u;
    const int aoff = lds_byte(wr * 64 + fr, fq * 8), boff = lds_byte(wc * 32 + fr, fq * 8);
#define PG8_SA(b, h) (((b) * 2 + (h)) * HTB)
#define PG8_SB(b, h) ((4 + (b) * 2 + (h)) * HTB)
#define PG8_STAGE(bufoff, gbase, voff) do { _Pragma("unroll") for (int _i = 0; _i < 2; ++_i) \
        __builtin_amdgcn_global_load_lds((const unsigned*)((const char*)(gbase) + (voff)[_i]), (PG8_LAS unsigned*)(lds + (bufoff) + ldsw + _i * 8192), 16, 0, 0); } while (0)
#define PG8_LDA(dst, b, h) do { _Pragma("unroll") for (int m = 0; m < 4; ++m) _Pragma("unroll") for (int k = 0; k < 2; ++k) dst[m][k] = *(const PG8_LAS bf16x8*)(lds + PG8_SA(b, h) + aoff + m * 2048 + k * 1024); } while (0)
#define PG8_LDB(dst, b, h) do { _Pragma("unroll") for (int n = 0; n < 2; ++n) _Pragma("unroll") for (int k = 0; k < 2; ++k) dst[n][k] = *(const PG8_LAS bf16x8*)(lds + PG8_SB(b, h) + boff + n * 2048 + k * 1024); } while (0)
#define PG8_MMA(ai, bj, At, Bt) do { __builtin_amdgcn_s_setprio(1); _Pragma("unroll") for (int m = 0; m < 4; ++m) _Pragma("unroll") for (int n = 0; n < 2; ++n) _Pragma("unroll") for (int k = 0; k < 2; ++k) \
        acc[ai][bj][m][n] = __builtin_amdgcn_mfma_f32_16x16x32_bf16(Bt[n][k], At[m][k], acc[ai][bj][m][n], 0, 0, 0); __builtin_amdgcn_s_setprio(0); } while (0)
#define PG8_WAIT_V(n) asm volatile("s_waitcnt vmcnt(" #n ")" ::: "memory")
#define PG8_WAIT_L(n) asm volatile("s_waitcnt lgkmcnt(" #n ")" ::: "memory")
#define PG8_BAR __builtin_amdgcn_s_barrier()
#define PG8_SCHED __builtin_amdgcn_sched_barrier(0)
    Unit cur, nxt; int ui = 0;
    if (!S.next(0, cur)) return;
    f32x4 acc[2][2][4][2];
#pragma unroll
    for (int a = 0; a < 2; ++a)
#pragma unroll
        for (int b = 0; b < 2; ++b)
#pragma unroll
            for (int m = 0; m < 4; ++m)
#pragma unroll
                for (int n = 0; n < 2; ++n) acc[a][b][m][n] = (f32x4){0.f, 0.f, 0.f, 0.f};
    bf16x8 At[4][2], B0[2][2], B1[2][2];
    const char* cA = (const char*)g.A + (size_t)cur.pm * tstep + (size_t)cur.koff; const char* cB = (const char*)g.Bt + (size_t)cur.pn * tstep + (size_t)cur.koff;
    S.a_ready(cur);
    PG8_STAGE(PG8_SB(0, 0), cB, voffB); PG8_STAGE(PG8_SA(0, 0), cA, voffA); PG8_STAGE(PG8_SB(0, 1), cB + hstep, voffB); PG8_STAGE(PG8_SA(0, 1), cA + hstep, voffA);
    if (wr == 1) PG8_BAR;
    PG8_WAIT_V(4); PG8_BAR;
    PG8_STAGE(PG8_SB(1, 0), cB + kstep, voffB); PG8_STAGE(PG8_SA(1, 0), cA + kstep, voffA); PG8_STAGE(PG8_SB(1, 1), cB + hstep + kstep, voffB);
    PG8_WAIT_V(6); PG8_BAR;
    PG8_STAMP();
    for (;;) {
        const bool has_next = S.next(ui + 1, nxt);
        const char* nA = has_next ? (const char*)g.A + (size_t)nxt.pm * tstep + (size_t)nxt.koff : cA; const char* nB = has_next ? (const char*)g.Bt + (size_t)nxt.pn * tstep + (size_t)nxt.koff : cB;
        const int nt = cur.nt;
        for (int t = 0; t < nt; t += 2) {
            const bool last = (t == nt - 2);
            const char* a1 = cA + (size_t)(t + 1) * kstep;
            const char* a2 = last ? nA : cA + (size_t)(t + 2) * kstep; const char* b2 = last ? nB : cB + (size_t)(t + 2) * kstep;
            const char* a3 = a2 + kstep; const char* b3 = b2 + kstep;
            if (last && has_next) S.a_ready(nxt);
            PG8_LDB(B0, 0, 0); PG8_SCHED; PG8_LDA(At, 0, 0); PG8_STAGE(PG8_SA(1, 1), a1 + hstep, voffA);
            PG8_WAIT_L(8); PG8_BAR; PG8_WAIT_L(0); PG8_MMA(0, 0, At, B0); PG8_BAR; PG8_SCHED;
            PG8_LDB(B1, 0, 1); PG8_STAGE(PG8_SB(0, 0), b2, voffB);
            PG8_BAR; PG8_WAIT_L(0); PG8_MMA(0, 1, At, B1); PG8_BAR;
            PG8_LDA(At, 0, 1); PG8_STAGE(PG8_SA(0, 0), a2, voffA);
            PG8_BAR; PG8_WAIT_L(0); PG8_MMA(1, 0, At, B0); PG8_BAR; PG8_SCHED;
            PG8_STAGE(PG8_SB(0, 1), b2 + hstep, voffB);
            PG8_WAIT_V(6); PG8_BAR; PG8_MMA(1, 1, At, B1); PG8_BAR;
            PG8_LDB(B0, 1, 0); PG8_SCHED; PG8_LDA(At, 1, 0); PG8_STAGE(PG8_SA(0, 1), a2 + hstep, voffA);
            PG8_WAIT_L(8); PG8_BAR; PG8_WAIT_L(0); PG8_MMA(0, 0, At, B0); PG8_BAR; PG8_SCHED;
            PG8_LDB(B1, 1, 1); PG8_STAGE(PG8_SB(1, 0), b3, voffB);
            PG8_BAR; PG8_WAIT_L(0); PG8_MMA(0, 1, At, B1); PG8_BAR;
            PG8_LDA(At, 1, 1); PG8_STAGE(PG8_SA(1, 0), a3, voffA);
            PG8_BAR; PG8_WAIT_L(0); PG8_MMA(1, 0, At, B0); PG8_BAR; PG8_SCHED;
            PG8_STAGE(PG8_SB(1, 1), b3 + hstep, voffB);
            PG8_WAIT_V(6); PG8_BAR; PG8_MMA(1, 1, At, B1); PG8_BAR;
        }
        PG8_STAMP();
        if constexpr (!Epi::AFTER_DRAIN) { E(acc, cur, wr, wc, fr, fq); S.done(cur); }
        PG8_STAMP();
        if (!has_next) break;
#pragma unroll
        for (int a = 0; a < 2; ++a)
#pragma unroll
            for (int b = 0; b < 2; ++b)
#pragma unroll
                for (int m = 0; m < 4; ++m)
#pragma unroll
                    for (int n = 0; n < 2; ++n) acc[a][b][m][n] = (f32x4){0.f, 0.f, 0.f, 0.f};
        cur = nxt; cA = nA; cB = nB; ++ui;
    }
    PG8_WAIT_V(0);
    if (wr == 0) PG8_BAR;
    PG8_BAR;
    if constexpr (Epi::AFTER_DRAIN) { E.fused(acc, cur, wr, wc, fr, fq, lds, wid, lane); S.done(cur); }
    PG8_STAMP();
    if (STAMP && wid == 0) { stamps[lane] = lane < nts ? (((unsigned long long)(unsigned)ts_hi << 32) | (unsigned)ts_lo) : 0ull;
        if (lane == 62) stamps[62] = rt_entry; if (lane == 63) stamps[63] = (unsigned long long)wall_clock64(); }
#undef PG8_STAMP
#undef PG8_SA
#undef PG8_SB
#undef PG8_STAGE
#undef PG8_LDA
#undef PG8_LDB
#undef PG8_MMA
#undef PG8_WAIT_V
#undef PG8_WAIT_L
#undef PG8_BAR
#undef PG8_SCHED
}
}
using pg8::bf16_t; using pg8::bf16x8; using pg8::f32x4; using pg8::u32x4; using pg8::Unit; using pg8::cvt_pk_bf16;
#define LAS __attribute__((address_space(3)))
typedef unsigned u32x2 __attribute__((ext_vector_type(2)));

constexpr int DM = 1024, DFF = 2816, MP = 16384, MS = 2048, MT = 18432, INWP = 2304, ZW = 2304;
constexpr int NTILE = 288;
constexpr float EPS = 1e-6f;
constexpr float QSCALE = 0.07216878364870322f * 1.4426950408889634f;
constexpr int ZQ = 0, ZKV = 384, ZPE = 640, ZHQ = 704, ZHF = 960, ZHI = 1216, ZHG = 1472, ZCU = 1728, ZCV = 1984;
constexpr size_t SZ_WGU = 4ull * 5632 * 1024 * 2, SZ_WDN = 4ull * 1024 * 2816 * 2, SZ_WIN = 2ull * 2304 * 1024 * 2, SZ_WQ = 2ull * 1280 * 384 * 2, SZ_WMIX = 2ull * 1024 * 1536 * 2;
constexpr size_t SKEW = 69888;
constexpr size_t OFF_WGU = 0, OFF_WDN = OFF_WGU + SZ_WGU + SKEW, OFF_WIN = OFF_WDN + SZ_WDN + SKEW, OFF_WQ = OFF_WIN + SZ_WIN + SKEW, OFF_WMIX = OFF_WQ + SZ_WQ + SKEW;
constexpr size_t OFF_X = OFF_WMIX + SZ_WMIX + SKEW, SZ_X = (size_t)MT * 1024 * 4;
constexpr size_t OFF_D = OFF_X + SZ_X + SKEW, SZ_D = (size_t)MT * 1024 * 2;
constexpr size_t OFF_H = OFF_D + SZ_D + SKEW, SZ_H = (size_t)MT * 1024 * 2;
constexpr size_t OFF_ACT = OFF_H + SZ_H + SKEW, SZ_ACT = (size_t)MT * 2816 * 2;
constexpr size_t KROWS = 16384 + 32 * 2112;
constexpr size_t OFF_KC = OFF_ACT + SZ_ACT + SKEW, SZ_KC = KROWS * 640;
constexpr size_t OFF_CT = OFF_KC + SZ_KC + SKEW, SZ_CT = KROWS * 512;
constexpr size_t OFF_MIXA = OFF_CT + SZ_CT + SKEW, SZ_MIXA = (size_t)MT * 1536 * 2;
constexpr size_t OFF_SST = OFF_MIXA + SZ_MIXA + SKEW, SZ_SST = 1024ull * 4096 * 4;
constexpr size_t OFF_ROPE = OFF_SST + SZ_SST + SKEW, SZ_ROPE = 4096ull * 32 * 8;
constexpr size_t OFF_CTL = OFF_ROPE + SZ_ROPE + SKEW, SZ_CTL = 32768;
constexpr size_t OFF_BCUM = OFF_CTL + SZ_CTL + SKEW, SZ_BCUM = (size_t)MT * 256 * 4;
constexpr size_t WS_END = OFF_BCUM + SZ_BCUM;
constexpr size_t OFF_Z = OFF_ACT, SZ_Z = (size_t)MT * ZW * 2;
constexpr size_t OFF_QN = OFF_Z + SZ_Z + SKEW;
constexpr size_t OFF_Q = OFF_X + 1048576 + SKEW;
constexpr size_t OFF_U = OFF_Q + (size_t)MT * 1280 * 2 + SKEW;
constexpr size_t OFF_DEC = OFF_U + 1152ull * 4096 * 4;
static_assert(OFF_QN + (size_t)MT * 384 * 2 <= OFF_ACT + SZ_ACT, "z/qn overlay");
static_assert(OFF_DEC + 1152ull * 64 * 4 <= OFF_X + SZ_X, "Q/U overlay");
constexpr size_t O_Y = 0, O_CKVP = 18874368, O_KPEP = 27262976, O_HGP = 29360128, O_CKVS = 29491200, O_KPES = 30539776, O_HGS = 30801920, O_CMV = 31850496;

constexpr int LDS_MAIN = 157696, LDS_BYTES = LDS_MAIN + 64;
constexpr int NPHASE = 25;

struct Args { const float* in[21]; float* out; unsigned char* ws; int ph_lo, ph_hi; };
typedef const __attribute__((address_space(4))) Args CArgs;

__device__ __forceinline__ int bid_() { int b = blockIdx.x; asm volatile("" : "+s"(b)); return b; }
__device__ __forceinline__ int gdim_() { int g = gridDim.x; asm volatile("" : "+s"(g)); return g; }
__device__ __forceinline__ float bf2f(unsigned short b) { return __uint_as_float(((unsigned)b) << 16); }
__device__ __forceinline__ float bflo(unsigned w) { return __uint_as_float(w << 16); }
__device__ __forceinline__ float bfhi(unsigned w) { return __uint_as_float(w & 0xffff0000u); }
__device__ __forceinline__ unsigned short f2bf(float f) { unsigned u = __float_as_uint(f); u += 0x7FFFu + ((u >> 16) & 1u); return (unsigned short)(u >> 16); }
__device__ __forceinline__ float wave_sum(float v) {
#pragma unroll
    for (int o = 32; o >= 1; o >>= 1) v += __shfl_xor(v, o);
    return v; }
__device__ __forceinline__ float sigmoidf_(float x) { return __builtin_amdgcn_rcpf(1.0f + __expf(-x)); }
__device__ __forceinline__ float siluf_(float x) { return x * sigmoidf_(x); }
__device__ __forceinline__ float geluf_(float x) { const float y = 0.7978845608028654f * (x + 0.044715f * x * x * x); return x - x * __builtin_amdgcn_rcpf(__expf(2.0f * y) + 1.0f); }

struct EpiBf {
    static constexpr bool PERM = true, AFTER_DRAIN = false;
    bf16_t* O; int ldc; bf16_t* O1;
    __device__ __forceinline__ void operator()(const f32x4 (&acc)[2][2][4][2], const Unit& u, int wr, int wc, int fr, int fq) const {
        const int row0 = u.pm * 256 + wr * 64 + fr, col0 = u.pn * 256 + wc * 32 + 8 * fq; bf16_t* Ob = (O1 && u.ks >= 0) ? O1 + ((long)u.ks * MS - MP) * (long)ldc : O;
#pragma unroll
        for (int ai = 0; ai < 2; ++ai)
#pragma unroll
            for (int m = 0; m < 4; ++m) { bf16_t* rowp = Ob + (size_t)(row0 + ai * 128 + m * 16) * ldc + col0;
#pragma unroll
                for (int bj = 0; bj < 2; ++bj) { const f32x4 v0 = acc[ai][bj][m][0], v1 = acc[ai][bj][m][1];
                    u32x4 w; w.x = cvt_pk_bf16(v0[0], v0[1]); w.y = cvt_pk_bf16(v0[2], v0[3]); w.z = cvt_pk_bf16(v1[0], v1[1]); w.w = cvt_pk_bf16(v1[2], v1[3]);
                    *(u32x4*)(rowp + bj * 128) = w; } }
    }
};
struct EpiSwiGLU {
    static constexpr bool PERM = true, AFTER_DRAIN = false;
    bf16_t* O;
    __device__ __forceinline__ void operator()(const f32x4 (&acc)[2][2][4][2], const Unit& u, int wr, int wc, int fr, int fq) const {
        const int row0 = u.pm * 256 + wr * 64 + fr, col0 = u.pn * 128 + wc * 32 + 8 * fq;
#pragma unroll
        for (int ai = 0; ai < 2; ++ai)
#pragma unroll
            for (int m = 0; m < 4; ++m) { bf16_t* rowp = O + (size_t)(row0 + ai * 128 + m * 16) * DFF + col0;
                const f32x4 g0 = acc[ai][0][m][0], g1 = acc[ai][0][m][1], u0 = acc[ai][1][m][0], u1 = acc[ai][1][m][1];
                u32x4 w; w.x = cvt_pk_bf16(siluf_(g0[0]) * u0[0], siluf_(g0[1]) * u0[1]); w.y = cvt_pk_bf16(siluf_(g0[2]) * u0[2], siluf_(g0[3]) * u0[3]);
                w.z = cvt_pk_bf16(siluf_(g1[0]) * u1[0], siluf_(g1[1]) * u1[1]); w.w = cvt_pk_bf16(siluf_(g1[2]) * u1[2], siluf_(g1[3]) * u1[3]);
                *(u32x4*)rowp = w; }
    }
};
struct EpiQ {
    static constexpr bool PERM = true, AFTER_DRAIN = false;
    bf16_t* Q;
    __device__ __forceinline__ void operator()(const f32x4 (&acc)[2][2][4][2], const Unit& u, int wr, int wc, int fr, int fq) const {
        const int row0 = u.pm * 256 + wr * 64 + fr;
        const int off0 = u.pn < 4 ? u.pn * 320 + wc * 32 + 8 * fq : wc * 320 + 256 + 8 * fq, bjs = u.pn < 4 ? 128 : 32;
#pragma unroll
        for (int ai = 0; ai < 2; ++ai)
#pragma unroll
            for (int m = 0; m < 4; ++m) { bf16_t* rowp = Q + (size_t)(row0 + ai * 128 + m * 16) * 1280 + off0;
#pragma unroll
                for (int bj = 0; bj < 2; ++bj) { const f32x4 v0 = acc[ai][bj][m][0], v1 = acc[ai][bj][m][1];
                    u32x4 w; w.x = cvt_pk_bf16(v0[0], v0[1]); w.y = cvt_pk_bf16(v0[2], v0[3]); w.z = cvt_pk_bf16(v1[0], v1[1]); w.w = cvt_pk_bf16(v1[2], v1[3]);
                    *(u32x4*)(rowp + bj * bjs) = w; } }
    }
};
struct TailSplitOrder {
    int G, c, nsp, nt_full, nt_sub, kb_sub;
    __device__ bool next(int i, Unit& u) const {
        const int L = i * G + c;
        if (L < 256) { const int off = L >> 3; u.pm = (L & 7) * 8 + (off >> 2); u.pn = off & 3; u.ks = -1; u.nt = nt_full; u.koff = 0; return true; }
        const int s2 = L - 256; if (s2 >= 32 * nsp) return false;
        const int pair = s2 & 31; u.pm = 64 + (pair >> 2); u.pn = pair & 3; u.ks = s2 >> 5; u.nt = nt_sub; u.koff = u.ks * kb_sub; return true;
    }
    __device__ __forceinline__ void a_ready(const Unit&) const {}
    __device__ __forceinline__ void done(const Unit&) const {}
};
template <class Epi> __device__ __forceinline__ void run_gemm(unsigned char* lds, const bf16_t* A, const bf16_t* Bt, int M, int N, int K, const Epi& E, int nsp = 0  ) {
    pg8::Gemm g{A, Bt, M, N, K, K};
    if (nsp) { TailSplitOrder S; S.G = gdim_(); S.c = bid_(); S.nsp = nsp; S.nt_full = K / 64; S.nt_sub = K / nsp / 64; S.kb_sub = K / nsp * 2; pg8::gemm_phase<Epi, TailSplitOrder, false>((PG8_LAS unsigned char*)lds, g, S, E, nullptr); }
    else { pg8::StaticOrder S; S.init(M, N, gdim_(), bid_(), 1); S.unt = K / 64; S.ukb = K * 2; pg8::gemm_phase<Epi, pg8::StaticOrder, false>((PG8_LAS unsigned char*)lds, g, S, E, nullptr); }
}
#define GAS __attribute__((address_space(1)))
#define XB_TMO      128
#define XB_XCNT(j)  (256  + 64 * (j))
#define XB_XSUB(j)  (1280 + 64 * (j))
#define XB_XGEN(j)  (2304 + 64 * (j))
#define XB_TOP      3328
#define XB_TOPGEN   3392
#define XCD_BAR_WORDS 3456
#define XB_SPIN_CAP (1u << 18)

__device__ __forceinline__ unsigned xb_ld(unsigned* p)              { return __hip_atomic_load(p, __ATOMIC_RELAXED, __HIP_MEMORY_SCOPE_AGENT); }
__device__ __forceinline__ unsigned xb_add(unsigned* p, unsigned v) { return __hip_atomic_fetch_add(p, v, __ATOMIC_RELAXED, __HIP_MEMORY_SCOPE_AGENT); }
__device__ __forceinline__ unsigned xb_xcc_id() { return (unsigned)__builtin_amdgcn_s_getreg((3 << 11) | 20) & 0xFu; }
#define XB_SPIN(cond, bar) do { unsigned _sp = 0; while (cond) { __builtin_amdgcn_s_sleep(1); \
    if ((++_sp & 255u) == 0u) { if (xb_ld(&(bar)[XB_TMO])) break; if (_sp > XB_SPIN_CAP) { atomicAdd(&(bar)[XB_TMO], 1u); break; } } } } while (0)

struct XcdBarrier {
    unsigned* bar; unsigned x;
    volatile LAS unsigned* st;
};

__device__ __forceinline__ XcdBarrier xcd_barrier_post(unsigned* bar, volatile LAS unsigned* st) {
    XcdBarrier b; b.bar = bar; b.x = xb_xcc_id(); b.st = st;
    if (threadIdx.x == 0) (void)xb_add(&bar[XB_XCNT(b.x)], 1u);
    return b;
}
__device__ __forceinline__ void xcd_barrier_complete(unsigned* bar, unsigned x, unsigned& nloc, unsigned& nx) {
    const unsigned G = gridDim.x * gridDim.y * gridDim.z;
    unsigned sum, cnt, mine, sp = 0u;
    for (;;) {
        sum = 0u; cnt = 0u; mine = 0u;
#pragma unroll
        for (unsigned j = 0; j < 16; ++j) { const unsigned c = xb_ld(&bar[XB_XCNT(j)]); sum += c; cnt += (c > 0u) ? 1u : 0u; mine = (j == x) ? c : mine; }
        if (sum == G) break;
        __builtin_amdgcn_s_sleep(1);
        if ((++sp & 255u) == 0u) { if (xb_ld(&bar[XB_TMO])) break; if (sp > XB_SPIN_CAP) { atomicAdd(&bar[XB_TMO], 1u); break; } }
    }
    nloc = mine > 0u ? mine : 1u; nx = cnt > 0u ? cnt : 1u;
}

__device__ __forceinline__ void xcd_barrier(const XcdBarrier& b) {
    asm volatile("s_waitcnt vmcnt(0)" ::: "memory");
    __syncthreads();
    if (threadIdx.x == 0) {
        unsigned* bar = b.bar; asm volatile("" : "+s"(bar));
        __builtin_amdgcn_s_waitcnt(0);
        unsigned nloc = b.st[0], nx = b.st[1];
        if (nloc == 0u) { xcd_barrier_complete(bar, b.x, nloc, nx); b.st[0] = nloc; b.st[1] = nx; }
        const unsigned old = xb_add(&bar[XB_XSUB(b.x)], 1u);
        const unsigned gen = old / nloc;
        if (old + 1u == (gen + 1u) * nloc) {
            __builtin_amdgcn_fence(__ATOMIC_RELEASE, "agent");
            asm volatile("s_waitcnt vmcnt(0)" ::: "memory");
            const unsigned og = xb_add(&bar[XB_TOP], 1u);
            const unsigned tg = og / nx;
            if (og + 1u == (tg + 1u) * nx) xb_add(&bar[XB_TOPGEN], 1u);
            else XB_SPIN(xb_ld(&bar[XB_TOPGEN]) == tg, bar);
            __builtin_amdgcn_fence(__ATOMIC_ACQUIRE, "agent");
            xb_add(&bar[XB_XGEN(b.x)], 1u);
            asm volatile("s_waitcnt vmcnt(0)" ::: "memory");
        } else {
            XB_SPIN(xb_ld(&bar[XB_XGEN(b.x)]) == gen, bar);
            __builtin_amdgcn_fence(__ATOMIC_ACQUIRE, "agent");
            asm volatile("s_waitcnt vmcnt(0)" ::: "memory");
        }
    }
    __syncthreads();
}
__device__ __forceinline__ void tr_tile(const float* __restrict__ src, int srcN, bf16_t* __restrict__ dst, int dstK, int k0, int n0, int mode, float* T) {
    int tid = threadIdx.x; asm volatile("" : "+v"(tid));
    float4 v[4];
#pragma unroll
    for (int e = 0; e < 4; ++e) { const int idx = tid + 512 * e, kk = idx >> 4, n4 = idx & 15; { const f32x4 q4 = __builtin_nontemporal_load((const f32x4*)(src + (size_t)(k0 + kk) * srcN + n0 + 4 * n4)); v[e] = make_float4(q4[0], q4[1], q4[2], q4[3]); } }
#pragma unroll
    for (int e = 0; e < 4; ++e) { const int idx = tid + 512 * e, kk = idx >> 4, n4 = idx & 15; float* t = T + kk * 65 + 4 * n4; t[0] = v[e].x; t[1] = v[e].y; t[2] = v[e].z; t[3] = v[e].w; }
    __syncthreads();
#pragma unroll
    for (int e = 0; e < 2; ++e) { const int idx = tid + 512 * e, nn = idx >> 4, kq = idx & 15; const int n = n0 + nn;
        const int row = mode == 0 ? n : ((n >> 7) * 256 + (n & 127) + (mode == 2 ? 128 : 0)); const float* t = T + (8 * kq) * 65 + nn;
        u32x4 w; w.x = cvt_pk_bf16(t[0], t[65]); w.y = cvt_pk_bf16(t[130], t[195]); w.z = cvt_pk_bf16(t[260], t[325]); w.w = cvt_pk_bf16(t[390], t[455]);
        *(u32x4*)(dst + (size_t)row * dstK + k0 + 8 * kq) = w; }
    __syncthreads();
}
__device__ __forceinline__ void tr_task(const float* src, int srcN, int K, bf16_t* dst, int dstK, int mode, float* T) {
    const int tn = srcN >> 6, nt = (K >> 7) * tn;
    for (int t = bid_(); t < nt; t += gdim_()) tr_tile(src, srcN, dst, dstK, (t / tn) * 128, (t % tn) * 64, mode, T);
}
template <bool XIN_F32, bool XOUT_F32>
__device__ __forceinline__ void ew_phase(const bf16_t* __restrict__ D, const bf16_t* D1  , int nsp, const void* xa  , const float* __restrict__ xb  , void* xout  ,
                                         const float* __restrict__ gpost, float coef, const float* __restrict__ gpre, bf16_t* hout, const float* __restrict__ gin, float* rsb  ) {
    int tid = threadIdx.x; asm volatile("" : "+v"(tid)); const int lane = tid & 63, wave = tid >> 6;
    const int rstep = gdim_() * 8;
    for (int rb = bid_() * 8 + wave; rb < MT; rb += 2 * rstep) {
        float4 xv[2][4]; float dv[2][4][4];
#pragma unroll
        for (int u = 0; u < 2; ++u) { const int r = rb + u * rstep; if (r < MT) {
            if (XIN_F32) { const float* xr = (xb && r >= MP) ? xb + (size_t)(r - MP) * DM : (const float*)xa + (size_t)r * DM;
#pragma unroll
                for (int i = 0; i < 4; ++i) { const f32x4 q4 = __builtin_nontemporal_load((const f32x4*)(xr + lane * 4 + 256 * i)); xv[u][i] = make_float4(q4[0], q4[1], q4[2], q4[3]); } }
            else {
#pragma unroll
                for (int i = 0; i < 4; ++i) { const u32x2 w = __builtin_nontemporal_load((const u32x2*)((const bf16_t*)xa + (size_t)r * DM + lane * 4 + 256 * i)); xv[u][i] = make_float4(bflo(w.x), bfhi(w.x), bflo(w.y), bfhi(w.y)); }
                const float ir = __builtin_amdgcn_rcpf(rsb[r]);
#pragma unroll
                for (int i = 0; i < 4; ++i) { const float4 gi = *(const float4*)(gin + lane * 4 + 256 * i);
                    xv[u][i].x *= ir * __builtin_amdgcn_rcpf(gi.x); xv[u][i].y *= ir * __builtin_amdgcn_rcpf(gi.y); xv[u][i].z *= ir * __builtin_amdgcn_rcpf(gi.z); xv[u][i].w *= ir * __builtin_amdgcn_rcpf(gi.w); } }
            if (D) {
#pragma unroll
                for (int i = 0; i < 4; ++i) { const u32x2 w = __builtin_nontemporal_load((const u32x2*)(D + (size_t)r * DM + lane * 4 + 256 * i)); dv[u][i][0] = bflo(w.x); dv[u][i][1] = bfhi(w.x); dv[u][i][2] = bflo(w.y); dv[u][i][3] = bfhi(w.y);
                    } } } }
        if (D1) {
#pragma unroll
            for (int u = 0; u < 2; ++u) { const int r = rb + u * rstep; if (r >= MP && r < MT) {
#pragma unroll
                for (int i = 0; i < 4; ++i) { dv[u][i][0] = 0.f; dv[u][i][1] = 0.f; dv[u][i][2] = 0.f; dv[u][i][3] = 0.f; }
                for (int ks = 0; ks < nsp; ++ks) {
#pragma unroll
                    for (int i = 0; i < 4; ++i) { const u32x2 w1 = __builtin_nontemporal_load((const u32x2*)(D1 + ((size_t)ks * MS + (r - MP)) * DM + lane * 4 + 256 * i)); dv[u][i][0] += bflo(w1.x); dv[u][i][1] += bfhi(w1.x); dv[u][i][2] += bflo(w1.y); dv[u][i][3] += bfhi(w1.y); } } } } }
#pragma unroll
        for (int u = 0; u < 2; ++u) { const int r = rb + u * rstep; if (r < MT) {
            if (D) { float ss = 0.f;
#pragma unroll
                for (int i = 0; i < 4; ++i) ss += dv[u][i][0] * dv[u][i][0] + dv[u][i][1] * dv[u][i][1] + dv[u][i][2] * dv[u][i][2] + dv[u][i][3] * dv[u][i][3];
                ss = wave_sum(ss); const float rs = coef * rsqrtf(ss * (1.0f / 1024.0f) + EPS);
#pragma unroll
                for (int i = 0; i < 4; ++i) { const float4 g = *(const float4*)(gpost + lane * 4 + 256 * i);
                    xv[u][i].x += dv[u][i][0] * rs * g.x; xv[u][i].y += dv[u][i][1] * rs * g.y; xv[u][i].z += dv[u][i][2] * rs * g.z; xv[u][i].w += dv[u][i][3] * rs * g.w; } }
            if (XOUT_F32) {
#pragma unroll
                for (int i = 0; i < 4; ++i) __builtin_nontemporal_store((f32x4){xv[u][i].x, xv[u][i].y, xv[u][i].z, xv[u][i].w}, (f32x4*)((float*)xout + (size_t)r * DM + lane * 4 + 256 * i)); }

            if (hout) { float ss = 0.f;
#pragma unroll
                for (int i = 0; i < 4; ++i) ss += xv[u][i].x * xv[u][i].x + xv[u][i].y * xv[u][i].y + xv[u][i].z * xv[u][i].z + xv[u][i].w * xv[u][i].w;
                ss = wave_sum(ss); const float rs = rsqrtf(ss * (1.0f / 1024.0f) + EPS); if (lane == 0) rsb[r] = rs;
#pragma unroll
                for (int i = 0; i < 4; ++i) { const float4 g = *(const float4*)(gpre + lane * 4 + 256 * i); uint2 w;
                    w.x = cvt_pk_bf16(xv[u][i].x * rs * g.x, xv[u][i].y * rs * g.y); w.y = cvt_pk_bf16(xv[u][i].z * rs * g.z, xv[u][i].w * rs * g.w);
                    *(uint2*)(hout + (size_t)r * DM + lane * 4 + 256 * i) = w; } } } }
    }
}
__device__ __forceinline__ int wtask_count(int kind) { return kind < 6 ? 352 : kind == 6 ? 281 : kind == 7 ? 64 : kind == 8 ? 256 : kind == 9 ? 96 : 192; }
__device__ void wtask_run(CArgs& a, int l, int kind, int t, unsigned char* lds) {
    unsigned char* ws = a.ws; float* T = (float*)lds; int tid = threadIdx.x; asm volatile("" : "+v"(tid));
    if (kind < 6) { const int f = kind / 3, m = kind % 3; const size_t lf = (size_t)(l * 2 + f);
        if (m < 2) tr_tile(a.in[6 + m] + lf * 1024 * 2816, 2816, (bf16_t*)(ws + OFF_WGU) + lf * 5632 * 1024, 1024, (t / 44) * 128, (t % 44) * 64, 1 + m, T);
        else tr_tile(a.in[8] + lf * 2816 * 1024, 1024, (bf16_t*)(ws + OFF_WDN) + lf * 1024 * 2816, 2816, (t / 16) * 128, (t % 16) * 64, 0, T);
    } else if (kind == 6) { bf16_t* win = (bf16_t*)(ws + OFF_WIN) + (size_t)l * 2304 * 1024;
        if (t < 280) tr_tile(a.in[9] + (size_t)l * 1024 * 2240, 2240, win, 1024, (t / 35) * 128, (t % 35) * 64, 0, T);
        else { for (int i = tid; i < 64 * 1024 / 2; i += 512) ((unsigned*)(win + 2240 * 1024))[i] = 0u; }
    } else if (kind == 7) { bf16_t* wmix = (bf16_t*)(ws + OFF_WMIX) + (size_t)l * 1024 * 1536;
        tr_tile(a.in[10] + (size_t)l * 1024 * 1024 + 512 * 1024, 1024, wmix + 1024, 1536, (t / 16) * 128, (t % 16) * 64, 0, T);
    } else if (kind == 8) {
        bf16_t* wmix = (bf16_t*)(ws + OFF_WMIX) + (size_t)l * 1024 * 1536; const float* wuv = a.in[15] + (size_t)l * 256 * 512; const float* wo = a.in[10] + (size_t)l * 1024 * 1024;
        const int i = t * 512 + tid; const int n = i & 1023, hcb = t >> 1, h = hcb >> 5, cb = hcb & 31;
        float* W = T;
        __syncthreads();
#pragma unroll
        for (int e = 0; e < 2; ++e) { const int q = tid + 512 * e, j = q >> 7, v = q & 127; W[v * 8 + j] = wuv[((8 * cb + j) * 4 + h) * 128 + v]; }
        __syncthreads();
        const float* bv = wo + (size_t)(h * 128) * 1024 + n; float acc[8];
#pragma unroll
        for (int j = 0; j < 8; ++j) acc[j] = 0.f;
#pragma unroll 1
        for (int v0 = 0; v0 < 128; v0 += 16) { float bb[16];
#pragma unroll
            for (int u = 0; u < 16; ++u) bb[u] = bv[(size_t)(v0 + u) * 1024];
#pragma unroll
            for (int u = 0; u < 16; ++u) { const float4 w0 = *(const float4*)(W + (v0 + u) * 8), w1 = *(const float4*)(W + (v0 + u) * 8 + 4);
                acc[0] += w0.x * bb[u]; acc[1] += w0.y * bb[u]; acc[2] += w0.z * bb[u]; acc[3] += w0.w * bb[u]; acc[4] += w1.x * bb[u]; acc[5] += w1.y * bb[u]; acc[6] += w1.z * bb[u]; acc[7] += w1.w * bb[u]; } }
        u32x4 w; w.x = cvt_pk_bf16(acc[0], acc[1]); w.y = cvt_pk_bf16(acc[2], acc[3]); w.z = cvt_pk_bf16(acc[4], acc[5]); w.w = cvt_pk_bf16(acc[6], acc[7]);
        *(u32x4*)(wmix + (size_t)n * 1536 + h * 256 + 8 * cb) = w;
        __syncthreads();
    } else { bf16_t* wq = (bf16_t*)(ws + OFF_WQ) + (size_t)l * 1280 * 384; const float* wuk = a.in[14] + (size_t)l * 256 * 512; const float* wqb = a.in[12] + (size_t)l * 384 * 768;
        const int i = t * 512 + tid;
        if (kind == 9) {
            const int k = i % 384, hcb = i / 384, h = hcb >> 5, cb = hcb & 31;
            const float4* bv = (const float4*)(wqb + (size_t)k * 768 + h * 192); float acc[8];
#pragma unroll
            for (int j = 0; j < 8; ++j) acc[j] = 0.f;
#pragma unroll 2
            for (int v = 0; v < 32; ++v) { const float4 y = bv[v];
#pragma unroll
                for (int j = 0; j < 8; ++j) { const float4 x = *(const float4*)(wuk + ((8 * cb + j) * 4 + h) * 128 + 4 * v); acc[j] += x.x * y.x + x.y * y.y + x.z * y.z + x.w * y.w; } }
#pragma unroll
            for (int j = 0; j < 8; ++j) wq[(size_t)(h * 256 + 8 * cb + j) * 384 + k] = f2bf(acc[j] * QSCALE);
        } else {
            const int k = i % 384, j = i / 384, half = j >> 7, jj = j & 127, h = jj >> 5, fi = jj & 31;
            wq[(size_t)(1024 + j) * 384 + k] = f2bf(wqb[(size_t)k * 768 + h * 192 + 128 + half * 32 + fi] * QSCALE); }
    }
}
__device__ void wtasks(CArgs& a, int l, int k0, int k1, int cw, unsigned char* lds) {
    unsigned* ctr = (unsigned*)(a.ws + OFF_CTL) + cw; LAS unsigned* slot = (LAS unsigned*)(lds + LDS_MAIN + 16);
    int total = 0; for (int k = k0; k < k1; ++k) total += wtask_count(k);
    for (;;) {
        __syncthreads();
        { int t0 = threadIdx.x; asm volatile("" : "+v"(t0)); if (t0 == 0) *slot = atomicAdd(ctr, 1u); }
        __syncthreads();
        int it = (int)*slot;
        if (it >= total) break;
        int k = k0; while (it >= wtask_count(k)) { it -= wtask_count(k); ++k; }
        wtask_run(a, l, k, it, lds);
    }
}
__device__ void phase_init(CArgs& a, unsigned char* lds) {
    unsigned char* ws = a.ws;
    int tid = threadIdx.x; asm volatile("" : "+v"(tid)); const size_t gtid = (size_t)bid_() * 512 + tid, gsz = (size_t)gdim_() * 512;
    for (size_t i = gtid; i < 4096 * 32; i += gsz) { const int pos = (int)(i >> 5), fi = (int)(i & 31);
        const float w = exp2f(-(float)fi * (13.287712379549449f / 32.0f)); const double ang = (double)((float)pos * w);
        const double k = rint(ang * 0.15915494309189535); const float rr = (float)(ang - k * 6.283185307179586);
        ((float2*)(ws + OFF_ROPE))[i] = make_float2(__cosf(rr), __sinf(rr)); }
    wtasks(a, 0, 0, 3, 256, lds); wtasks(a, 0, 6, 7, 272, lds);
    ew_phase<true, false>(nullptr, nullptr, 0, a.in[0], a.in[1], nullptr, nullptr, 0.f, a.in[5], (bf16_t*)(ws + OFF_H), nullptr, (float*)(ws + OFF_X));
}
__device__ void tail_wtasks(CArgs& a, int ph, unsigned char* lds) {
    switch (ph) {
    case 1:  wtasks(a, 0, 10, 11, 257, lds); wtasks(a, 0, 7, 8, 258, lds); break;
    case 2:  wtasks(a, 0, 3, 4, 259, lds); break;
    case 4:  wtasks(a, 0, 9, 10, 260, lds); wtasks(a, 0, 4, 5, 261, lds); break;
    case 6:  wtasks(a, 0, 8, 9, 262, lds); break;
    case 8:  wtasks(a, 0, 5, 6, 263, lds); break;
    case 10: wtasks(a, 1, 0, 3, 264, lds); wtasks(a, 1, 6, 7, 265, lds); wtasks(a, 1, 9, 10, 266, lds); break;
    case 11: wtasks(a, 1, 10, 11, 267, lds); wtasks(a, 1, 7, 8, 268, lds); break;
    case 14: wtasks(a, 1, 3, 4, 269, lds); break;
    case 16: wtasks(a, 1, 4, 6, 270, lds); break;
    case 18: wtasks(a, 1, 8, 9, 271, lds); break;
    default: break; }
}
__device__ __forceinline__ int keyof32(int p) { const int g = p >> 3, j = p & 7; return j < 4 ? 4 * g + j : 16 + 4 * g + (j - 4); }
__device__ __forceinline__ void ct_write(const bf16_t* ctile, bf16_t* dst  , size_t rowstride) {
    int tid = threadIdx.x; asm volatile("" : "+v"(tid)); const int c = tid >> 1, half = tid & 1;
    unsigned w[16];
#pragma unroll
    for (int p = 0; p < 32; p += 2) { const int t0 = 32 * half + keyof32(p), t1 = 32 * half + keyof32(p + 1);
        w[p >> 1] = (unsigned)ctile[t0 * 264 + c] | ((unsigned)ctile[t1 * 264 + c] << 16); }
    uint4* d = (uint4*)(dst + (size_t)c * rowstride + 32 * half);
#pragma unroll
    for (int i = 0; i < 4; ++i) d[i] = make_uint4(w[4 * i], w[4 * i + 1], w[4 * i + 2], w[4 * i + 3]);
}
__device__ __forceinline__ float lb_of(CArgs& a, int l, int e) { if (l == 0) return 0.f; const float a0 = a.in[16][e], a1 = a.in[16][256 + e]; return 1.0f / (1.0f + __expf(a0 - a1)); }
__device__ void prep_mla_tile(CArgs& a, int l, int T, unsigned char* lds) {
    unsigned char* ws = a.ws; int tid = threadIdx.x; asm volatile("" : "+v"(tid)); const int lane = tid & 63, wave = tid >> 6;
    const bf16_t* z = (const bf16_t*)(ws + OFF_Z); const int r0 = T * 64;
    const bool prm = T < 256; const int b = prm ? (T >> 6) : (T - 256), j = prm ? (T & 63) : 0; const int pos0 = prm ? j * 64 : 2048;
    bf16_t* kc = (bf16_t*)(ws + OFF_KC) + (prm ? (size_t)(b * 4096 + j * 64) : (size_t)16384 + (size_t)b * 2112 + 2048) * 320;
    bf16_t* ct = (bf16_t*)(ws + OFF_CT) + (prm ? (size_t)b * 256 * 4096 + j * 64 : (size_t)16384 * 256 + (size_t)b * 256 * 2112 + 2048);
    const size_t ctstride = prm ? 4096 : 2112;
    float* ockv = a.out + (prm ? O_CKVP + ((size_t)(l * 4 + b) * 4096 + j * 64) * 256 : O_CKVS + ((size_t)(l * 32 + b) * 64) * 256);
    float* okpe = a.out + (prm ? O_KPEP + ((size_t)(l * 4 + b) * 4096 + j * 64) * 64 : O_KPES + ((size_t)(l * 32 + b) * 64) * 64);
    bf16_t* qn = (bf16_t*)(ws + OFF_QN); const float* qag = a.in[11] + l * 384; const float* kvg = a.in[13] + l * 256;
    const float2* rope = (const float2*)(ws + OFF_ROPE);
    bf16_t* ctile = (bf16_t*)lds;
    float qg[6];
#pragma unroll
    for (int i = 0; i < 3; ++i) { qg[2 * i] = qag[2 * lane + 128 * i]; qg[2 * i + 1] = qag[2 * lane + 128 * i + 1]; }
    const float4 g4 = *(const float4*)(kvg + 4 * lane);
#pragma unroll 1
    for (int tb = 0; tb < 8; tb += 4) {
        unsigned wq[4][3]; uint2 wk[4]; bf16_t p1[4], p2[4];
#pragma unroll
        for (int u = 0; u < 4; ++u) { const bf16_t* zr = z + (size_t)(r0 + wave + 8 * (tb + u)) * ZW;
#pragma unroll
            for (int i = 0; i < 3; ++i) wq[u][i] = __builtin_nontemporal_load((const unsigned*)(zr + ZQ + 2 * lane + 128 * i));
            { const u32x2 q2 = __builtin_nontemporal_load((const u32x2*)(zr + ZKV + 4 * lane)); wk[u] = make_uint2(q2.x, q2.y); } p1[u] = __builtin_nontemporal_load(zr + ZPE + (lane & 31)); p2[u] = __builtin_nontemporal_load(zr + ZPE + 32 + (lane & 31)); }
#pragma unroll
        for (int u = 0; u < 4; ++u) { const int t = wave + 8 * (tb + u);
            { float v[6]; float ss = 0.f;
#pragma unroll
              for (int i = 0; i < 3; ++i) { v[2 * i] = bflo(wq[u][i]); v[2 * i + 1] = bfhi(wq[u][i]); ss += v[2 * i] * v[2 * i] + v[2 * i + 1] * v[2 * i + 1]; }
              ss = wave_sum(ss); const float rs = rsqrtf(ss * (1.0f / 384.0f) + EPS);
#pragma unroll
              for (int i = 0; i < 3; ++i) *(unsigned*)(qn + (size_t)(r0 + t) * 384 + 2 * lane + 128 * i) = cvt_pk_bf16(v[2 * i] * rs * qg[2 * i], v[2 * i + 1] * rs * qg[2 * i + 1]); }
            { float v0 = bflo(wk[u].x), v1 = bfhi(wk[u].x), v2 = bflo(wk[u].y), v3 = bfhi(wk[u].y);
              const float ss = wave_sum(v0 * v0 + v1 * v1 + v2 * v2 + v3 * v3); const float rs = rsqrtf(ss * (1.0f / 256.0f) + EPS);
              v0 *= rs * g4.x; v1 *= rs * g4.y; v2 *= rs * g4.z; v3 *= rs * g4.w;
              __builtin_nontemporal_store((f32x4){v0, v1, v2, v3}, (f32x4*)(ockv + (size_t)t * 256 + 4 * lane));
              uint2 o; o.x = cvt_pk_bf16(v0, v1); o.y = cvt_pk_bf16(v2, v3);
              *(uint2*)(kc + (size_t)t * 320 + 4 * lane) = o; *(uint2*)(ctile + t * 264 + 4 * lane) = o; }
            if (lane < 32) { const float x1 = bf2f(p1[u]), x2 = bf2f(p2[u]); const float2 cs = rope[(pos0 + t) * 32 + lane];
              const float o1 = x1 * cs.x - x2 * cs.y, o2 = x2 * cs.x + x1 * cs.y;
              okpe[(size_t)t * 64 + lane] = o1; okpe[(size_t)t * 64 + 32 + lane] = o2; kc[(size_t)t * 320 + 256 + lane] = f2bf(o1); kc[(size_t)t * 320 + 288 + lane] = f2bf(o2); } }
    }
    __syncthreads();
    ct_write(ctile, ct, ctstride);
    __syncthreads();
}
__device__ void prep_hgrn_tile(CArgs& a, int l, int T, unsigned char* lds) {
    unsigned char* ws = a.ws; int tid = threadIdx.x; asm volatile("" : "+v"(tid)); asm volatile("" : "+s"(l));
    const bf16_t* z = (const bf16_t*)(ws + OFF_Z); const int r0 = T * 64;
    float* lf = (float*)lds; float* vt = (float*)(lds + 65536); float* tot = (float*)(lds + 131072);
    const int ep = tid & 255, hf = tid >> 8; const float lbv = lb_of(a, l, ep);
    bf16_t zfr[32]; float pref[32];
    { bf16_t zvr[32];
#pragma unroll
      for (int i = 0; i < 32; ++i) { const bf16_t* zr = z + (size_t)(r0 + 32 * hf + i) * ZW; zfr[i] = zr[ZHF + ep]; zvr[i] = zr[ZHI + ep]; }
      float run = 0.f;
#pragma unroll
      for (int i = 0; i < 32; ++i) { const float f = lbv + (1.0f - lbv) * sigmoidf_(bf2f(zfr[i])); run += __logf(fmaxf(f, 1e-30f)); pref[i] = run; vt[(32 * hf + i) * 256 + ep] = bf2f(zvr[i]); }
      tot[hf * 256 + ep] = run; }
    __syncthreads();
    { const float t0 = tot[ep], bl = t0 + tot[256 + ep], off = hf ? t0 : 0.f;
#pragma unroll
      for (int i = 0; i < 32; ++i) { lf[(32 * hf + i) * 256 + ep] = (1.0f - lbv) * sigmoidf_(-bf2f(zfr[i])) * __expf(bl - pref[i] - off); ((float*)(ws + OFF_BCUM))[(size_t)(r0 + 32 * hf + i) * 256 + ep] = pref[i] + off; }
      if (hf == 0) ((float*)(ws + OFF_DEC))[T * 256 + ep] = __expf(bl); }
    __syncthreads();
    { const int h = tid >> 7, eb = (tid & 127) >> 3, db = tid & 7; float acc[4][8];
#pragma unroll
      for (int i = 0; i < 4; ++i)
#pragma unroll
          for (int jj = 0; jj < 8; ++jj) acc[i][jj] = 0.f;
#pragma unroll 4
      for (int s = 0; s < 64; ++s) { const float4 kv = *(const float4*)(lf + s * 256 + h * 64 + eb * 4); const float4 v0 = *(const float4*)(vt + s * 256 + h * 64 + db * 8), v1 = *(const float4*)(vt + s * 256 + h * 64 + db * 8 + 4);
          const float kk[4] = {kv.x, kv.y, kv.z, kv.w}; const float vv[8] = {v0.x, v0.y, v0.z, v0.w, v1.x, v1.y, v1.z, v1.w};
#pragma unroll
          for (int i = 0; i < 4; ++i)
#pragma unroll
              for (int jj = 0; jj < 8; ++jj) acc[i][jj] += kk[i] * vv[jj]; }
      float* U = (float*)(ws + OFF_U) + (size_t)(T * 4 + h) * 4096;
#pragma unroll
      for (int i = 0; i < 4; ++i) { *(float4*)(U + (eb * 4 + i) * 64 + db * 8) = make_float4(acc[i][0], acc[i][1], acc[i][2], acc[i][3]); *(float4*)(U + (eb * 4 + i) * 64 + db * 8 + 4) = make_float4(acc[i][4], acc[i][5], acc[i][6], acc[i][7]); } }
    __syncthreads();
}
__device__ void prep_cache_tile(CArgs& a, int l, int P, unsigned char* lds) {
    unsigned char* ws = a.ws; int tid = threadIdx.x; asm volatile("" : "+v"(tid)); const int b = P >> 5, kt = P & 31;
    const float* ckv = a.in[2] + ((size_t)(l * 32 + b) * 2048 + kt * 64) * 256; const float* kpe = a.in[3] + ((size_t)(l * 32 + b) * 2048 + kt * 64) * 64;
    bf16_t* kc = (bf16_t*)(ws + OFF_KC) + ((size_t)16384 + (size_t)b * 2112 + kt * 64) * 320;
    bf16_t* ct = (bf16_t*)(ws + OFF_CT) + (size_t)16384 * 256 + (size_t)b * 256 * 2112 + kt * 64;
    bf16_t* ctile = (bf16_t*)lds;
#pragma unroll
    for (int i = 0; i < 8; ++i) { const int q = tid + 512 * i, t = q >> 6, c4 = q & 63; const f32x4 q4 = __builtin_nontemporal_load((const f32x4*)(ckv + (size_t)t * 256 + c4 * 4)); const float4 v = make_float4(q4[0], q4[1], q4[2], q4[3]);
        uint2 o; o.x = cvt_pk_bf16(v.x, v.y); o.y = cvt_pk_bf16(v.z, v.w); *(uint2*)(kc + (size_t)t * 320 + c4 * 4) = o; *(uint2*)(ctile + t * 264 + c4 * 4) = o; }
#pragma unroll
    for (int i = 0; i < 2; ++i) { const int q = tid + 512 * i, t = q >> 4, c4 = q & 15; const f32x4 q4 = __builtin_nontemporal_load((const f32x4*)(kpe + (size_t)t * 64 + c4 * 4)); const float4 v = make_float4(q4[0], q4[1], q4[2], q4[3]);
        uint2 o; o.x = cvt_pk_bf16(v.x, v.y); o.y = cvt_pk_bf16(v.z, v.w); *(uint2*)(kc + (size_t)t * 320 + 256 + c4 * 4) = o; }
    __syncthreads();
    ct_write(ctile, ct, 2112);
    __syncthreads();
}
__device__ void phase_prep(CArgs& a, int l, unsigned char* lds, int rep = 0) {
    unsigned* ctr = (unsigned*)(a.ws + OFF_CTL) + 16 * (l + 1) + 8 + 128 * rep; LAS unsigned* slot = (LAS unsigned*)(lds + LDS_MAIN + 16);
    for (;;) {
        __syncthreads();
        { int t0 = threadIdx.x; asm volatile("" : "+v"(t0)); if (t0 == 0) *slot = atomicAdd(ctr, 1u); }
        __syncthreads();
        const int it = (int)*slot;
        if (it >= 2 * NTILE) break;
        if (it < NTILE) prep_hgrn_tile(a, l, it, lds); else prep_mla_tile(a, l, it - NTILE, lds);
    }
}
__device__ void phase_cache(CArgs& a, int l, unsigned char* lds) {
    unsigned* ctr = (unsigned*)(a.ws + OFF_CTL) + 16 * (l + 1) + 12; LAS unsigned* slot = (LAS unsigned*)(lds + LDS_MAIN + 16);
    for (;;) {
        __syncthreads();
        { int t0 = threadIdx.x; asm volatile("" : "+v"(t0)); if (t0 == 0) *slot = atomicAdd(ctr, 1u); }
        __syncthreads();
        const int it = (int)*slot;
        if (it >= 1024) break;
        prep_cache_tile(a, l, it, lds);
    }
}
__device__ void phase_scan(CArgs& a, int l) {
    unsigned char* ws = a.ws; int tid = threadIdx.x; asm volatile("" : "+v"(tid)); const size_t gtid = (size_t)bid_() * 512 + tid, gsz = (size_t)gdim_() * 512;
    const float* U = (const float*)(ws + OFF_U); const float* dec = (const float*)(ws + OFF_DEC); float* sst = (float*)(ws + OFF_SST);
    for (size_t i = gtid; i < 16 * 4096; i += gsz) { const int bh = (int)(i >> 12), ed = (int)(i & 4095), b = bh >> 2, h = bh & 3, e = ed >> 6; float S = 0.f;
#pragma unroll 16
        for (int j = 0; j < 64; ++j) { const size_t ch = (size_t)((b * 64 + j) * 4 + h); sst[ch * 4096 + ed] = S; S = dec[ch * 64 + e] * S + __builtin_nontemporal_load(U + ch * 4096 + ed); }
        a.out[O_HGP + (size_t)(l * 16 + bh) * 4096 + ed] = S; }
    for (size_t i = gtid; i < 128 * 4096; i += gsz) { const int bh = (int)(i >> 12), ed = (int)(i & 4095), b = bh >> 2, h = bh & 3, e = ed >> 6; const size_t ch = (size_t)((256 + b) * 4 + h);
        const float S0 = a.in[4][(size_t)(l * 128 + bh) * 4096 + ed];
        a.out[O_HGS + (size_t)(l * 128 + bh) * 4096 + ed] = dec[ch * 64 + e] * S0 + U[ch * 4096 + ed]; }
}
constexpr int KSTR = 656, VSTR = 144, VOFF = 64 * KSTR, ABUF = VOFF + 256 * VSTR;
__device__ __forceinline__ int swz16(int row) { return (((row & 15) + 4) >> 3) & 1; }
__device__ void attn_item(CArgs& a, int idx, unsigned char* ldsg) {
    unsigned char* ws = a.ws; LAS unsigned char* lds = (LAS unsigned char*)ldsg;
    int tid = threadIdx.x; asm volatile("" : "+v"(tid)); const int lane = tid & 63, wave = __builtin_amdgcn_readfirstlane(tid >> 6), lr = lane & 15, g = lane >> 4;
    const int gx = (g ^ swz16(lr)) * 16;
    int b, hp, nkt, r0; const unsigned char* kcb; const unsigned char* ctb; int ctstride;
    if (idx >= 256 && idx < 320) { const int s = idx - 256; b = s >> 1; hp = s & 1; nkt = 33; r0 = MP + b * 64;
        kcb = ws + OFF_KC + ((size_t)16384 + (size_t)b * 2112) * 640; ctb = ws + OFF_CT + ((size_t)16384 * 256 + (size_t)b * 256 * 2112) * 2; ctstride = 4224; }
    else { const int k = idx < 256 ? idx : idx - 64; const int j = 63 - (k >> 3), sub = k & 7; b = sub >> 1; hp = sub & 1; nkt = j + 1; r0 = b * 4096 + j * 64;
        kcb = ws + OFF_KC + (size_t)b * 4096 * 640; ctb = ws + OFF_CT + (size_t)b * 256 * 4096 * 2; ctstride = 8192; }
    const int head = hp * 2 + (wave >> 2); const int qrow = r0 + (wave & 3) * 16 + lr;
    unsigned ko[6], vo[5];
#pragma unroll
    for (int i = 0; i < 6; ++i) { const int n = i * 512 + tid, row = n / 41, pc = n - row * 41; ko[i] = (unsigned)(row * 640 + (pc < 40 ? (pc ^ swz16(row)) * 16 : 0)); }
#pragma unroll
    for (int i = 0; i < 5; ++i) { const int n = i * 512 + tid, row = n / 9, pc = n - row * 9; vo[i] = (unsigned)(row * ctstride + (pc < 8 ? (pc ^ swz16(row)) * 16 : 0)); }
#define ATT_DMA(kt, bo) do { const unsigned char* kg = kcb + (size_t)(kt) * 40960; const unsigned char* vg = ctb + (size_t)(kt) * 128; \
        _Pragma("unroll") for (int i = 0; i < 6; ++i) if (i < 5 || wave == 0) __builtin_amdgcn_global_load_lds((const unsigned*)(kg + ko[i]), (LAS unsigned*)(lds + (bo) + (i * 512 + wave * 64) * 16), 16, 0, 0); \
        _Pragma("unroll") for (int i = 0; i < 5; ++i) if (i < 4 || wave < 4) __builtin_amdgcn_global_load_lds((const unsigned*)(vg + vo[i]), (LAS unsigned*)(lds + (bo) + VOFF + (i * 512 + wave * 64) * 16), 16, 0, 0); } while (0)
    __syncthreads();
    ATT_DMA(0, 0);
    bf16x8 qf[10];
    { const bf16_t* qp = (const bf16_t*)(ws + OFF_Q) + (size_t)qrow * 1280 + head * 320 + g * 8;
#pragma unroll
      for (int ks = 0; ks < 10; ++ks) qf[ks] = __builtin_nontemporal_load((const bf16x8*)(qp + ks * 32));
      const int pos = qrow < MP ? (qrow & 4095) : 2048 + ((qrow - MP) & 63); const float2* rp = (const float2*)(ws + OFF_ROPE) + pos * 32 + 8 * g;
      u32x4 w1 = __builtin_bit_cast(u32x4, qf[8]), w2 = __builtin_bit_cast(u32x4, qf[9]);
      float4 cs4[4];
#pragma unroll
      for (int jp = 0; jp < 4; ++jp) cs4[jp] = *(const float4*)(rp + 2 * jp);
#pragma unroll
      for (int jp = 0; jp < 4; ++jp) { const float a1 = bflo(w1[jp]), b1 = bfhi(w1[jp]), a2 = bflo(w2[jp]), b2 = bfhi(w2[jp]);
          w1[jp] = cvt_pk_bf16(a1 * cs4[jp].x - a2 * cs4[jp].y, b1 * cs4[jp].z - b2 * cs4[jp].w); w2[jp] = cvt_pk_bf16(a2 * cs4[jp].x + a1 * cs4[jp].y, b2 * cs4[jp].z + b1 * cs4[jp].w); }
      qf[8] = __builtin_bit_cast(bf16x8, w1); qf[9] = __builtin_bit_cast(bf16x8, w2); }
    f32x4 o[16];
#pragma unroll
    for (int i = 0; i < 16; ++i) o[i] = (f32x4){0.f, 0.f, 0.f, 0.f};
    float mrun = -1e30f, lsum = 0.f;
    asm volatile("s_waitcnt vmcnt(0)" ::: "memory");
    __syncthreads();
    const int koff = lr * KSTR + gx, voff = VOFF + lr * VSTR + gx;
    for (int kt = 0; kt < nkt; ++kt) {
        const int bo = (kt & 1) * ABUF;
        if (kt + 1 < nkt) ATT_DMA(kt + 1, ABUF - bo);
        const LAS unsigned char* kb = lds + bo + koff; const LAS unsigned char* vb = lds + bo + voff;
        f32x4 s[4];
#pragma unroll
        for (int i = 0; i < 4; ++i) s[i] = (f32x4){0.f, 0.f, 0.f, 0.f};
        bf16x8 kf[2][4];
#pragma unroll
        for (int k4 = 0; k4 < 4; ++k4) kf[0][k4] = *(const LAS bf16x8*)(kb + k4 * 16 * KSTR);
#pragma unroll
        for (int ks = 0; ks < 10; ++ks) {
            if (ks < 9) {
#pragma unroll
                for (int k4 = 0; k4 < 4; ++k4) kf[(ks + 1) & 1][k4] = *(const LAS bf16x8*)(kb + k4 * 16 * KSTR + (ks + 1) * 64); }
            __builtin_amdgcn_sched_barrier(0);
#pragma unroll
            for (int k4 = 0; k4 < 4; ++k4) s[k4] = __builtin_amdgcn_mfma_f32_16x16x32_bf16(kf[ks & 1][k4], qf[ks], s[k4], 0, 0, 0);
            __builtin_amdgcn_sched_barrier(0);
        }
        bf16x8 vf[2][4];
#pragma unroll
        for (int q4 = 0; q4 < 4; ++q4) vf[0][q4] = *(const LAS bf16x8*)(vb + (q4 >> 1) * 16 * VSTR + (q4 & 1) * 64);
        __builtin_amdgcn_sched_barrier(0);
        float mx = s[0][0];
#pragma unroll
        for (int k4 = 0; k4 < 4; ++k4)
#pragma unroll
            for (int i = 0; i < 4; ++i) mx = fmaxf(mx, s[k4][i]);
        mx = fmaxf(mx, __shfl_xor(mx, 16)); mx = fmaxf(mx, __shfl_xor(mx, 32));
        if (!__all(mx - mrun <= 8.0f)) {
            const float mnew = fmaxf(mrun, mx), alpha = __builtin_amdgcn_exp2f(mrun - mnew); mrun = mnew; lsum *= alpha;
#pragma unroll
            for (int i = 0; i < 16; ++i) o[i] *= alpha; }
        float ps = 0.f;
#pragma unroll
        for (int k4 = 0; k4 < 4; ++k4)
#pragma unroll
            for (int i = 0; i < 4; ++i) { s[k4][i] = __builtin_amdgcn_exp2f(s[k4][i] - mrun); ps += s[k4][i]; }
        lsum += ps;
        bf16x8 pb[2];
#pragma unroll
        for (int s2 = 0; s2 < 2; ++s2) { u32x4 w; w.x = cvt_pk_bf16(s[2 * s2][0], s[2 * s2][1]); w.y = cvt_pk_bf16(s[2 * s2][2], s[2 * s2][3]);
            w.z = cvt_pk_bf16(s[2 * s2 + 1][0], s[2 * s2 + 1][1]); w.w = cvt_pk_bf16(s[2 * s2 + 1][2], s[2 * s2 + 1][3]); pb[s2] = __builtin_bit_cast(bf16x8, w); }
#pragma unroll
        for (int cp = 0; cp < 8; ++cp) {
            if (cp < 7) {
#pragma unroll
                for (int q4 = 0; q4 < 4; ++q4) vf[(cp + 1) & 1][q4] = *(const LAS bf16x8*)(vb + (2 * (cp + 1) + (q4 >> 1)) * 16 * VSTR + (q4 & 1) * 64); }
            __builtin_amdgcn_sched_barrier(0);
#pragma unroll
            for (int q4 = 0; q4 < 4; ++q4) o[2 * cp + (q4 >> 1)] = __builtin_amdgcn_mfma_f32_16x16x32_bf16(vf[cp & 1][q4], pb[q4 & 1], o[2 * cp + (q4 >> 1)], 0, 0, 0);
            __builtin_amdgcn_sched_barrier(0);
        }
        asm volatile("s_waitcnt vmcnt(0)" ::: "memory");
        __syncthreads();
    }
#undef ATT_DMA
    lsum += __shfl_xor(lsum, 16); lsum += __shfl_xor(lsum, 32);
    const float inv = 1.0f / lsum;
    bf16_t* op = (bf16_t*)(ws + OFF_MIXA) + (size_t)qrow * 1536 + head * 256 + 4 * g;
#pragma unroll
    for (int ct = 0; ct < 16; ++ct) { uint2 w; w.x = cvt_pk_bf16(o[ct][0] * inv, o[ct][1] * inv); w.y = cvt_pk_bf16(o[ct][2] * inv, o[ct][3] * inv); *(uint2*)(op + 16 * ct) = w; }
}
constexpr int HS = 72;
constexpr int H_BC = 0, H_QT = 2 * 16640, H_KT = H_QT + 2 * 64 * HS * 2, H_QH = H_KT + 2 * 64 * HS * 2, H_VT = H_QH + 2 * 64 * HS * 2, H_ST = H_VT + 2 * 64 * HS * 2, H_END = H_ST + 2 * 64 * HS * 2;
static_assert(H_END <= LDS_MAIN, "hgrn lds");
__device__ __forceinline__ int posof64(int t) { const int u = t & 31; const int p = u < 16 ? 8 * (u >> 2) + (u & 3) : 8 * ((u - 16) >> 2) + 4 + ((u - 16) & 3); return (t & 32) + p; }
__device__ void hgrn_out_tile(CArgs& a, int l, int T, unsigned char* ldsg) {
    unsigned char* ws = a.ws; int tid = threadIdx.x; asm volatile("" : "+v"(tid)); asm volatile("" : "+s"(l)); const int lane = tid & 63, wave = tid >> 6, lr = lane & 15, g = lane >> 4;
    LAS unsigned char* lds = (LAS unsigned char*)ldsg;
    const bf16_t* z = (const bf16_t*)(ws + OFF_Z); const int r0 = T * 64;
    const int c = tid & 127, hh = c >> 6, e = c & 63, tq = tid >> 7;
    LAS float* bc = (LAS float*)(lds + H_BC) + hh * 4160;
    LAS bf16_t* QT = (LAS bf16_t*)(lds + H_QT) + hh * 64 * HS; LAS bf16_t* KT = (LAS bf16_t*)(lds + H_KT) + hh * 64 * HS; LAS bf16_t* QH = (LAS bf16_t*)(lds + H_QH) + hh * 64 * HS; LAS bf16_t* VT = (LAS bf16_t*)(lds + H_VT) + hh * 64 * HS;
    const float lbv0 = lb_of(a, l, hh * 64 + e), lbv1 = lb_of(a, l, (2 + hh) * 64 + e);
    for (int hp = 0; hp < 2; ++hp) {
        const int h = 2 * hp + hh; const float lbv = hp ? lbv1 : lbv0;
        { const float* bcum = (const float*)(ws + OFF_BCUM) + (size_t)r0 * 256 + h * 64 + e; const float rr = bcum[31 * 256];
          float s0v[16];
#pragma unroll
          for (int i = 0; i < 16; ++i) { const int idx = tid + 512 * i, h2 = idx >> 12, ed = idx & 4095; const int hg = 2 * hp + h2;
              const float* S0 = T < 256 ? (const float*)(ws + OFF_SST) + (size_t)(T * 4 + hg) * 4096 : a.in[4] + (size_t)(l * 128 + (T - 256) * 4 + hg) * 4096;
              s0v[i] = __builtin_nontemporal_load(S0 + ed); }
#pragma unroll 1
          for (int i0 = 0; i0 < 16; i0 += 8) {
          bf16_t zq[8], zf16[8], zv[8]; float bbv[8];
#pragma unroll
          for (int i = 0; i < 8; ++i) { const bf16_t* zr = z + (size_t)(r0 + tq * 16 + i0 + i) * ZW + h * 64 + e; zq[i] = __builtin_nontemporal_load(zr + ZHQ); zf16[i] = __builtin_nontemporal_load(zr + ZHF); zv[i] = __builtin_nontemporal_load(zr + ZHI); bbv[i] = __builtin_nontemporal_load(bcum + (tq * 16 + i0 + i) * 256); }
#pragma unroll
          for (int i = 0; i < 8; ++i) { const int t = tq * 16 + i0 + i; const float bb = bbv[i];
              const float q = bf2f(zq[i]), zf = bf2f(zf16[i]); const float k = (1.0f - lbv) * sigmoidf_(-zf);
              QH[t * HS + e] = f2bf(q * __expf(bb)); QT[t * HS + e] = f2bf(q * __expf(fminf(bb - rr, 80.f))); KT[t * HS + e] = f2bf(k * __expf(fminf(rr - bb, 80.f)));
              VT[e * HS + posof64(t)] = zv[i]; } }
#pragma unroll
          for (int i = 0; i < 16; ++i) { const int idx = tid + 512 * i, h2 = idx >> 12, ed = idx & 4095; ((LAS bf16_t*)(lds + H_ST))[h2 * 64 * HS + (ed & 63) * HS + (ed >> 6)] = f2bf(s0v[i]); } }
        __syncthreads();
        { const int wh = wave >> 2, tb = wave & 3; const int hw = 2 * hp + wh;
          const LAS unsigned char* qt = lds + H_QT + wh * 64 * HS * 2; const LAS unsigned char* kt = lds + H_KT + wh * 64 * HS * 2; const LAS unsigned char* qh = lds + H_QH + wh * 64 * HS * 2;
          const LAS unsigned char* vt = lds + H_VT + wh * 64 * HS * 2; const LAS unsigned char* st = lds + H_ST + wh * 64 * HS * 2;
          const int trow = 16 * tb + lr;
          float4 ogv[4]; uint2 gwv[4];
#pragma unroll
          for (int db = 0; db < 4; ++db) { const int d0 = hw * 64 + 16 * db + 4 * g; ogv[db] = *(const float4*)(a.in[17] + l * 256 + d0); { const u32x2 q2 = __builtin_nontemporal_load((const u32x2*)(z + (size_t)(r0 + trow) * ZW + ZHG + d0)); gwv[db] = make_uint2(q2.x, q2.y); } }
          bf16x8 qtf[2], qhf[2];
#pragma unroll
          for (int ks = 0; ks < 2; ++ks) { qtf[ks] = *(const LAS bf16x8*)(qt + trow * (HS * 2) + (32 * ks + 8 * g) * 2); qhf[ks] = *(const LAS bf16x8*)(qh + trow * (HS * 2) + (32 * ks + 8 * g) * 2); }
          f32x4 aT[4];
#pragma unroll
          for (int sb = 0; sb < 4; ++sb) { aT[sb] = (f32x4){0.f, 0.f, 0.f, 0.f};
#pragma unroll
              for (int ks = 0; ks < 2; ++ks) { const bf16x8 kf = *(const LAS bf16x8*)(kt + (16 * sb + lr) * (HS * 2) + (32 * ks + 8 * g) * 2); aT[sb] = __builtin_amdgcn_mfma_f32_16x16x32_bf16(kf, qtf[ks], aT[sb], 0, 0, 0); }
#pragma unroll
              for (int i = 0; i < 4; ++i) aT[sb][i] = (16 * sb + 4 * g + i <= trow) ? aT[sb][i] : 0.f; }
          bf16x8 pb[2];
#pragma unroll
          for (int s2 = 0; s2 < 2; ++s2) { u32x4 w; w.x = cvt_pk_bf16(aT[2 * s2][0], aT[2 * s2][1]); w.y = cvt_pk_bf16(aT[2 * s2][2], aT[2 * s2][3]);
              w.z = cvt_pk_bf16(aT[2 * s2 + 1][0], aT[2 * s2 + 1][1]); w.w = cvt_pk_bf16(aT[2 * s2 + 1][2], aT[2 * s2 + 1][3]); pb[s2] = __builtin_bit_cast(bf16x8, w); }
          f32x4 o[4]; float ss = 0.f;
#pragma unroll
          for (int db = 0; db < 4; ++db) { o[db] = (f32x4){0.f, 0.f, 0.f, 0.f};
#pragma unroll
              for (int ks = 0; ks < 2; ++ks) { const bf16x8 sf = *(const LAS bf16x8*)(st + (16 * db + lr) * (HS * 2) + (32 * ks + 8 * g) * 2); o[db] = __builtin_amdgcn_mfma_f32_16x16x32_bf16(sf, qhf[ks], o[db], 0, 0, 0); }
#pragma unroll
              for (int s2 = 0; s2 < 2; ++s2) { const bf16x8 vf = *(const LAS bf16x8*)(vt + (16 * db + lr) * (HS * 2) + (32 * s2 + 8 * g) * 2); o[db] = __builtin_amdgcn_mfma_f32_16x16x32_bf16(vf, pb[s2], o[db], 0, 0, 0); }
              ss += o[db][0] * o[db][0] + o[db][1] * o[db][1] + o[db][2] * o[db][2] + o[db][3] * o[db][3]; }
          ss += __shfl_xor(ss, 16); ss += __shfl_xor(ss, 32);
          const float rs = rsqrtf(ss * (1.0f / 64.0f) + EPS);
#pragma unroll
          for (int db = 0; db < 4; ++db) { const int d0 = hw * 64 + 16 * db + 4 * g; const float4 og = ogv[db]; const uint2 gw = gwv[db];
              uint2 w; w.x = cvt_pk_bf16(o[db][0] * rs * og.x * siluf_(bflo(gw.x)), o[db][1] * rs * og.y * siluf_(bfhi(gw.x)));
              w.y = cvt_pk_bf16(o[db][2] * rs * og.z * siluf_(bflo(gw.y)), o[db][3] * rs * og.w * siluf_(bfhi(gw.y)));
              *(uint2*)((bf16_t*)(ws + OFF_MIXA) + (size_t)(r0 + trow) * 1536 + 1024 + d0) = w; } }
        __syncthreads();
    }
}
template <bool PRM> __device__ __forceinline__ void cmlp_item_t(CArgs& a, int l, int it, unsigned char* ldsg) {
    int tid = threadIdx.x; asm volatile("" : "+v"(tid)); asm volatile("" : "+s"(l)); const int lane = tid & 63, wave = tid >> 6, lr = lane & 15, lg = lane >> 4; const int ci = it >> 2, g = it & 3;
    constexpr int L = PRM ? 128 : 64, WS = L + 8;
    const int r0 = PRM ? ci * 128 : MP + (ci - 128) * 64;
    LAS unsigned char* lds = (LAS unsigned char*)ldsg; LAS bf16_t* Wb = (LAS bf16_t*)lds; LAS bf16_t* vT = (LAS bf16_t*)(lds + 128 * 136 * 2);
    const bf16_t* z = (const bf16_t*)(a.ws + OFF_Z); const float* wsrc = a.in[19] + (size_t)(l * 4 + g) * 128 * 128;
    const float vg = a.in[18][l * 256 + g * 64 + lane];
    bf16_t zc[L / 8];
#pragma unroll
    for (int i = 0; i < L / 8; ++i) zc[i] = __builtin_nontemporal_load(z + (size_t)(r0 + wave + 8 * i) * ZW + ZCV + g * 64 + lane);
    { constexpr int NQ = L * L / 4 / 512, SH = PRM ? 5 : 4; float4 wv[NQ];
#pragma unroll
      for (int i = 0; i < NQ; ++i) { const int idx = tid + 512 * i, t = idx >> SH, s4 = idx & ((1 << SH) - 1); wv[i] = *(const float4*)(wsrc + t * 128 + 4 * s4); }
#pragma unroll
      for (int i = 0; i < NQ; ++i) { const int idx = tid + 512 * i, t = idx >> SH, s0 = 4 * (idx & ((1 << SH) - 1));
          u32x2 w; w.x = cvt_pk_bf16(s0 <= t ? wv[i].x : 0.f, s0 + 1 <= t ? wv[i].y : 0.f); w.y = cvt_pk_bf16(s0 + 2 <= t ? wv[i].z : 0.f, s0 + 3 <= t ? wv[i].w : 0.f);
          *(LAS u32x2*)(Wb + t * WS + s0) = w; } }
    {
#pragma unroll
      for (int i = 0; i < L / 8; ++i) { const int t = wave + 8 * i; const float x = geluf_(bf2f(zc[i])); const float ss = wave_sum(x * x);
          const float vv = x * rsqrtf(ss * (1.0f / 64.0f) + EPS) * vg; vT[lane * WS + t] = f2bf(vv);
          if (!PRM) a.out[O_CMV + ((size_t)(l * 32 + (ci - 128)) * 64 + t) * 256 + g * 64 + lane] = vv; } }
    __syncthreads();
    { constexpr int NT = PRM ? 4 : 2;
      const int tt = PRM ? wave : (wave & 3); const int t = 16 * tt + lr; const float bs = a.in[20][(size_t)(l * 4 + g) * 128 + t];
      uint2 cwv[NT];
#pragma unroll
      for (int n = 0; n < NT; ++n) { const int dt = PRM ? n : 2 * (wave >> 2) + n; { const u32x2 q2 = __builtin_nontemporal_load((const u32x2*)(z + (size_t)(r0 + t) * ZW + ZCU + g * 64 + 16 * dt + 4 * lg)); cwv[n] = make_uint2(q2.x, q2.y); } }
#pragma unroll
      for (int n = 0; n < NT; ++n) { const int dt = PRM ? n : 2 * (wave >> 2) + n; f32x4 acc = (f32x4){0.f, 0.f, 0.f, 0.f};
#pragma unroll
          for (int ks = 0; ks < L / 32; ++ks) { if (32 * ks <= 16 * tt + 15) {
              const bf16x8 vf = *(const LAS bf16x8*)(vT + (16 * dt + lr) * WS + 32 * ks + 8 * lg); const bf16x8 wf = *(const LAS bf16x8*)(Wb + t * WS + 32 * ks + 8 * lg);
              acc = __builtin_amdgcn_mfma_f32_16x16x32_bf16(vf, wf, acc, 0, 0, 0); } }
          const int d0 = g * 64 + 16 * dt + 4 * lg; const uint2 cw = cwv[n];
          uint2 o; o.x = cvt_pk_bf16(geluf_(bflo(cw.x)) * (acc[0] + bs), geluf_(bfhi(cw.x)) * (acc[1] + bs)); o.y = cvt_pk_bf16(geluf_(bflo(cw.y)) * (acc[2] + bs), geluf_(bfhi(cw.y)) * (acc[3] + bs));
          *(uint2*)((bf16_t*)(a.ws + OFF_MIXA) + (size_t)(r0 + t) * 1536 + 1280 + d0) = o; } }
    __syncthreads();
}
__device__ void cmlp_item(CArgs& a, int l, int it, unsigned char* lds) { if ((it >> 2) < 128) cmlp_item_t<true>(a, l, it, lds); else cmlp_item_t<false>(a, l, it, lds); }
__device__ void phase_mix(CArgs& a, int l, unsigned char* lds, int rep) {
    unsigned* ctr = (unsigned*)(a.ws + OFF_CTL) + 16 * (l + 1) + 128 * rep; LAS unsigned* slot = (LAS unsigned*)(lds + LDS_MAIN + 16);
    for (;;) {
        __syncthreads();
        { int t0 = threadIdx.x; asm volatile("" : "+v"(t0)); if (t0 == 0) *slot = atomicAdd(ctr, 1u); }
        __syncthreads();
        const int it = (int)*slot;
        if (it >= 576 + NTILE + 640) break;
        if (it < 576) { attn_item(a, it, lds); if (PROBE_MIX & 1) { __syncthreads(); attn_item(a, it, lds); } }
        else if (it < 576 + NTILE) { hgrn_out_tile(a, l, it - 576, lds); if (PROBE_MIX & 2) { __syncthreads(); hgrn_out_tile(a, l, it - 576, lds); } }
        else { cmlp_item(a, l, it - 576 - NTILE, lds); if (PROBE_MIX & 4) { __syncthreads(); cmlp_item(a, l, it - 576 - NTILE, lds); } }
    }
}
__global__ void __launch_bounds__(512) mk_fwd(Args a_) {
    extern __shared__ __attribute__((aligned(16))) unsigned char lds[];
    if (threadIdx.x < 16) ((LAS unsigned*)(lds + LDS_MAIN))[threadIdx.x] = 0u;
    __syncthreads();
    XcdBarrier bar = xcd_barrier_post((unsigned*)(a_.ws + OFF_CTL) + 1024, (volatile LAS unsigned*)(lds + LDS_MAIN));
    const int ph_lo = a_.ph_lo, ph_hi = a_.ph_hi;
    for (int ph = ph_lo; ph < ph_hi; ++ph) {
        CArgs* ap = (CArgs*)__builtin_amdgcn_kernarg_segment_ptr(); asm volatile("" : "+s"(ap)); CArgs& a = *ap;
        unsigned char* ws = a.ws;
        if (ph == 0) { phase_init(a, lds); if ((PROBE_DUP >> 12) & 1) { __syncthreads(); phase_init(a, lds); } }
        else { const int l = (ph - 1) / 12, p = (ph - 1) % 12; const float* ng = a.in[5] + (size_t)l * 6 * 1024;
            bf16_t* H = (bf16_t*)(ws + OFF_H); bf16_t* ACT = (bf16_t*)(ws + OFF_ACT); bf16_t* D = (bf16_t*)(ws + OFF_D); bf16_t* D1 = (bf16_t*)(ws + ((p == 7 || p == 8) ? OFF_ACT : OFF_MIXA));   float* RS = (float*)(ws + OFF_X);
            const int reps = ((PROBE_DUP >> p) & 1) ? 2 : 1;
            for (int rep = 0; rep < reps; ++rep) {
            if (rep) __syncthreads();
            switch (p) {
            case 0: case 9: { const int f = p == 0 ? 0 : 1; EpiSwiGLU E{ACT}; run_gemm(lds, H, (const bf16_t*)(ws + OFF_WGU) + (size_t)(l * 2 + f) * 5632 * 1024, MT, 5632, 1024, E);
                if (p == 0 && !rep) phase_cache(a, l, lds); } break;
            case 1: case 10: { const int f = p == 1 ? 0 : 1; EpiBf E{D, 1024, D1}; run_gemm(lds, ACT, (const bf16_t*)(ws + OFF_WDN) + (size_t)(l * 2 + f) * 1024 * 2816, MT, 1024, 2816, E, 11); } break;
            case 2: ew_phase<false, false>(D, D1, 11, H, nullptr, nullptr, ng + 1024, 0.5f, ng + 2048, H, ng, RS); break;
            case 3: { EpiBf E{(bf16_t*)(ws + OFF_Z), ZW, nullptr}; run_gemm(lds, H, (const bf16_t*)(ws + OFF_WIN) + (size_t)l * 2304 * 1024, MT, 2304, 1024, E); } break;
            case 4: phase_prep(a, l, lds, rep); break;
            case 5: { phase_scan(a, l); EpiQ E{(bf16_t*)(ws + OFF_Q)}; run_gemm(lds, (const bf16_t*)(ws + OFF_QN), (const bf16_t*)(ws + OFF_WQ) + (size_t)l * 1280 * 384, MT, 1280, 384, E); } break;
            case 6: phase_mix(a, l, lds, rep); break;
            case 7: { EpiBf E{D, 1024, D1}; run_gemm(lds, (const bf16_t*)(ws + OFF_MIXA), (const bf16_t*)(ws + OFF_WMIX) + (size_t)l * 1024 * 1536, MT, 1024, 1536, E, 6); } break;
            case 8: ew_phase<false, false>(D, D1, 6, H, nullptr, nullptr, ng + 3 * 1024, 1.0f, ng + 4 * 1024, H, ng + 2048, RS); break;
            case 11: if (l == 0) ew_phase<false, false>(D, D1, 11, H, nullptr, nullptr, ng + 5 * 1024, 0.5f, ng + 6 * 1024, H, ng + 4 * 1024, RS); else ew_phase<false, true>(D, D1, 11, H, nullptr, a.out + O_Y, ng + 5 * 1024, 0.5f, nullptr, nullptr, ng + 4 * 1024, RS); break;
            }
            }
            tail_wtasks(a, ph, lds);
        }
        if (ph + 1 < ph_hi) {
            if (ph_lo < 0) { __threadfence(); cg::this_grid().sync(); }
            xcd_barrier(bar); }
    }
}

extern "C" void kernel_launch(void* const* d_in, const int* in_sizes, int n_in, void* d_out, int out_size, void* d_ws, size_t ws_size, hipStream_t stream) {
    static int grid = 0;
    if (grid == 0) {
        if (n_in != 21 || ws_size < WS_END) { fprintf(stderr, "kernel_launch: bad inputs n_in %d ws %zu need %zu\n", n_in, ws_size, (size_t)WS_END); grid = -1; return; }
        int dev = 0, cus = 0, per_cu = 0;
        hipGetDevice(&dev); hipDeviceGetAttribute(&cus, hipDeviceAttributeMultiprocessorCount, dev);
        if (hipFuncSetAttribute((const void*)mk_fwd, hipFuncAttributeMaxDynamicSharedMemorySize, LDS_BYTES) != hipSuccess) { fprintf(stderr, "hipFuncSetAttribute failed\n"); grid = -1; return; }
        if (hipOccupancyMaxActiveBlocksPerMultiprocessor(&per_cu, (const void*)mk_fwd, 512, LDS_BYTES) != hipSuccess || per_cu < 1) per_cu = 1;
        (void)hipGetLastError();
        grid = cus * 1;
    }
    if (grid < 0) return;
    if (hipMemsetAsync((char*)d_ws + OFF_CTL, 0, SZ_CTL, stream) != hipSuccess) { fprintf(stderr, "memset failed\n"); return; }
    Args a{};
    for (int i = 0; i < 21; ++i) a.in[i] = (const float*)d_in[i];
    a.out = (float*)d_out; a.ws = (unsigned char*)d_ws;
#if ONE_LAUNCH
    a.ph_lo = 0; a.ph_hi = NPHASE;
    void* args[] = {&a};
    hipError_t e = hipLaunchCooperativeKernel((const void*)mk_fwd, dim3(grid), dim3(512), args, LDS_BYTES, stream);
    if (e != hipSuccess) fprintf(stderr, "cooperative launch failed: %s (grid %d)\n", hipGetErrorString(e), grid);
#else
    for (int ph = 0; ph < NPHASE; ++ph) { a.ph_lo = ph; a.ph_hi = ph + 1; hipLaunchKernelGGL(mk_fwd, dim3(grid), dim3(512), LDS_BYTES, stream, a); }
#endif
}
```

```cpp
#include <hip/hip_runtime.h>
#include <hip/hip_cooperative_groups.h>
#include <cstdio>
namespace cg = cooperative_groups;
#ifndef ONE_LAUNCH
#define ONE_LAUNCH 1
#endif
#ifndef PROBE_DUP
#define PROBE_DUP 0
#endif
#ifndef PROBE_MIX
#define PROBE_MIX 0
#endif
namespace pg8 {
#define PG8_LAS __attribute__((address_space(3)))
typedef unsigned short bf16_t;
typedef short bf16x8 __attribute__((ext_vector_type(8)));
typedef float f32x4 __attribute__((ext_vector_type(4)));
typedef unsigned u32x4 __attribute__((ext_vector_type(4)));
constexpr int BM = 256, BK = 64, HALF = 128, HTB = HALF * BK * 2  , STAGE_BYTES = 8 * HTB, NXCD = 8, WGM = 8;

__host__ __device__ __forceinline__ int lds_byte(int r, int c) { const int st = (r >> 4) * 2 + (c >> 5), rr = r & 15, cc = c & 31, ob = rr * 64 + cc * 2; return st * 1024 + (ob ^ (((ob >> 9) & 1) << 5)); }
__host__ __device__ __forceinline__ void stage_rc(int b, int& R, int& C) { const int st = b / 1024, sb = b % 1024, swz = sb ^ (((sb >> 9) & 1) << 5); R = (st >> 1) * 16 + swz / 64; C = (st & 1) * 32 + (swz % 64) / 2; }
__host__ __device__ __forceinline__ int perm32(int rho) { const int n = rho >> 4, i = rho & 15; return 8 * (i >> 2) + 4 * n + (i & 3); }

struct Unit { int pm, pn, ks, nt, koff; };
struct Gemm { const bf16_t* A; const bf16_t* Bt; int M, N, K, ld; };

struct StaticOrder {
    int nM, nN, nwg, G, c, nN0, unt, ukb;
    __host__ __device__ void init(int M, int N, int G_, int c_, int nsplit = 1) { nM = M / BM; nN0 = N / BM; nN = nN0 * nsplit; nwg = nM * nN; G = G_; c = c_; }
    __host__ __device__ bool next(int i, Unit& u) const {
        const long L = (long)i * G + c; if (L >= nwg) return false;
        int wgid = (int)L; { const int q = nwg / NXCD, r = nwg % NXCD, xcd = wgid % NXCD, off = wgid / NXCD; wgid = (xcd < r ? xcd * (q + 1) : r * (q + 1) + (xcd - r) * q) + off; }
        const int nig = WGM * nN, gid = wgid / nig, fm = gid * WGM, gsz = (nM - fm) < WGM ? (nM - fm) : WGM;
        u.pm = fm + ((wgid % nig) % gsz); const int pn = (wgid % nig) / gsz; u.ks = pn / nN0; u.pn = pn - u.ks * nN0; u.nt = unt; u.koff = u.ks * ukb; return true;
    }
    __device__ __forceinline__ void a_ready(const Unit&) const {}
    __device__ __forceinline__ void done(const Unit&) const {}
};
__device__ __forceinline__ unsigned cvt_pk_bf16(float lo, float hi) { unsigned r; asm volatile("v_cvt_pk_bf16_f32 %0, %1, %2" : "=v"(r) : "v"(lo), "v"(hi)); return r; }
typedef float f32x2 __attribute__((ext_vector_type(2)));
template <class Epi, class Sched, bool STAMP = false>
__device__ __forceinline__ void gemm_phase(PG8_LAS unsigned char* lds, const Gemm g, const Sched& S, const Epi& E, unsigned long long* stamps) {
    int tid = threadIdx.x; asm volatile("" : "+v"(tid)); const int wid = __builtin_amdgcn_readfirstlane(tid >> 6), lane = tid & 63, wr = wid >> 2, wc = wid & 3, fr = lane & 15, fq = lane >> 4;
    const int K = g.ld;
    int ts_lo = 0, ts_hi = 0, nts = 0; const unsigned long long rt_entry = STAMP ? (unsigned long long)wall_clock64() : 0ull;
#define PG8_STAMP() do { if (STAMP && wid == 0 && nts < 64) { const unsigned long long _c = (unsigned long long)clock64(); \
        ts_lo = (lane == nts) ? (int)(unsigned)_c : ts_lo; ts_hi = (lane == nts) ? (int)(unsigned)(_c >> 32) : ts_hi; ++nts; } } while (0)
    PG8_STAMP();
    unsigned voffA[2], voffB[2];
#pragma unroll
    for (int i = 0; i < 2; ++i) { int R, C; stage_rc(tid * 16 + i * 8192, R, C); const int Rb = Epi::PERM ? ((R & ~31) + perm32(R & 31)) : R;
        voffA[i] = (unsigned)(R * K + C) * 2u; voffB[i] = (unsigned)(Rb * K + C) * 2u; }
    const size_t kstep = (size_t)(BK * 2);
    const size_t hstep = (size_t)HALF * K * 2;
    const size_t tstep = 2 * hstep;
    const unsigned ldsw = (unsigned)wid * 1024u;
    const int aoff = lds_byte(wr * 64 + fr, fq * 8), boff = lds_byte(wc * 32 + fr, fq * 8);
#define PG8_SA(b, h) (((b) * 2 + (h)) * HTB)
#define PG8_SB(b, h) ((4 + (b) * 2 + (h)) * HTB)
#define PG8_STAGE(bufoff, gbase, voff) do { _Pragma("unroll") for (int _i = 0; _i < 2; ++_i) \
        __builtin_amdgcn_global_load_lds((const unsigned*)((const char*)(gbase) + (voff)[_i]), (PG8_LAS unsigned*)(lds + (bufoff) + ldsw + _i * 8192), 16, 0, 0); } while (0)
#define PG8_LDA(dst, b, h) do { _Pragma("unroll") for (int m = 0; m < 4; ++m) _Pragma("unroll") for (int k = 0; k < 2; ++k) dst[m][k] = *(const PG8_LAS bf16x8*)(lds + PG8_SA(b, h) + aoff + m * 2048 + k * 1024); } while (0)
#define PG8_LDB(dst, b, h) do { _Pragma("unroll") for (int n = 0; n < 2; ++n) _Pragma("unroll") for (int k = 0; k < 2; ++k) dst[n][k] = *(const PG8_LAS bf16x8*)(lds + PG8_SB(b, h) + boff + n * 2048 + k * 1024); } while (0)
#define PG8_MMA(ai, bj, At, Bt) do { __builtin_amdgcn_s_setprio(1); _Pragma("unroll") for (int m = 0; m < 4; ++m) _Pragma("unroll") for (int n = 0; n < 2; ++n) _Pragma("unroll") for (int k = 0; k < 2; ++k) \
        acc[ai][bj][m][n] = __builtin_amdgcn_mfma_f32_16x16x32_bf16(Bt[n][k], At[m][k], acc[ai][bj][m][n], 0, 0, 0); __builtin_amdgcn_s_setprio(0); } while (0)
#define PG8_WAIT_V(n) asm volatile("s_waitcnt vmcnt(" #n ")" ::: "memory")
#define PG8_WAIT_L(n) asm volatile("s_waitcnt lgkmcnt(" #n ")" ::: "memory")
#define PG8_BAR __builtin_amdgcn_s_barrier()
#define PG8_SCHED __builtin_amdgcn_sched_barrier(0)
    Unit cur, nxt; int ui = 0;
    if (!S.next(0, cur)) return;
    f32x4 acc[2][2][4][2];
#pragma unroll
    for (int a = 0; a < 2; ++a)
#pragma unroll
        for (int b = 0; b < 2; ++b)
#pragma unroll
            for (int m = 0; m < 4; ++m)
#pragma unroll
                for (int n = 0; n < 2; ++n) acc[a][b][m][n] = (f32x4){0.f, 0.f, 0.f, 0.f};
    bf16x8 At[4][2], B0[2][2], B1[2][2];
    const char* cA = (const char*)g.A + (size_t)cur.pm * tstep + (size_t)cur.koff; const char* cB = (const char*)g.Bt + (size_t)cur.pn * tstep + (size_t)cur.koff;
    S.a_ready(cur);
    PG8_STAGE(PG8_SB(0, 0), cB, voffB); PG8_STAGE(PG8_SA(0, 0), cA, voffA); PG8_STAGE(PG8_SB(0, 1), cB + hstep, voffB); PG8_STAGE(PG8_SA(0, 1), cA + hstep, voffA);
    if (wr == 1) PG8_BAR;
    PG8_WAIT_V(4); PG8_BAR;
    PG8_STAGE(PG8_SB(1, 0), cB + kstep, voffB); PG8_STAGE(PG8_SA(1, 0), cA + kstep, voffA); PG8_STAGE(PG8_SB(1, 1), cB + hstep + kstep, voffB);
    PG8_WAIT_V(6); PG8_BAR;
    PG8_STAMP();
    for (;;) {
        const bool has_next = S.next(ui + 1, nxt);
        const char* nA = has_next ? (const char*)g.A + (size_t)nxt.pm * tstep + (size_t)nxt.koff : cA; const char* nB = has_next ? (const char*)g.Bt + (size_t)nxt.pn * tstep + (size_t)nxt.koff : cB;
        const int nt = cur.nt;
        for (int t = 0; t < nt; t += 2) {
            const bool last = (t == nt - 2);
            const char* a1 = cA + (size_t)(t + 1) * kstep;
            const char* a2 = last ? nA : cA + (size_t)(t + 2) * kstep; const char* b2 = last ? nB : cB + (size_t)(t + 2) * kstep;
            const char* a3 = a2 + kstep; const char* b3 = b2 + kstep;
            if (last && has_next) S.a_ready(nxt);
            PG8_LDB(B0, 0, 0); PG8_SCHED; PG8_LDA(At, 0, 0); PG8_STAGE(PG8_SA(1, 1), a1 + hstep, voffA);
            PG8_WAIT_L(8); PG8_BAR; PG8_WAIT_L(0); PG8_MMA(0, 0, At, B0); PG8_BAR; PG8_SCHED;
            PG8_LDB(B1, 0, 1); PG8_STAGE(PG8_SB(0, 0), b2, voffB);
            PG8_BAR; PG8_WAIT_L(0); PG8_MMA(0, 1, At, B1); PG8_BAR;
            PG8_LDA(At, 0, 1); PG8_STAGE(PG8_SA(0, 0), a2, voffA);
            PG8_BAR; PG8_WAIT_L(0); PG8_MMA(1, 0, At, B0); PG8_BAR; PG8_SCHED;
            PG8_STAGE(PG8_SB(0, 1), b2 + hstep, voffB);
            PG8_WAIT_V(6); PG8_BAR; PG8_MMA(1, 1, At, B1); PG8_BAR;
            PG8_LDB(B0, 1, 0); PG8_SCHED; PG8_LDA(At, 1, 0); PG8_STAGE(PG8_SA(0, 1), a2 + hstep, voffA);
            PG8_WAIT_L(8); PG8_BAR; PG8_WAIT_L(0); PG8_MMA(0, 0, At, B0); PG8_BAR; PG8_SCHED;
            PG8_LDB(B1, 1, 1); PG8_STAGE(PG8_SB(1, 0), b3, voffB);
            PG8_BAR; PG8_WAIT_L(0); PG8_MMA(0, 1, At, B1); PG8_BAR;
            PG8_LDA(At, 1, 1); PG8_STAGE(PG8_SA(1, 0), a3, voffA);
            PG8_BAR; PG8_WAIT_L(0); PG8_MMA(1, 0, At, B0); PG8_BAR; PG8_SCHED;
            PG8_STAGE(PG8_SB(1, 1), b3 + hstep, voffB);
            PG8_WAIT_V(6); PG8_BAR; PG8_MMA(1, 1, At, B1); PG8_BAR;
        }
        PG8_STAMP();
        if constexpr (!Epi::AFTER_DRAIN) { E(acc, cur, wr, wc, fr, fq); S.done(cur); }
        PG8_STAMP();
        if (!has_next) break;
#pragma unroll
        for (int a = 0; a < 2; ++a)
#pragma unroll
            for (int b = 0; b < 2; ++b)
#pragma unroll
                for (int m = 0; m < 4; ++m)
#pragma unroll
                    for (int n = 0; n < 2; ++n) acc[a][b][m][n] = (f32x4){0.f, 0.f, 0.f, 0.f};
        cur = nxt; cA = nA; cB = nB; ++ui;
    }
    PG8_WAIT_V(0);
    if (wr == 0) PG8_BAR;
    PG8_BAR;
    if constexpr (Epi::AFTER_DRAIN) { E.fused(acc, cur, wr, wc, fr, fq, lds, wid, lane); S.done(cur); }
    PG8_STAMP();
    if (STAMP && wid == 0) { stamps[lane] = lane < nts ? (((unsigned long long)(unsigned)ts_hi << 32) | (unsigned)ts_lo) : 0ull;
        if (lane == 62) stamps[62] = rt_entry; if (lane == 63) stamps[63] = (unsigned long long)wall_clock64(); }
#undef PG8_STAMP
#undef PG8_SA
#undef PG8_SB
#undef PG8_STAGE
#undef PG8_LDA
#undef PG8_LDB
#undef PG8_MMA
#undef PG8_WAIT_V
#undef PG8_WAIT_L
#undef PG8_BAR
#undef PG8_SCHED
}
}
using pg8::bf16_t; using pg8::bf16x8; using pg8::f32x4; using pg8::u32x4; using pg8::Unit; using pg8::cvt_pk_bf16;
#define LAS __attribute__((address_space(3)))
typedef unsigned u32x2 __attribute__((ext_vector_type(2)));

constexpr int DM = 1024, DFF = 2816, MP = 16384, MS = 2048, MT = 18432, INWP = 2304, ZW = 2304;
constexpr int NTILE = 288;
constexpr float EPS = 1e-6f;
constexpr float QSCALE = 0.07216878364870322f * 1.4426950408889634f;
constexpr int ZQ = 0, ZKV = 384, ZPE = 640, ZHQ = 704, ZHF = 960, ZHI = 1216, ZHG = 1472, ZCU = 1728, ZCV = 1984;
constexpr size_t SZ_WGU = 4ull * 5632 * 1024 * 2, SZ_WDN = 4ull * 1024 * 2816 * 2, SZ_WIN = 2ull * 2304 * 1024 * 2, SZ_WQ = 2ull * 1280 * 384 * 2, SZ_WMIX = 2ull * 1024 * 1536 * 2;
constexpr size_t SKEW = 69888;
constexpr size_t OFF_WGU = 0, OFF_WDN = OFF_WGU + SZ_WGU + SKEW, OFF_WIN = OFF_WDN + SZ_WDN + SKEW, OFF_WQ = OFF_WIN + SZ_WIN + SKEW, OFF_WMIX = OFF_WQ + SZ_WQ + SKEW;
constexpr size_t OFF_X = OFF_WMIX + SZ_WMIX + SKEW, SZ_X = (size_t)MT * 1024 * 4;
constexpr size_t OFF_D = OFF_X + SZ_X + SKEW, SZ_D = (size_t)MT * 1024 * 2;
constexpr size_t OFF_H = OFF_D + SZ_D + SKEW, SZ_H = (size_t)MT * 1024 * 2;
constexpr size_t OFF_ACT = OFF_H + SZ_H + SKEW, SZ_ACT = (size_t)MT * 2816 * 2;
constexpr size_t KROWS = 16384 + 32 * 2112;
constexpr size_t OFF_KC = OFF_ACT + SZ_ACT + SKEW, SZ_KC = KROWS * 640;
constexpr size_t OFF_CT = OFF_KC + SZ_KC + SKEW, SZ_CT = KROWS * 512;
constexpr size_t OFF_MIXA = OFF_CT + SZ_CT + SKEW, SZ_MIXA = (size_t)MT * 1536 * 2;
constexpr size_t OFF_SST = OFF_MIXA + SZ_MIXA + SKEW, SZ_SST = 1024ull * 4096 * 4;
constexpr size_t OFF_ROPE = OFF_SST + SZ_SST + SKEW, SZ_ROPE = 4096ull * 32 * 8;
constexpr size_t OFF_CTL = OFF_ROPE + SZ_ROPE + SKEW, SZ_CTL = 32768;
constexpr size_t OFF_BCUM = OFF_CTL + SZ_CTL + SKEW, SZ_BCUM = (size_t)MT * 256 * 4;
constexpr size_t WS_END = OFF_BCUM + SZ_BCUM;
constexpr size_t OFF_Z = OFF_ACT, SZ_Z = (size_t)MT * ZW * 2;
constexpr size_t OFF_QN = OFF_Z + SZ_Z + SKEW;
constexpr size_t OFF_Q = OFF_X + 1048576 + SKEW;
constexpr size_t OFF_U = OFF_Q + (size_t)MT * 1280 * 2 + SKEW;
constexpr size_t OFF_DEC = OFF_U + 1152ull * 4096 * 4;
static_assert(OFF_QN + (size_t)MT * 384 * 2 <= OFF_ACT + SZ_ACT, "z/qn overlay");
static_assert(OFF_DEC + 1152ull * 64 * 4 <= OFF_X + SZ_X, "Q/U overlay");
constexpr size_t O_Y = 0, O_CKVP = 18874368, O_KPEP = 27262976, O_HGP = 29360128, O_CKVS = 29491200, O_KPES = 30539776, O_HGS = 30801920, O_CMV = 31850496;

constexpr int LDS_MAIN = 157696, LDS_BYTES = LDS_MAIN + 64;
constexpr int NPHASE = 25;

struct Args { const float* in[21]; float* out; unsigned char* ws; int ph_lo, ph_hi; };
typedef const __attribute__((address_space(4))) Args CArgs;

__device__ __forceinline__ int bid_() { int b = blockIdx.x; asm volatile("" : "+s"(b)); return b; }
__device__ __forceinline__ int gdim_() { int g = gridDim.x; asm volatile("" : "+s"(g)); return g; }
__device__ __forceinline__ float bf2f(unsigned short b) { return __uint_as_float(((unsigned)b) << 16); }
__device__ __forceinline__ float bflo(unsigned w) { return __uint_as_float(w << 16); }
__device__ __forceinline__ float bfhi(unsigned w) { return __uint_as_float(w & 0xffff0000u); }
__device__ __forceinline__ unsigned short f2bf(float f) { unsigned u = __float_as_uint(f); u += 0x7FFFu + ((u >> 16) & 1u); return (unsigned short)(u >> 16); }
__device__ __forceinline__ float wave_sum(float v) {
#pragma unroll
    for (int o = 32; o >= 1; o >>= 1) v += __shfl_xor(v, o);
    return v; }
__device__ __forceinline__ float sigmoidf_(float x) { return __builtin_amdgcn_rcpf(1.0f + __expf(-x)); }
__device__ __forceinline__ float siluf_(float x) { return x * sigmoidf_(x); }
__device__ __forceinline__ float geluf_(float x) { const float y = 0.7978845608028654f * (x + 0.044715f * x * x * x); return x - x * __builtin_amdgcn_rcpf(__expf(2.0f * y) + 1.0f); }

struct EpiBf {
    static constexpr bool PERM = true, AFTER_DRAIN = false;
    bf16_t* O; int ldc; bf16_t* O1;
    __device__ __forceinline__ void operator()(const f32x4 (&acc)[2][2][4][2], const Unit& u, int wr, int wc, int fr, int fq) const {
        const int row0 = u.pm * 256 + wr * 64 + fr, col0 = u.pn * 256 + wc * 32 + 8 * fq; bf16_t* Ob = (O1 && u.ks >= 0) ? O1 + ((long)u.ks * MS - MP) * (long)ldc : O;
#pragma unroll
        for (int ai = 0; ai < 2; ++ai)
#pragma unroll
            for (int m = 0; m < 4; ++m) { bf16_t* rowp = Ob + (size_t)(row0 + ai * 128 + m * 16) * ldc + col0;
#pragma unroll
                for (int bj = 0; bj < 2; ++bj) { const f32x4 v0 = acc[ai][bj][m][0], v1 = acc[ai][bj][m][1];
                    u32x4 w; w.x = cvt_pk_bf16(v0[0], v0[1]); w.y = cvt_pk_bf16(v0[2], v0[3]); w.z = cvt_pk_bf16(v1[0], v1[1]); w.w = cvt_pk_bf16(v1[2], v1[3]);
                    *(u32x4*)(rowp + bj * 128) = w; } }
    }
};
struct EpiSwiGLU {
    static constexpr bool PERM = true, AFTER_DRAIN = false;
    bf16_t* O;
    __device__ __forceinline__ void operator()(const f32x4 (&acc)[2][2][4][2], const Unit& u, int wr, int wc, int fr, int fq) const {
        const int row0 = u.pm * 256 + wr * 64 + fr, col0 = u.pn * 128 + wc * 32 + 8 * fq;
#pragma unroll
        for (int ai = 0; ai < 2; ++ai)
#pragma unroll
            for (int m = 0; m < 4; ++m) { bf16_t* rowp = O + (size_t)(row0 + ai * 128 + m * 16) * DFF + col0;
                const f32x4 g0 = acc[ai][0][m][0], g1 = acc[ai][0][m][1], u0 = acc[ai][1][m][0], u1 = acc[ai][1][m][1];
                u32x4 w; w.x = cvt_pk_bf16(siluf_(g0[0]) * u0[0], siluf_(g0[1]) * u0[1]); w.y = cvt_pk_bf16(siluf_(g0[2]) * u0[2], siluf_(g0[3]) * u0[3]);
                w.z = cvt_pk_bf16(siluf_(g1[0]) * u1[0], siluf_(g1[1]) * u1[1]); w.w = cvt_pk_bf16(siluf_(g1[2]) * u1[2], siluf_(g1[3]) * u1[3]);
                *(u32x4*)rowp = w; }
    }
};
struct EpiQ {
    static constexpr bool PERM = true, AFTER_DRAIN = false;
    bf16_t* Q;
    __device__ __forceinline__ void operator()(const f32x4 (&acc)[2][2][4][2], const Unit& u, int wr, int wc, int fr, int fq) const {
        const int row0 = u.pm * 256 + wr * 64 + fr;
        const int off0 = u.pn < 4 ? u.pn * 320 + wc * 32 + 8 * fq : wc * 320 + 256 + 8 * fq, bjs = u.pn < 4 ? 128 : 32;
#pragma unroll
        for (int ai = 0; ai < 2; ++ai)
#pragma unroll
            for (int m = 0; m < 4; ++m) { bf16_t* rowp = Q + (size_t)(row0 + ai * 128 + m * 16) * 1280 + off0;
#pragma unroll
                for (int bj = 0; bj < 2; ++bj) { const f32x4 v0 = acc[ai][bj][m][0], v1 = acc[ai][bj][m][1];
                    u32x4 w; w.x = cvt_pk_bf16(v0[0], v0[1]); w.y = cvt_pk_bf16(v0[2], v0[3]); w.z = cvt_pk_bf16(v1[0], v1[1]); w.w = cvt_pk_bf16(v1[2], v1[3]);
                    *(u32x4*)(rowp + bj * bjs) = w; } }
    }
};
struct TailSplitOrder {
    int G, c, nsp, nt_full, nt_sub, kb_sub;
    __device__ bool next(int i, Unit& u) const {
        const int L = i * G + c;
        if (L < 256) { const int off = L >> 3; u.pm = (L & 7) * 8 + (off >> 2); u.pn = off & 3; u.ks = -1; u.nt = nt_full; u.koff = 0; return true; }
        const int s2 = L - 256; if (s2 >= 32 * nsp) return false;
        const int pair = s2 & 31; u.pm = 64 + (pair >> 2); u.pn = pair & 3; u.ks = s2 >> 5; u.nt = nt_sub; u.koff = u.ks * kb_sub; return true;
    }
    __device__ __forceinline__ void a_ready(const Unit&) const {}
    __device__ __forceinline__ void done(const Unit&) const {}
};
template <class Epi> __device__ __forceinline__ void run_gemm(unsigned char* lds, const bf16_t* A, const bf16_t* Bt, int M, int N, int K, const Epi& E, int nsp = 0  ) {
    pg8::Gemm g{A, Bt, M, N, K, K};
    if (nsp) { TailSplitOrder S; S.G = gdim_(); S.c = bid_(); S.nsp = nsp; S.nt_full = K / 64; S.nt_sub = K / nsp / 64; S.kb_sub = K / nsp * 2; pg8::gemm_phase<Epi, TailSplitOrder, false>((PG8_LAS unsigned char*)lds, g, S, E, nullptr); }
    else { pg8::StaticOrder S; S.init(M, N, gdim_(), bid_(), 1); S.unt = K / 64; S.ukb = K * 2; pg8::gemm_phase<Epi, pg8::StaticOrder, false>((PG8_LAS unsigned char*)lds, g, S, E, nullptr); }
}
#define GAS __attribute__((address_space(1)))
#define XB_TMO      128
#define XB_XCNT(j)  (256  + 64 * (j))
#define XB_XSUB(j)  (1280 + 64 * (j))
#define XB_XGEN(j)  (2304 + 64 * (j))
#define XB_TOP      3328
#define XB_TOPGEN   3392
#define XCD_BAR_WORDS 3456
#define XB_SPIN_CAP (1u << 18)

__device__ __forceinline__ unsigned xb_ld(unsigned* p)              { return __hip_atomic_load(p, __ATOMIC_RELAXED, __HIP_MEMORY_SCOPE_AGENT); }
__device__ __forceinline__ unsigned xb_add(unsigned* p, unsigned v) { return __hip_atomic_fetch_add(p, v, __ATOMIC_RELAXED, __HIP_MEMORY_SCOPE_AGENT); }
__device__ __forceinline__ unsigned xb_xcc_id() { return (unsigned)__builtin_amdgcn_s_getreg((3 << 11) | 20) & 0xFu; }
#define XB_SPIN(cond, bar) do { unsigned _sp = 0; while (cond) { __builtin_amdgcn_s_sleep(1); \
    if ((++_sp & 255u) == 0u) { if (xb_ld(&(bar)[XB_TMO])) break; if (_sp > XB_SPIN_CAP) { atomicAdd(&(bar)[XB_TMO], 1u); break; } } } } while (0)

struct XcdBarrier {
    unsigned* bar; unsigned x;
    volatile LAS unsigned* st;
};

__device__ __forceinline__ XcdBarrier xcd_barrier_post(unsigned* bar, volatile LAS unsigned* st) {
    XcdBarrier b; b.bar = bar; b.x = xb_xcc_id(); b.st = st;
    if (threadIdx.x == 0) (void)xb_add(&bar[XB_XCNT(b.x)], 1u);
    return b;
}
__device__ __forceinline__ void xcd_barrier_complete(unsigned* bar, unsigned x, unsigned& nloc, unsigned& nx) {
    const unsigned G = gridDim.x * gridDim.y * gridDim.z;
    unsigned sum, cnt, mine, sp = 0u;
    for (;;) {
        sum = 0u; cnt = 0u; mine = 0u;
#pragma unroll
        for (unsigned j = 0; j < 16; ++j) { const unsigned c = xb_ld(&bar[XB_XCNT(j)]); sum += c; cnt += (c > 0u) ? 1u : 0u; mine = (j == x) ? c : mine; }
        if (sum == G) break;
        __builtin_amdgcn_s_sleep(1);
        if ((++sp & 255u) == 0u) { if (xb_ld(&bar[XB_TMO])) break; if (sp > XB_SPIN_CAP) { atomicAdd(&bar[XB_TMO], 1u); break; } }
    }
    nloc = mine > 0u ? mine : 1u; nx = cnt > 0u ? cnt : 1u;
}

__device__ __forceinline__ void xcd_barrier(const XcdBarrier& b) {
    asm volatile("s_waitcnt vmcnt(0)" ::: "memory");
    __syncthreads();
    if (threadIdx.x == 0) {
        unsigned* bar = b.bar; asm volatile("" : "+s"(bar));
        __builtin_amdgcn_s_waitcnt(0);
        unsigned nloc = b.st[0], nx = b.st[1];
        if (nloc == 0u) { xcd_barrier_complete(bar, b.x, nloc, nx); b.st[0] = nloc; b.st[1] = nx; }
        const unsigned old = xb_add(&bar[XB_XSUB(b.x)], 1u);
        const unsigned gen = old / nloc;
        if (old + 1u == (gen + 1u) * nloc) {
            __builtin_amdgcn_fence(__ATOMIC_RELEASE, "agent");
            asm volatile("s_waitcnt vmcnt(0)" ::: "memory");
            const unsigned og = xb_add(&bar[XB_TOP], 1u);
            const unsigned tg = og / nx;
            if (og + 1u == (tg + 1u) * nx) xb_add(&bar[XB_TOPGEN], 1u);
            else XB_SPIN(xb_ld(&bar[XB_TOPGEN]) == tg, bar);
            __builtin_amdgcn_fence(__ATOMIC_ACQUIRE, "agent");
            xb_add(&bar[XB_XGEN(b.x)], 1u);
            asm volatile("s_waitcnt vmcnt(0)" ::: "memory");
        } else {
            XB_SPIN(xb_ld(&bar[XB_XGEN(b.x)]) == gen, bar);
            __builtin_amdgcn_fence(__ATOMIC_ACQUIRE, "agent");
            asm volatile("s_waitcnt vmcnt(0)" ::: "memory");
        }
    }
    __syncthreads();
}
__device__ __forceinline__ void tr_tile(const float* __restrict__ src, int srcN, bf16_t* __restrict__ dst, int dstK, int k0, int n0, int mode, float* T) {
    int tid = threadIdx.x; asm volatile("" : "+v"(tid));
    float4 v[4];
#pragma unroll
    for (int e = 0; e < 4; ++e) { const int idx = tid + 512 * e, kk = idx >> 4, n4 = idx & 15; { const f32x4 q4 = __builtin_nontemporal_load((const f32x4*)(src + (size_t)(k0 + kk) * srcN + n0 + 4 * n4)); v[e] = make_float4(q4[0], q4[1], q4[2], q4[3]); } }
#pragma unroll
    for (int e = 0; e < 4; ++e) { const int idx = tid + 512 * e, kk = idx >> 4, n4 = idx & 15; float* t = T + kk * 65 + 4 * n4; t[0] = v[e].x; t[1] = v[e].y; t[2] = v[e].z; t[3] = v[e].w; }
    __syncthreads();
#pragma unroll
    for (int e = 0; e < 2; ++e) { const int idx = tid + 512 * e, nn = idx >> 4, kq = idx & 15; const int n = n0 + nn;
        const int row = mode == 0 ? n : ((n >> 7) * 256 + (n & 127) + (mode == 2 ? 128 : 0)); const float* t = T + (8 * kq) * 65 + nn;
        u32x4 w; w.x = cvt_pk_bf16(t[0], t[65]); w.y = cvt_pk_bf16(t[130], t[195]); w.z = cvt_pk_bf16(t[260], t[325]); w.w = cvt_pk_bf16(t[390], t[455]);
        *(u32x4*)(dst + (size_t)row * dstK + k0 + 8 * kq) = w; }
    __syncthreads();
}
__device__ __forceinline__ void tr_task(const float* src, int srcN, int K, bf16_t* dst, int dstK, int mode, float* T) {
    const int tn = srcN >> 6, nt = (K >> 7) * tn;
    for (int t = bid_(); t < nt; t += gdim_()) tr_tile(src, srcN, dst, dstK, (t / tn) * 128, (t % tn) * 64, mode, T);
}
template <bool XIN_F32, bool XOUT_F32>
__device__ __forceinline__ void ew_phase(const bf16_t* __restrict__ D, const bf16_t* D1  , int nsp, const void* xa  , const float* __restrict__ xb  , void* xout  ,
                                         const float* __restrict__ gpost, float coef, const float* __restrict__ gpre, bf16_t* hout, const float* __restrict__ gin, float* rsb  ) {
    int tid = threadIdx.x; asm volatile("" : "+v"(tid)); const int lane = tid & 63, wave = tid >> 6;
    const int rstep = gdim_() * 8;
    for (int rb = bid_() * 8 + wave; rb < MT; rb += 2 * rstep) {
        float4 xv[2][4]; float dv[2][4][4];
#pragma unroll
        for (int u = 0; u < 2; ++u) { const int r = rb + u * rstep; if (r < MT) {
            if (XIN_F32) { const float* xr = (xb && r >= MP) ? xb + (size_t)(r - MP) * DM : (const float*)xa + (size_t)r * DM;
#pragma unroll
                for (int i = 0; i < 4; ++i) { const f32x4 q4 = __builtin_nontemporal_load((const f32x4*)(xr + lane * 4 + 256 * i)); xv[u][i] = make_float4(q4[0], q4[1], q4[2], q4[3]); } }
            else {
#pragma unroll
                for (int i = 0; i < 4; ++i) { const u32x2 w = __builtin_nontemporal_load((const u32x2*)((const bf16_t*)xa + (size_t)r * DM + lane * 4 + 256 * i)); xv[u][i] = make_float4(bflo(w.x), bfhi(w.x), bflo(w.y), bfhi(w.y)); }
                const float ir = __builtin_amdgcn_rcpf(rsb[r]);
#pragma unroll
                for (int i = 0; i < 4; ++i) { const float4 gi = *(const float4*)(gin + lane * 4 + 256 * i);
                    xv[u][i].x *= ir * __builtin_amdgcn_rcpf(gi.x); xv[u][i].y *= ir * __builtin_amdgcn_rcpf(gi.y); xv[u][i].z *= ir * __builtin_amdgcn_rcpf(gi.z); xv[u][i].w *= ir * __builtin_amdgcn_rcpf(gi.w); } }
            if (D) {
#pragma unroll
                for (int i = 0; i < 4; ++i) { const u32x2 w = __builtin_nontemporal_load((const u32x2*)(D + (size_t)r * DM + lane * 4 + 256 * i)); dv[u][i][0] = bflo(w.x); dv[u][i][1] = bfhi(w.x); dv[u][i][2] = bflo(w.y); dv[u][i][3] = bfhi(w.y);
                    } } } }
        if (D1) {
#pragma unroll
            for (int u = 0; u < 2; ++u) { const int r = rb + u * rstep; if (r >= MP && r < MT) {
#pragma unroll
                for (int i = 0; i < 4; ++i) { dv[u][i][0] = 0.f; dv[u][i][1] = 0.f; dv[u][i][2] = 0.f; dv[u][i][3] = 0.f; }
                for (int ks = 0; ks < nsp; ++ks) {
#pragma unroll
                    for (int i = 0; i < 4; ++i) { const u32x2 w1 = __builtin_nontemporal_load((const u32x2*)(D1 + ((size_t)ks * MS + (r - MP)) * DM + lane * 4 + 256 * i)); dv[u][i][0] += bflo(w1.x); dv[u][i][1] += bfhi(w1.x); dv[u][i][2] += bflo(w1.y); dv[u][i][3] += bfhi(w1.y); } } } } }
#pragma unroll
        for (int u = 0; u < 2; ++u) { const int r = rb + u * rstep; if (r < MT) {
            if (D) { float ss = 0.f;
#pragma unroll
                for (int i = 0; i < 4; ++i) ss += dv[u][i][0] * dv[u][i][0] + dv[u][i][1] * dv[u][i][1] + dv[u][i][2] * dv[u][i][2] + dv[u][i][3] * dv[u][i][3];
                ss = wave_sum(ss); const float rs = coef * rsqrtf(ss * (1.0f / 1024.0f) + EPS);
#pragma unroll
                for (int i = 0; i < 4; ++i) { const float4 g = *(const float4*)(gpost + lane * 4 + 256 * i);
                    xv[u][i].x += dv[u][i][0] * rs * g.x; xv[u][i].y += dv[u][i][1] * rs * g.y; xv[u][i].z += dv[u][i][2] * rs * g.z; xv[u][i].w += dv[u][i][3] * rs * g.w; } }
            if (XOUT_F32) {
#pragma unroll
                for (int i = 0; i < 4; ++i) __builtin_nontemporal_store((f32x4){xv[u][i].x, xv[u][i].y, xv[u][i].z, xv[u][i].w}, (f32x4*)((float*)xout + (size_t)r * DM + lane * 4 + 256 * i)); }

            if (hout) { float ss = 0.f;
#pragma unroll
                for (int i = 0; i < 4; ++i) ss += xv[u][i].x * xv[u][i].x + xv[u][i].y * xv[u][i].y + xv[u][i].z * xv[u][i].z + xv[u][i].w * xv[u][i].w;
                ss = wave_sum(ss); const float rs = rsqrtf(ss * (1.0f / 1024.0f) + EPS); if (lane == 0) rsb[r] = rs;
#pragma unroll
                for (int i = 0; i < 4; ++i) { const float4 g = *(const float4*)(gpre + lane * 4 + 256 * i); uint2 w;
                    w.x = cvt_pk_bf16(xv[u][i].x * rs * g.x, xv[u][i].y * rs * g.y); w.y = cvt_pk_bf16(xv[u][i].z * rs * g.z, xv[u][i].w * rs * g.w);
                    *(uint2*)(hout + (size_t)r * DM + lane * 4 + 256 * i) = w; } } } }
    }
}
__device__ __forceinline__ int wtask_count(int kind) { return kind < 6 ? 352 : kind == 6 ? 281 : kind == 7 ? 64 : kind == 8 ? 256 : kind == 9 ? 96 : 192; }
__device__ void wtask_run(CArgs& a, int l, int kind, int t, unsigned char* lds) {
    unsigned char* ws = a.ws; float* T = (float*)lds; int tid = threadIdx.x; asm volatile("" : "+v"(tid));
    if (kind < 6) { const int f = kind / 3, m = kind % 3; const size_t lf = (size_t)(l * 2 + f);
        if (m < 2) tr_tile(a.in[6 + m] + lf * 1024 * 2816, 2816, (bf16_t*)(ws + OFF_WGU) + lf * 5632 * 1024, 1024, (t / 44) * 128, (t % 44) * 64, 1 + m, T);
        else tr_tile(a.in[8] + lf * 2816 * 1024, 1024, (bf16_t*)(ws + OFF_WDN) + lf * 1024 * 2816, 2816, (t / 16) * 128, (t % 16) * 64, 0, T);
    } else if (kind == 6) { bf16_t* win = (bf16_t*)(ws + OFF_WIN) + (size_t)l * 2304 * 1024;
        if (t < 280) tr_tile(a.in[9] + (size_t)l * 1024 * 2240, 2240, win, 1024, (t / 35) * 128, (t % 35) * 64, 0, T);
        else { for (int i = tid; i < 64 * 1024 / 2; i += 512) ((unsigned*)(win + 2240 * 1024))[i] = 0u; }
    } else if (kind == 7) { bf16_t* wmix = (bf16_t*)(ws + OFF_WMIX) + (size_t)l * 1024 * 1536;
        tr_tile(a.in[10] + (size_t)l * 1024 * 1024 + 512 * 1024, 1024, wmix + 1024, 1536, (t / 16) * 128, (t % 16) * 64, 0, T);
    } else if (kind == 8) {
        bf16_t* wmix = (bf16_t*)(ws + OFF_WMIX) + (size_t)l * 1024 * 1536; const float* wuv = a.in[15] + (size_t)l * 256 * 512; const float* wo = a.in[10] + (size_t)l * 1024 * 1024;
        const int i = t * 512 + tid; const int n = i & 1023, hcb = t >> 1, h = hcb >> 5, cb = hcb & 31;
        float* W = T;
        __syncthreads();
#pragma unroll
        for (int e = 0; e < 2; ++e) { const int q = tid + 512 * e, j = q >> 7, v = q & 127; W[v * 8 + j] = wuv[((8 * cb + j) * 4 + h) * 128 + v]; }
        __syncthreads();
        const float* bv = wo + (size_t)(h * 128) * 1024 + n; float acc[8];
#pragma unroll
        for (int j = 0; j < 8; ++j) acc[j] = 0.f;
#pragma unroll 1
        for (int v0 = 0; v0 < 128; v0 += 16) { float bb[16];
#pragma unroll
            for (int u = 0; u < 16; ++u) bb[u] = bv[(size_t)(v0 + u) * 1024];
#pragma unroll
            for (int u = 0; u < 16; ++u) { const float4 w0 = *(const float4*)(W + (v0 + u) * 8), w1 = *(const float4*)(W + (v0 + u) * 8 + 4);
                acc[0] += w0.x * bb[u]; acc[1] += w0.y * bb[u]; acc[2] += w0.z * bb[u]; acc[3] += w0.w * bb[u]; acc[4] += w1.x * bb[u]; acc[5] += w1.y * bb[u]; acc[6] += w1.z * bb[u]; acc[7] += w1.w * bb[u]; } }
        u32x4 w; w.x = cvt_pk_bf16(acc[0], acc[1]); w.y = cvt_pk_bf16(acc[2], acc[3]); w.z = cvt_pk_bf16(acc[4], acc[5]); w.w = cvt_pk_bf16(acc[6], acc[7]);
        *(u32x4*)(wmix + (size_t)n * 1536 + h * 256 + 8 * cb) = w;
        __syncthreads();
    } else { bf16_t* wq = (bf16_t*)(ws + OFF_WQ) + (size_t)l * 1280 * 384; const float* wuk = a.in[14] + (size_t)l * 256 * 512; const float* wqb = a.in[12] + (size_t)l * 384 * 768;
        const int i = t * 512 + tid;
        if (kind == 9) {
            const int k = i % 384, hcb = i / 384, h = hcb >> 5, cb = hcb & 31;
            const float4* bv = (const float4*)(wqb + (size_t)k * 768 + h * 192); float acc[8];
#pragma unroll
            for (int j = 0; j < 8; ++j) acc[j] = 0.f;
#pragma unroll 2
            for (int v = 0; v < 32; ++v) { const float4 y = bv[v];
#pragma unroll
                for (int j = 0; j < 8; ++j) { const float4 x = *(const float4*)(wuk + ((8 * cb + j) * 4 + h) * 128 + 4 * v); acc[j] += x.x * y.x + x.y * y.y + x.z * y.z + x.w * y.w; } }
#pragma unroll
            for (int j = 0; j < 8; ++j) wq[(size_t)(h * 256 + 8 * cb + j) * 384 + k] = f2bf(acc[j] * QSCALE);
        } else {
            const int k = i % 384, j = i / 384, half = j >> 7, jj = j & 127, h = jj >> 5, fi = jj & 31;
            wq[(size_t)(1024 + j) * 384 + k] = f2bf(wqb[(size_t)k * 768 + h * 192 + 128 + half * 32 + fi] * QSCALE); }
    }
}
__device__ void wtasks(CArgs& a, int l, int k0, int k1, int cw, unsigned char* lds) {
    unsigned* ctr = (unsigned*)(a.ws + OFF_CTL) + cw; LAS unsigned* slot = (LAS unsigned*)(lds + LDS_MAIN + 16);
    int total = 0; for (int k = k0; k < k1; ++k) total += wtask_count(k);
    for (;;) {
        __syncthreads();
        { int t0 = threadIdx.x; asm volatile("" : "+v"(t0)); if (t0 == 0) *slot = atomicAdd(ctr, 1u); }
        __syncthreads();
        int it = (int)*slot;
        if (it >= total) break;
        int k = k0; while (it >= wtask_count(k)) { it -= wtask_count(k); ++k; }
        wtask_run(a, l, k, it, lds);
    }
}
__device__ void phase_init(CArgs& a, unsigned char* lds) {
    unsigned char* ws = a.ws;
    int tid = threadIdx.x; asm volatile("" : "+v"(tid)); const size_t gtid = (size_t)bid_() * 512 + tid, gsz = (size_t)gdim_() * 512;
    for (size_t i = gtid; i < 4096 * 32; i += gsz) { const int pos = (int)(i >> 5), fi = (int)(i & 31);
        const float w = exp2f(-(float)fi * (13.287712379549449f / 32.0f)); const double ang = (double)((float)pos * w);
        const double k = rint(ang * 0.15915494309189535); const float rr = (float)(ang - k * 6.283185307179586);
        ((float2*)(ws + OFF_ROPE))[i] = make_float2(__cosf(rr), __sinf(rr)); }
    wtasks(a, 0, 0, 3, 256, lds); wtasks(a, 0, 6, 7, 272, lds);
    ew_phase<true, false>(nullptr, nullptr, 0, a.in[0], a.in[1], nullptr, nullptr, 0.f, a.in[5], (bf16_t*)(ws + OFF_H), nullptr, (float*)(ws + OFF_X));
}
__device__ void tail_wtasks(CArgs& a, int ph, unsigned char* lds) {
    switch (ph) {
    case 1:  wtasks(a, 0, 10, 11, 257, lds); wtasks(a, 0, 7, 8, 258, lds); break;
    case 2:  wtasks(a, 0, 3, 4, 259, lds); break;
    case 4:  wtasks(a, 0, 9, 10, 260, lds); wtasks(a, 0, 4, 5, 261, lds); break;
    case 6:  wtasks(a, 0, 8, 9, 262, lds); break;
    case 8:  wtasks(a, 0, 5, 6, 263, lds); break;
    case 10: wtasks(a, 1, 0, 3, 264, lds); wtasks(a, 1, 6, 7, 265, lds); wtasks(a, 1, 9, 10, 266, lds); break;
    case 11: wtasks(a, 1, 10, 11, 267, lds); wtasks(a, 1, 7, 8, 268, lds); break;
    case 14: wtasks(a, 1, 3, 4, 269, lds); break;
    case 16: wtasks(a, 1, 4, 6, 270, lds); break;
    case 18: wtasks(a, 1, 8, 9, 271, lds); break;
    default: break; }
}
__device__ __forceinline__ int keyof32(int p) { const int g = p >> 3, j = p & 7; return j < 4 ? 4 * g + j : 16 + 4 * g + (j - 4); }
__device__ __forceinline__ void ct_write(const bf16_t* ctile, bf16_t* dst  , size_t rowstride) {
    int tid = threadIdx.x; asm volatile("" : "+v"(tid)); const int c = tid >> 1, half = tid & 1;
    unsigned w[16];
#pragma unroll
    for (int p = 0; p < 32; p += 2) { const int t0 = 32 * half + keyof32(p), t1 = 32 * half + keyof32(p + 1);
        w[p >> 1] = (unsigned)ctile[t0 * 264 + c] | ((unsigned)ctile[t1 * 264 + c] << 16); }
    uint4* d = (uint4*)(dst + (size_t)c * rowstride + 32 * half);
#pragma unroll
    for (int i = 0; i < 4; ++i) d[i] = make_uint4(w[4 * i], w[4 * i + 1], w[4 * i + 2], w[4 * i + 3]);
}
__device__ __forceinline__ float lb_of(CArgs& a, int l, int e) { if (l == 0) return 0.f; const float a0 = a.in[16][e], a1 = a.in[16][256 + e]; return 1.0f / (1.0f + __expf(a0 - a1)); }
__device__ void prep_mla_tile(CArgs& a, int l, int T, unsigned char* lds) {
    unsigned char* ws = a.ws; int tid = threadIdx.x; asm volatile("" : "+v"(tid)); const int lane = tid & 63, wave = tid >> 6;
    const bf16_t* z = (const bf16_t*)(ws + OFF_Z); const int r0 = T * 64;
    const bool prm = T < 256; const int b = prm ? (T >> 6) : (T - 256), j = prm ? (T & 63) : 0; const int pos0 = prm ? j * 64 : 2048;
    bf16_t* kc = (bf16_t*)(ws + OFF_KC) + (prm ? (size_t)(b * 4096 + j * 64) : (size_t)16384 + (size_t)b * 2112 + 2048) * 320;
    bf16_t* ct = (bf16_t*)(ws + OFF_CT) + (prm ? (size_t)b * 256 * 4096 + j * 64 : (size_t)16384 * 256 + (size_t)b * 256 * 2112 + 2048);
    const size_t ctstride = prm ? 4096 : 2112;
    float* ockv = a.out + (prm ? O_CKVP + ((size_t)(l * 4 + b) * 4096 + j * 64) * 256 : O_CKVS + ((size_t)(l * 32 + b) * 64) * 256);
    float* okpe = a.out + (prm ? O_KPEP + ((size_t)(l * 4 + b) * 4096 + j * 64) * 64 : O_KPES + ((size_t)(l * 32 + b) * 64) * 64);
    bf16_t* qn = (bf16_t*)(ws + OFF_QN); const float* qag = a.in[11] + l * 384; const float* kvg = a.in[13] + l * 256;
    const float2* rope = (const float2*)(ws + OFF_ROPE);
    bf16_t* ctile = (bf16_t*)lds;
    float qg[6];
#pragma unroll
    for (int i = 0; i < 3; ++i) { qg[2 * i] = qag[2 * lane + 128 * i]; qg[2 * i + 1] = qag[2 * lane + 128 * i + 1]; }
    const float4 g4 = *(const float4*)(kvg + 4 * lane);
#pragma unroll 1
    for (int tb = 0; tb < 8; tb += 4) {
        unsigned wq[4][3]; uint2 wk[4]; bf16_t p1[4], p2[4];
#pragma unroll
        for (int u = 0; u < 4; ++u) { const bf16_t* zr = z + (size_t)(r0 + wave + 8 * (tb + u)) * ZW;
#pragma unroll
            for (int i = 0; i < 3; ++i) wq[u][i] = __builtin_nontemporal_load((const unsigned*)(zr + ZQ + 2 * lane + 128 * i));
            { const u32x2 q2 = __builtin_nontemporal_load((const u32x2*)(zr + ZKV + 4 * lane)); wk[u] = make_uint2(q2.x, q2.y); } p1[u] = __builtin_nontemporal_load(zr + ZPE + (lane & 31)); p2[u] = __builtin_nontemporal_load(zr + ZPE + 32 + (lane & 31)); }
#pragma unroll
        for (int u = 0; u < 4; ++u) { const int t = wave + 8 * (tb + u);
            { float v[6]; float ss = 0.f;
#pragma unroll
              for (int i = 0; i < 3; ++i) { v[2 * i] = bflo(wq[u][i]); v[2 * i + 1] = bfhi(wq[u][i]); ss += v[2 * i] * v[2 * i] + v[2 * i + 1] * v[2 * i + 1]; }
              ss = wave_sum(ss); const float rs = rsqrtf(ss * (1.0f / 384.0f) + EPS);
#pragma unroll
              for (int i = 0; i < 3; ++i) *(unsigned*)(qn + (size_t)(r0 + t) * 384 + 2 * lane + 128 * i) = cvt_pk_bf16(v[2 * i] * rs * qg[2 * i], v[2 * i + 1] * rs * qg[2 * i + 1]); }
            { float v0 = bflo(wk[u].x), v1 = bfhi(wk[u].x), v2 = bflo(wk[u].y), v3 = bfhi(wk[u].y);
              const float ss = wave_sum(v0 * v0 + v1 * v1 + v2 * v2 + v3 * v3); const float rs = rsqrtf(ss * (1.0f / 256.0f) + EPS);
              v0 *= rs * g4.x; v1 *= rs * g4.y; v2 *= rs * g4.z; v3 *= rs * g4.w;
              __builtin_nontemporal_store((f32x4){v0, v1, v2, v3}, (f32x4*)(ockv + (size_t)t * 256 + 4 * lane));
              uint2 o; o.x = cvt_pk_bf16(v0, v1); o.y = cvt_pk_bf16(v2, v3);
              *(uint2*)(kc + (size_t)t * 320 + 4 * lane) = o; *(uint2*)(ctile + t * 264 + 4 * lane) = o; }
            if (lane < 32) { const float x1 = bf2f(p1[u]), x2 = bf2f(p2[u]); const float2 cs = rope[(pos0 + t) * 32 + lane];
              const float o1 = x1 * cs.x - x2 * cs.y, o2 = x2 * cs.x + x1 * cs.y;
              __builtin_nontemporal_store(o1, okpe + (size_t)t * 64 + lane); __builtin_nontemporal_store(o2, okpe + (size_t)t * 64 + 32 + lane); kc[(size_t)t * 320 + 256 + lane] = f2bf(o1); kc[(size_t)t * 320 + 288 + lane] = f2bf(o2); } }
    }
    __syncthreads();
    ct_write(ctile, ct, ctstride);
    __syncthreads();
}
__device__ void prep_hgrn_tile(CArgs& a, int l, int T, unsigned char* lds) {
    unsigned char* ws = a.ws; int tid = threadIdx.x; asm volatile("" : "+v"(tid)); asm volatile("" : "+s"(l));
    const bf16_t* z = (const bf16_t*)(ws + OFF_Z); const int r0 = T * 64;
    float* lf = (float*)lds; float* vt = (float*)(lds + 65536); float* tot = (float*)(lds + 131072);
    const int ep = tid & 255, hf = tid >> 8; const float lbv = lb_of(a, l, ep);
    bf16_t zfr[32]; float pref[32];
    { bf16_t zvr[32];
#pragma unroll
      for (int i = 0; i < 32; ++i) { const bf16_t* zr = z + (size_t)(r0 + 32 * hf + i) * ZW; zfr[i] = zr[ZHF + ep]; zvr[i] = zr[ZHI + ep]; }
      float run = 0.f;
#pragma unroll
      for (int i = 0; i < 32; ++i) { const float f = lbv + (1.0f - lbv) * sigmoidf_(bf2f(zfr[i])); run += __logf(fmaxf(f, 1e-30f)); pref[i] = run; vt[(32 * hf + i) * 256 + ep] = bf2f(zvr[i]); }
      tot[hf * 256 + ep] = run; }
    __syncthreads();
    { const float t0 = tot[ep], bl = t0 + tot[256 + ep], off = hf ? t0 : 0.f;
#pragma unroll
      for (int i = 0; i < 32; ++i) { lf[(32 * hf + i) * 256 + ep] = (1.0f - lbv) * sigmoidf_(-bf2f(zfr[i])) * __expf(bl - pref[i] - off); ((float*)(ws + OFF_BCUM))[(size_t)(r0 + 32 * hf + i) * 256 + ep] = pref[i] + off; }
      if (hf == 0) ((float*)(ws + OFF_DEC))[T * 256 + ep] = __expf(bl); }
    __syncthreads();
    { const int h = tid >> 7, eb = (tid & 127) >> 3, db = tid & 7; float acc[4][8];
#pragma unroll
      for (int i = 0; i < 4; ++i)
#pragma unroll
          for (int jj = 0; jj < 8; ++jj) acc[i][jj] = 0.f;
#pragma unroll 4
      for (int s = 0; s < 64; ++s) { const float4 kv = *(const float4*)(lf + s * 256 + h * 64 + eb * 4); const float4 v0 = *(const float4*)(vt + s * 256 + h * 64 + db * 8), v1 = *(const float4*)(vt + s * 256 + h * 64 + db * 8 + 4);
          const float kk[4] = {kv.x, kv.y, kv.z, kv.w}; const float vv[8] = {v0.x, v0.y, v0.z, v0.w, v1.x, v1.y, v1.z, v1.w};
#pragma unroll
          for (int i = 0; i < 4; ++i)
#pragma unroll
              for (int jj = 0; jj < 8; ++jj) acc[i][jj] += kk[i] * vv[jj]; }
      float* U = (float*)(ws + OFF_U) + (size_t)(T * 4 + h) * 4096;
#pragma unroll
      for (int i = 0; i < 4; ++i) { *(float4*)(U + (eb * 4 + i) * 64 + db * 8) = make_float4(acc[i][0], acc[i][1], acc[i][2], acc[i][3]); *(float4*)(U + (eb * 4 + i) * 64 + db * 8 + 4) = make_float4(acc[i][4], acc[i][5], acc[i][6], acc[i][7]); } }
    __syncthreads();
}
__device__ void prep_cache_tile(CArgs& a, int l, int P, unsigned char* lds) {
    unsigned char* ws = a.ws; int tid = threadIdx.x; asm volatile("" : "+v"(tid)); const int b = P >> 5, kt = P & 31;
    const float* ckv = a.in[2] + ((size_t)(l * 32 + b) * 2048 + kt * 64) * 256; const float* kpe = a.in[3] + ((size_t)(l * 32 + b) * 2048 + kt * 64) * 64;
    bf16_t* kc = (bf16_t*)(ws + OFF_KC) + ((size_t)16384 + (size_t)b * 2112 + kt * 64) * 320;
    bf16_t* ct = (bf16_t*)(ws + OFF_CT) + (size_t)16384 * 256 + (size_t)b * 256 * 2112 + kt * 64;
    bf16_t* ctile = (bf16_t*)lds;
#pragma unroll
    for (int i = 0; i < 8; ++i) { const int q = tid + 512 * i, t = q >> 6, c4 = q & 63; const f32x4 q4 = __builtin_nontemporal_load((const f32x4*)(ckv + (size_t)t * 256 + c4 * 4)); const float4 v = make_float4(q4[0], q4[1], q4[2], q4[3]);
        uint2 o; o.x = cvt_pk_bf16(v.x, v.y); o.y = cvt_pk_bf16(v.z, v.w); *(uint2*)(kc + (size_t)t * 320 + c4 * 4) = o; *(uint2*)(ctile + t * 264 + c4 * 4) = o; }
#pragma unroll
    for (int i = 0; i < 2; ++i) { const int q = tid + 512 * i, t = q >> 4, c4 = q & 15; const f32x4 q4 = __builtin_nontemporal_load((const f32x4*)(kpe + (size_t)t * 64 + c4 * 4)); const float4 v = make_float4(q4[0], q4[1], q4[2], q4[3]);
        uint2 o; o.x = cvt_pk_bf16(v.x, v.y); o.y = cvt_pk_bf16(v.z, v.w); *(uint2*)(kc + (size_t)t * 320 + 256 + c4 * 4) = o; }
    __syncthreads();
    ct_write(ctile, ct, 2112);
    __syncthreads();
}
__device__ void phase_prep(CArgs& a, int l, unsigned char* lds, int rep = 0) {
    unsigned* ctr = (unsigned*)(a.ws + OFF_CTL) + 16 * (l + 1) + 8 + 128 * rep; LAS unsigned* slot = (LAS unsigned*)(lds + LDS_MAIN + 16);
    for (;;) {
        __syncthreads();
        { int t0 = threadIdx.x; asm volatile("" : "+v"(t0)); if (t0 == 0) *slot = atomicAdd(ctr, 1u); }
        __syncthreads();
        const int it = (int)*slot;
        if (it >= 2 * NTILE) break;
        if (it < NTILE) prep_hgrn_tile(a, l, it, lds); else prep_mla_tile(a, l, it - NTILE, lds);
    }
}
__device__ void phase_cache(CArgs& a, int l, unsigned char* lds) {
    unsigned* ctr = (unsigned*)(a.ws + OFF_CTL) + 16 * (l + 1) + 12; LAS unsigned* slot = (LAS unsigned*)(lds + LDS_MAIN + 16);
    for (;;) {
        __syncthreads();
        { int t0 = threadIdx.x; asm volatile("" : "+v"(t0)); if (t0 == 0) *slot = atomicAdd(ctr, 1u); }
        __syncthreads();
        const int it = (int)*slot;
        if (it >= 1024) break;
        prep_cache_tile(a, l, it, lds);
    }
}
__device__ void phase_scan(CArgs& a, int l) {
    unsigned char* ws = a.ws; int tid = threadIdx.x; asm volatile("" : "+v"(tid)); const size_t gtid = (size_t)bid_() * 512 + tid, gsz = (size_t)gdim_() * 512;
    const float* U = (const float*)(ws + OFF_U); const float* dec = (const float*)(ws + OFF_DEC); float* sst = (float*)(ws + OFF_SST);
    for (size_t i = gtid; i < 16 * 4096; i += gsz) { const int bh = (int)(i >> 12), ed = (int)(i & 4095), b = bh >> 2, h = bh & 3, e = ed >> 6; float S = 0.f;
#pragma unroll 16
        for (int j = 0; j < 64; ++j) { const size_t ch = (size_t)((b * 64 + j) * 4 + h); sst[ch * 4096 + ed] = S; S = dec[ch * 64 + e] * S + __builtin_nontemporal_load(U + ch * 4096 + ed); }
        __builtin_nontemporal_store(S, a.out + O_HGP + (size_t)(l * 16 + bh) * 4096 + ed); }
    for (size_t i = gtid; i < 128 * 4096; i += gsz) { const int bh = (int)(i >> 12), ed = (int)(i & 4095), b = bh >> 2, h = bh & 3, e = ed >> 6; const size_t ch = (size_t)((256 + b) * 4 + h);
        const float S0 = a.in[4][(size_t)(l * 128 + bh) * 4096 + ed];
        __builtin_nontemporal_store(dec[ch * 64 + e] * S0 + __builtin_nontemporal_load(U + ch * 4096 + ed), a.out + O_HGS + (size_t)(l * 128 + bh) * 4096 + ed); }
}
constexpr int KSTR = 656, VSTR = 144, VOFF = 64 * KSTR, ABUF = VOFF + 256 * VSTR;
__device__ __forceinline__ int swz16(int row) { return (((row & 15) + 4) >> 3) & 1; }
__device__ void attn_item(CArgs& a, int idx, unsigned char* ldsg) {
    unsigned char* ws = a.ws; LAS unsigned char* lds = (LAS unsigned char*)ldsg;
    int tid = threadIdx.x; asm volatile("" : "+v"(tid)); const int lane = tid & 63, wave = __builtin_amdgcn_readfirstlane(tid >> 6), lr = lane & 15, g = lane >> 4;
    const int gx = (g ^ swz16(lr)) * 16;
    int b, hp, nkt, r0; const unsigned char* kcb; const unsigned char* ctb; int ctstride;
    if (idx >= 256 && idx < 320) { const int s = idx - 256; b = s >> 1; hp = s & 1; nkt = 33; r0 = MP + b * 64;
        kcb = ws + OFF_KC + ((size_t)16384 + (size_t)b * 2112) * 640; ctb = ws + OFF_CT + ((size_t)16384 * 256 + (size_t)b * 256 * 2112) * 2; ctstride = 4224; }
    else { const int k = idx < 256 ? idx : idx - 64; const int j = 63 - (k >> 3), sub = k & 7; b = sub >> 1; hp = sub & 1; nkt = j + 1; r0 = b * 4096 + j * 64;
        kcb = ws + OFF_KC + (size_t)b * 4096 * 640; ctb = ws + OFF_CT + (size_t)b * 256 * 4096 * 2; ctstride = 8192; }
    const int head = hp * 2 + (wave >> 2); const int qrow = r0 + (wave & 3) * 16 + lr;
    unsigned ko[6], vo[5];
#pragma unroll
    for (int i = 0; i < 6; ++i) { const int n = i * 512 + tid, row = n / 41, pc = n - row * 41; ko[i] = (unsigned)(row * 640 + (pc < 40 ? (pc ^ swz16(row)) * 16 : 0)); }
#pragma unroll
    for (int i = 0; i < 5; ++i) { const int n = i * 512 + tid, row = n / 9, pc = n - row * 9; vo[i] = (unsigned)(row * ctstride + (pc < 8 ? (pc ^ swz16(row)) * 16 : 0)); }
#define ATT_DMA(kt, bo) do { const unsigned char* kg = kcb + (size_t)(kt) * 40960; const unsigned char* vg = ctb + (size_t)(kt) * 128; \
        _Pragma("unroll") for (int i = 0; i < 6; ++i) if (i < 5 || wave == 0) __builtin_amdgcn_global_load_lds((const unsigned*)(kg + ko[i]), (LAS unsigned*)(lds + (bo) + (i * 512 + wave * 64) * 16), 16, 0, 0); \
        _Pragma("unroll") for (int i = 0; i < 5; ++i) if (i < 4 || wave < 4) __builtin_amdgcn_global_load_lds((const unsigned*)(vg + vo[i]), (LAS unsigned*)(lds + (bo) + VOFF + (i * 512 + wave * 64) * 16), 16, 0, 0); } while (0)
    __syncthreads();
    ATT_DMA(0, 0);
    bf16x8 qf[10];
    { const bf16_t* qp = (const bf16_t*)(ws + OFF_Q) + (size_t)qrow * 1280 + head * 320 + g * 8;
#pragma unroll
      for (int ks = 0; ks < 10; ++ks) qf[ks] = __builtin_nontemporal_load((const bf16x8*)(qp + ks * 32));
      const int pos = qrow < MP ? (qrow & 4095) : 2048 + ((qrow - MP) & 63); const float2* rp = (const float2*)(ws + OFF_ROPE) + pos * 32 + 8 * g;
      u32x4 w1 = __builtin_bit_cast(u32x4, qf[8]), w2 = __builtin_bit_cast(u32x4, qf[9]);
      float4 cs4[4];
#pragma unroll
      for (int jp = 0; jp < 4; ++jp) cs4[jp] = *(const float4*)(rp + 2 * jp);
#pragma unroll
      for (int jp = 0; jp < 4; ++jp) { const float a1 = bflo(w1[jp]), b1 = bfhi(w1[jp]), a2 = bflo(w2[jp]), b2 = bfhi(w2[jp]);
          w1[jp] = cvt_pk_bf16(a1 * cs4[jp].x - a2 * cs4[jp].y, b1 * cs4[jp].z - b2 * cs4[jp].w); w2[jp] = cvt_pk_bf16(a2 * cs4[jp].x + a1 * cs4[jp].y, b2 * cs4[jp].z + b1 * cs4[jp].w); }
      qf[8] = __builtin_bit_cast(bf16x8, w1); qf[9] = __builtin_bit_cast(bf16x8, w2); }
    f32x4 o[16];
#pragma unroll
    for (int i = 0; i < 16; ++i) o[i] = (f32x4){0.f, 0.f, 0.f, 0.f};
    float mrun = -1e30f, lsum = 0.f;
    asm volatile("s_waitcnt vmcnt(0)" ::: "memory");
    __syncthreads();
    const int koff = lr * KSTR + gx, voff = VOFF + lr * VSTR + gx;
    for (int kt = 0; kt < nkt; ++kt) {
        const int bo = (kt & 1) * ABUF;
        if (kt + 1 < nkt) ATT_DMA(kt + 1, ABUF - bo);
        const LAS unsigned char* kb = lds + bo + koff; const LAS unsigned char* vb = lds + bo + voff;
        f32x4 s[4];
#pragma unroll
        for (int i = 0; i < 4; ++i) s[i] = (f32x4){0.f, 0.f, 0.f, 0.f};
        bf16x8 kf[2][4];
#pragma unroll
        for (int k4 = 0; k4 < 4; ++k4) kf[0][k4] = *(const LAS bf16x8*)(kb + k4 * 16 * KSTR);
#pragma unroll
        for (int ks = 0; ks < 10; ++ks) {
            if (ks < 9) {
#pragma unroll
                for (int k4 = 0; k4 < 4; ++k4) kf[(ks + 1) & 1][k4] = *(const LAS bf16x8*)(kb + k4 * 16 * KSTR + (ks + 1) * 64); }
            __builtin_amdgcn_sched_barrier(0);
#pragma unroll
            for (int k4 = 0; k4 < 4; ++k4) s[k4] = __builtin_amdgcn_mfma_f32_16x16x32_bf16(kf[ks & 1][k4], qf[ks], s[k4], 0, 0, 0);
            __builtin_amdgcn_sched_barrier(0);
        }
        bf16x8 vf[2][4];
#pragma unroll
        for (int q4 = 0; q4 < 4; ++q4) vf[0][q4] = *(const LAS bf16x8*)(vb + (q4 >> 1) * 16 * VSTR + (q4 & 1) * 64);
        __builtin_amdgcn_sched_barrier(0);
        float mx = s[0][0];
#pragma unroll
        for (int k4 = 0; k4 < 4; ++k4)
#pragma unroll
            for (int i = 0; i < 4; ++i) mx = fmaxf(mx, s[k4][i]);
        mx = fmaxf(mx, __shfl_xor(mx, 16)); mx = fmaxf(mx, __shfl_xor(mx, 32));
        if (!__all(mx - mrun <= 8.0f)) {
            const float mnew = fmaxf(mrun, mx), alpha = __builtin_amdgcn_exp2f(mrun - mnew); mrun = mnew; lsum *= alpha;
#pragma unroll
            for (int i = 0; i < 16; ++i) o[i] *= alpha; }
        float ps = 0.f;
#pragma unroll
        for (int k4 = 0; k4 < 4; ++k4)
#pragma unroll
            for (int i = 0; i < 4; ++i) { s[k4][i] = __builtin_amdgcn_exp2f(s[k4][i] - mrun); ps += s[k4][i]; }
        lsum += ps;
        bf16x8 pb[2];
#pragma unroll
        for (int s2 = 0; s2 < 2; ++s2) { u32x4 w; w.x = cvt_pk_bf16(s[2 * s2][0], s[2 * s2][1]); w.y = cvt_pk_bf16(s[2 * s2][2], s[2 * s2][3]);
            w.z = cvt_pk_bf16(s[2 * s2 + 1][0], s[2 * s2 + 1][1]); w.w = cvt_pk_bf16(s[2 * s2 + 1][2], s[2 * s2 + 1][3]); pb[s2] = __builtin_bit_cast(bf16x8, w); }
#pragma unroll
        for (int cp = 0; cp < 8; ++cp) {
            if (cp < 7) {
#pragma unroll
                for (int q4 = 0; q4 < 4; ++q4) vf[(cp + 1) & 1][q4] = *(const LAS bf16x8*)(vb + (2 * (cp + 1) + (q4 >> 1)) * 16 * VSTR + (q4 & 1) * 64); }
            __builtin_amdgcn_sched_barrier(0);
#pragma unroll
            for (int q4 = 0; q4 < 4; ++q4) o[2 * cp + (q4 >> 1)] = __builtin_amdgcn_mfma_f32_16x16x32_bf16(vf[cp & 1][q4], pb[q4 & 1], o[2 * cp + (q4 >> 1)], 0, 0, 0);
            __builtin_amdgcn_sched_barrier(0);
        }
        asm volatile("s_waitcnt vmcnt(0)" ::: "memory");
        __syncthreads();
    }
#undef ATT_DMA
    lsum += __shfl_xor(lsum, 16); lsum += __shfl_xor(lsum, 32);
    const float inv = 1.0f / lsum;
    bf16_t* op = (bf16_t*)(ws + OFF_MIXA) + (size_t)qrow * 1536 + head * 256 + 4 * g;
#pragma unroll
    for (int ct = 0; ct < 16; ++ct) { uint2 w; w.x = cvt_pk_bf16(o[ct][0] * inv, o[ct][1] * inv); w.y = cvt_pk_bf16(o[ct][2] * inv, o[ct][3] * inv); *(uint2*)(op + 16 * ct) = w; }
}
constexpr int HS = 72;
constexpr int H_BC = 0, H_QT = 2 * 16640, H_KT = H_QT + 2 * 64 * HS * 2, H_QH = H_KT + 2 * 64 * HS * 2, H_VT = H_QH + 2 * 64 * HS * 2, H_ST = H_VT + 2 * 64 * HS * 2, H_END = H_ST + 2 * 64 * HS * 2;
static_assert(H_END <= LDS_MAIN, "hgrn lds");
__device__ __forceinline__ int posof64(int t) { const int u = t & 31; const int p = u < 16 ? 8 * (u >> 2) + (u & 3) : 8 * ((u - 16) >> 2) + 4 + ((u - 16) & 3); return (t & 32) + p; }
__device__ void hgrn_out_tile(CArgs& a, int l, int T, unsigned char* ldsg) {
    unsigned char* ws = a.ws; int tid = threadIdx.x; asm volatile("" : "+v"(tid)); asm volatile("" : "+s"(l)); const int lane = tid & 63, wave = tid >> 6, lr = lane & 15, g = lane >> 4;
    LAS unsigned char* lds = (LAS unsigned char*)ldsg;
    const bf16_t* z = (const bf16_t*)(ws + OFF_Z); const int r0 = T * 64;
    const int c = tid & 127, hh = c >> 6, e = c & 63, tq = tid >> 7;
    LAS float* bc = (LAS float*)(lds + H_BC) + hh * 4160;
    LAS bf16_t* QT = (LAS bf16_t*)(lds + H_QT) + hh * 64 * HS; LAS bf16_t* KT = (LAS bf16_t*)(lds + H_KT) + hh * 64 * HS; LAS bf16_t* QH = (LAS bf16_t*)(lds + H_QH) + hh * 64 * HS; LAS bf16_t* VT = (LAS bf16_t*)(lds + H_VT) + hh * 64 * HS;
    const float lbv0 = lb_of(a, l, hh * 64 + e), lbv1 = lb_of(a, l, (2 + hh) * 64 + e);
    for (int hp = 0; hp < 2; ++hp) {
        const int h = 2 * hp + hh; const float lbv = hp ? lbv1 : lbv0;
        { const float* bcum = (const float*)(ws + OFF_BCUM) + (size_t)r0 * 256 + h * 64 + e; const float rr = bcum[31 * 256];
          float s0v[16];
#pragma unroll
          for (int i = 0; i < 16; ++i) { const int idx = tid + 512 * i, h2 = idx >> 12, ed = idx & 4095; const int hg = 2 * hp + h2;
              const float* S0 = T < 256 ? (const float*)(ws + OFF_SST) + (size_t)(T * 4 + hg) * 4096 : a.in[4] + (size_t)(l * 128 + (T - 256) * 4 + hg) * 4096;
              s0v[i] = __builtin_nontemporal_load(S0 + ed); }
#pragma unroll 1
          for (int i0 = 0; i0 < 16; i0 += 8) {
          bf16_t zq[8], zf16[8], zv[8]; float bbv[8];
#pragma unroll
          for (int i = 0; i < 8; ++i) { const bf16_t* zr = z + (size_t)(r0 + tq * 16 + i0 + i) * ZW + h * 64 + e; zq[i] = __builtin_nontemporal_load(zr + ZHQ); zf16[i] = __builtin_nontemporal_load(zr + ZHF); zv[i] = __builtin_nontemporal_load(zr + ZHI); bbv[i] = __builtin_nontemporal_load(bcum + (tq * 16 + i0 + i) * 256); }
#pragma unroll
          for (int i = 0; i < 8; ++i) { const int t = tq * 16 + i0 + i; const float bb = bbv[i];
              const float q = bf2f(zq[i]), zf = bf2f(zf16[i]); const float k = (1.0f - lbv) * sigmoidf_(-zf);
              QH[t * HS + e] = f2bf(q * __expf(bb)); QT[t * HS + e] = f2bf(q * __expf(fminf(bb - rr, 80.f))); KT[t * HS + e] = f2bf(k * __expf(fminf(rr - bb, 80.f)));
              VT[e * HS + posof64(t)] = zv[i]; } }
#pragma unroll
          for (int i = 0; i < 16; ++i) { const int idx = tid + 512 * i, h2 = idx >> 12, ed = idx & 4095; ((LAS bf16_t*)(lds + H_ST))[h2 * 64 * HS + (ed & 63) * HS + (ed >> 6)] = f2bf(s0v[i]); } }
        __syncthreads();
        { const int wh = wave >> 2, tb = wave & 3; const int hw = 2 * hp + wh;
          const LAS unsigned char* qt = lds + H_QT + wh * 64 * HS * 2; const LAS unsigned char* kt = lds + H_KT + wh * 64 * HS * 2; const LAS unsigned char* qh = lds + H_QH + wh * 64 * HS * 2;
          const LAS unsigned char* vt = lds + H_VT + wh * 64 * HS * 2; const LAS unsigned char* st = lds + H_ST + wh * 64 * HS * 2;
          const int trow = 16 * tb + lr;
          float4 ogv[4]; uint2 gwv[4];
#pragma unroll
          for (int db = 0; db < 4; ++db) { const int d0 = hw * 64 + 16 * db + 4 * g; ogv[db] = *(const float4*)(a.in[17] + l * 256 + d0); { const u32x2 q2 = __builtin_nontemporal_load((const u32x2*)(z + (size_t)(r0 + trow) * ZW + ZHG + d0)); gwv[db] = make_uint2(q2.x, q2.y); } }
          bf16x8 qtf[2], qhf[2];
#pragma unroll
          for (int ks = 0; ks < 2; ++ks) { qtf[ks] = *(const LAS bf16x8*)(qt + trow * (HS * 2) + (32 * ks + 8 * g) * 2); qhf[ks] = *(const LAS bf16x8*)(qh + trow * (HS * 2) + (32 * ks + 8 * g) * 2); }
          f32x4 aT[4];
#pragma unroll
          for (int sb = 0; sb < 4; ++sb) { aT[sb] = (f32x4){0.f, 0.f, 0.f, 0.f};
#pragma unroll
              for (int ks = 0; ks < 2; ++ks) { const bf16x8 kf = *(const LAS bf16x8*)(kt + (16 * sb + lr) * (HS * 2) + (32 * ks + 8 * g) * 2); aT[sb] = __builtin_amdgcn_mfma_f32_16x16x32_bf16(kf, qtf[ks], aT[sb], 0, 0, 0); }
#pragma unroll
              for (int i = 0; i < 4; ++i) aT[sb][i] = (16 * sb + 4 * g + i <= trow) ? aT[sb][i] : 0.f; }
          bf16x8 pb[2];
#pragma unroll
          for (int s2 = 0; s2 < 2; ++s2) { u32x4 w; w.x = cvt_pk_bf16(aT[2 * s2][0], aT[2 * s2][1]); w.y = cvt_pk_bf16(aT[2 * s2][2], aT[2 * s2][3]);
              w.z = cvt_pk_bf16(aT[2 * s2 + 1][0], aT[2 * s2 + 1][1]); w.w = cvt_pk_bf16(aT[2 * s2 + 1][2], aT[2 * s2 + 1][3]); pb[s2] = __builtin_bit_cast(bf16x8, w); }
          f32x4 o[4]; float ss = 0.f;
#pragma unroll
          for (int db = 0; db < 4; ++db) { o[db] = (f32x4){0.f, 0.f, 0.f, 0.f};
#pragma unroll
              for (int ks = 0; ks < 2; ++ks) { const bf16x8 sf = *(const LAS bf16x8*)(st + (16 * db + lr) * (HS * 2) + (32 * ks + 8 * g) * 2); o[db] = __builtin_amdgcn_mfma_f32_16x16x32_bf16(sf, qhf[ks], o[db], 0, 0, 0); }
#pragma unroll
              for (int s2 = 0; s2 < 2; ++s2) { const bf16x8 vf = *(const LAS bf16x8*)(vt + (16 * db + lr) * (HS * 2) + (32 * s2 + 8 * g) * 2); o[db] = __builtin_amdgcn_mfma_f32_16x16x32_bf16(vf, pb[s2], o[db], 0, 0, 0); }
              ss += o[db][0] * o[db][0] + o[db][1] * o[db][1] + o[db][2] * o[db][2] + o[db][3] * o[db][3]; }
          ss += __shfl_xor(ss, 16); ss += __shfl_xor(ss, 32);
          const float rs = rsqrtf(ss * (1.0f / 64.0f) + EPS);
#pragma unroll
          for (int db = 0; db < 4; ++db) { const int d0 = hw * 64 + 16 * db + 4 * g; const float4 og = ogv[db]; const uint2 gw = gwv[db];
              uint2 w; w.x = cvt_pk_bf16(o[db][0] * rs * og.x * siluf_(bflo(gw.x)), o[db][1] * rs * og.y * siluf_(bfhi(gw.x)));
              w.y = cvt_pk_bf16(o[db][2] * rs * og.z * siluf_(bflo(gw.y)), o[db][3] * rs * og.w * siluf_(bfhi(gw.y)));
              *(uint2*)((bf16_t*)(ws + OFF_MIXA) + (size_t)(r0 + trow) * 1536 + 1024 + d0) = w; } }
        __syncthreads();
    }
}
template <bool PRM> __device__ __forceinline__ void cmlp_item_t(CArgs& a, int l, int it, unsigned char* ldsg) {
    int tid = threadIdx.x; asm volatile("" : "+v"(tid)); asm volatile("" : "+s"(l)); const int lane = tid & 63, wave = tid >> 6, lr = lane & 15, lg = lane >> 4; const int ci = it >> 2, g = it & 3;
    constexpr int L = PRM ? 128 : 64, WS = L + 8;
    const int r0 = PRM ? ci * 128 : MP + (ci - 128) * 64;
    LAS unsigned char* lds = (LAS unsigned char*)ldsg; LAS bf16_t* Wb = (LAS bf16_t*)lds; LAS bf16_t* vT = (LAS bf16_t*)(lds + 128 * 136 * 2);
    const bf16_t* z = (const bf16_t*)(a.ws + OFF_Z); const float* wsrc = a.in[19] + (size_t)(l * 4 + g) * 128 * 128;
    const float vg = a.in[18][l * 256 + g * 64 + lane];
    bf16_t zc[L / 8];
#pragma unroll
    for (int i = 0; i < L / 8; ++i) zc[i] = __builtin_nontemporal_load(z + (size_t)(r0 + wave + 8 * i) * ZW + ZCV + g * 64 + lane);
    { constexpr int NQ = L * L / 4 / 512, SH = PRM ? 5 : 4; float4 wv[NQ];
#pragma unroll
      for (int i = 0; i < NQ; ++i) { const int idx = tid + 512 * i, t = idx >> SH, s4 = idx & ((1 << SH) - 1); wv[i] = *(const float4*)(wsrc + t * 128 + 4 * s4); }
#pragma unroll
      for (int i = 0; i < NQ; ++i) { const int idx = tid + 512 * i, t = idx >> SH, s0 = 4 * (idx & ((1 << SH) - 1));
          u32x2 w; w.x = cvt_pk_bf16(s0 <= t ? wv[i].x : 0.f, s0 + 1 <= t ? wv[i].y : 0.f); w.y = cvt_pk_bf16(s0 + 2 <= t ? wv[i].z : 0.f, s0 + 3 <= t ? wv[i].w : 0.f);
          *(LAS u32x2*)(Wb + t * WS + s0) = w; } }
    {
#pragma unroll
      for (int i = 0; i < L / 8; ++i) { const int t = wave + 8 * i; const float x = geluf_(bf2f(zc[i])); const float ss = wave_sum(x * x);
          const float vv = x * rsqrtf(ss * (1.0f / 64.0f) + EPS) * vg; vT[lane * WS + t] = f2bf(vv);
          if (!PRM) __builtin_nontemporal_store(vv, a.out + O_CMV + ((size_t)(l * 32 + (ci - 128)) * 64 + t) * 256 + g * 64 + lane); } }
    __syncthreads();
    { constexpr int NT = PRM ? 4 : 2;
      const int tt = PRM ? wave : (wave & 3); const int t = 16 * tt + lr; const float bs = a.in[20][(size_t)(l * 4 + g) * 128 + t];
      uint2 cwv[NT];
#pragma unroll
      for (int n = 0; n < NT; ++n) { const int dt = PRM ? n : 2 * (wave >> 2) + n; { const u32x2 q2 = __builtin_nontemporal_load((const u32x2*)(z + (size_t)(r0 + t) * ZW + ZCU + g * 64 + 16 * dt + 4 * lg)); cwv[n] = make_uint2(q2.x, q2.y); } }
#pragma unroll
      for (int n = 0; n < NT; ++n) { const int dt = PRM ? n : 2 * (wave >> 2) + n; f32x4 acc = (f32x4){0.f, 0.f, 0.f, 0.f};
#pragma unroll
          for (int ks = 0; ks < L / 32; ++ks) { if (32 * ks <= 16 * tt + 15) {
              const bf16x8 vf = *(const LAS bf16x8*)(vT + (16 * dt + lr) * WS + 32 * ks + 8 * lg); const bf16x8 wf = *(const LAS bf16x8*)(Wb + t * WS + 32 * ks + 8 * lg);
              acc = __builtin_amdgcn_mfma_f32_16x16x32_bf16(vf, wf, acc, 0, 0, 0); } }
          const int d0 = g * 64 + 16 * dt + 4 * lg; const uint2 cw = cwv[n];
          uint2 o; o.x = cvt_pk_bf16(geluf_(bflo(cw.x)) * (acc[0] + bs), geluf_(bfhi(cw.x)) * (acc[1] + bs)); o.y = cvt_pk_bf16(geluf_(bflo(cw.y)) * (acc[2] + bs), geluf_(bfhi(cw.y)) * (acc[3] + bs));
          *(uint2*)((bf16_t*)(a.ws + OFF_MIXA) + (size_t)(r0 + t) * 1536 + 1280 + d0) = o; } }
    __syncthreads();
}
__device__ void cmlp_item(CArgs& a, int l, int it, unsigned char* lds) { if ((it >> 2) < 128) cmlp_item_t<true>(a, l, it, lds); else cmlp_item_t<false>(a, l, it, lds); }
__device__ void phase_mix(CArgs& a, int l, unsigned char* lds, int rep) {
    unsigned* ctr = (unsigned*)(a.ws + OFF_CTL) + 16 * (l + 1) + 128 * rep; LAS unsigned* slot = (LAS unsigned*)(lds + LDS_MAIN + 16);
    for (;;) {
        __syncthreads();
        { int t0 = threadIdx.x; asm volatile("" : "+v"(t0)); if (t0 == 0) *slot = atomicAdd(ctr, 1u); }
        __syncthreads();
        const int it = (int)*slot;
        if (it >= 576 + NTILE + 640) break;
        if (it < 576) { attn_item(a, it, lds); if (PROBE_MIX & 1) { __syncthreads(); attn_item(a, it, lds); } }
        else if (it < 576 + NTILE) { hgrn_out_tile(a, l, it - 576, lds); if (PROBE_MIX & 2) { __syncthreads(); hgrn_out_tile(a, l, it - 576, lds); } }
        else { cmlp_item(a, l, it - 576 - NTILE, lds); if (PROBE_MIX & 4) { __syncthreads(); cmlp_item(a, l, it - 576 - NTILE, lds); } }
    }
}
__global__ void __launch_bounds__(512) mk_fwd(Args a_) {
    extern __shared__ __attribute__((aligned(16))) unsigned char lds[];
    if (threadIdx.x < 16) ((LAS unsigned*)(lds + LDS_MAIN))[threadIdx.x] = 0u;
    __syncthreads();
    XcdBarrier bar = xcd_barrier_post((unsigned*)(a_.ws + OFF_CTL) + 1024, (volatile LAS unsigned*)(lds + LDS_MAIN));
    const int ph_lo = a_.ph_lo, ph_hi = a_.ph_hi;
    for (int ph = ph_lo; ph < ph_hi; ++ph) {
        CArgs* ap = (CArgs*)__builtin_amdgcn_kernarg_segment_ptr(); asm volatile("" : "+s"(ap)); CArgs& a = *ap;
        unsigned char* ws = a.ws;
        if (ph == 0) { phase_init(a, lds); if ((PROBE_DUP >> 12) & 1) { __syncthreads(); phase_init(a, lds); } }
        else { const int l = (ph - 1) / 12, p = (ph - 1) % 12; const float* ng = a.in[5] + (size_t)l * 6 * 1024;
            bf16_t* H = (bf16_t*)(ws + OFF_H); bf16_t* ACT = (bf16_t*)(ws + OFF_ACT); bf16_t* D = (bf16_t*)(ws + OFF_D); bf16_t* D1 = (bf16_t*)(ws + ((p == 7 || p == 8) ? OFF_ACT : OFF_MIXA));   float* RS = (float*)(ws + OFF_X);
            const int reps = ((PROBE_DUP >> p) & 1) ? 2 : 1;
            for (int rep = 0; rep < reps; ++rep) {
            if (rep) __syncthreads();
            switch (p) {
            case 0: case 9: { const int f = p == 0 ? 0 : 1; EpiSwiGLU E{ACT}; run_gemm(lds, H, (const bf16_t*)(ws + OFF_WGU) + (size_t)(l * 2 + f) * 5632 * 1024, MT, 5632, 1024, E);
                if (p == 0 && !rep) phase_cache(a, l, lds); } break;
            case 1: case 10: { const int f = p == 1 ? 0 : 1; EpiBf E{D, 1024, D1}; run_gemm(lds, ACT, (const bf16_t*)(ws + OFF_WDN) + (size_t)(l * 2 + f) * 1024 * 2816, MT, 1024, 2816, E, 11); } break;
            case 2: ew_phase<false, false>(D, D1, 11, H, nullptr, nullptr, ng + 1024, 0.5f, ng + 2048, H, ng, RS); break;
            case 3: { EpiBf E{(bf16_t*)(ws + OFF_Z), ZW, nullptr}; run_gemm(lds, H, (const bf16_t*)(ws + OFF_WIN) + (size_t)l * 2304 * 1024, MT, 2304, 1024, E); } break;
            case 4: phase_prep(a, l, lds, rep); break;
            case 5: { phase_scan(a, l); EpiQ E{(bf16_t*)(ws + OFF_Q)}; run_gemm(lds, (const bf16_t*)(ws + OFF_QN), (const bf16_t*)(ws + OFF_WQ) + (size_t)l * 1280 * 384, MT, 1280, 384, E); } break;
            case 6: phase_mix(a, l, lds, rep); break;
            case 7: { EpiBf E{D, 1024, D1}; run_gemm(lds, (const bf16_t*)(ws + OFF_MIXA), (const bf16_t*)(ws + OFF_WMIX) + (size_t)l * 1024 * 1536, MT, 1024, 1536, E, 6); } break;
            case 8: ew_phase<false, false>(D, D1, 6, H, nullptr, nullptr, ng + 3 * 1024, 1.0f, ng + 4 * 1024, H, ng + 2048, RS); break;
            case 11: if (l == 0) ew_phase<false, false>(D, D1, 11, H, nullptr, nullptr, ng + 5 * 1024, 0.5f, ng + 6 * 1024, H, ng + 4 * 1024, RS); else ew_phase<false, true>(D, D1, 11, H, nullptr, a.out + O_Y, ng + 5 * 1024, 0.5f, nullptr, nullptr, ng + 4 * 1024, RS); break;
            }
            }
            tail_wtasks(a, ph, lds);
        }
        if (ph + 1 < ph_hi) {
            if (ph_lo < 0) { __threadfence(); cg::this_grid().sync(); }
            xcd_barrier(bar); }
    }
}

extern "C" void kernel_launch(void* const* d_in, const int* in_sizes, int n_in, void* d_out, int out_size, void* d_ws, size_t ws_size, hipStream_t stream) {
    static int grid = 0;
    if (grid == 0) {
        if (n_in != 21 || ws_size < WS_END) { fprintf(stderr, "kernel_launch: bad inputs n_in %d ws %zu need %zu\n", n_in, ws_size, (size_t)WS_END); grid = -1; return; }
        int dev = 0, cus = 0, per_cu = 0;
        hipGetDevice(&dev); hipDeviceGetAttribute(&cus, hipDeviceAttributeMultiprocessorCount, dev);
        if (hipFuncSetAttribute((const void*)mk_fwd, hipFuncAttributeMaxDynamicSharedMemorySize, LDS_BYTES) != hipSuccess) { fprintf(stderr, "hipFuncSetAttribute failed\n"); grid = -1; return; }
        if (hipOccupancyMaxActiveBlocksPerMultiprocessor(&per_cu, (const void*)mk_fwd, 512, LDS_BYTES) != hipSuccess || per_cu < 1) per_cu = 1;
        (void)hipGetLastError();
        grid = cus * 1;
    }
    if (grid < 0) return;
    if (hipMemsetAsync((char*)d_ws + OFF_CTL, 0, SZ_CTL, stream) != hipSuccess) { fprintf(stderr, "memset failed\n"); return; }
    Args a{};
    for (int i = 0; i < 21; ++i) a.in[i] = (const float*)d_in[i];
    a.out = (float*)d_out; a.ws = (unsigned char*)d_ws;
#if ONE_LAUNCH
    a.ph_lo = 0; a.ph_hi = NPHASE;
    void* args[] = {&a};
    hipError_t e = hipLaunchCooperativeKernel((const void*)mk_fwd, dim3(grid), dim3(512), args, LDS_BYTES, stream);
    if (e != hipSuccess) fprintf(stderr, "cooperative launch failed: %s (grid %d)\n", hipGetErrorString(e), grid);
#else
    for (int ph = 0; ph < NPHASE; ++ph) { a.ph_lo = ph; a.ph_hi = ph + 1; hipLaunchKernelGGL(mk_fwd, dim3(grid), dim3(512), LDS_BYTES, stream, a); }
#endif
}
```
